# Optimizing an MI355X kernel written in HIP

```python
import math
import jax, jax.numpy as jnp
from jax import lax
import numpy as np

D_MODEL = 2048
BATCH = 4
SEQ = 4096
DEPTH = 4

N_MIXERS = 2
N_MLA_LAYERS = (DEPTH + N_MIXERS - 1) // N_MIXERS
N_DIL_LAYERS = DEPTH // N_MIXERS

ROPE_THETA = 500000.0
NORM_EPS = 1e-6
ATTN_BLOCK = 128

MLA_HEADS = 16
MLA_Q_RANK = 512
MLA_KV_RANK = 512
MLA_NOPE = 128
MLA_ROPE = 64
MLA_V = 128

DIL_GROUPS = ((128, 1), (512, 4), (2048, 16))
DIL_HEADS = 16
DIL_HEAD_DIM = 128
DIL_ROT = DIL_HEAD_DIM // 4

FFN_HIDDEN = 5632
CONV_WIDTH = 3

kernel_name = "hybrid_mla_dilated_convffn"


def rms_norm(x, g):
    xf = x.astype(jnp.float32)
    y = xf * lax.rsqrt(jnp.mean(xf * xf, axis=-1, keepdims=True) + NORM_EPS)
    return (y * g.astype(jnp.float32)).astype(x.dtype)


def rope(x, positions):
    r = x.shape[-1]
    inv_freq = ROPE_THETA ** (-jnp.arange(0, r, 2, dtype=jnp.float32) / r)
    ang = positions.astype(jnp.float32)[..., None] * inv_freq
    cos = jnp.cos(ang)[:, :, None, :]
    sin = jnp.sin(ang)[:, :, None, :]
    xf = x.astype(jnp.float32)
    x1, x2 = xf[..., : r // 2], xf[..., r // 2:]
    out = jnp.concatenate([x1 * cos - x2 * sin, x2 * cos + x1 * sin], axis=-1)
    return out.astype(x.dtype)


def partial_rope(x, positions):
    return jnp.concatenate([rope(x[..., :DIL_ROT], positions), x[..., DIL_ROT:]], axis=-1)


def dense_causal_attention(q, k, v, scale):
    B, S, H, Dk = q.shape
    nb = S // ATTN_BLOCK
    qb = q.reshape(B, nb, ATTN_BLOCK, H, Dk).transpose(1, 0, 2, 3, 4)
    k_idx = jnp.arange(S)
    starts = jnp.arange(nb) * ATTN_BLOCK

    def one_block(args):
        q_blk, start = args
        s = jnp.einsum('bqhd,bkhd->bhqk', q_blk, k, preferred_element_type=jnp.float32) * scale
        q_idx = start + jnp.arange(ATTN_BLOCK)
        mask = k_idx[None, :] <= q_idx[:, None]
        s = jnp.where(mask, s, -jnp.inf)
        p = jax.nn.softmax(s, axis=-1).astype(v.dtype)
        return jnp.einsum('bhqk,bkhd->bqhd', p, v)

    out = lax.map(one_block, (qb, starts))
    return out.transpose(1, 0, 2, 3, 4).reshape(B, S, H, v.shape[-1])


def mla_mixer(h, positions, wq_a, q_norm, wq_b, wkv_a, kv_norm, wkv_b, wo):
    B, S, _ = h.shape
    q = (rms_norm(h @ wq_a, q_norm) @ wq_b).reshape(B, S, MLA_HEADS, MLA_NOPE + MLA_ROPE)
    q_nope, q_pe = q[..., :MLA_NOPE], rope(q[..., MLA_NOPE:], positions)
    kv_a = h @ wkv_a
    c_kv = kv_a[..., :MLA_KV_RANK]
    k_pe = rope(kv_a[..., None, MLA_KV_RANK:], positions)
    kv = (rms_norm(c_kv, kv_norm) @ wkv_b).reshape(B, S, MLA_HEADS, MLA_NOPE + MLA_V)
    k_nope, v = kv[..., :MLA_NOPE], kv[..., MLA_NOPE:]
    q_full = jnp.concatenate([q_nope, q_pe], axis=-1)
    k_full = jnp.concatenate(
        [k_nope, jnp.broadcast_to(k_pe, (B, S, MLA_HEADS, MLA_ROPE))], axis=-1)
    o = dense_causal_attention(q_full, k_full, v, (MLA_NOPE + MLA_ROPE) ** -0.5)
    return o.reshape(B, S, MLA_HEADS * MLA_V) @ wo


def dilated_group_attention(q, k, v, window, dilation, scale):
    B, S, H, hd = q.shape
    span = window // dilation
    L = S // dilation
    nb = -(-L // ATTN_BLOCK)
    Lp = nb * ATTN_BLOCK
    Q = ATTN_BLOCK

    def to_residue(t):
        t = t.reshape(B, L, dilation, H, hd).transpose(0, 2, 1, 3, 4).reshape(B * dilation, L, H, hd)
        t = jnp.pad(t, ((0, 0), (0, Lp - L), (0, 0), (0, 0)))
        return t.reshape(B * dilation, nb, Q, H, hd)

    def with_prev(t):
        prev = jnp.pad(t[:, :-1], ((0, 0), (1, 0), (0, 0), (0, 0), (0, 0)))
        return jnp.concatenate([prev, t], axis=2)

    qr = to_residue(q)
    kb = with_prev(to_residue(k))
    vb = with_prev(to_residue(v))
    s = jnp.einsum('nbqhd,nbkhd->nbhqk', qr, kb, preferred_element_type=jnp.float32) * scale
    qi = jnp.arange(Q)[:, None]
    ki = jnp.arange(2 * Q)[None, :]
    dist = qi + Q - ki
    band = (dist >= 0) & (dist <= span)
    has_prev = (jnp.arange(nb) > 0)[:, None, None] | (ki >= Q)[None]
    mask = band[None] & has_prev
    s = jnp.where(mask[None, :, None], s, -jnp.inf)
    lse = jax.nn.logsumexp(s, axis=-1)
    p = jnp.exp(s - lse[..., None]).astype(v.dtype)
    o = jnp.einsum('nbhqk,nbkhd->nbqhd', p, vb)
    o = o.reshape(B * dilation, Lp, H, hd)[:, :L]
    o = o.reshape(B, dilation, L, H, hd).transpose(0, 2, 1, 3, 4).reshape(B, S, H, hd)
    lse = lse.transpose(0, 1, 3, 2).reshape(B * dilation, Lp, H)[:, :L]
    lse = lse.reshape(B, dilation, L, H).transpose(0, 2, 1, 3).reshape(B, S, H)
    return o, lse


def dilated_mixer(h, positions, w_in, wo):
    B, S, _ = h.shape
    G = len(DIL_GROUPS)
    qkv = (h @ w_in).reshape(B, S, G, 3, DIL_HEADS, DIL_HEAD_DIM)
    outs, lses = [], []
    for g, (window, dilation) in enumerate(DIL_GROUPS):
        q = partial_rope(qkv[:, :, g, 0], positions)
        k = partial_rope(qkv[:, :, g, 1], positions)
        v = qkv[:, :, g, 2]
        o, l = dilated_group_attention(q, k, v, window, dilation, DIL_HEAD_DIM ** -0.5)
        outs.append(o)
        lses.append(l)
    alpha = jax.nn.softmax(jnp.stack(lses), axis=0)
    o = jnp.einsum('gbsh,gbshd->bshd', alpha, jnp.stack(outs).astype(jnp.float32)).astype(h.dtype)
    return o.reshape(B, S, DIL_HEADS * DIL_HEAD_DIM) @ wo


def conv_ffn(h, w_up, conv_w, conv_b, w_down):
    S = h.shape[1]
    u = h @ w_up
    up = jnp.pad(u, ((0, 0), (CONV_WIDTH - 1, 0), (0, 0)))
    c = conv_b + up[:, 0:S] * conv_w[0]
    for j in range(1, CONV_WIDTH):
        c = c + up[:, j:j + S] * conv_w[j]
    gate, val = c[..., :FFN_HIDDEN], c[..., FFN_HIDDEN:]
    return (jax.nn.silu(gate) * val) @ w_down


def setup_inputs(seed: int = 0) -> dict:
    key = jax.random.key(seed)
    ks = iter(jax.random.split(key, 32))

    def w(shape, fan_in):
        return jax.random.normal(next(ks), shape, jnp.float32) * fan_in ** -0.5

    def gain(shape):
        return 1.0 + 0.01 * jax.random.normal(next(ks), shape, jnp.float32)

    NA, ND = N_MLA_LAYERS, N_DIL_LAYERS
    G = len(DIL_GROUPS)
    return {
        "x": jax.random.normal(next(ks), (BATCH, SEQ, D_MODEL), jnp.float32),
        "positions": jnp.broadcast_to(jnp.arange(SEQ, dtype=jnp.int32), (BATCH, SEQ)),
        "attn_norm": gain((DEPTH, D_MODEL)),
        "ffn_norm": gain((DEPTH, D_MODEL)),
        "final_norm": gain((D_MODEL,)),
        "mla_wq_a": w((NA, D_MODEL, MLA_Q_RANK), D_MODEL),
        "mla_q_norm": gain((NA, MLA_Q_RANK)),
        "mla_wq_b": w((NA, MLA_Q_RANK, MLA_HEADS * (MLA_NOPE + MLA_ROPE)), MLA_Q_RANK),
        "mla_wkv_a": w((NA, D_MODEL, MLA_KV_RANK + MLA_ROPE), D_MODEL),
        "mla_kv_norm": gain((NA, MLA_KV_RANK)),
        "mla_wkv_b": w((NA, MLA_KV_RANK, MLA_HEADS * (MLA_NOPE + MLA_V)), MLA_KV_RANK),
        "mla_wo": w((NA, MLA_HEADS * MLA_V, D_MODEL), MLA_HEADS * MLA_V),
        "dil_w_in": w((ND, D_MODEL, G * 3 * DIL_HEADS * DIL_HEAD_DIM), D_MODEL),
        "dil_wo": w((ND, DIL_HEADS * DIL_HEAD_DIM, D_MODEL), DIL_HEADS * DIL_HEAD_DIM),
        "ffn_w_up": w((DEPTH, D_MODEL, 2 * FFN_HIDDEN), D_MODEL),
        "ffn_conv_w": w((DEPTH, CONV_WIDTH, 2 * FFN_HIDDEN), CONV_WIDTH),
        "ffn_conv_b": 0.01 * jax.random.normal(next(ks), (DEPTH, 2 * FFN_HIDDEN), jnp.float32),
        "ffn_w_down": w((DEPTH, FFN_HIDDEN, D_MODEL), FFN_HIDDEN),
    }


def reference(x, positions, attn_norm, ffn_norm, final_norm,
              mla_wq_a, mla_q_norm, mla_wq_b, mla_wkv_a, mla_kv_norm, mla_wkv_b, mla_wo,
              dil_w_in, dil_wo,
              ffn_w_up, ffn_conv_w, ffn_conv_b, ffn_w_down):
    for i in range(DEPTH):
        h = rms_norm(x, attn_norm[i])
        j = i // N_MIXERS
        if i % N_MIXERS == 0:
            x = x + mla_mixer(h, positions, mla_wq_a[j], mla_q_norm[j], mla_wq_b[j],
                              mla_wkv_a[j], mla_kv_norm[j], mla_wkv_b[j], mla_wo[j])
        else:
            x = x + dilated_mixer(h, positions, dil_w_in[j], dil_wo[j])
        h = rms_norm(x, ffn_norm[i])
        x = x + conv_ffn(h, ffn_w_up[i], ffn_conv_w[i], ffn_conv_b[i], ffn_w_down[i])
    return rms_norm(x, final_norm)
```

```cpp
#include <hip/hip_runtime.h>
#include <cstdio>
#include <cstdint>
#ifndef PROBE_DUP
#define PROBE_DUP 0
#endif
namespace pg8 {
#define PG8_LAS __attribute__((address_space(3)))
typedef unsigned short bf16_t;
typedef short bf16x8 __attribute__((ext_vector_type(8)));
typedef float f32x4 __attribute__((ext_vector_type(4)));
typedef unsigned u32x4 __attribute__((ext_vector_type(4)));
constexpr int BM = 256, BK = 64, HALF = 128, HTB = HALF * BK * 2  , STAGE_BYTES = 8 * HTB, NXCD = 8, WGM = 8;

__host__ __device__ __forceinline__ int lds_byte(int r, int c) { const int st = (r >> 4) * 2 + (c >> 5), rr = r & 15, cc = c & 31, ob = rr * 64 + cc * 2; return st * 1024 + (ob ^ (((ob >> 9) & 1) << 5)); }
__host__ __device__ __forceinline__ void stage_rc(int b, int& R, int& C) { const int st = b / 1024, sb = b % 1024, swz = sb ^ (((sb >> 9) & 1) << 5); R = (st >> 1) * 16 + swz / 64; C = (st & 1) * 32 + (swz % 64) / 2; }
__host__ __device__ __forceinline__ int perm32(int rho) { const int n = rho >> 4, i = rho & 15; return 8 * (i >> 2) + 4 * n + (i & 3); }

struct Unit { int pm, pn; };
struct Gemm { const bf16_t* A; const bf16_t* Bt; int M, N, K; };

struct StaticOrder {
    int nM, nN, nwg, G, c;
    __host__ __device__ void init(int M, int N, int G_, int c_) { nM = M / BM; nN = N / BM; nwg = nM * nN; G = G_; c = c_; }
    __host__ __device__ __forceinline__ bool next(int i, Unit& u) const {
        const long L = (long)i * G + c; if (L >= nwg) return false;
        int wgid = (int)L; { const int q = nwg / NXCD, r = nwg % NXCD, xcd = wgid % NXCD, off = wgid / NXCD; wgid = (xcd < r ? xcd * (q + 1) : r * (q + 1) + (xcd - r) * q) + off; }
        const int nig = WGM * nN, gid = wgid / nig, fm = gid * WGM, gsz = (nM - fm) < WGM ? (nM - fm) : WGM;
        u.pm = fm + ((wgid % nig) % gsz); u.pn = (wgid % nig) / gsz; return true;
    }
    __device__ __forceinline__ void a_ready(const Unit&) const {}
    __device__ __forceinline__ void done(const Unit&) const {}
};

__device__ __forceinline__ unsigned cvt_pk_bf16(float lo, float hi) { unsigned r; asm volatile("v_cvt_pk_bf16_f32 %0, %1, %2" : "=v"(r) : "v"(lo), "v"(hi)); return r; }
typedef float f32x2 __attribute__((ext_vector_type(2)));
typedef unsigned u32x2 __attribute__((ext_vector_type(2)));
__device__ __forceinline__ u32x4 pack8bf(const f32x4 a, const f32x4 b) { u32x4 w; w.x = cvt_pk_bf16(a[0], a[1]); w.y = cvt_pk_bf16(a[2], a[3]); w.z = cvt_pk_bf16(b[0], b[1]); w.w = cvt_pk_bf16(b[2], b[3]); return w; }
#define PG8_NOPRE struct Pre {}; __device__ __forceinline__ void pre_issue(Pre&, const Unit&, int, int) const {} __device__ __forceinline__ void pre_finish(Pre&, int, int) const {}
struct EpiF32Store {
    PG8_NOPRE
    static constexpr bool PERM = false, AFTER_DRAIN = false;
    float* C; int ldc;
    __device__ __forceinline__ void operator()(const f32x4 (&acc)[2][2][4][2], const Unit& u, int wr, int wc, int fr, int fq, int ui) const {
        const int row0 = u.pm * BM + wr * 64 + fr, col0 = u.pn * BM + wc * 32 + 4 * fq;
#pragma unroll
        for (int ai = 0; ai < 2; ++ai)
#pragma unroll
            for (int m = 0; m < 4; ++m) { float* rowp = C + (size_t)(row0 + ai * HALF + m * 16) * ldc + col0;
#pragma unroll
                for (int bj = 0; bj < 2; ++bj)
#pragma unroll
                    for (int n = 0; n < 2; ++n) *(f32x4*)(rowp + bj * HALF + n * 16) = acc[ai][bj][m][n]; }
    }
};
struct EpiRes {
    PG8_NOPRE
    static constexpr bool PERM = false, AFTER_DRAIN = false;
    const float* base; float* out; int ldc;
    __device__ __forceinline__ void operator()(const f32x4 (&acc)[2][2][4][2], const Unit& u, int wr, int wc, int fr, int fq, int ui) const {
        const int row0 = u.pm * BM + wr * 64 + fr, col0 = u.pn * BM + wc * 32 + 4 * fq;
#pragma unroll
        for (int ai = 0; ai < 2; ++ai) {
            f32x4 bs[4][2][2];
#pragma unroll
            for (int m = 0; m < 4; ++m) { const size_t off = (size_t)(row0 + ai * HALF + m * 16) * ldc + col0;
#pragma unroll
                for (int bj = 0; bj < 2; ++bj)
#pragma unroll
                    for (int n = 0; n < 2; ++n) bs[m][bj][n] = *(const f32x4*)(base + off + bj * HALF + n * 16); }
#pragma unroll
            for (int m = 0; m < 4; ++m) { const size_t off = (size_t)(row0 + ai * HALF + m * 16) * ldc + col0;
#pragma unroll
                for (int bj = 0; bj < 2; ++bj)
#pragma unroll
                    for (int n = 0; n < 2; ++n) *(f32x4*)(out + off + bj * HALF + n * 16) = bs[m][bj][n] + acc[ai][bj][m][n]; }
            asm volatile("" ::: "memory"); }
    }
};
struct EpiBf16Plain {
    PG8_NOPRE
    static constexpr bool PERM = true, AFTER_DRAIN = false;
    bf16_t* O; int ldc;
    __device__ __forceinline__ void operator()(const f32x4 (&acc)[2][2][4][2], const Unit& u, int wr, int wc, int fr, int fq, int ui) const {
        const int row0 = u.pm * BM + wr * 64 + fr, col0 = u.pn * BM + wc * 32 + 8 * fq;
#pragma unroll
        for (int ai = 0; ai < 2; ++ai)
#pragma unroll
            for (int m = 0; m < 4; ++m) { bf16_t* rowp = O + (size_t)(row0 + ai * HALF + m * 16) * ldc + col0;
#pragma unroll
                for (int bj = 0; bj < 2; ++bj) *(u32x4*)(rowp + bj * HALF) = pack8bf(acc[ai][bj][m][0], acc[ai][bj][m][1]); }
    }
};

#define PG8_DPP(old_, src_, ctrl_) __uint_as_float((unsigned)__builtin_amdgcn_update_dpp((int)__float_as_uint(old_), (int)__float_as_uint(src_), (ctrl_), 0xF, 0xF, false))
struct EpiUpConv {
    static constexpr bool PERM = true, AFTER_DRAIN = false;
    bf16_t* ACT; float* HALO; float* FIX; const float* cw; const float* cb;
    PG8_LAS float* xh; PG8_LAS float* cwl;
    PG8_NOPRE
    __device__ __forceinline__ void operator()(const f32x4 (&acc)[2][2][4][2], const Unit& u, int wr, int wc, int fr_, int fq_, int ui) const {
        int fr = fr_, fq = fq_; asm volatile("" : "+v"(fr), "+v"(fq));
        const int ch0 = 128 * u.pn + 32 * wc + 8 * fq;
        f32x4 wv = {0.f, 0.f, 0.f, 0.f};
        if (wr == 0) { const int lane = fq * 16 + fr; wv = *(const f32x4*)((wc < 3 ? cw + (size_t)wc * 11264 : cb) + (lane < 32 ? 128 * u.pn + lane * 4 : 5632 + 128 * u.pn + (lane - 32) * 4)); }
        if (fr >= 14) {
#pragma unroll
            for (int ai = 0; ai < 2; ++ai) if (ai == 0 || wr == 0) { PG8_LAS float* b = xh + ((((ai == 0 ? wr : 2) * 4 + wc) * 2 + (fr - 14)) * 4 + fq) * 16;
#pragma unroll
                for (int bj = 0; bj < 2; ++bj)
#pragma unroll
                    for (int n = 0; n < 2; ++n) *(PG8_LAS f32x4*)(b + (bj * 2 + n) * 4) = acc[ai][bj][3][n]; }
            if (wr == 1) { float* hp = HALO + ((size_t)u.pm * 2 + (fr - 14)) * 11264 + ch0;
#pragma unroll
                for (int bj = 0; bj < 2; ++bj)
#pragma unroll
                    for (int n = 0; n < 2; ++n) *(f32x4*)(hp + bj * 5632 + n * 4) = acc[1][bj][3][n]; }
        }
        if (wr == 0) *(PG8_LAS f32x4*)(cwl + wc * 256 + (fq * 16 + fr) * 4) = wv;
        asm volatile("s_waitcnt lgkmcnt(0)" ::: "memory"); __builtin_amdgcn_s_barrier(); asm volatile("" ::: "memory");
        const bool fixtile = (u.pm & 15) != 0;
#pragma unroll
        for (int n = 0; n < 2; ++n) {
            const PG8_LAS float* cwb = cwl + wc * 32 + fq * 8 + n * 4;
#pragma unroll
            for (int ai = 0; ai < 2; ++ai)
#pragma unroll
                for (int m = 0; m < 4; ++m) {
                    f32x4 c[2];
#pragma unroll
                    for (int bj = 0; bj < 2; ++bj) {
                        f32x4 W[4];
#pragma unroll
                        for (int t = 0; t < 4; ++t) W[t] = *(const PG8_LAS f32x4*)(cwb + t * 256 + bj * 128);
                        f32x4 h1 = {0.f, 0.f, 0.f, 0.f}, h2 = {0.f, 0.f, 0.f, 0.f};
                        if (m == 0 && !(ai == 0 && wr == 0)) { const int slot = ai == 0 ? 0 : (wr == 0 ? 1 : 2); const PG8_LAS float* b = xh + (((slot * 4 + wc) * 2) * 4 + fq) * 16 + n * 4 + bj * 8;
                            h2 = *(const PG8_LAS f32x4*)b; h1 = *(const PG8_LAS f32x4*)(b + 64); }
#pragma unroll
                        for (int k = 0; k < 4; ++k) { const float cur = acc[ai][bj][m][n][k]; float x1, z;
                            if (m == 0) { x1 = h1[k]; z = fr == 0 ? h2[k] : h1[k]; }
                            else { const float p = acc[ai][bj][m > 0 ? m - 1 : 0][n][k]; x1 = PG8_DPP(0.f, p, 0x121); z = PG8_DPP(0.f, p, 0x122); }
                            const float t1 = PG8_DPP(x1, cur, 0x111), t2 = PG8_DPP(z, cur, 0x112);
                            c[bj][k] = W[3][k] + W[0][k] * t2 + W[1][k] * t1 + W[2][k] * cur; }
                        __builtin_amdgcn_sched_barrier(0);
                    }
                    const int row = u.pm * BM + ai * HALF + wr * 64 + m * 16 + fr;
                    if (ai == 0 && m == 0 && wr == 0 && fixtile && fr < 2) {
                        float* fp = FIX + ((size_t)u.pm * 2 + fr) * 11264 + ch0 + n * 4;
                        *(f32x4*)fp = c[0]; *(f32x4*)(fp + 5632) = c[1];
                    } else {
                        f32x4 a;
#pragma unroll
                        for (int k = 0; k < 4; ++k) { const float g = c[0][k]; a[k] = g * __builtin_amdgcn_rcpf(1.0f + __builtin_amdgcn_exp2f(-1.4426950408889634f * g)) * c[1][k]; }
                        u32x2 w; w.x = cvt_pk_bf16(a[0], a[1]); w.y = cvt_pk_bf16(a[2], a[3]);
                        *(u32x2*)(ACT + (size_t)row * 5632 + ch0 + n * 4) = w;
                    }
                    asm volatile("" ::: "memory"); __builtin_amdgcn_sched_barrier(0);
                }
        }
    }
};
struct EpiQMla {
    PG8_NOPRE
    static constexpr bool PERM = true, AFTER_DRAIN = false;
    bf16_t* Q; const float* cosT; const float* sinT;
    __device__ __forceinline__ void operator()(const f32x4 (&acc)[2][2][4][2], const Unit& u, int wr, int wc, int fr, int fq, int ui) const {
        const int row0 = u.pm * BM + wr * 64 + fr;
        if (u.pn < 8) {
            const int col0 = u.pn * BM + wc * 32 + 8 * fq;
#pragma unroll
            for (int ai = 0; ai < 2; ++ai)
#pragma unroll
                for (int m = 0; m < 4; ++m) { bf16_t* rowp = Q + (size_t)(row0 + ai * HALF + m * 16) * 3072 + col0;
#pragma unroll
                    for (int bj = 0; bj < 2; ++bj) *(u32x4*)(rowp + bj * HALF) = pack8bf(acc[ai][bj][m][0], acc[ai][bj][m][1]); }
        } else {
            const int head = 4 * (u.pn - 8) + wc, i0 = 8 * fq;
#pragma unroll
            for (int ai = 0; ai < 2; ++ai)
#pragma unroll
                for (int m = 0; m < 4; ++m) { const int row = row0 + ai * HALF + m * 16;
                    const f32x4 c0 = *(const f32x4*)(cosT + (size_t)row * 32 + i0), c1 = *(const f32x4*)(cosT + (size_t)row * 32 + i0 + 4);
                    const f32x4 s0 = *(const f32x4*)(sinT + (size_t)row * 32 + i0), s1 = *(const f32x4*)(sinT + (size_t)row * 32 + i0 + 4);
                    const f32x4 x1a = acc[ai][0][m][0], x1b = acc[ai][0][m][1], x2a = acc[ai][1][m][0], x2b = acc[ai][1][m][1];
                    const f32x4 y1a = x1a * c0 - x2a * s0, y1b = x1b * c1 - x2b * s1, y2a = x2a * c0 + x1a * s0, y2b = x2b * c1 + x1b * s1;
                    bf16_t* dst = Q + (size_t)row * 3072 + 2048 + head * 64 + i0;
                    *(u32x4*)dst = pack8bf(y1a, y1b); *(u32x4*)(dst + 32) = pack8bf(y2a, y2b); }
        }
    }
};
struct EpiQkvDil {
    PG8_NOPRE
    static constexpr bool PERM = true, AFTER_DRAIN = false;
    bf16_t* O; const float* cosT; const float* sinT;
    __device__ __forceinline__ void operator()(const f32x4 (&acc)[2][2][4][2], const Unit& u, int wr, int wc, int fr, int fq, int ui) const {
        const int row0 = u.pm * BM + wr * 64 + fr;
        const int g = u.pn / 24, rem = u.pn - g * 24, t = rem >> 3, T = rem & 7, sh = 2 * g;
        const size_t plane = ((size_t)(g * 3 + t) * 16 + 2 * T) * 4;
        if (t == 2 || wc != 0) {
            const int dim0 = wc * 32 + 8 * fq;
#pragma unroll
            for (int ai = 0; ai < 2; ++ai)
#pragma unroll
                for (int m = 0; m < 4; ++m) { const int row = row0 + ai * HALF + m * 16, b = row >> 12, s = row & 4095, sp = ((s & ((1 << sh) - 1)) << (12 - sh)) + (s >> sh);
#pragma unroll
                    for (int bj = 0; bj < 2; ++bj) *(u32x4*)(O + ((plane + bj * 4 + b) * 4096 + sp) * 128 + dim0) = pack8bf(acc[ai][bj][m][0], acc[ai][bj][m][1]); }
        } else {
            const int hh = fq >> 1, i0 = 8 * (fq & 1);
#pragma unroll
            for (int ai = 0; ai < 2; ++ai)
#pragma unroll
                for (int m = 0; m < 4; ++m) { const int row = row0 + ai * HALF + m * 16, b = row >> 12, s = row & 4095, sp = ((s & ((1 << sh) - 1)) << (12 - sh)) + (s >> sh);
                    const f32x4 c0 = *(const f32x4*)(cosT + (size_t)row * 16 + i0), c1 = *(const f32x4*)(cosT + (size_t)row * 16 + i0 + 4);
                    const f32x4 s0 = *(const f32x4*)(sinT + (size_t)row * 16 + i0), s1 = *(const f32x4*)(sinT + (size_t)row * 16 + i0 + 4);
                    const f32x4 x1a = acc[ai][0][m][0], x1b = acc[ai][0][m][1], x2a = acc[ai][1][m][0], x2b = acc[ai][1][m][1];
                    const f32x4 y1a = x1a * c0 - x2a * s0, y1b = x1b * c1 - x2b * s1, y2a = x2a * c0 + x1a * s0, y2b = x2b * c1 + x1b * s1;
                    bf16_t* dst = O + ((plane + hh * 4 + b) * 4096 + sp) * 128 + i0;
                    *(u32x4*)dst = pack8bf(y1a, y1b); *(u32x4*)(dst + 16) = pack8bf(y2a, y2b); }
        }
    }
};

template <class Epi, class Sched, bool ALIGN_EPI = false, bool SP2 = false, int EPI_REP = 1>
__device__ __forceinline__ void gemm_phase(PG8_LAS unsigned char* lds, const Gemm g, const Sched& S, const Epi& E) {
    int tid_ = threadIdx.x; asm volatile("" : "+v"(tid_));
    const int tid = tid_, wid = __builtin_amdgcn_readfirstlane(tid >> 6), lane = tid & 63, wr = wid >> 2, wc = wid & 3, fr = lane & 15, fq = lane >> 4;
    const int K = g.K, nt = K / BK;
    unsigned voffA[2], voffB[2];
#pragma unroll
    for (int i = 0; i < 2; ++i) { int R, C; stage_rc(tid * 16 + i * 8192, R, C); const int Rb = Epi::PERM ? ((R & ~31) + perm32(R & 31)) : R;
        voffA[i] = (unsigned)(R * K + C) * 2u; voffB[i] = (unsigned)(Rb * K + C) * 2u; }
    const size_t kstep = (size_t)(BK * 2);
    const size_t hstep = (size_t)HALF * K * 2;
    const size_t tstep = 2 * hstep;
    const unsigned ldsw = (unsigned)wid * 1024u;
    const int aoff = lds_byte(wr * 64 + fr, fq * 8), boff = lds_byte(wc * 32 + fr, fq * 8);
#define PG8_SA(b, h) (((b) * 2 + (h)) * HTB)
#define PG8_SB(b, h) ((4 + (b) * 2 + (h)) * HTB)
#define PG8_STAGE(bufoff, gbase, voff) do { _Pragma("unroll") for (int _i = 0; _i < 2; ++_i) \
        __builtin_amdgcn_global_load_lds((const unsigned*)((const char*)(gbase) + (voff)[_i]), (PG8_LAS unsigned*)(lds + (bufoff) + ldsw + _i * 8192), 16, 0, 0); } while (0)
#define PG8_LDA(dst, b, h) do { _Pragma("unroll") for (int m = 0; m < 4; ++m) _Pragma("unroll") for (int k = 0; k < 2; ++k) dst[m][k] = *(const PG8_LAS bf16x8*)(lds + PG8_SA(b, h) + aoff + m * 2048 + k * 1024); } while (0)
#define PG8_LDB(dst, b, h) do { _Pragma("unroll") for (int n = 0; n < 2; ++n) _Pragma("unroll") for (int k = 0; k < 2; ++k) dst[n][k] = *(const PG8_LAS bf16x8*)(lds + PG8_SB(b, h) + boff + n * 2048 + k * 1024); } while (0)
#define PG8_MMA(ai, bj, At, Bt) do { __builtin_amdgcn_s_setprio(1); _Pragma("unroll") for (int m = 0; m < 4; ++m) _Pragma("unroll") for (int n = 0; n < 2; ++n) _Pragma("unroll") for (int k = 0; k < 2; ++k) \
        acc[ai][bj][m][n] = __builtin_amdgcn_mfma_f32_16x16x32_bf16(Bt[n][k], At[m][k], acc[ai][bj][m][n], 0, 0, 0); __builtin_amdgcn_s_setprio(0); } while (0)
#define PG8_WAIT_V(n) asm volatile("s_waitcnt vmcnt(" #n ")" ::: "memory")
#define PG8_WAIT_L(n) asm volatile("s_waitcnt lgkmcnt(" #n ")" ::: "memory")
#define PG8_BAR __builtin_amdgcn_s_barrier()
#define PG8_SCHED __builtin_amdgcn_sched_barrier(0)
    Unit cur, nxt; int ui = 0;
    typename Epi::Pre pre;
    if (!S.next(0, cur)) return;
    f32x4 acc[2][2][4][2];
#pragma unroll
    for (int a = 0; a < 2; ++a)
#pragma unroll
        for (int b = 0; b < 2; ++b)
#pragma unroll
            for (int m = 0; m < 4; ++m)
#pragma unroll
                for (int n = 0; n < 2; ++n) acc[a][b][m][n] = (f32x4){0.f, 0.f, 0.f, 0.f};
    bf16x8 At[4][2], B0[2][2], B1[2][2];
    const char* cA = (const char*)g.A + (size_t)cur.pm * tstep; const char* cB = (const char*)g.Bt + (size_t)cur.pn * tstep;
    S.a_ready(cur);
    if constexpr (SP2) {
        PG8_STAGE(PG8_SB(0, 0), cB, voffB); PG8_STAGE(PG8_SB(0, 1), cB + hstep, voffB); PG8_STAGE(PG8_SA(0, 0), cA, voffA); PG8_STAGE(PG8_SA(0, 1), cA + hstep, voffA);
        if (wr == 1) PG8_BAR;
        PG8_WAIT_V(2); PG8_BAR;
        PG8_STAGE(PG8_SB(1, 0), cB + kstep, voffB); PG8_STAGE(PG8_SA(1, 0), cA + kstep, voffA); PG8_STAGE(PG8_SB(1, 1), cB + hstep + kstep, voffB);
        PG8_WAIT_V(6); PG8_BAR;
    } else {
        PG8_STAGE(PG8_SB(0, 0), cB, voffB); PG8_STAGE(PG8_SA(0, 0), cA, voffA); PG8_STAGE(PG8_SB(0, 1), cB + hstep, voffB); PG8_STAGE(PG8_SA(0, 1), cA + hstep, voffA);
        if (wr == 1) PG8_BAR;
        PG8_WAIT_V(4); PG8_BAR;
        PG8_STAGE(PG8_SB(1, 0), cB + kstep, voffB); PG8_STAGE(PG8_SA(1, 0), cA + kstep, voffA); PG8_STAGE(PG8_SB(1, 1), cB + hstep + kstep, voffB);
        PG8_WAIT_V(6); PG8_BAR;
    }
    for (;;) {
        const bool has_next = S.next(ui + 1, nxt);
        const char* nA = has_next ? (const char*)g.A + (size_t)nxt.pm * tstep : cA; const char* nB = has_next ? (const char*)g.Bt + (size_t)nxt.pn * tstep : cB;
        for (int t = 0; t < nt; t += 2) {
            const bool last = (t == nt - 2);
            const char* a1 = cA + (size_t)(t + 1) * kstep;
            const char* a2 = last ? nA : cA + (size_t)(t + 2) * kstep; const char* b2 = last ? nB : cB + (size_t)(t + 2) * kstep;
            const char* a3 = a2 + kstep; const char* b3 = b2 + kstep;
            if (last && has_next) S.a_ready(nxt);
            if (t == 0) E.pre_issue(pre, cur, tid, ui); else if (t == 2) E.pre_finish(pre, tid, ui);
            if constexpr (SP2) {
            PG8_LDB(B0, 0, 0); PG8_LDB(B1, 0, 1); PG8_SCHED; PG8_LDA(At, 0, 0); PG8_STAGE(PG8_SA(1, 1), a1 + hstep, voffA);
            PG8_WAIT_V(8); PG8_WAIT_L(0); PG8_BAR; PG8_MMA(0, 0, At, B0); PG8_MMA(0, 1, At, B1); PG8_BAR; PG8_SCHED;
            PG8_LDA(At, 0, 1); PG8_STAGE(PG8_SB(0, 0), b2, voffB); PG8_STAGE(PG8_SB(0, 1), b2 + hstep, voffB); PG8_STAGE(PG8_SA(0, 0), a2, voffA);
            PG8_WAIT_V(8); PG8_WAIT_L(0); PG8_BAR; PG8_MMA(1, 0, At, B0); PG8_MMA(1, 1, At, B1); PG8_BAR; PG8_SCHED;
            PG8_LDB(B0, 1, 0); PG8_LDB(B1, 1, 1); PG8_SCHED; PG8_LDA(At, 1, 0); PG8_STAGE(PG8_SA(0, 1), a2 + hstep, voffA);
            PG8_WAIT_V(8); PG8_WAIT_L(0); PG8_BAR; PG8_MMA(0, 0, At, B0); PG8_MMA(0, 1, At, B1); PG8_BAR; PG8_SCHED;
            PG8_LDA(At, 1, 1); PG8_STAGE(PG8_SB(1, 0), b3, voffB); PG8_STAGE(PG8_SB(1, 1), b3 + hstep, voffB); PG8_STAGE(PG8_SA(1, 0), a3, voffA);
            PG8_WAIT_V(8); PG8_WAIT_L(0); PG8_BAR; PG8_MMA(1, 0, At, B0); PG8_MMA(1, 1, At, B1); PG8_BAR; PG8_SCHED;
            } else {
            PG8_LDB(B0, 0, 0); PG8_SCHED; PG8_LDA(At, 0, 0); PG8_STAGE(PG8_SA(1, 1), a1 + hstep, voffA);
            PG8_WAIT_L(8); PG8_BAR; PG8_WAIT_L(0); PG8_MMA(0, 0, At, B0); PG8_BAR; PG8_SCHED;
            PG8_LDB(B1, 0, 1); PG8_STAGE(PG8_SB(0, 0), b2, voffB);
            PG8_BAR; PG8_WAIT_L(0); PG8_MMA(0, 1, At, B1); PG8_BAR;
            PG8_LDA(At, 0, 1); PG8_STAGE(PG8_SA(0, 0), a2, voffA);
            PG8_BAR; PG8_WAIT_L(0); PG8_MMA(1, 0, At, B0); PG8_BAR; PG8_SCHED;
            PG8_STAGE(PG8_SB(0, 1), b2 + hstep, voffB);
            PG8_WAIT_V(6); PG8_BAR; PG8_MMA(1, 1, At, B1); PG8_BAR;
            PG8_LDB(B0, 1, 0); PG8_SCHED; PG8_LDA(At, 1, 0); PG8_STAGE(PG8_SA(0, 1), a2 + hstep, voffA);
            PG8_WAIT_L(8); PG8_BAR; PG8_WAIT_L(0); PG8_MMA(0, 0, At, B0); PG8_BAR; PG8_SCHED;
            PG8_LDB(B1, 1, 1); PG8_STAGE(PG8_SB(1, 0), b3, voffB);
            PG8_BAR; PG8_WAIT_L(0); PG8_MMA(0, 1, At, B1); PG8_BAR;
            PG8_LDA(At, 1, 1); PG8_STAGE(PG8_SA(1, 0), a3, voffA);
            PG8_BAR; PG8_WAIT_L(0); PG8_MMA(1, 0, At, B0); PG8_BAR; PG8_SCHED;
            PG8_STAGE(PG8_SB(1, 1), b3 + hstep, voffB);
            PG8_WAIT_V(6); PG8_BAR; PG8_MMA(1, 1, At, B1); PG8_BAR;
            }
        }
        if constexpr (ALIGN_EPI) { if (wr == 0) PG8_BAR; }
        if constexpr (!Epi::AFTER_DRAIN) { _Pragma("unroll") for (int rep_ = 0; rep_ < EPI_REP; ++rep_) E(acc, cur, wr, wc, fr, fq, ui); S.done(cur); }
        if (!has_next) break;
#pragma unroll
        for (int a = 0; a < 2; ++a)
#pragma unroll
            for (int b = 0; b < 2; ++b)
#pragma unroll
                for (int m = 0; m < 4; ++m)
#pragma unroll
                    for (int n = 0; n < 2; ++n) acc[a][b][m][n] = (f32x4){0.f, 0.f, 0.f, 0.f};
        cur = nxt; cA = nA; cB = nB; ++ui;
        if constexpr (ALIGN_EPI) { if (wr == 1) PG8_BAR; }
    }
    PG8_WAIT_V(0);
    if constexpr (!ALIGN_EPI) { if (wr == 0) PG8_BAR; }
    PG8_BAR;
    if constexpr (Epi::AFTER_DRAIN) { E.fused(acc, cur, wr, wc, fr, fq, lds, wid, lane); S.done(cur); }
#undef PG8_SA
#undef PG8_SB
#undef PG8_STAGE
#undef PG8_LDA
#undef PG8_LDB
#undef PG8_MMA
#undef PG8_WAIT_V
#undef PG8_WAIT_L
#undef PG8_BAR
#undef PG8_SCHED
}
}
namespace att {
typedef unsigned short bf16;
typedef short bf16x8 __attribute__((ext_vector_type(8)));
typedef short s16x4 __attribute__((ext_vector_type(4)));
typedef float f32x16 __attribute__((ext_vector_type(16)));
typedef float f32x4 __attribute__((ext_vector_type(4)));
typedef unsigned u32x4 __attribute__((ext_vector_type(4)));
constexpr int NW = 8, QBLK = 32, KVBLK = 64, QB = NW * QBLK;
constexpr int SHM_V = KVBLK * 128 * 2, SHM_K = KVBLK * 128 * 2, KPE_ROW = 144, SHM_KPE = KVBLK * KPE_ROW;
constexpr int OFF_V = 0, OFF_K = 2 * SHM_V, OFF_WS = OFF_K + 2 * SHM_K, OFF_KPE = OFF_WS + NW * 64 * 4, OFF_QPE = OFF_KPE + 2 * SHM_KPE, LDS_BYTES = OFF_QPE + NW * 4096;
constexpr float THR = 8.f;

#define KSWZ(row, colB) ((row) * 256 + ((colB) ^ (((row) & 7) << 4)))
#define SBAR() __builtin_amdgcn_sched_barrier(0)
__device__ __forceinline__ int v_st(int k, int c) { const int kk = (k & ~0xC) | ((k & 4) << 1) | ((k & 8) >> 1); return ((kk >> 3) * 4 + (c >> 5)) * 512 + ((kk & 7) * 32 + (c & 31)) * 2; }
__device__ __forceinline__ int v_rd_base(int lane) { return ((lane & 3) << 3) | (((lane >> 2) & 3) << 6) | (((lane >> 4) & 1) << 5) | (((lane >> 5) & 1) << 8); }
constexpr int v_rd_off(int d0, int ks, int half) { return d0 * 512 + ks * 4096 + half * 2048; }
__device__ __forceinline__ int crow(int r, int hi) { return (r & 3) + 8 * (r >> 2) + 4 * hi; }
__device__ __forceinline__ unsigned cvtpk(float lo, float hi) { unsigned r; asm volatile("v_cvt_pk_bf16_f32 %0, %1, %2" : "=v"(r) : "v"(lo), "v"(hi)); return r; }
__device__ __forceinline__ bf16x8 ld8(const bf16* p) { return *reinterpret_cast<const bf16x8*>(p); }
__device__ __forceinline__ void mask_tile(f32x16& p0, f32x16& p1, int dq, unsigned W) {
    const float NEG = -__builtin_inff();
#pragma unroll
    for (int r = 0; r < 16; ++r) {
        const int c = (r & 3) + 8 * (r >> 2);
        if ((unsigned)(dq - c) >= W) p0[r] = NEG;
        if ((unsigned)(dq - c - 32) >= W) p1[r] = NEG;
    }
}
__device__ __forceinline__ void partialSM(f32x16& p0, f32x16& p1, float& m_reg, float& mn, float& alpha, const float scale) {
    float pmax = p0[0]; for (int r = 1; r < 16; ++r) pmax = fmaxf(pmax, p0[r]); for (int r = 0; r < 16; ++r) pmax = fmaxf(pmax, p1[r]);
    { auto rr = __builtin_amdgcn_permlane32_swap(__float_as_uint(pmax), __float_as_uint(pmax), false, false);
      pmax = fmaxf(__uint_as_float(rr[0]), __uint_as_float(rr[1])); }
    const float C2 = 1.4426950408889634f * scale;
    if (__builtin_expect(__all((pmax - m_reg) * scale <= THR), 1)) { mn = m_reg; alpha = 1.f; }
    else { mn = fmaxf(m_reg, pmax); alpha = __builtin_amdgcn_exp2f((m_reg - mn) * C2); m_reg = mn; }
    const float mnL = -mn * C2;
    for (int r = 0; r < 16; ++r) p0[r] = fmaf(p0[r], C2, mnL); for (int r = 0; r < 16; ++r) p1[r] = fmaf(p1[r], C2, mnL);
    for (int r = 0; r < 16; ++r) p0[r] = __builtin_amdgcn_exp2f(p0[r]);
}
__device__ __forceinline__ void finishSM(f32x16& p0, f32x16& p1, float alpha, float& l_reg, bf16x8& pa0, bf16x8& pa1, bf16x8& pa2, bf16x8& pa3) {
    for (int r = 0; r < 16; ++r) p1[r] = __builtin_amdgcn_exp2f(p1[r]);
    float ps = 0; for (int r = 0; r < 16; ++r) ps += p0[r]; for (int r = 0; r < 16; ++r) ps += p1[r];
    { auto rr = __builtin_amdgcn_permlane32_swap(__float_as_uint(ps), __float_as_uint(ps), false, false);
      ps = __uint_as_float(rr[0]) + __uint_as_float(rr[1]); }
    l_reg = l_reg * alpha + ps;
#define PK4(P, B_, OUT) do { unsigned a0 = cvtpk(P[B_+0], P[B_+1]), a1 = cvtpk(P[B_+2], P[B_+3]);                          \
        unsigned b0 = cvtpk(P[B_+4], P[B_+5]), b1 = cvtpk(P[B_+6], P[B_+7]);                                             \
        auto r0 = __builtin_amdgcn_permlane32_swap(a0, b0, false, false); auto r1 = __builtin_amdgcn_permlane32_swap(a1, b1, false, false); \
        u32x4 w = {r0[0], r1[0], r0[1], r1[1]}; OUT = *reinterpret_cast<bf16x8*>(&w); } while (0)
    PK4(p0, 0, pa0); PK4(p0, 8, pa1); PK4(p1, 0, pa2); PK4(p1, 8, pa3);
#undef PK4
}
template <int KB, bool SK, bool PE>
__device__ __forceinline__ void qkt(f32x16& p0, f32x16& p1, const char* lds, int r32, int hi, int wid, int lane, const bf16x8* qr, bool act) {
    if (SK && !act) { const float NEG = -__builtin_inff();
#pragma unroll
        for (int r = 0; r < 16; ++r) { p0[r] = NEG; p1[r] = NEG; } return; }
    p0 = f32x16{}; p1 = f32x16{};
    const char* kb[4];
#pragma unroll
    for (int dd = 0; dd < 4; ++dd) kb[dd] = lds + OFF_K + KB * SHM_K + KSWZ(r32, (dd * 16 + hi * 8) * 2);
#pragma unroll
    for (int d0 = 0; d0 < 8; ++d0) { const char* a = kb[d0 & 3] + (d0 >> 2) * 128;
        bf16x8 b0 = *reinterpret_cast<const bf16x8*>(a);
        bf16x8 b1 = *reinterpret_cast<const bf16x8*>(a + 32 * 256);
        p0 = __builtin_amdgcn_mfma_f32_32x32x16_bf16(b0, qr[d0], p0, 0, 0, 0);
        p1 = __builtin_amdgcn_mfma_f32_32x32x16_bf16(b1, qr[d0], p1, 0, 0, 0); }
    if constexpr (PE) {
        const char* kp = lds + OFF_KPE + KB * SHM_KPE + r32 * KPE_ROW + hi * 16;
        const char* qp = lds + OFF_QPE + wid * 4096 + lane * 16;
#pragma unroll
        for (int d0 = 0; d0 < 4; ++d0) {
            bf16x8 b0 = *reinterpret_cast<const bf16x8*>(kp + d0 * 32);
            bf16x8 b1 = *reinterpret_cast<const bf16x8*>(kp + d0 * 32 + 32 * KPE_ROW);
            bf16x8 qf = *reinterpret_cast<const bf16x8*>(qp + d0 * 1024);
            p0 = __builtin_amdgcn_mfma_f32_32x32x16_bf16(b0, qf, p0, 0, 0, 0);
            p1 = __builtin_amdgcn_mfma_f32_32x32x16_bf16(b1, qf, p1, 0, 0, 0); }
    }
}
template <int VB, bool SK>
__device__ __forceinline__ void pv_tile(f32x16* o, int vb0, bf16x8 pa0, bf16x8 pa1, bf16x8 pa2, bf16x8 pa3, bool act) {
    if (SK && !act) return;
#define TRRD(dst, off) asm volatile("ds_read_b64_tr_b16 %0, %1 offset:%2" : "=&v"(dst) : "v"(vb0), "i"(off) : "memory")
#define PV_D0(d0) do { s16x4 l0, l1, l2, l3, h0, h1, h2, h3; constexpr int b_ = OFF_V + VB * SHM_V + v_rd_off(d0, 0, 0); \
        TRRD(l0, b_); TRRD(h0, b_ + 2048); TRRD(l1, b_ + 4096); TRRD(h1, b_ + 6144); TRRD(l2, b_ + 8192); TRRD(h2, b_ + 10240); TRRD(l3, b_ + 12288); TRRD(h3, b_ + 14336); \
        asm volatile("s_waitcnt lgkmcnt(0)" ::: "memory"); SBAR();   \
        o[d0] = __builtin_amdgcn_mfma_f32_32x32x16_bf16(pa0, (bf16x8){l0[0], l0[1], l0[2], l0[3], h0[0], h0[1], h0[2], h0[3]}, o[d0], 0, 0, 0);   \
        o[d0] = __builtin_amdgcn_mfma_f32_32x32x16_bf16(pa1, (bf16x8){l1[0], l1[1], l1[2], l1[3], h1[0], h1[1], h1[2], h1[3]}, o[d0], 0, 0, 0);   \
        o[d0] = __builtin_amdgcn_mfma_f32_32x32x16_bf16(pa2, (bf16x8){l2[0], l2[1], l2[2], l2[3], h2[0], h2[1], h2[2], h2[3]}, o[d0], 0, 0, 0);   \
        o[d0] = __builtin_amdgcn_mfma_f32_32x32x16_bf16(pa3, (bf16x8){l3[0], l3[1], l3[2], l3[3], h3[0], h3[1], h3[2], h3[3]}, o[d0], 0, 0, 0); } while (0)
    PV_D0(0); PV_D0(1); PV_D0(2); PV_D0(3);
#undef PV_D0
#undef TRRD
}

struct Prm { int qs, kvs, os, qpes, kpes, lses, skv, W; float scale; };
struct BlockRef { const bf16* Q; const bf16* K; const bf16* V; bf16* O; const bf16* Qpe; const bf16* Kpe; float* Lse; int P0; };
template <bool PE> struct Seam { bf16x8 qr[8]; bf16x8 st_v0, st_v1, st_k0, st_k1, st_kp; };
__device__ __forceinline__ int swa_jlo(int P0, int W) { const int lowk = P0 - W + 1; return lowk > 0 ? lowk / KVBLK : 0; }
#define VMW() asm volatile("s_waitcnt vmcnt(0)" ::: "memory")
#define LDG(base, off) (*(const bf16x8*)((const char*)(base) + (off)))
#define SLOAD_H(R_, k0) do { const char* kb__ = (const char*)(R_).K + (size_t)(k0) * P.kvs * 2; const char* vb__ = (const char*)(R_).V + (size_t)(k0) * P.kvs * 2; const size_t h__ = (size_t)32 * P.kvs * 2; \
                              S.st_v0 = LDG(vb__, kvoff); S.st_v1 = LDG(vb__ + h__, kvoff); S.st_k0 = LDG(kb__, kvoff); S.st_k1 = LDG(kb__ + h__, kvoff); \
                              if constexpr (PE) S.st_kp = LDG((const char*)(R_).Kpe + (size_t)(k0) * P.kpes * 2, kpoff); } while (0)
#define SWRITE_HK(bf) do { *(bf16x8*)(K_lds + (bf) * SHM_K + kws) = S.st_k0; *(bf16x8*)(K_lds + (bf) * SHM_K + kws + 32 * 256) = S.st_k1; \
                           if constexpr (PE) *(bf16x8*)(lds + OFF_KPE + (bf) * SHM_KPE + pws) = S.st_kp; } while (0)
#define SWRITE_HV(bf) do { *(bf16x8*)(V_lds + (bf) * SHM_V + vst0) = S.st_v0; *(bf16x8*)(V_lds + (bf) * SHM_V + vst1) = S.st_v1; } while (0)
#define SWRITE_H(bf) do { SWRITE_HV(bf); SWRITE_HK(bf); } while (0)
template <bool PE>
__device__ __forceinline__ void swa_prime(const BlockRef& cur, const Prm& P, char* lds, Seam<PE>& S) {
    int tid_ = threadIdx.x; asm volatile("" : "+v"(tid_));
    const int tid = tid_, wid = __builtin_amdgcn_readfirstlane(tid >> 6), lane = tid & 63, r32 = lane & 31, hi = lane >> 5;
    const int sr = tid >> 4, sc = (tid & 15) * 8, kws = KSWZ(sr, sc * 2); char* K_lds = lds + OFF_K;
    const int pr = tid >> 3, pc = (tid & 7) * 8, pws = pr * KPE_ROW + (tid & 7) * 16;
    const unsigned kvoff = (unsigned)(sr * P.kvs + sc) * 2u, kpoff = (unsigned)(pr * P.kpes + pc) * 2u, qoff = (unsigned)((wid * QBLK + r32) * P.qs + hi * 8) * 2u, qpoff = (unsigned)((wid * QBLK + r32) * P.qpes + hi * 8) * 2u;
    const int kb0 = swa_jlo(cur.P0, P.W) * KVBLK;
#pragma unroll
    for (int d0 = 0; d0 < 8; ++d0) S.qr[d0] = LDG(cur.Q, qoff + d0 * 32);
    if constexpr (PE) {
#pragma unroll
        for (int d0 = 0; d0 < 4; ++d0) *(bf16x8*)(lds + OFF_QPE + wid * 4096 + d0 * 1024 + lane * 16) = LDG(cur.Qpe, qpoff + d0 * 32);
    }
    SLOAD_H(cur, kb0); VMW(); SWRITE_HK(0);
    __syncthreads();
}
template <bool PE, bool SK, bool LSE, bool EARLY>
__device__ __forceinline__ void swa_block(const BlockRef& cur, const BlockRef& nxt, const Prm& P, char* lds, Seam<PE>& S) {
    int tid_ = threadIdx.x; asm volatile("" : "+v"(tid_));
    const int tid = tid_, wid = __builtin_amdgcn_readfirstlane(tid >> 6), lane = tid & 63, r32 = lane & 31, hi = lane >> 5;
    const int W = P.W;
    const int j_lo = swa_jlo(cur.P0, W);
    int j_hi = (cur.P0 + QB - 1) / KVBLK + 1; if (j_hi > P.skv / KVBLK) j_hi = P.skv / KVBLK;
    const int NT = j_hi - j_lo;
    const int kbn = swa_jlo(nxt.P0, W) * KVBLK;
    const int qlo = cur.P0 + wid * QBLK, qm = qlo + r32 - 4 * hi;
    char* V_lds = lds + OFF_V; char* K_lds = lds + OFF_K;
    float* ws = (float*)(lds + OFF_WS) + wid * 64; float* li_l = ws, * al_l = ws + 32;
    float m_reg = -1e30f, l_reg = 0; f32x16 o[4] = {};
    const int sr = tid >> 4, sc = (tid & 15) * 8, vst0 = v_st(sr, sc), vst1 = v_st(32 + sr, sc), kws = KSWZ(sr, sc * 2);
    const int pr = tid >> 3, pc = (tid & 7) * 8, pws = pr * KPE_ROW + (tid & 7) * 16;
    const unsigned kvoff = (unsigned)(sr * P.kvs + sc) * 2u, kpoff = (unsigned)(pr * P.kpes + pc) * 2u;
    const int vb0 = (int)(uintptr_t)lds + v_rd_base(lane);
#define RESC(a) do { if (__any((a) < 1.f)) { if (hi == 0) al_l[r32] = (a); asm volatile("s_waitcnt lgkmcnt(0)" ::: "memory");              \
                     for (int d_ = 0; d_ < 4; ++d_) for (int r = 0; r < 16; ++r) o[d_][r] *= al_l[crow(r, hi)]; } } while (0)
#define KBASE(t) ((j_lo + (t)) * KVBLK)
#define ACT(t) (KBASE(t) <= qlo + QBLK - 1 && KBASE(t) + KVBLK - 1 >= qlo - W + 1)
#define MASKT(P0_, P1_, t) do { const int kb_ = KBASE(t); if ((!SK || ACT(t)) && (kb_ + KVBLK - 1 > qlo || kb_ <= qlo + QBLK - 1 - W)) mask_tile(P0_, P1_, qm - kb_, (unsigned)W); } while (0)
    f32x16 pA0, pA1, pB0, pB1; float mnA, mnB, alA, alB; bf16x8 pa0, pa1, pa2, pa3;
    SWRITE_HV(0); SBAR();
    if (NT > 1) { SLOAD_H(cur, KBASE(1)); }
    SBAR(); qkt<0, SK, PE>(pA0, pA1, lds, r32, hi, wid, lane, S.qr, ACT(0));
    MASKT(pA0, pA1, 0); partialSM(pA0, pA1, m_reg, mnA, alA, P.scale);
    if (NT > 1) { VMW(); SWRITE_H(1); }
    __syncthreads();
#define HALF_STEP(PX0, PX1, mnX, alX, PY0, PY1, alY, t, KB, VB, SB) do {                                                      \
        SBAR(); if (EARLY && (t) + 1 < NT) { SLOAD_H(cur, KBASE((t) + 1)); SBAR(); }                                          \
        qkt<KB, SK, PE>(PX0, PX1, lds, r32, hi, wid, lane, S.qr, ACT(t));                                                     \
        finishSM(PY0, PY1, alY, l_reg, pa0, pa1, pa2, pa3); SBAR();                                                           \
        if (!EARLY && (t) + 1 < NT) { SLOAD_H(cur, KBASE((t) + 1)); SBAR(); }                                                 \
        pv_tile<VB, SK>(o, vb0, pa0, pa1, pa2, pa3, ACT((t) - 1)); MASKT(PX0, PX1, (t)); partialSM(PX0, PX1, m_reg, mnX, alX, P.scale); \
        __syncthreads();                                                                                                      \
        if ((t) + 1 < NT) { VMW(); SWRITE_H(SB); }                                                                            \
        RESC(alX); __syncthreads(); } while (0)
    for (int t = 1; t + 1 < NT; t += 2) {
        HALF_STEP(pB0, pB1, mnB, alB, pA0, pA1, alA, t, 1, 0, 0);
        HALF_STEP(pA0, pA1, mnA, alA, pB0, pB1, alB, t + 1, 0, 1, 1);
    }
    const bool even = (NT & 1) == 0;
    if (even) { SBAR(); qkt<1, SK, PE>(pB0, pB1, lds, r32, hi, wid, lane, S.qr, ACT(NT - 1)); SBAR(); }
    SLOAD_H(nxt, kbn); SBAR();
    { const unsigned qoff = (unsigned)((wid * QBLK + r32) * P.qs + hi * 8) * 2u;
#pragma unroll
      for (int d0 = 0; d0 < 8; ++d0) S.qr[d0] = LDG(nxt.Q, qoff + d0 * 32); }
    bf16x8 qpn[4];
    if constexpr (PE) { const unsigned qpoff = (unsigned)((wid * QBLK + r32) * P.qpes + hi * 8) * 2u;
#pragma unroll
        for (int d0 = 0; d0 < 4; ++d0) qpn[d0] = LDG(nxt.Qpe, qpoff + d0 * 32);
    }
    SBAR();
    finishSM(pA0, pA1, alA, l_reg, pa0, pa1, pa2, pa3); SBAR();
    pv_tile<0, SK>(o, vb0, pa0, pa1, pa2, pa3, ACT(even ? NT - 2 : NT - 1));
    if (even) { MASKT(pB0, pB1, NT - 1); partialSM(pB0, pB1, m_reg, mnB, alB, P.scale); __syncthreads(); RESC(alB);
        finishSM(pB0, pB1, alB, l_reg, pa0, pa1, pa2, pa3); SBAR(); pv_tile<1, SK>(o, vb0, pa0, pa1, pa2, pa3, ACT(NT - 1)); }
    SBAR();
    VMW(); SWRITE_HK(0);
    if constexpr (PE) {
#pragma unroll
        for (int d0 = 0; d0 < 4; ++d0) *(bf16x8*)(lds + OFF_QPE + wid * 4096 + d0 * 1024 + lane * 16) = qpn[d0];
    }
    SBAR();
    if (hi == 0) li_l[r32] = l_reg; asm volatile("s_waitcnt lgkmcnt(0)" ::: "memory");
    float rli[16];
#pragma unroll
    for (int r = 0; r < 16; ++r) rli[r] = __builtin_amdgcn_rcpf(li_l[crow(r, hi)]);
    const unsigned ooff = (unsigned)((wid * QBLK + 4 * hi) * P.os + r32) * 2u;
#pragma unroll
    for (int r = 0; r < 16; ++r) { char* ob = (char*)cur.O + (size_t)((r & 3) + 8 * (r >> 2)) * P.os * 2;
#pragma unroll
        for (int d0 = 0; d0 < 4; ++d0) { const float v = o[d0][r] * rli[r];
            const float vn = __uint_as_float((unsigned)__builtin_amdgcn_update_dpp(0, (int)__float_as_uint(v), 0xB1, 0xF, 0xF, true));
            if ((r32 & 1) == 0) *(unsigned*)(ob + ooff + d0 * 64) = cvtpk(v, vn); } }
    if constexpr (LSE) { if (hi == 0) *(float*)((char*)cur.Lse + (unsigned)((wid * QBLK + r32) * P.lses) * 4u) = m_reg * P.scale + __logf(l_reg); }
    __syncthreads();
#undef RESC
#undef KBASE
#undef ACT
#undef MASKT
#undef HALF_STEP
}
#undef LDG
#undef VMW
#undef SLOAD_H
#undef SWRITE_HK
#undef SWRITE_HV
#undef SWRITE_H
#undef KSWZ
#undef SBAR
}
constexpr int NWAVES = 8;
constexpr int BATCH = 4, SEQ = 4096, DM = 2048, M = BATCH * SEQ;
constexpr int NQKVA = 1280;
constexpr int NQB = 3072, NKVB = 4096, NDIL = 18432, FF = 5632, NUP = 2 * FF;
constexpr float EPS = 1e-6f;
constexpr size_t MiB = (size_t)1 << 20;
constexpr size_t WS_CTL = 0, CTL_ZERO_BYTES = 64 * 1024;
constexpr size_t WS_COSM = 1 * MiB, WS_SINM = 3 * MiB, WS_COSD = 5 * MiB, WS_SIND = 6 * MiB;
constexpr size_t WS_WMLA = 8 * MiB, WMLA_STRIDE = 20 * MiB, WMLA_QKVA = 0, WMLA_QB = 5 * MiB, WMLA_KVB = 8 * MiB, WMLA_WO = 12 * MiB;
constexpr size_t WS_WDIL = WS_WMLA + 2 * WMLA_STRIDE, WDIL_STRIDE = 80 * MiB, WDIL_IN = 0, WDIL_WO = 72 * MiB;
constexpr size_t WS_WFFN = WS_WDIL + 2 * WDIL_STRIDE, WFFN_STRIDE = 66 * MiB, WFFN_UP = 0, WFFN_DOWN = 44 * MiB;
constexpr size_t WS_H = WS_WFFN + 4 * WFFN_STRIDE;
constexpr size_t WS_S = WS_H + 64 * MiB;
constexpr size_t S_QKVA = 0, S_QN = 80 * MiB, S_CKVN = 96 * MiB, S_KPE = 112 * MiB, S_Q = 114 * MiB, S_KV = 210 * MiB, S_AO_MLA = 338 * MiB;
constexpr size_t S_QKV = 0, S_OG = 576 * MiB, S_LSE = 768 * MiB, S_AO_DIL = 771 * MiB;
constexpr size_t S_U = 0, S_ACT = 352 * MiB;
constexpr size_t WS_HALO = WS_S + 835 * MiB, WS_FIX = WS_HALO + 6 * MiB;
constexpr size_t WS_END = WS_FIX + 6 * MiB;
static_assert(WS_H == 472 * MiB && WS_END == 1383 * MiB, "d_ws map");
constexpr int CW_BAR = 4096;
constexpr int RING_OFF = 0, RING_BYTES = 131072, LDSCTL_OFF = RING_BYTES, MISC_OFF = LDSCTL_OFF + 320, XH_OFF = RING_BYTES + 1024  , CWL_OFF = XH_OFF + 6144  , LDS_BYTES = 163840;
static_assert(CWL_OFF + 8192 <= LDS_BYTES, "LDS map");
static_assert(att::LDS_BYTES <= RING_BYTES && pg8::STAGE_BYTES <= RING_BYTES, "LDS map");

#define GAS __attribute__((address_space(1)))
#define LAS __attribute__((address_space(3)))
typedef unsigned short bf16;
typedef unsigned v4u __attribute__((ext_vector_type(4)));
typedef unsigned v2u __attribute__((ext_vector_type(2)));
typedef float f32x4 __attribute__((ext_vector_type(4)));
typedef GAS unsigned gu32;
#define RLX_AGENT __ATOMIC_RELAXED, __HIP_MEMORY_SCOPE_AGENT
#define LDS_WAIT() asm volatile("s_waitcnt lgkmcnt(0)" ::: "memory")
__device__ __forceinline__ unsigned pk2(float lo, float hi) { return pg8::cvt_pk_bf16(lo, hi); }
__device__ __forceinline__ float bf_lo(unsigned w) { return __uint_as_float(w << 16); }
__device__ __forceinline__ float bf_hi(unsigned w) { return __uint_as_float(w & 0xffff0000u); }

#define XB_TMO      128
#define XB_XCNT(j)  (256  + 64 * (j))
#define XB_XSUB(j)  (1280 + 64 * (j))
#define XB_XGEN(j)  (2304 + 64 * (j))
#define XB_TOP      3328
#define XB_TOPGEN   3392
#define XCD_BAR_WORDS 3456
#define XB_SPIN_CAP (1u << 18)

__device__ __forceinline__ unsigned xb_ld(unsigned* p)              { return __hip_atomic_load(p, __ATOMIC_RELAXED, __HIP_MEMORY_SCOPE_AGENT); }
__device__ __forceinline__ unsigned xb_add(unsigned* p, unsigned v) { return __hip_atomic_fetch_add(p, v, __ATOMIC_RELAXED, __HIP_MEMORY_SCOPE_AGENT); }
__device__ __forceinline__ unsigned xb_xcc_id() { return (unsigned)__builtin_amdgcn_s_getreg((3 << 11) | 20) & 0xFu; }
#define XB_SPIN(cond, bar) do { unsigned _sp = 0; while (cond) { __builtin_amdgcn_s_sleep(1); \
    if ((++_sp & 255u) == 0u) { if (xb_ld(&(bar)[XB_TMO])) break; if (_sp > XB_SPIN_CAP) { atomicAdd(&(bar)[XB_TMO], 1u); break; } } } } while (0)

struct XcdBarrier {
    unsigned* bar; unsigned x;
    volatile LAS unsigned* st;
};

__device__ __forceinline__ XcdBarrier xcd_barrier_post(unsigned* bar, volatile LAS unsigned* st) {
    XcdBarrier b; b.bar = bar; b.x = xb_xcc_id(); b.st = st;
    if (threadIdx.x == 0) (void)xb_add(&bar[XB_XCNT(b.x)], 1u);
    return b;
}
__device__ __forceinline__ void xcd_barrier_complete(unsigned* bar, unsigned x, unsigned& nloc, unsigned& nx) {
    const unsigned G = gridDim.x * gridDim.y * gridDim.z;
    unsigned sum, cnt, mine, sp = 0u;
    for (;;) {
        sum = 0u; cnt = 0u; mine = 0u;
#pragma unroll
        for (unsigned j = 0; j < 16; ++j) { const unsigned c = xb_ld(&bar[XB_XCNT(j)]); sum += c; cnt += (c > 0u) ? 1u : 0u; mine = (j == x) ? c : mine; }
        if (sum == G) break;
        __builtin_amdgcn_s_sleep(1);
        if ((++sp & 255u) == 0u) { if (xb_ld(&bar[XB_TMO])) break; if (sp > XB_SPIN_CAP) { atomicAdd(&bar[XB_TMO], 1u); break; } }
    }
    nloc = mine > 0u ? mine : 1u; nx = cnt > 0u ? cnt : 1u;
}

__device__ __forceinline__ void xcd_barrier(const XcdBarrier& b) {
    asm volatile("s_waitcnt vmcnt(0)" ::: "memory");
    __syncthreads();
    if (threadIdx.x == 0) {
        __attribute__((address_space(1))) unsigned* barg_ = (__attribute__((address_space(1))) unsigned*)b.bar; unsigned bx_ = b.x;
        asm volatile("" : "+s"(barg_), "+s"(bx_)); unsigned* bar = (unsigned*)barg_;
        __builtin_amdgcn_s_waitcnt(0);
        unsigned nloc = b.st[0], nx = b.st[1];
        if (nloc == 0u) { xcd_barrier_complete(bar, bx_, nloc, nx); b.st[0] = nloc; b.st[1] = nx; }
        const unsigned old = xb_add(&bar[XB_XSUB(bx_)], 1u);
        const unsigned gen = old / nloc;
        if (old + 1u == (gen + 1u) * nloc) {
            __builtin_amdgcn_fence(__ATOMIC_RELEASE, "agent");
            asm volatile("s_waitcnt vmcnt(0)" ::: "memory");
            const unsigned og = xb_add(&bar[XB_TOP], 1u);
            const unsigned tg = og / nx;
            if (og + 1u == (tg + 1u) * nx) xb_add(&bar[XB_TOPGEN], 1u);
            else XB_SPIN(xb_ld(&bar[XB_TOPGEN]) == tg, bar);
            __builtin_amdgcn_fence(__ATOMIC_ACQUIRE, "agent");
            xb_add(&bar[XB_XGEN(bx_)], 1u);
            asm volatile("s_waitcnt vmcnt(0)" ::: "memory");
        } else {
            XB_SPIN(xb_ld(&bar[XB_XGEN(bx_)]) == gen, bar);
            __builtin_amdgcn_fence(__ATOMIC_ACQUIRE, "agent");
            asm volatile("s_waitcnt vmcnt(0)" ::: "memory");
        }
    }
    __syncthreads();
}


__device__ __forceinline__ const void* karg(int k) {
    const __attribute__((address_space(4))) char* kp = (const __attribute__((address_space(4))) char*)__builtin_amdgcn_kernarg_segment_ptr();
    asm volatile("" : "+s"(kp));
    return *(const void* const __attribute__((address_space(4)))*)(kp + 8 * k);
}
#define LANE_IDS() int tid_ = threadIdx.x; asm volatile("" : "+v"(tid_)); const int tid = tid_, lane = tid & 63, wave = __builtin_amdgcn_readfirstlane(tid >> 6); (void)tid; (void)lane; (void)wave
struct Frame {
    LAS unsigned char* lds;
    volatile LAS unsigned* MISC;
    gu32* ctl;
    int vcu, G;
    float* out; unsigned char* wsb;
};
#define SWZ_XOR(v, m) __uint_as_float((unsigned)__builtin_amdgcn_ds_swizzle((int)__float_as_uint(v), (((m) << 10) | 0x1f)))
__device__ __forceinline__ float xor32(float v) { auto rr = __builtin_amdgcn_permlane32_swap(__float_as_uint(v), __float_as_uint(v), false, false); return __uint_as_float((threadIdx.x & 32) ? rr[0] : rr[1]); }
__device__ __forceinline__ float xor1(float v) { return __uint_as_float((unsigned)__builtin_amdgcn_update_dpp(0, (int)__float_as_uint(v), 0xB1, 0xF, 0xF, true)); }
__device__ __forceinline__ float wave_sum(float v) {
    v += SWZ_XOR(v, 1); v += SWZ_XOR(v, 2); v += SWZ_XOR(v, 4); v += SWZ_XOR(v, 8); v += SWZ_XOR(v, 16);
    auto rr = __builtin_amdgcn_permlane32_swap(__float_as_uint(v), __float_as_uint(v), false, false);
    return __uint_as_float(rr[0]) + __uint_as_float(rr[1]);
}
__device__ __forceinline__ float dot4(const f32x4 a) { return (a.x * a.x + a.y * a.y) + (a.z * a.z + a.w * a.w); }

template <int KIND> __device__ __forceinline__ int dest_row(int n) {
    if constexpr (KIND == 0) return n;
    else if constexpr (KIND == 4) { const int v = n >= FF, c = v ? n - FF : n; return 256 * (c >> 7) + 128 * v + (c & 127); }
    else if constexpr (KIND == 1) {
        const int h = n / 192, d = n - h * 192;
        if (d < 128) return h * 128 + d;
        const int i = d - 128, t = h >> 2, hh = h & 3;
        return 2048 + 256 * t + 32 * hh + (i < 32 ? i : 128 + (i - 32));
    } else {
        const int g = n / 6144, r = n - g * 6144, t = r >> 11, r2 = r & 2047, h = r2 >> 7, d = r2 & 127;
        if (t == 2) return n;
        const int T = h >> 1, hh = h & 1;
        const int tc = d < 16 ? 16 * hh + d : (d < 32 ? 128 + 16 * hh + (d - 16) : hh * 128 + d);
        return g * 6144 + t * 2048 + T * 256 + tc;
    }
}
template <int KIND> __device__ __forceinline__ void p0_transpose_item(const float* W, int K, int N, bf16* WT, int row_off, LAS float* scr, int item, int lane) {
    const int nblk = N / 32, kb = item / nblk, nb = item - kb * nblk, k0 = 64 * kb, n0 = 32 * nb;
#pragma unroll 8
    for (int i = 0; i < 32; ++i) { const int kk = 2 * i + (lane >> 5); scr[kk * 33 + (lane & 31)] = W[(size_t)(k0 + kk) * N + n0 + (lane & 31)]; }
    LDS_WAIT(); asm volatile("" ::: "memory");
    const int c = lane & 7;
#pragma unroll
    for (int j = 0; j < 4; ++j) { const int n = (lane >> 3) + 8 * j; const LAS float* s = scr + (8 * c) * 33 + n;
        v4u o; o.x = pk2(s[0 * 33], s[1 * 33]); o.y = pk2(s[2 * 33], s[3 * 33]); o.z = pk2(s[4 * 33], s[5 * 33]); o.w = pk2(s[6 * 33], s[7 * 33]);
        *(GAS v4u*)(WT + (size_t)(row_off + dest_row<KIND>(n0 + n)) * K + k0 + 8 * c) = o; }
    LDS_WAIT(); asm volatile("" ::: "memory");
}
__device__ const double kRopeRev[32] = {
    0.15915494309189535, 0.10561541722123227, 0.0700865215877985, 0.046509502471476706, 0.03086376340470123, 0.020481231595318977, 0.013591370636193905, 0.009019250376164549,
    0.005985185712713705, 0.00397177664679776, 0.002635675898667414, 0.001749037788521446, 0.001160663641240061, 0.0007702178288757531, 0.0005111175045375439, 0.00033917820861925017,
    0.00022507907903927653, 0.00014936275542995963, 9.911730936901935e-05, 6.577436917438735e-05, 4.364795279280289e-05, 2.8964835496204437e-05, 1.9221100684944863e-05, 1.2755146204410543e-05,
    8.464330808241401e-06, 5.616940400618127e-06, 3.727408601915352e-06, 2.473512961630074e-06, 1.6414262627950345e-06, 1.0892524995776498e-06, 7.228293068832865e-07, 4.796704226907546e-07};

__device__ __forceinline__ void norm_rows_bf16(Frame& F, const float* src, const float* gain, bf16* dst) {
    LANE_IDS();
    const int gw = F.vcu * NWAVES + wave, NGW = F.G * NWAVES;
    f32x4 g[8];
#pragma unroll
    for (int j = 0; j < 8; ++j) g[j] = *(const f32x4*)(gain + 4 * lane + 256 * j);
    for (int m = gw; m < M; m += NGW) {
        const GAS f32x4* xr = (const GAS f32x4*)(src + (size_t)m * DM) + lane;
        f32x4 v[8]; float s = 0.f;
#pragma unroll
        for (int j = 0; j < 8; ++j) { v[j] = xr[64 * j]; s += dot4(v[j]); }
        const float r = 1.0f / sqrtf(wave_sum(s) * (1.0f / DM) + EPS);
        GAS v2u* o8 = (GAS v2u*)(dst + (size_t)m * DM) + lane;
#pragma unroll
        for (int j = 0; j < 8; ++j) { const f32x4 y = (v[j] * r) * g[j]; v2u w; w.x = pk2(y.x, y.y); w.y = pk2(y.z, y.w); o8[64 * j] = w; }
    }
}
__device__ __forceinline__ void norm_rows_f32_inplace(Frame& F, float* x, const float* gain) {
    LANE_IDS();
    const int gw = F.vcu * NWAVES + wave, NGW = F.G * NWAVES;
    f32x4 g[8];
#pragma unroll
    for (int j = 0; j < 8; ++j) g[j] = *(const f32x4*)(gain + 4 * lane + 256 * j);
    for (int m = gw; m < M; m += NGW) {
        GAS f32x4* xr = (GAS f32x4*)(x + (size_t)m * DM) + lane;
        f32x4 v[8]; float s = 0.f;
#pragma unroll
        for (int j = 0; j < 8; ++j) { v[j] = xr[64 * j]; s += dot4(v[j]); }
        const float r = 1.0f / sqrtf(wave_sum(s) * (1.0f / DM) + EPS);
#pragma unroll
        for (int j = 0; j < 8; ++j) xr[64 * j] = (v[j] * r) * g[j];
    }
}

__device__ __forceinline__ void p0_prologue(Frame& F) {
    LANE_IDS();
    LAS float* scr = (LAS float*)(F.lds + RING_OFF + wave * 16384);
    const int gw = F.vcu * NWAVES + wave, NGW = F.G * NWAVES;
    unsigned char* ws = F.wsb;
    constexpr int I0 = 32 * 16, I1 = 32 * 18, I2 = 8 * 96, I3 = 8 * 128, I4 = 32 * 64, I5 = 32 * 576, I6 = 32 * 64, I7 = 32 * 352, I8 = 88 * 64;
    constexpr int NITEMS = 2 * (I0 + I1 + I2 + I3 + I4 + I5 + I6) + 4 * (I7 + I8);
    for (int it = gw; it < NITEMS; it += NGW) {
        int r = it;
        if (r < 2 * I5) { const int l = r / I5; p0_transpose_item<2>((const float*)karg(12) + (size_t)l * DM * NDIL, DM, NDIL, (bf16*)(ws + WS_WDIL + l * WDIL_STRIDE + WDIL_IN), 0, scr, r - l * I5, lane); continue; } r -= 2 * I5;
        if (r < 4 * I7) { const int l = r / I7; p0_transpose_item<4>((const float*)karg(14) + (size_t)l * DM * NUP, DM, NUP, (bf16*)(ws + WS_WFFN + l * WFFN_STRIDE + WFFN_UP), 0, scr, r - l * I7, lane); continue; } r -= 4 * I7;
        if (r < 4 * I8) { const int l = r / I8; p0_transpose_item<0>((const float*)karg(17) + (size_t)l * FF * DM, FF, DM, (bf16*)(ws + WS_WFFN + l * WFFN_STRIDE + WFFN_DOWN), 0, scr, r - l * I8, lane); continue; } r -= 4 * I8;
        if (r < 2 * I6) { const int l = r / I6; p0_transpose_item<0>((const float*)karg(13) + (size_t)l * DM * DM, DM, DM, (bf16*)(ws + WS_WDIL + l * WDIL_STRIDE + WDIL_WO), 0, scr, r - l * I6, lane); continue; } r -= 2 * I6;
        if (r < 2 * I4) { const int l = r / I4; p0_transpose_item<0>((const float*)karg(11) + (size_t)l * DM * DM, DM, DM, (bf16*)(ws + WS_WMLA + l * WMLA_STRIDE + WMLA_WO), 0, scr, r - l * I4, lane); continue; } r -= 2 * I4;
        if (r < 2 * I3) { const int l = r / I3; p0_transpose_item<0>((const float*)karg(10) + (size_t)l * 512 * NKVB, 512, NKVB, (bf16*)(ws + WS_WMLA + l * WMLA_STRIDE + WMLA_KVB), 0, scr, r - l * I3, lane); continue; } r -= 2 * I3;
        if (r < 2 * I2) { const int l = r / I2; p0_transpose_item<1>((const float*)karg(7) + (size_t)l * 512 * NQB, 512, NQB, (bf16*)(ws + WS_WMLA + l * WMLA_STRIDE + WMLA_QB), 0, scr, r - l * I2, lane); continue; } r -= 2 * I2;
        if (r < 2 * I1) { const int l = r / I1; p0_transpose_item<0>((const float*)karg(8) + (size_t)l * DM * 576, DM, 576, (bf16*)(ws + WS_WMLA + l * WMLA_STRIDE + WMLA_QKVA), 512, scr, r - l * I1, lane); continue; } r -= 2 * I1;
        { const int l = r / I0; p0_transpose_item<0>((const float*)karg(5) + (size_t)l * DM * 512, DM, 512, (bf16*)(ws + WS_WMLA + l * WMLA_STRIDE + WMLA_QKVA), 0, scr, r - l * I0, lane); }
    }
    const int gt = F.vcu * (NWAVES * 64) + tid, NGT = F.G * NWAVES * 64;
    for (int i = gt; i < 2 * 192 * DM / 8; i += NGT) { const int l = i / (192 * DM / 8), e = i - l * (192 * DM / 8);
        *((GAS v4u*)(ws + WS_WMLA + l * WMLA_STRIDE + WMLA_QKVA + (size_t)1088 * DM * 2) + e) = (v4u){0u, 0u, 0u, 0u}; }
    const int* pos = (const int*)karg(1);
    for (int i = gt; i < M * 32; i += NGT) { const int row = i >> 5, k = i & 31;
        const double rev = (double)pos[row] * kRopeRev[k]; const float fr = (float)(rev - __builtin_rint(rev));
        const float c = __builtin_amdgcn_cosf(fr), s = __builtin_amdgcn_sinf(fr);
        ((float*)(ws + WS_COSM))[i] = c; ((float*)(ws + WS_SINM))[i] = s;
        if ((k & 1) == 0) { ((float*)(ws + WS_COSD))[row * 16 + (k >> 1)] = c; ((float*)(ws + WS_SIND))[row * 16 + (k >> 1)] = s; } }
    norm_rows_bf16(F, (const float*)karg(0), (const float*)karg(2), (bf16*)(ws + WS_H));
}

__device__ __forceinline__ void mla_mid(Frame& F, int j) {
    LANE_IDS();
    const int gw = F.vcu * NWAVES + wave, NGW = F.G * NWAVES;
    unsigned char* ws = F.wsb;
    const float* qkva = (const float*)(ws + WS_S + S_QKVA);
    bf16* QN = (bf16*)(ws + WS_S + S_QN); bf16* CK = (bf16*)(ws + WS_S + S_CKVN); bf16* KPE = (bf16*)(ws + WS_S + S_KPE);
    const float* gq = (const float*)karg(6) + j * 512; const float* gk = (const float*)karg(9) + j * 512;
    const float* cosM = (const float*)(ws + WS_COSM); const float* sinM = (const float*)(ws + WS_SINM);
    f32x4 g1[2], g2[2];
#pragma unroll
    for (int t = 0; t < 2; ++t) { g1[t] = *(const f32x4*)(gq + 4 * lane + 256 * t); g2[t] = *(const f32x4*)(gk + 4 * lane + 256 * t); }
    for (int m = gw; m < M; m += NGW) {
        const float* row = qkva + (size_t)m * NQKVA;
        f32x4 a[2], c[2];
#pragma unroll
        for (int t = 0; t < 2; ++t) { a[t] = *(const GAS f32x4*)(row + 4 * lane + 256 * t); c[t] = *(const GAS f32x4*)(row + 512 + 4 * lane + 256 * t); }
        const float kp = row[1024 + lane];
        const float cs = cosM[(size_t)m * 32 + (lane & 31)], sn = sinM[(size_t)m * 32 + (lane & 31)];
        const float ra = 1.0f / sqrtf(wave_sum(dot4(a[0]) + dot4(a[1])) * (1.0f / 512) + EPS);
        const float rc = 1.0f / sqrtf(wave_sum(dot4(c[0]) + dot4(c[1])) * (1.0f / 512) + EPS);
#pragma unroll
        for (int t = 0; t < 2; ++t) { const f32x4 y = (a[t] * ra) * g1[t], z = (c[t] * rc) * g2[t]; v2u w;
            w.x = pk2(y.x, y.y); w.y = pk2(y.z, y.w); *((GAS v2u*)(QN + (size_t)m * 512 + 256 * t) + lane) = w;
            w.x = pk2(z.x, z.y); w.y = pk2(z.z, z.w); *((GAS v2u*)(CK + (size_t)m * 512 + 256 * t) + lane) = w; }
        const float pp = xor32(kp);
        const float ro = lane < 32 ? kp * cs - pp * sn : kp * cs + pp * sn;
        const float rn = xor1(ro);
        if ((lane & 1) == 0) *(GAS unsigned*)(KPE + (size_t)m * 64 + lane) = pk2(ro, rn);
    }
}

__device__ __forceinline__ void ffn_conv(Frame& F, int layer) {
    LANE_IDS();
    const int gw = F.vcu * NWAVES + wave, NGW = F.G * NWAVES;
    unsigned char* ws = F.wsb;
    const bf16* U = (const bf16*)(ws + WS_S + S_U); bf16* ACT = (bf16*)(ws + WS_S + S_ACT);
    const float* cw = (const float*)karg(15) + (size_t)layer * 3 * NUP; const float* cb = (const float*)karg(16) + (size_t)layer * NUP;
    constexpr int NSTRIP = M / 32, NCW = FF / 512, NIT = NSTRIP * NCW;
    for (int it = gw; it < NIT; it += NGW) {
        const int strip = it / NCW, cwv = it - strip * NCW, c0 = cwv * 512 + lane * 8, t0 = strip * 32;
        float wg[3][8], wv[3][8], bg[8], bv[8];
#pragma unroll
        for (int k = 0; k < 3; ++k)
#pragma unroll
            for (int e = 0; e < 8; e += 4) { const f32x4 a = *(const f32x4*)(cw + (size_t)k * NUP + c0 + e), b = *(const f32x4*)(cw + (size_t)k * NUP + FF + c0 + e);
                wg[k][e] = a.x; wg[k][e + 1] = a.y; wg[k][e + 2] = a.z; wg[k][e + 3] = a.w; wv[k][e] = b.x; wv[k][e + 1] = b.y; wv[k][e + 2] = b.z; wv[k][e + 3] = b.w; }
#pragma unroll
        for (int e = 0; e < 8; e += 4) { const f32x4 a = *(const f32x4*)(cb + c0 + e), b = *(const f32x4*)(cb + FF + c0 + e);
            bg[e] = a.x; bg[e + 1] = a.y; bg[e + 2] = a.z; bg[e + 3] = a.w; bv[e] = b.x; bv[e + 1] = b.y; bv[e + 2] = b.z; bv[e + 3] = b.w; }
        float g2[8], g1[8], v2[8], v1[8];
        if ((t0 & (SEQ - 1)) == 0) {
#pragma unroll
            for (int e = 0; e < 8; ++e) { g2[e] = 0.f; g1[e] = 0.f; v2[e] = 0.f; v1[e] = 0.f; }
        } else {
            const v4u a2 = *(const GAS v4u*)(U + (size_t)(t0 - 2) * NUP + c0), a1 = *(const GAS v4u*)(U + (size_t)(t0 - 1) * NUP + c0);
            const v4u b2 = *(const GAS v4u*)(U + (size_t)(t0 - 2) * NUP + FF + c0), b1 = *(const GAS v4u*)(U + (size_t)(t0 - 1) * NUP + FF + c0);
#pragma unroll
            for (int q = 0; q < 4; ++q) { g2[2 * q] = bf_lo(a2[q]); g2[2 * q + 1] = bf_hi(a2[q]); g1[2 * q] = bf_lo(a1[q]); g1[2 * q + 1] = bf_hi(a1[q]);
                                          v2[2 * q] = bf_lo(b2[q]); v2[2 * q + 1] = bf_hi(b2[q]); v1[2 * q] = bf_lo(b1[q]); v1[2 * q + 1] = bf_hi(b1[q]); }
        }
#pragma unroll 4
        for (int r = 0; r < 32; ++r) {
            const v4u a0 = *(const GAS v4u*)(U + (size_t)(t0 + r) * NUP + c0), b0 = *(const GAS v4u*)(U + (size_t)(t0 + r) * NUP + FF + c0);
            float g0[8], v0[8], o[8];
#pragma unroll
            for (int q = 0; q < 4; ++q) { g0[2 * q] = bf_lo(a0[q]); g0[2 * q + 1] = bf_hi(a0[q]); v0[2 * q] = bf_lo(b0[q]); v0[2 * q + 1] = bf_hi(b0[q]); }
#pragma unroll
            for (int e = 0; e < 8; ++e) {
                const float gt_ = bg[e] + wg[0][e] * g2[e] + wg[1][e] * g1[e] + wg[2][e] * g0[e];
                const float vl = bv[e] + wv[0][e] * v2[e] + wv[1][e] * v1[e] + wv[2][e] * v0[e];
                o[e] = gt_ / (1.0f + __expf(-gt_)) * vl;
                g2[e] = g1[e]; g1[e] = g0[e]; v2[e] = v1[e]; v1[e] = v0[e]; }
            v4u w; w.x = pk2(o[0], o[1]); w.y = pk2(o[2], o[3]); w.z = pk2(o[4], o[5]); w.w = pk2(o[6], o[7]);
            *(GAS v4u*)(ACT + (size_t)(t0 + r) * FF + c0) = w;
        }
    }
}

__device__ __forceinline__ void dil_merge(Frame& F) {
    LANE_IDS();
    const int gw = F.vcu * NWAVES + wave, NGW = F.G * NWAVES;
    unsigned char* ws = F.wsb;
    const bf16* OG = (const bf16*)(ws + WS_S + S_OG); const float* LSE = (const float*)(ws + WS_S + S_LSE); bf16* AO = (bf16*)(ws + WS_S + S_AO_DIL);
    for (int m = gw; m < M; m += NGW) {
        const int b = m >> 12, s = m & (SEQ - 1);
        const size_t sp0 = s, sp1 = (size_t)(s & 3) * (SEQ / 4) + (s >> 2), sp2 = (size_t)(s & 15) * (SEQ / 16) + (s >> 4);
#pragma unroll
        for (int j = 0; j < 4; ++j) { const int col = 8 * lane + 512 * j, head = col >> 7, dim = col & 127;
            const size_t r0 = ((size_t)(0 * 16 + head) * BATCH + b) * SEQ + sp0, r1 = ((size_t)(1 * 16 + head) * BATCH + b) * SEQ + sp1, r2 = ((size_t)(2 * 16 + head) * BATCH + b) * SEQ + sp2;
            const float l0 = LSE[r0], l1 = LSE[r1], l2 = LSE[r2];
            const float mx = fmaxf(l0, fmaxf(l1, l2)); float e0 = __expf(l0 - mx), e1 = __expf(l1 - mx), e2 = __expf(l2 - mx);
            const float inv = 1.0f / (e0 + e1 + e2); e0 *= inv; e1 *= inv; e2 *= inv;
            const v4u a = *(const GAS v4u*)(OG + r0 * 128 + dim), bb = *(const GAS v4u*)(OG + r1 * 128 + dim), c = *(const GAS v4u*)(OG + r2 * 128 + dim);
            v4u w;
#pragma unroll
            for (int q = 0; q < 4; ++q) w[q] = pk2(e0 * bf_lo(a[q]) + e1 * bf_lo(bb[q]) + e2 * bf_lo(c[q]), e0 * bf_hi(a[q]) + e1 * bf_hi(bb[q]) + e2 * bf_hi(c[q]));
            *(GAS v4u*)(AO + (size_t)m * DM + col) = w; }
    }
}

__device__ __forceinline__ void ffn_fixup(Frame& F, int layer, int pm) {
    LANE_IDS();
    if ((pm & 15) == 0) return;
    unsigned char* ws = F.wsb;
    const float* HALO = (const float*)(ws + WS_HALO); const float* FIX = (const float*)(ws + WS_FIX); bf16* ACT = (bf16*)(ws + WS_S + S_ACT);
    const float* cw = (const float*)karg(15) + (size_t)layer * 3 * NUP;
    for (int idx = tid; idx < 2 * (FF / 8); idx += NWAVES * 64) { const int rs = idx / (FF / 8), ch = (idx - rs * (FF / 8)) * 8;
        float o[8];
#pragma unroll
        for (int e = 0; e < 8; e += 4) {
            f32x4 cg = *(const GAS f32x4*)(FIX + ((size_t)pm * 2 + rs) * NUP + ch + e), cv = *(const GAS f32x4*)(FIX + ((size_t)pm * 2 + rs) * NUP + FF + ch + e);
            const f32x4 u1g = *(const GAS f32x4*)(HALO + ((size_t)(pm - 1) * 2 + 1) * NUP + ch + e), u1v = *(const GAS f32x4*)(HALO + ((size_t)(pm - 1) * 2 + 1) * NUP + FF + ch + e);
            const f32x4 u2g = *(const GAS f32x4*)(HALO + ((size_t)(pm - 1) * 2 + 0) * NUP + ch + e), u2v = *(const GAS f32x4*)(HALO + ((size_t)(pm - 1) * 2 + 0) * NUP + FF + ch + e);
            const f32x4 w0g = *(const f32x4*)(cw + ch + e), w0v = *(const f32x4*)(cw + FF + ch + e), w1g = *(const f32x4*)(cw + NUP + ch + e), w1v = *(const f32x4*)(cw + NUP + FF + ch + e);
            if (rs == 0) { cg = cg + w1g * u1g + w0g * u2g; cv = cv + w1v * u1v + w0v * u2v; } else { cg = cg + w0g * u1g; cv = cv + w0v * u1v; }
#pragma unroll
            for (int k = 0; k < 4; ++k) o[e + k] = cg[k] * __builtin_amdgcn_rcpf(1.0f + __builtin_amdgcn_exp2f(-1.4426950408889634f * cg[k])) * cv[k]; }
        v4u w; w.x = pk2(o[0], o[1]); w.y = pk2(o[2], o[3]); w.z = pk2(o[4], o[5]); w.w = pk2(o[6], o[7]);
        *(GAS v4u*)(ACT + ((size_t)pm * 256 + rs) * FF + ch) = w; }
}

struct MlaRef {
    const bf16* Q; const bf16* KV; const bf16* KPE; bf16* AO; int vcu;
    __device__ __forceinline__ att::BlockRef operator()(int i) const {
        const int I = vcu + 256 * (i >> 1), bh = I >> 3, x = I & 7, qb = (i & 1) ? 15 - x : x, b = bh >> 4, h = bh & 15;
        const size_t row0 = (size_t)b * SEQ + (size_t)qb * 256;
        att::BlockRef r; r.Q = Q + row0 * NQB + h * 128; r.Qpe = Q + row0 * NQB + 2048 + h * 64;
        r.K = KV + (size_t)b * SEQ * NKVB + h * 256; r.V = r.K + 128; r.Kpe = KPE + (size_t)b * SEQ * 64;
        r.O = AO + row0 * DM + h * 128; r.Lse = nullptr; r.P0 = qb * 256; return r;
    }
};
struct DilRef {
    const bf16* QKV; bf16* OG; float* LSE; int vcu, g;
    __device__ __forceinline__ att::BlockRef operator()(int i) const {
        const int I = vcu + 256 * i, sh = 2 * g, d = 1 << sh, nqbs = 4 - sh;
        const int seq = I >> nqbs, qb = I & ((1 << nqbs) - 1), h = seq & 15, br = seq >> 4, rr = br & (d - 1), b = br >> sh;
        const size_t sp0 = (size_t)rr * (SEQ >> sh), spq = sp0 + (size_t)qb * 256;
        const size_t hb = ((size_t)(g * 3) * 16 + h) * BATCH + b, tstep = (size_t)16 * BATCH * SEQ * 128;
        att::BlockRef r; r.Q = QKV + (hb * SEQ + spq) * 128; r.Qpe = nullptr; r.Kpe = nullptr;
        r.K = QKV + tstep + (hb * SEQ + sp0) * 128; r.V = r.K + tstep;
        const size_t ob = ((size_t)g * 16 + h) * BATCH + b;
        r.O = OG + (ob * SEQ + spq) * 128; r.Lse = LSE + ob * SEQ + spq; r.P0 = qb * 256; return r;
    }
};
template <bool PE, bool SK, bool LSE, bool EARLY, class RefFn>
__device__ __forceinline__ void attn_run(char* lds, const att::Prm& P, int n, const RefFn& ref) {
    att::BlockRef cur = ref(0); att::Seam<PE> S;
    att::swa_prime<PE>(cur, P, lds, S);
    for (int i = 0;; ++i) {
        const bool last = i + 1 >= n;
        const att::BlockRef nxt = last ? cur : ref(i + 1);
        att::swa_block<PE, SK, LSE, EARLY>(cur, nxt, P, lds, S);
        if (last) break;
        cur = nxt;
    }
}

struct Args { const void* in[18]; float* out; unsigned char* ws; };
__global__ void __launch_bounds__(NWAVES * 64, 2) fwd_kernel(Args args) {
    extern __shared__ __attribute__((aligned(16))) unsigned char lds[];
    Frame F;
    F.lds = (LAS unsigned char*)lds;
    F.MISC = (volatile LAS unsigned*)(F.lds + MISC_OFF);
    F.G = gridDim.x; { const int bx = blockIdx.x; F.vcu = (F.G % 8 == 0) ? (bx % 8) * (F.G / 8) + bx / 8 : bx; }
        F.out = args.out; F.wsb = args.ws;
    F.ctl = (gu32*)(args.ws + WS_CTL);
#define ws F.wsb
#define RELAUNDER() asm volatile("" : "+s"(F.vcu), "+s"(F.wsb), "+s"(F.out))
    for (int u = threadIdx.x; u < (LDS_BYTES - LDSCTL_OFF) / 4; u += NWAVES * 64) ((LAS unsigned*)(F.lds + LDSCTL_OFF))[u] = 0u;
    __syncthreads();
    XcdBarrier bar = xcd_barrier_post((unsigned*)(F.ctl + CW_BAR), F.MISC + 8);
#if PROBE_DUP & 1024
#define GRID_BAR() do { xcd_barrier(bar); xcd_barrier(bar); } while (0)
#else
#define GRID_BAR() xcd_barrier(bar)
#endif
    typedef pg8::StaticOrder SO;
#define GEMMR(EpiT, Aptr, Bptr, N_, K_, Eobj, REP_) do { pg8::Gemm g_{(const bf16*)(Aptr), (const bf16*)(Bptr), M, (N_), (K_)}; SO S_; S_.init(M, (N_), F.G, (int)blockIdx.x); \
        pg8::gemm_phase<EpiT, SO, true, true, REP_>(F.lds + RING_OFF, g_, S_, (Eobj)); } while (0)
#define GEMM(EpiT, Aptr, Bptr, N_, K_, Eobj) GEMMR(EpiT, Aptr, Bptr, N_, K_, Eobj, 1)

    bf16* H = (bf16*)(ws + WS_H);
    const float* cosM = (const float*)(ws + WS_COSM); const float* sinM = (const float*)(ws + WS_SINM);
    const float* cosD = (const float*)(ws + WS_COSD); const float* sinD = (const float*)(ws + WS_SIND);

    p0_prologue(F);
#if PROBE_DUP & 64
    p0_prologue(F);
#endif
    GRID_BAR();

    for (int j = 0; j < 2; ++j) {
        {
            RELAUNDER();
            const unsigned char* wl = ws + WS_WMLA + j * WMLA_STRIDE;
            float* QKVA = (float*)(ws + WS_S + S_QKVA); bf16* QN = (bf16*)(ws + WS_S + S_QN); bf16* CK = (bf16*)(ws + WS_S + S_CKVN); bf16* KPE = (bf16*)(ws + WS_S + S_KPE);
            bf16* Q = (bf16*)(ws + WS_S + S_Q); bf16* KV = (bf16*)(ws + WS_S + S_KV); bf16* AO = (bf16*)(ws + WS_S + S_AO_MLA);
            if (j > 0) {
#if PROBE_DUP & 32
            norm_rows_bf16(F, F.out, (const float*)karg(2) + (2 * j) * DM, H);
#endif
            norm_rows_bf16(F, F.out, (const float*)karg(2) + (2 * j) * DM, H); GRID_BAR(); }
            { pg8::EpiF32Store E{QKVA, NQKVA}; GEMM(pg8::EpiF32Store, H, wl + WMLA_QKVA, NQKVA, DM, E); }
            GRID_BAR();
            mla_mid(F, j);
#if PROBE_DUP & 32
            mla_mid(F, j);
#endif
            GRID_BAR();
            { pg8::EpiQMla E{Q, cosM, sinM}; GEMM(pg8::EpiQMla, QN, wl + WMLA_QB, NQB, 512, E); }
            { pg8::EpiBf16Plain E{KV, NKVB}; GEMM(pg8::EpiBf16Plain, CK, wl + WMLA_KVB, NKVB, 512, E); }
            GRID_BAR();
            RELAUNDER();
            { att::Prm P{NQB, NKVB, DM, NQB, 64, 0, SEQ, SEQ, 0.07216878364870322f};
              MlaRef R{Q, KV, KPE, AO, F.vcu};
              attn_run<true, false, false, false>((char*)lds + RING_OFF, P, 4, R);
#if PROBE_DUP & 1
              attn_run<true, false, false, false>((char*)lds + RING_OFF, P, 4, R);
#endif
            }
            GRID_BAR();
#if PROBE_DUP & 128
            { pg8::EpiRes E{(const float*)F.out, (float*)(ws + WS_S + S_KV), DM}; GEMM(pg8::EpiRes, AO, wl + WMLA_WO, DM, DM, E); }
#endif
            { pg8::EpiRes E{j == 0 ? (const float*)karg(0) : (const float*)F.out, F.out, DM}; GEMM(pg8::EpiRes, AO, wl + WMLA_WO, DM, DM, E); }
            GRID_BAR();
        }
        {
            RELAUNDER();
            const int layer = 2 * j; const unsigned char* wl = ws + WS_WFFN + layer * WFFN_STRIDE;
            bf16* ACT = (bf16*)(ws + WS_S + S_ACT);

#if PROBE_DUP & 32
            norm_rows_bf16(F, F.out, (const float*)karg(3) + layer * DM, H);
#endif
            norm_rows_bf16(F, F.out, (const float*)karg(3) + layer * DM, H); GRID_BAR();
            { pg8::EpiUpConv E{ACT, (float*)(ws + WS_HALO), (float*)(ws + WS_FIX), (const float*)karg(15) + (size_t)layer * 3 * NUP, (const float*)karg(16) + (size_t)layer * NUP,
                               (PG8_LAS float*)(F.lds + XH_OFF), (PG8_LAS float*)(F.lds + CWL_OFF)};
              GEMM(pg8::EpiUpConv, H, wl + WFFN_UP, NUP, DM, E);
#if PROBE_DUP & 4
              GEMM(pg8::EpiUpConv, H, wl + WFFN_UP, NUP, DM, E);
#endif
            }
            GRID_BAR();
            { SO S_; S_.init(M, DM, F.G, (int)blockIdx.x); pg8::Unit u_; for (int i = 0; S_.next(i, u_); ++i) ffn_fixup(F, layer, u_.pm);
              asm volatile("s_waitcnt vmcnt(0)" ::: "memory"); __syncthreads(); }
#if PROBE_DUP & 256
            { pg8::EpiRes E{F.out, (float*)(ws + WS_S + S_U), DM}; GEMM(pg8::EpiRes, ACT, wl + WFFN_DOWN, DM, FF, E); }
#endif
            { pg8::EpiRes E{F.out, F.out, DM}; GEMM(pg8::EpiRes, ACT, wl + WFFN_DOWN, DM, FF, E); }
            GRID_BAR();
        }
        {
            RELAUNDER();
            const unsigned char* wl = ws + WS_WDIL + j * WDIL_STRIDE;
            bf16* QKV = (bf16*)(ws + WS_S + S_QKV); bf16* OG = (bf16*)(ws + WS_S + S_OG); float* LSE = (float*)(ws + WS_S + S_LSE); bf16* AO = (bf16*)(ws + WS_S + S_AO_DIL);

#if PROBE_DUP & 32
            norm_rows_bf16(F, F.out, (const float*)karg(2) + (2 * j + 1) * DM, H);
#endif
            norm_rows_bf16(F, F.out, (const float*)karg(2) + (2 * j + 1) * DM, H); GRID_BAR();
            { pg8::EpiQkvDil E{QKV, cosD, sinD}; GEMM(pg8::EpiQkvDil, H, wl + WDIL_IN, NDIL, DM, E);
#if PROBE_DUP & 8
              GEMM(pg8::EpiQkvDil, H, wl + WDIL_IN, NDIL, DM, E);
#endif
            }
            GRID_BAR();
#pragma unroll 1
            for (int g = 0; g < 3; ++g) { const int d = 1 << (2 * g);
              att::Prm P{128, 128, 128, 0, 0, 1, SEQ / d, 129, 0.08838834764831845f};
              DilRef R{QKV, OG, LSE, F.vcu, g};
              attn_run<false, true, true, true>((char*)lds + RING_OFF, P, 4, R);
#if PROBE_DUP & 2
              attn_run<false, true, true, true>((char*)lds + RING_OFF, P, 4, R);
#endif
            }
            GRID_BAR();
            dil_merge(F);
#if PROBE_DUP & 32
            dil_merge(F);
#endif
            GRID_BAR();
#if PROBE_DUP & 128
            { pg8::EpiRes E{F.out, (float*)(ws + WS_S + S_QKV), DM}; GEMM(pg8::EpiRes, AO, wl + WDIL_WO, DM, DM, E); }
#endif
            { pg8::EpiRes E{F.out, F.out, DM}; GEMM(pg8::EpiRes, AO, wl + WDIL_WO, DM, DM, E); }
            GRID_BAR();
        }
        {
            RELAUNDER();
            const int layer = 2 * j + 1; const unsigned char* wl = ws + WS_WFFN + layer * WFFN_STRIDE;
            bf16* ACT = (bf16*)(ws + WS_S + S_ACT);

#if PROBE_DUP & 32
            norm_rows_bf16(F, F.out, (const float*)karg(3) + layer * DM, H);
#endif
            norm_rows_bf16(F, F.out, (const float*)karg(3) + layer * DM, H); GRID_BAR();
            { pg8::EpiUpConv E{ACT, (float*)(ws + WS_HALO), (float*)(ws + WS_FIX), (const float*)karg(15) + (size_t)layer * 3 * NUP, (const float*)karg(16) + (size_t)layer * NUP,
                               (PG8_LAS float*)(F.lds + XH_OFF), (PG8_LAS float*)(F.lds + CWL_OFF)};
              GEMM(pg8::EpiUpConv, H, wl + WFFN_UP, NUP, DM, E);
#if PROBE_DUP & 4
              GEMM(pg8::EpiUpConv, H, wl + WFFN_UP, NUP, DM, E);
#endif
            }
            GRID_BAR();
            { SO S_; S_.init(M, DM, F.G, (int)blockIdx.x); pg8::Unit u_; for (int i = 0; S_.next(i, u_); ++i) ffn_fixup(F, layer, u_.pm);
              asm volatile("s_waitcnt vmcnt(0)" ::: "memory"); __syncthreads(); }
#if PROBE_DUP & 256
            { pg8::EpiRes E{F.out, (float*)(ws + WS_S + S_U), DM}; GEMM(pg8::EpiRes, ACT, wl + WFFN_DOWN, DM, FF, E); }
#endif
            { pg8::EpiRes E{F.out, F.out, DM}; GEMM(pg8::EpiRes, ACT, wl + WFFN_DOWN, DM, FF, E); }
            GRID_BAR();
        }
    }
    RELAUNDER();
    norm_rows_f32_inplace(F, F.out, (const float*)karg(4));
#undef ws
#undef RELAUNDER
#undef GEMM
#undef GEMMR
#undef GRID_BAR
}

extern "C" void kernel_launch(void* const* d_in, const int* in_sizes, int n_in, void* d_out, int out_size, void* d_ws, size_t ws_size, hipStream_t stream) {
    static int grid = 0;
    if (grid == 0) {
        if (n_in != 18 || in_sizes[0] != M * DM || out_size != M * DM || ws_size < WS_END) {
            fprintf(stderr, "kernel_launch: shape / workspace mismatch (n_in %d, in0 %d, out %d, ws %zu, need %zu); nothing launched\n", n_in, n_in > 0 ? in_sizes[0] : -1, out_size, ws_size, (size_t)WS_END); grid = -1; return; }
        int dev = 0, cus = 0, per_cu = 0;
        if (hipGetDevice(&dev) != hipSuccess || hipDeviceGetAttribute(&cus, hipDeviceAttributeMultiprocessorCount, dev) != hipSuccess) { grid = -1; return; }
        if (hipFuncSetAttribute((const void*)fwd_kernel, hipFuncAttributeMaxDynamicSharedMemorySize, LDS_BYTES) != hipSuccess) { fprintf(stderr, "kernel_launch: hipFuncSetAttribute failed\n"); grid = -1; return; }
        if (hipOccupancyMaxActiveBlocksPerMultiprocessor(&per_cu, (const void*)fwd_kernel, NWAVES * 64, LDS_BYTES) != hipSuccess || per_cu < 1) fprintf(stderr, "kernel_launch: occupancy query reports %d\n", per_cu);
        (void)hipGetLastError();
        if (cus < 256) { fprintf(stderr, "kernel_launch: built for a 256-CU device, found %d CUs; nothing launched\n", cus); grid = -1; return; }
        grid = 256;
    }
    if (grid < 0) return;
    if (hipMemsetAsync((char*)d_ws + WS_CTL, 0, CTL_ZERO_BYTES, stream) != hipSuccess) return;
    Args a{};
    for (int i = 0; i < 18; ++i) a.in[i] = d_in[i];
    a.out = (float*)d_out; a.ws = (unsigned char*)d_ws;
    hipLaunchKernelGGL(fwd_kernel, dim3(grid), dim3(NWAVES * 64), LDS_BYTES, stream, a);
}
```

```cpp
#include <hip/hip_runtime.h>
#include <cstdio>
#include <cstdint>
#ifndef PROBE_DUP
#define PROBE_DUP 0
#endif
namespace pg8 {
#define PG8_LAS __attribute__((address_space(3)))
typedef unsigned short bf16_t;
typedef short bf16x8 __attribute__((ext_vector_type(8)));
typedef float f32x4 __attribute__((ext_vector_type(4)));
typedef unsigned u32x4 __attribute__((ext_vector_type(4)));
constexpr int BM = 256, BK = 64, HALF = 128, HTB = HALF * BK * 2  , STAGE_BYTES = 8 * HTB, NXCD = 8, WGM = 8;

__host__ __device__ __forceinline__ int lds_byte(int r, int c) { const int st = (r >> 4) * 2 + (c >> 5), rr = r & 15, cc = c & 31, ob = rr * 64 + cc * 2; return st * 1024 + (ob ^ (((ob >> 9) & 1) << 5)); }
__host__ __device__ __forceinline__ void stage_rc(int b, int& R, int& C) { const int st = b / 1024, sb = b % 1024, swz = sb ^ (((sb >> 9) & 1) << 5); R = (st >> 1) * 16 + swz / 64; C = (st & 1) * 32 + (swz % 64) / 2; }
__host__ __device__ __forceinline__ int perm32(int rho) { const int n = rho >> 4, i = rho & 15; return 8 * (i >> 2) + 4 * n + (i & 3); }

struct Unit { int pm, pn; };
struct Gemm { const bf16_t* A; const bf16_t* Bt; int M, N, K; };

struct StaticOrder {
    int nM, nN, nwg, G, c;
    __host__ __device__ void init(int M, int N, int G_, int c_) { nM = M / BM; nN = N / BM; nwg = nM * nN; G = G_; c = c_; }
    __host__ __device__ __forceinline__ bool next(int i, Unit& u) const {
        const long L = (long)i * G + c; if (L >= nwg) return false;
        int wgid = (int)L; { const int q = nwg / NXCD, r = nwg % NXCD, xcd = wgid % NXCD, off = wgid / NXCD; wgid = (xcd < r ? xcd * (q + 1) : r * (q + 1) + (xcd - r) * q) + off; }
        const int nig = WGM * nN, gid = wgid / nig, fm = gid * WGM, gsz = (nM - fm) < WGM ? (nM - fm) : WGM;
        u.pm = fm + ((wgid % nig) % gsz); u.pn = (wgid % nig) / gsz; return true;
    }
    __device__ __forceinline__ void a_ready(const Unit&) const {}
    __device__ __forceinline__ void done(const Unit&) const {}
};

__device__ __forceinline__ unsigned cvt_pk_bf16(float lo, float hi) { unsigned r; asm volatile("v_cvt_pk_bf16_f32 %0, %1, %2" : "=v"(r) : "v"(lo), "v"(hi)); return r; }
typedef float f32x2 __attribute__((ext_vector_type(2)));
typedef unsigned u32x2 __attribute__((ext_vector_type(2)));
__device__ __forceinline__ u32x4 pack8bf(const f32x4 a, const f32x4 b) { u32x4 w; w.x = cvt_pk_bf16(a[0], a[1]); w.y = cvt_pk_bf16(a[2], a[3]); w.z = cvt_pk_bf16(b[0], b[1]); w.w = cvt_pk_bf16(b[2], b[3]); return w; }
#define PG8_NOPRE struct Pre {}; __device__ __forceinline__ void pre_issue(Pre&, const Unit&, int, int) const {} __device__ __forceinline__ void pre_finish(Pre&, int, int) const {}
struct EpiF32Store {
    PG8_NOPRE
    static constexpr bool PERM = false, AFTER_DRAIN = false;
    float* C; int ldc;
    __device__ __forceinline__ void operator()(const f32x4 (&acc)[2][2][4][2], const Unit& u, int wr, int wc, int fr, int fq, int ui) const {
        const int row0 = u.pm * BM + wr * 64 + fr, col0 = u.pn * BM + wc * 32 + 4 * fq;
#pragma unroll
        for (int ai = 0; ai < 2; ++ai)
#pragma unroll
            for (int m = 0; m < 4; ++m) { float* rowp = C + (size_t)(row0 + ai * HALF + m * 16) * ldc + col0;
#pragma unroll
                for (int bj = 0; bj < 2; ++bj)
#pragma unroll
                    for (int n = 0; n < 2; ++n) *(f32x4*)(rowp + bj * HALF + n * 16) = acc[ai][bj][m][n]; }
    }
};
struct EpiRes {
    PG8_NOPRE
    static constexpr bool PERM = false, AFTER_DRAIN = false;
    const float* base; float* out; int ldc;
    __device__ __forceinline__ void operator()(const f32x4 (&acc)[2][2][4][2], const Unit& u, int wr, int wc, int fr, int fq, int ui) const {
        const int row0 = u.pm * BM + wr * 64 + fr, col0 = u.pn * BM + wc * 32 + 4 * fq;
#pragma unroll
        for (int ai = 0; ai < 2; ++ai) {
            f32x4 bs[4][2][2];
#pragma unroll
            for (int m = 0; m < 4; ++m) { const size_t off = (size_t)(row0 + ai * HALF + m * 16) * ldc + col0;
#pragma unroll
                for (int bj = 0; bj < 2; ++bj)
#pragma unroll
                    for (int n = 0; n < 2; ++n) bs[m][bj][n] = *(const f32x4*)(base + off + bj * HALF + n * 16); }
#pragma unroll
            for (int m = 0; m < 4; ++m) { const size_t off = (size_t)(row0 + ai * HALF + m * 16) * ldc + col0;
#pragma unroll
                for (int bj = 0; bj < 2; ++bj)
#pragma unroll
                    for (int n = 0; n < 2; ++n) *(f32x4*)(out + off + bj * HALF + n * 16) = bs[m][bj][n] + acc[ai][bj][m][n]; }
            asm volatile("" ::: "memory"); }
    }
};
struct EpiBf16Plain {
    PG8_NOPRE
    static constexpr bool PERM = true, AFTER_DRAIN = false;
    bf16_t* O; int ldc;
    __device__ __forceinline__ void operator()(const f32x4 (&acc)[2][2][4][2], const Unit& u, int wr, int wc, int fr, int fq, int ui) const {
        const int row0 = u.pm * BM + wr * 64 + fr, col0 = u.pn * BM + wc * 32 + 8 * fq;
#pragma unroll
        for (int ai = 0; ai < 2; ++ai)
#pragma unroll
            for (int m = 0; m < 4; ++m) { bf16_t* rowp = O + (size_t)(row0 + ai * HALF + m * 16) * ldc + col0;
#pragma unroll
                for (int bj = 0; bj < 2; ++bj) *(u32x4*)(rowp + bj * HALF) = pack8bf(acc[ai][bj][m][0], acc[ai][bj][m][1]); }
    }
};

#define PG8_DPP(old_, src_, ctrl_) __uint_as_float((unsigned)__builtin_amdgcn_update_dpp((int)__float_as_uint(old_), (int)__float_as_uint(src_), (ctrl_), 0xF, 0xF, false))
struct EpiUpConv {
    static constexpr bool PERM = true, AFTER_DRAIN = false;
    bf16_t* ACT; float* HALO; float* FIX; const float* cw; const float* cb;
    PG8_LAS float* xh; PG8_LAS float* cwl;
    PG8_NOPRE
    __device__ __forceinline__ void operator()(const f32x4 (&acc)[2][2][4][2], const Unit& u, int wr, int wc, int fr_, int fq_, int ui) const {
        int fr = fr_, fq = fq_; asm volatile("" : "+v"(fr), "+v"(fq));
        const int ch0 = 128 * u.pn + 32 * wc + 8 * fq;
        f32x4 wv = {0.f, 0.f, 0.f, 0.f};
        if (wr == 0) { const int lane = fq * 16 + fr; wv = *(const f32x4*)((wc < 3 ? cw + (size_t)wc * 11264 : cb) + (lane < 32 ? 128 * u.pn + lane * 4 : 5632 + 128 * u.pn + (lane - 32) * 4)); }
        if (fr >= 14) {
#pragma unroll
            for (int ai = 0; ai < 2; ++ai) if (ai == 0 || wr == 0) { PG8_LAS float* b = xh + ((((ai == 0 ? wr : 2) * 4 + wc) * 2 + (fr - 14)) * 4 + fq) * 16;
#pragma unroll
                for (int bj = 0; bj < 2; ++bj)
#pragma unroll
                    for (int n = 0; n < 2; ++n) *(PG8_LAS f32x4*)(b + (bj * 2 + n) * 4) = acc[ai][bj][3][n]; }
            if (wr == 1) { float* hp = HALO + ((size_t)u.pm * 2 + (fr - 14)) * 11264 + ch0;
#pragma unroll
                for (int bj = 0; bj < 2; ++bj)
#pragma unroll
                    for (int n = 0; n < 2; ++n) *(f32x4*)(hp + bj * 5632 + n * 4) = acc[1][bj][3][n]; }
        }
        if (wr == 0) *(PG8_LAS f32x4*)(cwl + wc * 256 + (fq * 16 + fr) * 4) = wv;
        asm volatile("s_waitcnt lgkmcnt(0)" ::: "memory"); __builtin_amdgcn_s_barrier(); asm volatile("" ::: "memory");
        const bool fixtile = (u.pm & 15) != 0;
#pragma unroll
        for (int n = 0; n < 2; ++n) {
            const PG8_LAS float* cwb = cwl + wc * 32 + fq * 8 + n * 4;
#pragma unroll
            for (int ai = 0; ai < 2; ++ai)
#pragma unroll
                for (int m = 0; m < 4; ++m) {
                    f32x4 c[2];
#pragma unroll
                    for (int bj = 0; bj < 2; ++bj) {
                        f32x4 W[4];
#pragma unroll
                        for (int t = 0; t < 4; ++t) W[t] = *(const PG8_LAS f32x4*)(cwb + t * 256 + bj * 128);
                        f32x4 h1 = {0.f, 0.f, 0.f, 0.f}, h2 = {0.f, 0.f, 0.f, 0.f};
                        if (m == 0 && !(ai == 0 && wr == 0)) { const int slot = ai == 0 ? 0 : (wr == 0 ? 1 : 2); const PG8_LAS float* b = xh + (((slot * 4 + wc) * 2) * 4 + fq) * 16 + n * 4 + bj * 8;
                            h2 = *(const PG8_LAS f32x4*)b; h1 = *(const PG8_LAS f32x4*)(b + 64); }
#pragma unroll
                        for (int k = 0; k < 4; ++k) { const float cur = acc[ai][bj][m][n][k]; float x1, z;
                            if (m == 0) { x1 = h1[k]; z = fr == 0 ? h2[k] : h1[k]; }
                            else { const float p = acc[ai][bj][m > 0 ? m - 1 : 0][n][k]; x1 = PG8_DPP(0.f, p, 0x121); z = PG8_DPP(0.f, p, 0x122); }
                            const float t1 = PG8_DPP(x1, cur, 0x111), t2 = PG8_DPP(z, cur, 0x112);
                            c[bj][k] = W[3][k] + W[0][k] * t2 + W[1][k] * t1 + W[2][k] * cur; }
                        __builtin_amdgcn_sched_barrier(0);
                    }
                    const int row = u.pm * BM + ai * HALF + wr * 64 + m * 16 + fr;
                    if (ai == 0 && m == 0 && wr == 0 && fixtile && fr < 2) {
                        float* fp = FIX + ((size_t)u.pm * 2 + fr) * 11264 + ch0 + n * 4;
                        *(f32x4*)fp = c[0]; *(f32x4*)(fp + 5632) = c[1];
                    } else {
                        f32x4 a;
#pragma unroll
                        for (int k = 0; k < 4; ++k) { const float g = c[0][k]; a[k] = g * __builtin_amdgcn_rcpf(1.0f + __builtin_amdgcn_exp2f(-1.4426950408889634f * g)) * c[1][k]; }
                        u32x2 w; w.x = cvt_pk_bf16(a[0], a[1]); w.y = cvt_pk_bf16(a[2], a[3]);
                        *(u32x2*)(ACT + (size_t)row * 5632 + ch0 + n * 4) = w;
                    }
                    asm volatile("" ::: "memory"); __builtin_amdgcn_sched_barrier(0);
                }
        }
    }
};
struct EpiKpe {
    PG8_NOPRE
    static constexpr bool PERM = true, AFTER_DRAIN = false;
    bf16_t* KPE; const float* cosT; const float* sinT;
    __device__ __forceinline__ void operator()(const f32x4 (&acc)[2][2][4][2], const Unit& u, int wr, int wc, int fr, int fq, int ui) const {
        if (wc != 0) return;
        const int row0 = u.pm * BM + wr * 64 + fr, i0 = 8 * fq;
#pragma unroll
        for (int ai = 0; ai < 2; ++ai)
#pragma unroll
            for (int m = 0; m < 4; ++m) { const int row = row0 + ai * HALF + m * 16;
                const f32x4 c0 = *(const f32x4*)(cosT + (size_t)row * 32 + i0), c1 = *(const f32x4*)(cosT + (size_t)row * 32 + i0 + 4);
                const f32x4 s0 = *(const f32x4*)(sinT + (size_t)row * 32 + i0), s1 = *(const f32x4*)(sinT + (size_t)row * 32 + i0 + 4);
                const f32x4 x1a = acc[ai][0][m][0], x1b = acc[ai][0][m][1], x2a = acc[ai][1][m][0], x2b = acc[ai][1][m][1];
                const f32x4 y1a = x1a * c0 - x2a * s0, y1b = x1b * c1 - x2b * s1, y2a = x2a * c0 + x1a * s0, y2b = x2b * c1 + x1b * s1;
                bf16_t* dst = KPE + (size_t)row * 64 + i0;
                *(u32x4*)dst = pack8bf(y1a, y1b); *(u32x4*)(dst + 32) = pack8bf(y2a, y2b); }
    }
};
struct OneUnit { int pm, pn;
    __device__ __forceinline__ bool next(int i, Unit& u) const { if (i) return false; u.pm = pm; u.pn = pn; return true; }
    __device__ __forceinline__ void a_ready(const Unit&) const {}
    __device__ __forceinline__ void done(const Unit&) const {}
};
struct EpiKvMla {
    PG8_NOPRE
    static constexpr bool PERM = true, AFTER_DRAIN = false;
    bf16_t* KH; bf16_t* VH;
    __device__ __forceinline__ void operator()(const f32x4 (&acc)[2][2][4][2], const Unit& u, int wr, int wc, int fr, int fq, int ui) const {
        const int row0 = u.pm * BM + wr * 64 + fr, dim0 = wc * 32 + 8 * fq;
#pragma unroll
        for (int ai = 0; ai < 2; ++ai)
#pragma unroll
            for (int m = 0; m < 4; ++m) { const int row = row0 + ai * HALF + m * 16, b = row >> 12, s = row & 4095;
                const size_t o = (((size_t)b * 16 + u.pn) * 4096 + s) * 128 + dim0;
                *(u32x4*)(KH + o) = pack8bf(acc[ai][0][m][0], acc[ai][0][m][1]); *(u32x4*)(VH + o) = pack8bf(acc[ai][1][m][0], acc[ai][1][m][1]); }
    }
};
struct EpiQMla {
    PG8_NOPRE
    static constexpr bool PERM = true, AFTER_DRAIN = false;
    bf16_t* Q; const float* cosT; const float* sinT;
    __device__ __forceinline__ void operator()(const f32x4 (&acc)[2][2][4][2], const Unit& u, int wr, int wc, int fr, int fq, int ui) const {
        const int row0 = u.pm * BM + wr * 64 + fr;
        if (u.pn < 8) {
            const int col0 = u.pn * BM + wc * 32 + 8 * fq;
#pragma unroll
            for (int ai = 0; ai < 2; ++ai)
#pragma unroll
                for (int m = 0; m < 4; ++m) { bf16_t* rowp = Q + (size_t)(row0 + ai * HALF + m * 16) * 3072 + col0;
#pragma unroll
                    for (int bj = 0; bj < 2; ++bj) *(u32x4*)(rowp + bj * HALF) = pack8bf(acc[ai][bj][m][0], acc[ai][bj][m][1]); }
        } else {
            const int head = 4 * (u.pn - 8) + wc, i0 = 8 * fq;
#pragma unroll
            for (int ai = 0; ai < 2; ++ai)
#pragma unroll
                for (int m = 0; m < 4; ++m) { const int row = row0 + ai * HALF + m * 16;
                    const f32x4 c0 = *(const f32x4*)(cosT + (size_t)row * 32 + i0), c1 = *(const f32x4*)(cosT + (size_t)row * 32 + i0 + 4);
                    const f32x4 s0 = *(const f32x4*)(sinT + (size_t)row * 32 + i0), s1 = *(const f32x4*)(sinT + (size_t)row * 32 + i0 + 4);
                    const f32x4 x1a = acc[ai][0][m][0], x1b = acc[ai][0][m][1], x2a = acc[ai][1][m][0], x2b = acc[ai][1][m][1];
                    const f32x4 y1a = x1a * c0 - x2a * s0, y1b = x1b * c1 - x2b * s1, y2a = x2a * c0 + x1a * s0, y2b = x2b * c1 + x1b * s1;
                    bf16_t* dst = Q + (size_t)row * 3072 + 2048 + head * 64 + i0;
                    *(u32x4*)dst = pack8bf(y1a, y1b); *(u32x4*)(dst + 32) = pack8bf(y2a, y2b); }
        }
    }
};
struct EpiQkvDil {
    PG8_NOPRE
    static constexpr bool PERM = true, AFTER_DRAIN = false;
    bf16_t* O; const float* cosT; const float* sinT;
    __device__ __forceinline__ void operator()(const f32x4 (&acc)[2][2][4][2], const Unit& u, int wr, int wc, int fr, int fq, int ui) const {
        const int row0 = u.pm * BM + wr * 64 + fr;
        const int g = u.pn / 24, rem = u.pn - g * 24, t = rem >> 3, T = rem & 7, sh = 2 * g;
        const size_t plane = ((size_t)(g * 3 + t) * 16 + 2 * T) * 4;
        if (t == 2 || wc != 0) {
            const int dim0 = wc * 32 + 8 * fq;
#pragma unroll
            for (int ai = 0; ai < 2; ++ai)
#pragma unroll
                for (int m = 0; m < 4; ++m) { const int row = row0 + ai * HALF + m * 16, b = row >> 12, s = row & 4095, sp = ((s & ((1 << sh) - 1)) << (12 - sh)) + (s >> sh);
#pragma unroll
                    for (int bj = 0; bj < 2; ++bj) *(u32x4*)(O + ((plane + bj * 4 + b) * 4096 + sp) * 128 + dim0) = pack8bf(acc[ai][bj][m][0], acc[ai][bj][m][1]); }
        } else {
            const int hh = fq >> 1, i0 = 8 * (fq & 1);
#pragma unroll
            for (int ai = 0; ai < 2; ++ai)
#pragma unroll
                for (int m = 0; m < 4; ++m) { const int row = row0 + ai * HALF + m * 16, b = row >> 12, s = row & 4095, sp = ((s & ((1 << sh) - 1)) << (12 - sh)) + (s >> sh);
                    const f32x4 c0 = *(const f32x4*)(cosT + (size_t)row * 16 + i0), c1 = *(const f32x4*)(cosT + (size_t)row * 16 + i0 + 4);
                    const f32x4 s0 = *(const f32x4*)(sinT + (size_t)row * 16 + i0), s1 = *(const f32x4*)(sinT + (size_t)row * 16 + i0 + 4);
                    const f32x4 x1a = acc[ai][0][m][0], x1b = acc[ai][0][m][1], x2a = acc[ai][1][m][0], x2b = acc[ai][1][m][1];
                    const f32x4 y1a = x1a * c0 - x2a * s0, y1b = x1b * c1 - x2b * s1, y2a = x2a * c0 + x1a * s0, y2b = x2b * c1 + x1b * s1;
                    bf16_t* dst = O + ((plane + hh * 4 + b) * 4096 + sp) * 128 + i0;
                    *(u32x4*)dst = pack8bf(y1a, y1b); *(u32x4*)(dst + 16) = pack8bf(y2a, y2b); }
        }
    }
};

template <class Epi, class Sched, bool ALIGN_EPI = false, bool SP2 = false, int EPI_REP = 1>
__device__ __forceinline__ void gemm_phase(PG8_LAS unsigned char* lds, const Gemm g, const Sched& S, const Epi& E) {
    int tid_ = threadIdx.x; asm volatile("" : "+v"(tid_));
    const int tid = tid_, wid = __builtin_amdgcn_readfirstlane(tid >> 6), lane = tid & 63, wr = wid >> 2, wc = wid & 3, fr = lane & 15, fq = lane >> 4;
    const int K = g.K, nt = K / BK;
    unsigned voffA[2], voffB[2];
#pragma unroll
    for (int i = 0; i < 2; ++i) { int R, C; stage_rc(tid * 16 + i * 8192, R, C); const int Rb = Epi::PERM ? ((R & ~31) + perm32(R & 31)) : R;
        voffA[i] = (unsigned)(R * K + C) * 2u; voffB[i] = (unsigned)(Rb * K + C) * 2u; }
    const size_t kstep = (size_t)(BK * 2);
    const size_t hstep = (size_t)HALF * K * 2;
    const size_t tstep = 2 * hstep;
    const unsigned ldsw = (unsigned)wid * 1024u;
    const int aoff = lds_byte(wr * 64 + fr, fq * 8), boff = lds_byte(wc * 32 + fr, fq * 8);
#define PG8_SA(b, h) (((b) * 2 + (h)) * HTB)
#define PG8_SB(b, h) ((4 + (b) * 2 + (h)) * HTB)
#define PG8_STAGE(bufoff, gbase, voff) do { _Pragma("unroll") for (int _i = 0; _i < 2; ++_i) \
        __builtin_amdgcn_global_load_lds((const unsigned*)((const char*)(gbase) + (voff)[_i]), (PG8_LAS unsigned*)(lds + (bufoff) + ldsw + _i * 8192), 16, 0, 0); } while (0)
#define PG8_LDA(dst, b, h) do { _Pragma("unroll") for (int m = 0; m < 4; ++m) _Pragma("unroll") for (int k = 0; k < 2; ++k) dst[m][k] = *(const PG8_LAS bf16x8*)(lds + PG8_SA(b, h) + aoff + m * 2048 + k * 1024); } while (0)
#define PG8_LDB(dst, b, h) do { _Pragma("unroll") for (int n = 0; n < 2; ++n) _Pragma("unroll") for (int k = 0; k < 2; ++k) dst[n][k] = *(const PG8_LAS bf16x8*)(lds + PG8_SB(b, h) + boff + n * 2048 + k * 1024); } while (0)
#define PG8_MMA(ai, bj, At, Bt) do { __builtin_amdgcn_s_setprio(1); _Pragma("unroll") for (int m = 0; m < 4; ++m) _Pragma("unroll") for (int n = 0; n < 2; ++n) _Pragma("unroll") for (int k = 0; k < 2; ++k) \
        acc[ai][bj][m][n] = __builtin_amdgcn_mfma_f32_16x16x32_bf16(Bt[n][k], At[m][k], acc[ai][bj][m][n], 0, 0, 0); __builtin_amdgcn_s_setprio(0); } while (0)
#define PG8_WAIT_V(n) asm volatile("s_waitcnt vmcnt(" #n ")" ::: "memory")
#define PG8_WAIT_L(n) asm volatile("s_waitcnt lgkmcnt(" #n ")" ::: "memory")
#define PG8_BAR __builtin_amdgcn_s_barrier()
#define PG8_SCHED __builtin_amdgcn_sched_barrier(0)
    Unit cur, nxt; int ui = 0;
    typename Epi::Pre pre;
    if (!S.next(0, cur)) return;
    f32x4 acc[2][2][4][2];
#pragma unroll
    for (int a = 0; a < 2; ++a)
#pragma unroll
        for (int b = 0; b < 2; ++b)
#pragma unroll
            for (int m = 0; m < 4; ++m)
#pragma unroll
                for (int n = 0; n < 2; ++n) acc[a][b][m][n] = (f32x4){0.f, 0.f, 0.f, 0.f};
    bf16x8 At[4][2], B0[2][2], B1[2][2];
    const char* cA = (const char*)g.A + (size_t)cur.pm * tstep; const char* cB = (const char*)g.Bt + (size_t)cur.pn * tstep;
    S.a_ready(cur);
    if constexpr (SP2) {
        PG8_STAGE(PG8_SB(0, 0), cB, voffB); PG8_STAGE(PG8_SB(0, 1), cB + hstep, voffB); PG8_STAGE(PG8_SA(0, 0), cA, voffA); PG8_STAGE(PG8_SA(0, 1), cA + hstep, voffA);
        if (wr == 1) PG8_BAR;
        PG8_WAIT_V(2); PG8_BAR;
        PG8_STAGE(PG8_SB(1, 0), cB + kstep, voffB); PG8_STAGE(PG8_SA(1, 0), cA + kstep, voffA); PG8_STAGE(PG8_SB(1, 1), cB + hstep + kstep, voffB);
        PG8_WAIT_V(6); PG8_BAR;
    } else {
        PG8_STAGE(PG8_SB(0, 0), cB, voffB); PG8_STAGE(PG8_SA(0, 0), cA, voffA); PG8_STAGE(PG8_SB(0, 1), cB + hstep, voffB); PG8_STAGE(PG8_SA(0, 1), cA + hstep, voffA);
        if (wr == 1) PG8_BAR;
        PG8_WAIT_V(4); PG8_BAR;
        PG8_STAGE(PG8_SB(1, 0), cB + kstep, voffB); PG8_STAGE(PG8_SA(1, 0), cA + kstep, voffA); PG8_STAGE(PG8_SB(1, 1), cB + hstep + kstep, voffB);
        PG8_WAIT_V(6); PG8_BAR;
    }
    for (;;) {
        const bool has_next = S.next(ui + 1, nxt);
        const char* nA = has_next ? (const char*)g.A + (size_t)nxt.pm * tstep : cA; const char* nB = has_next ? (const char*)g.Bt + (size_t)nxt.pn * tstep : cB;
        for (int t = 0; t < nt; t += 2) {
            const bool last = (t == nt - 2);
            const char* a1 = cA + (size_t)(t + 1) * kstep;
            const char* a2 = last ? nA : cA + (size_t)(t + 2) * kstep; const char* b2 = last ? nB : cB + (size_t)(t + 2) * kstep;
            const char* a3 = a2 + kstep; const char* b3 = b2 + kstep;
            if (last && has_next) S.a_ready(nxt);
            if (t == 0) E.pre_issue(pre, cur, tid, ui); else if (t == 2) E.pre_finish(pre, tid, ui);
            if constexpr (SP2) {
            PG8_LDB(B0, 0, 0); PG8_LDB(B1, 0, 1); PG8_SCHED; PG8_LDA(At, 0, 0); PG8_STAGE(PG8_SA(1, 1), a1 + hstep, voffA);
            PG8_WAIT_V(8); PG8_WAIT_L(0); PG8_BAR; PG8_MMA(0, 0, At, B0); PG8_MMA(0, 1, At, B1); PG8_BAR; PG8_SCHED;
            PG8_LDA(At, 0, 1); PG8_STAGE(PG8_SB(0, 0), b2, voffB); PG8_STAGE(PG8_SB(0, 1), b2 + hstep, voffB); PG8_STAGE(PG8_SA(0, 0), a2, voffA);
            PG8_WAIT_V(8); PG8_WAIT_L(0); PG8_BAR; PG8_MMA(1, 0, At, B0); PG8_MMA(1, 1, At, B1); PG8_BAR; PG8_SCHED;
            PG8_LDB(B0, 1, 0); PG8_LDB(B1, 1, 1); PG8_SCHED; PG8_LDA(At, 1, 0); PG8_STAGE(PG8_SA(0, 1), a2 + hstep, voffA);
            PG8_WAIT_V(8); PG8_WAIT_L(0); PG8_BAR; PG8_MMA(0, 0, At, B0); PG8_MMA(0, 1, At, B1); PG8_BAR; PG8_SCHED;
            PG8_LDA(At, 1, 1); PG8_STAGE(PG8_SB(1, 0), b3, voffB); PG8_STAGE(PG8_SB(1, 1), b3 + hstep, voffB); PG8_STAGE(PG8_SA(1, 0), a3, voffA);
            PG8_WAIT_V(8); PG8_WAIT_L(0); PG8_BAR; PG8_MMA(1, 0, At, B0); PG8_MMA(1, 1, At, B1); PG8_BAR; PG8_SCHED;
            } else {
            PG8_LDB(B0, 0, 0); PG8_SCHED; PG8_LDA(At, 0, 0); PG8_STAGE(PG8_SA(1, 1), a1 + hstep, voffA);
            PG8_WAIT_L(8); PG8_BAR; PG8_WAIT_L(0); PG8_MMA(0, 0, At, B0); PG8_BAR; PG8_SCHED;
            PG8_LDB(B1, 0, 1); PG8_STAGE(PG8_SB(0, 0), b2, voffB);
            PG8_BAR; PG8_WAIT_L(0); PG8_MMA(0, 1, At, B1); PG8_BAR;
            PG8_LDA(At, 0, 1); PG8_STAGE(PG8_SA(0, 0), a2, voffA);
            PG8_BAR; PG8_WAIT_L(0); PG8_MMA(1, 0, At, B0); PG8_BAR; PG8_SCHED;
            PG8_STAGE(PG8_SB(0, 1), b2 + hstep, voffB);
            PG8_WAIT_V(6); PG8_BAR; PG8_MMA(1, 1, At, B1); PG8_BAR;
            PG8_LDB(B0, 1, 0); PG8_SCHED; PG8_LDA(At, 1, 0); PG8_STAGE(PG8_SA(0, 1), a2 + hstep, voffA);
            PG8_WAIT_L(8); PG8_BAR; PG8_WAIT_L(0); PG8_MMA(0, 0, At, B0); PG8_BAR; PG8_SCHED;
            PG8_LDB(B1, 1, 1); PG8_STAGE(PG8_SB(1, 0), b3, voffB);
            PG8_BAR; PG8_WAIT_L(0); PG8_MMA(0, 1, At, B1); PG8_BAR;
            PG8_LDA(At, 1, 1); PG8_STAGE(PG8_SA(1, 0), a3, voffA);
            PG8_BAR; PG8_WAIT_L(0); PG8_MMA(1, 0, At, B0); PG8_BAR; PG8_SCHED;
            PG8_STAGE(PG8_SB(1, 1), b3 + hstep, voffB);
            PG8_WAIT_V(6); PG8_BAR; PG8_MMA(1, 1, At, B1); PG8_BAR;
            }
        }
        if constexpr (ALIGN_EPI) { if (wr == 0) PG8_BAR; }
        if constexpr (!Epi::AFTER_DRAIN) { _Pragma("unroll") for (int rep_ = 0; rep_ < EPI_REP; ++rep_) E(acc, cur, wr, wc, fr, fq, ui); S.done(cur); }
        if (!has_next) break;
#pragma unroll
        for (int a = 0; a < 2; ++a)
#pragma unroll
            for (int b = 0; b < 2; ++b)
#pragma unroll
                for (int m = 0; m < 4; ++m)
#pragma unroll
                    for (int n = 0; n < 2; ++n) acc[a][b][m][n] = (f32x4){0.f, 0.f, 0.f, 0.f};
        cur = nxt; cA = nA; cB = nB; ++ui;
        if constexpr (ALIGN_EPI) { if (wr == 1) PG8_BAR; }
    }
    PG8_WAIT_V(0);
    if constexpr (!ALIGN_EPI) { if (wr == 0) PG8_BAR; }
    PG8_BAR;
    if constexpr (Epi::AFTER_DRAIN) { E.fused(acc, cur, wr, wc, fr, fq, lds, wid, lane); S.done(cur); }
#undef PG8_SA
#undef PG8_SB
#undef PG8_STAGE
#undef PG8_LDA
#undef PG8_LDB
#undef PG8_MMA
#undef PG8_WAIT_V
#undef PG8_WAIT_L
#undef PG8_BAR
#undef PG8_SCHED
}
}
namespace att {
typedef unsigned short bf16;
typedef short bf16x8 __attribute__((ext_vector_type(8)));
typedef short s16x4 __attribute__((ext_vector_type(4)));
typedef float f32x16 __attribute__((ext_vector_type(16)));
typedef float f32x4 __attribute__((ext_vector_type(4)));
typedef unsigned u32x4 __attribute__((ext_vector_type(4)));
constexpr int NW = 8, QBLK = 32, KVBLK = 64, QB = NW * QBLK;
constexpr int SHM_V = KVBLK * 128 * 2, SHM_K = KVBLK * 128 * 2, KPE_ROW = 144, SHM_KPE = KVBLK * KPE_ROW;
constexpr int OFF_V = 0, OFF_K = 2 * SHM_V, OFF_WS = OFF_K + 2 * SHM_K, OFF_KPE = OFF_WS + NW * 64 * 4, OFF_QPE = OFF_KPE + 2 * SHM_KPE, LDS_BYTES = OFF_QPE + NW * 4096;
constexpr float THR = 8.f;

#define KSWZ(row, colB) ((row) * 256 + ((colB) ^ (((row) & 7) << 4)))
#define SBAR() __builtin_amdgcn_sched_barrier(0)
__device__ __forceinline__ int v_st(int k, int c) { const int kk = (k & ~0xC) | ((k & 4) << 1) | ((k & 8) >> 1); return ((kk >> 3) * 4 + (c >> 5)) * 512 + ((kk & 7) * 32 + (c & 31)) * 2; }
__device__ __forceinline__ int v_rd_base(int lane) { return ((lane & 3) << 3) | (((lane >> 2) & 3) << 6) | (((lane >> 4) & 1) << 5) | (((lane >> 5) & 1) << 8); }
constexpr int v_rd_off(int d0, int ks, int half) { return d0 * 512 + ks * 4096 + half * 2048; }
__device__ __forceinline__ int crow(int r, int hi) { return (r & 3) + 8 * (r >> 2) + 4 * hi; }
__device__ __forceinline__ unsigned cvtpk(float lo, float hi) { unsigned r; asm volatile("v_cvt_pk_bf16_f32 %0, %1, %2" : "=v"(r) : "v"(lo), "v"(hi)); return r; }
__device__ __forceinline__ bf16x8 ld8(const bf16* p) { return *reinterpret_cast<const bf16x8*>(p); }
__device__ __forceinline__ void mask_tile(f32x16& p0, f32x16& p1, int dq, unsigned W) {
    const float NEG = -__builtin_inff();
#pragma unroll
    for (int r = 0; r < 16; ++r) {
        const int c = (r & 3) + 8 * (r >> 2);
        if ((unsigned)(dq - c) >= W) p0[r] = NEG;
        if ((unsigned)(dq - c - 32) >= W) p1[r] = NEG;
    }
}
__device__ __forceinline__ void partialSM(f32x16& p0, f32x16& p1, float& m_reg, float& mn, float& alpha, const float scale) {
    float pmax = p0[0]; for (int r = 1; r < 16; ++r) pmax = fmaxf(pmax, p0[r]); for (int r = 0; r < 16; ++r) pmax = fmaxf(pmax, p1[r]);
    { auto rr = __builtin_amdgcn_permlane32_swap(__float_as_uint(pmax), __float_as_uint(pmax), false, false);
      pmax = fmaxf(__uint_as_float(rr[0]), __uint_as_float(rr[1])); }
    const float C2 = 1.4426950408889634f * scale;
    if (__builtin_expect(__all((pmax - m_reg) * scale <= THR), 1)) { mn = m_reg; alpha = 1.f; }
    else { mn = fmaxf(m_reg, pmax); alpha = __builtin_amdgcn_exp2f((m_reg - mn) * C2); m_reg = mn; }
    const float mnL = -mn * C2;
    for (int r = 0; r < 16; ++r) p0[r] = fmaf(p0[r], C2, mnL); for (int r = 0; r < 16; ++r) p1[r] = fmaf(p1[r], C2, mnL);
    for (int r = 0; r < 16; ++r) p0[r] = __builtin_amdgcn_exp2f(p0[r]);
}
__device__ __forceinline__ void finishSM(f32x16& p0, f32x16& p1, float alpha, float& l_reg, bf16x8& pa0, bf16x8& pa1, bf16x8& pa2, bf16x8& pa3) {
    for (int r = 0; r < 16; ++r) p1[r] = __builtin_amdgcn_exp2f(p1[r]);
    float ps = 0; for (int r = 0; r < 16; ++r) ps += p0[r]; for (int r = 0; r < 16; ++r) ps += p1[r];
    { auto rr = __builtin_amdgcn_permlane32_swap(__float_as_uint(ps), __float_as_uint(ps), false, false);
      ps = __uint_as_float(rr[0]) + __uint_as_float(rr[1]); }
    l_reg = l_reg * alpha + ps;
#define PK4(P, B_, OUT) do { unsigned a0 = cvtpk(P[B_+0], P[B_+1]), a1 = cvtpk(P[B_+2], P[B_+3]);                          \
        unsigned b0 = cvtpk(P[B_+4], P[B_+5]), b1 = cvtpk(P[B_+6], P[B_+7]);                                             \
        auto r0 = __builtin_amdgcn_permlane32_swap(a0, b0, false, false); auto r1 = __builtin_amdgcn_permlane32_swap(a1, b1, false, false); \
        u32x4 w = {r0[0], r1[0], r0[1], r1[1]}; OUT = *reinterpret_cast<bf16x8*>(&w); } while (0)
    PK4(p0, 0, pa0); PK4(p0, 8, pa1); PK4(p1, 0, pa2); PK4(p1, 8, pa3);
#undef PK4
}
template <int KB, bool SK, bool PE>
__device__ __forceinline__ void qkt(f32x16& p0, f32x16& p1, const char* lds, int r32, int hi, int wid, int lane, const bf16x8* qr, bool act) {
    if (SK && !act) { const float NEG = -__builtin_inff();
#pragma unroll
        for (int r = 0; r < 16; ++r) { p0[r] = NEG; p1[r] = NEG; } return; }
    p0 = f32x16{}; p1 = f32x16{};
    const char* kb[4];
#pragma unroll
    for (int dd = 0; dd < 4; ++dd) kb[dd] = lds + OFF_K + KB * SHM_K + KSWZ(r32, (dd * 16 + hi * 8) * 2);
#pragma unroll
    for (int d0 = 0; d0 < 8; ++d0) { const char* a = kb[d0 & 3] + (d0 >> 2) * 128;
        bf16x8 b0 = *reinterpret_cast<const bf16x8*>(a);
        bf16x8 b1 = *reinterpret_cast<const bf16x8*>(a + 32 * 256);
        p0 = __builtin_amdgcn_mfma_f32_32x32x16_bf16(b0, qr[d0], p0, 0, 0, 0);
        p1 = __builtin_amdgcn_mfma_f32_32x32x16_bf16(b1, qr[d0], p1, 0, 0, 0); }
    if constexpr (PE) {
        const char* kp = lds + OFF_KPE + KB * SHM_KPE + r32 * KPE_ROW + hi * 16;
        const char* qp = lds + OFF_QPE + wid * 4096 + lane * 16;
#pragma unroll
        for (int d0 = 0; d0 < 4; ++d0) {
            bf16x8 b0 = *reinterpret_cast<const bf16x8*>(kp + d0 * 32);
            bf16x8 b1 = *reinterpret_cast<const bf16x8*>(kp + d0 * 32 + 32 * KPE_ROW);
            bf16x8 qf = *reinterpret_cast<const bf16x8*>(qp + d0 * 1024);
            p0 = __builtin_amdgcn_mfma_f32_32x32x16_bf16(b0, qf, p0, 0, 0, 0);
            p1 = __builtin_amdgcn_mfma_f32_32x32x16_bf16(b1, qf, p1, 0, 0, 0); }
    }
}
template <int VB, bool SK>
__device__ __forceinline__ void pv_tile(f32x16* o, int vb0, bf16x8 pa0, bf16x8 pa1, bf16x8 pa2, bf16x8 pa3, bool act) {
    if (SK && !act) return;
#define TRRD(dst, off) asm volatile("ds_read_b64_tr_b16 %0, %1 offset:%2" : "=&v"(dst) : "v"(vb0), "i"(off) : "memory")
#define PV_D0(d0) do { s16x4 l0, l1, l2, l3, h0, h1, h2, h3; constexpr int b_ = OFF_V + VB * SHM_V + v_rd_off(d0, 0, 0); \
        TRRD(l0, b_); TRRD(h0, b_ + 2048); TRRD(l1, b_ + 4096); TRRD(h1, b_ + 6144); TRRD(l2, b_ + 8192); TRRD(h2, b_ + 10240); TRRD(l3, b_ + 12288); TRRD(h3, b_ + 14336); \
        asm volatile("s_waitcnt lgkmcnt(0)" ::: "memory"); SBAR();   \
        o[d0] = __builtin_amdgcn_mfma_f32_32x32x16_bf16(pa0, (bf16x8){l0[0], l0[1], l0[2], l0[3], h0[0], h0[1], h0[2], h0[3]}, o[d0], 0, 0, 0);   \
        o[d0] = __builtin_amdgcn_mfma_f32_32x32x16_bf16(pa1, (bf16x8){l1[0], l1[1], l1[2], l1[3], h1[0], h1[1], h1[2], h1[3]}, o[d0], 0, 0, 0);   \
        o[d0] = __builtin_amdgcn_mfma_f32_32x32x16_bf16(pa2, (bf16x8){l2[0], l2[1], l2[2], l2[3], h2[0], h2[1], h2[2], h2[3]}, o[d0], 0, 0, 0);   \
        o[d0] = __builtin_amdgcn_mfma_f32_32x32x16_bf16(pa3, (bf16x8){l3[0], l3[1], l3[2], l3[3], h3[0], h3[1], h3[2], h3[3]}, o[d0], 0, 0, 0); } while (0)
    PV_D0(0); PV_D0(1); PV_D0(2); PV_D0(3);
#undef PV_D0
#undef TRRD
}

struct Prm { int qs, kvs, os, qpes, kpes, lses, skv, W; float scale; };
struct BlockRef { const bf16* Q; const bf16* K; const bf16* V; bf16* O; const bf16* Qpe; const bf16* Kpe; float* Lse; int P0; };
template <bool PE> struct Seam { bf16x8 qr[8]; bf16x8 st_v0, st_v1, st_k0, st_k1, st_kp; };
__device__ __forceinline__ int swa_jlo(int P0, int W) { const int lowk = P0 - W + 1; return lowk > 0 ? lowk / KVBLK : 0; }
#define VMW() asm volatile("s_waitcnt vmcnt(0)" ::: "memory")
#define LDG(base, off) (*(const bf16x8*)((const char*)(base) + (off)))
#define SLOAD_H(R_, k0) do { const char* kb__ = (const char*)(R_).K + (size_t)(k0) * P.kvs * 2; const char* vb__ = (const char*)(R_).V + (size_t)(k0) * P.kvs * 2; const size_t h__ = (size_t)32 * P.kvs * 2; \
                              S.st_v0 = LDG(vb__, kvoff); S.st_v1 = LDG(vb__ + h__, kvoff); S.st_k0 = LDG(kb__, kvoff); S.st_k1 = LDG(kb__ + h__, kvoff); \
                              if constexpr (PE) S.st_kp = LDG((const char*)(R_).Kpe + (size_t)(k0) * P.kpes * 2, kpoff); } while (0)
#define SWRITE_HK(bf) do { *(bf16x8*)(K_lds + (bf) * SHM_K + kws) = S.st_k0; *(bf16x8*)(K_lds + (bf) * SHM_K + kws + 32 * 256) = S.st_k1; \
                           if constexpr (PE) *(bf16x8*)(lds + OFF_KPE + (bf) * SHM_KPE + pws) = S.st_kp; } while (0)
#define SWRITE_HV(bf) do { *(bf16x8*)(V_lds + (bf) * SHM_V + vst0) = S.st_v0; *(bf16x8*)(V_lds + (bf) * SHM_V + vst1) = S.st_v1; } while (0)
#define SWRITE_H(bf) do { SWRITE_HV(bf); SWRITE_HK(bf); } while (0)
template <bool PE>
__device__ __forceinline__ void swa_prime(const BlockRef& cur, const Prm& P, char* lds, Seam<PE>& S) {
    int tid_ = threadIdx.x; asm volatile("" : "+v"(tid_));
    const int tid = tid_, wid = __builtin_amdgcn_readfirstlane(tid >> 6), lane = tid & 63, r32 = lane & 31, hi = lane >> 5;
    const int sr = tid >> 4, sc = (tid & 15) * 8, kws = KSWZ(sr, sc * 2); char* K_lds = lds + OFF_K;
    const int pr = tid >> 3, pc = (tid & 7) * 8, pws = pr * KPE_ROW + (tid & 7) * 16;
    const unsigned kvoff = (unsigned)(sr * P.kvs + sc) * 2u, kpoff = (unsigned)(pr * P.kpes + pc) * 2u, qoff = (unsigned)((wid * QBLK + r32) * P.qs + hi * 8) * 2u, qpoff = (unsigned)((wid * QBLK + r32) * P.qpes + hi * 8) * 2u;
    const int kb0 = swa_jlo(cur.P0, P.W) * KVBLK;
#pragma unroll
    for (int d0 = 0; d0 < 8; ++d0) S.qr[d0] = LDG(cur.Q, qoff + d0 * 32);
    if constexpr (PE) {
#pragma unroll
        for (int d0 = 0; d0 < 4; ++d0) *(bf16x8*)(lds + OFF_QPE + wid * 4096 + d0 * 1024 + lane * 16) = LDG(cur.Qpe, qpoff + d0 * 32);
    }
    SLOAD_H(cur, kb0); VMW(); SWRITE_HK(0);
    __syncthreads();
}
template <bool PE, bool SK, bool LSE, bool EARLY>
__device__ __forceinline__ void swa_block(const BlockRef& cur, const BlockRef& nxt, const Prm& P, char* lds, Seam<PE>& S) {
    int tid_ = threadIdx.x; asm volatile("" : "+v"(tid_));
    const int tid = tid_, wid = __builtin_amdgcn_readfirstlane(tid >> 6), lane = tid & 63, r32 = lane & 31, hi = lane >> 5;
    const int W = P.W;
    const int j_lo = swa_jlo(cur.P0, W);
    int j_hi = (cur.P0 + QB - 1) / KVBLK + 1; if (j_hi > P.skv / KVBLK) j_hi = P.skv / KVBLK;
    const int NT = j_hi - j_lo;
    const int kbn = swa_jlo(nxt.P0, W) * KVBLK;
    const int qlo = cur.P0 + wid * QBLK, qm = qlo + r32 - 4 * hi;
    char* V_lds = lds + OFF_V; char* K_lds = lds + OFF_K;
    float* ws = (float*)(lds + OFF_WS) + wid * 64; float* li_l = ws, * al_l = ws + 32;
    float m_reg = -1e30f, l_reg = 0; f32x16 o[4] = {};
    const int sr = tid >> 4, sc = (tid & 15) * 8, vst0 = v_st(sr, sc), vst1 = v_st(32 + sr, sc), kws = KSWZ(sr, sc * 2);
    const int pr = tid >> 3, pc = (tid & 7) * 8, pws = pr * KPE_ROW + (tid & 7) * 16;
    const unsigned kvoff = (unsigned)(sr * P.kvs + sc) * 2u, kpoff = (unsigned)(pr * P.kpes + pc) * 2u;
    const int vb0 = (int)(uintptr_t)lds + v_rd_base(lane);
#define RESC(a) do { if (__any((a) < 1.f)) { if (hi == 0) al_l[r32] = (a); asm volatile("s_waitcnt lgkmcnt(0)" ::: "memory");              \
                     for (int d_ = 0; d_ < 4; ++d_) for (int r = 0; r < 16; ++r) o[d_][r] *= al_l[crow(r, hi)]; } } while (0)
#define KBASE(t) ((j_lo + (t)) * KVBLK)
#define ACT(t) (KBASE(t) <= qlo + QBLK - 1 && KBASE(t) + KVBLK - 1 >= qlo - W + 1)
#define MASKT(P0_, P1_, t) do { const int kb_ = KBASE(t); if ((!SK || ACT(t)) && (kb_ + KVBLK - 1 > qlo || kb_ <= qlo + QBLK - 1 - W)) mask_tile(P0_, P1_, qm - kb_, (unsigned)W); } while (0)
    f32x16 pA0, pA1, pB0, pB1; float mnA, mnB, alA, alB; bf16x8 pa0, pa1, pa2, pa3;
    SWRITE_HV(0); SBAR();
    if (NT > 1) { SLOAD_H(cur, KBASE(1)); }
    SBAR(); qkt<0, SK, PE>(pA0, pA1, lds, r32, hi, wid, lane, S.qr, ACT(0));
    MASKT(pA0, pA1, 0); partialSM(pA0, pA1, m_reg, mnA, alA, P.scale);
    if (NT > 1) { VMW(); SWRITE_H(1); }
    __syncthreads();
#define HALF_STEP(PX0, PX1, mnX, alX, PY0, PY1, alY, t, KB, VB, SB) do {                                                      \
        SBAR(); if (EARLY && (t) + 1 < NT) { SLOAD_H(cur, KBASE((t) + 1)); SBAR(); }                                          \
        qkt<KB, SK, PE>(PX0, PX1, lds, r32, hi, wid, lane, S.qr, ACT(t));                                                     \
        finishSM(PY0, PY1, alY, l_reg, pa0, pa1, pa2, pa3); SBAR();                                                           \
        if (!EARLY && (t) + 1 < NT) { SLOAD_H(cur, KBASE((t) + 1)); SBAR(); }                                                 \
        pv_tile<VB, SK>(o, vb0, pa0, pa1, pa2, pa3, ACT((t) - 1)); MASKT(PX0, PX1, (t)); partialSM(PX0, PX1, m_reg, mnX, alX, P.scale); \
        __syncthreads();                                                                                                      \
        if ((t) + 1 < NT) { VMW(); SWRITE_H(SB); }                                                                            \
        RESC(alX); __syncthreads(); } while (0)
    for (int t = 1; t + 1 < NT; t += 2) {
        HALF_STEP(pB0, pB1, mnB, alB, pA0, pA1, alA, t, 1, 0, 0);
        HALF_STEP(pA0, pA1, mnA, alA, pB0, pB1, alB, t + 1, 0, 1, 1);
    }
    const bool even = (NT & 1) == 0;
    if (even) { SBAR(); qkt<1, SK, PE>(pB0, pB1, lds, r32, hi, wid, lane, S.qr, ACT(NT - 1)); SBAR(); }
    SLOAD_H(nxt, kbn); SBAR();
    { const unsigned qoff = (unsigned)((wid * QBLK + r32) * P.qs + hi * 8) * 2u;
#pragma unroll
      for (int d0 = 0; d0 < 8; ++d0) S.qr[d0] = LDG(nxt.Q, qoff + d0 * 32); }
    bf16x8 qpn[4];
    if constexpr (PE) { const unsigned qpoff = (unsigned)((wid * QBLK + r32) * P.qpes + hi * 8) * 2u;
#pragma unroll
        for (int d0 = 0; d0 < 4; ++d0) qpn[d0] = LDG(nxt.Qpe, qpoff + d0 * 32);
    }
    SBAR();
    finishSM(pA0, pA1, alA, l_reg, pa0, pa1, pa2, pa3); SBAR();
    pv_tile<0, SK>(o, vb0, pa0, pa1, pa2, pa3, ACT(even ? NT - 2 : NT - 1));
    if (even) { MASKT(pB0, pB1, NT - 1); partialSM(pB0, pB1, m_reg, mnB, alB, P.scale); __syncthreads(); RESC(alB);
        finishSM(pB0, pB1, alB, l_reg, pa0, pa1, pa2, pa3); SBAR(); pv_tile<1, SK>(o, vb0, pa0, pa1, pa2, pa3, ACT(NT - 1)); }
    SBAR();
    VMW(); SWRITE_HK(0);
    if constexpr (PE) {
#pragma unroll
        for (int d0 = 0; d0 < 4; ++d0) *(bf16x8*)(lds + OFF_QPE + wid * 4096 + d0 * 1024 + lane * 16) = qpn[d0];
    }
    SBAR();
    if (hi == 0) li_l[r32] = l_reg; asm volatile("s_waitcnt lgkmcnt(0)" ::: "memory");
    float rli[16];
#pragma unroll
    for (int r = 0; r < 16; ++r) rli[r] = __builtin_amdgcn_rcpf(li_l[crow(r, hi)]);
    const unsigned ooff = (unsigned)((wid * QBLK + 4 * hi) * P.os + r32) * 2u;
#pragma unroll
    for (int r = 0; r < 16; ++r) { char* ob = (char*)cur.O + (size_t)((r & 3) + 8 * (r >> 2)) * P.os * 2;
#pragma unroll
        for (int d0 = 0; d0 < 4; ++d0) { const float v = o[d0][r] * rli[r];
            const float vn = __uint_as_float((unsigned)__builtin_amdgcn_update_dpp(0, (int)__float_as_uint(v), 0xB1, 0xF, 0xF, true));
            if ((r32 & 1) == 0) *(unsigned*)(ob + ooff + d0 * 64) = cvtpk(v, vn); } }
    if constexpr (LSE) { if (hi == 0) *(float*)((char*)cur.Lse + (unsigned)((wid * QBLK + r32) * P.lses) * 4u) = m_reg * P.scale + __logf(l_reg); }
    __syncthreads();
#undef RESC
#undef KBASE
#undef ACT
#undef MASKT
#undef HALF_STEP
}
#undef LDG
#undef VMW
#undef SLOAD_H
#undef SWRITE_HK
#undef SWRITE_HV
#undef SWRITE_H
#undef KSWZ
#undef SBAR
}
constexpr int NWAVES = 8;
constexpr int BATCH = 4, SEQ = 4096, DM = 2048, M = BATCH * SEQ;
constexpr int NQKVA = 1280;
constexpr int NQB = 3072, NKVB = 4096, NDIL = 18432, FF = 5632, NUP = 2 * FF;
constexpr float EPS = 1e-6f;
constexpr size_t MiB = (size_t)1 << 20;
constexpr size_t WS_CTL = 0, CTL_ZERO_BYTES = 64 * 1024;
constexpr size_t WS_COSM = 1 * MiB, WS_SINM = 3 * MiB, WS_COSD = 5 * MiB, WS_SIND = 6 * MiB;
constexpr size_t WS_WMLA = 8 * MiB, WMLA_STRIDE = 20 * MiB, WMLA_QKVA = 0, WMLA_QB = 5 * MiB, WMLA_KVB = 8 * MiB, WMLA_WO = 12 * MiB;
constexpr size_t WS_WDIL = WS_WMLA + 2 * WMLA_STRIDE, WDIL_STRIDE = 80 * MiB, WDIL_IN = 0, WDIL_WO = 72 * MiB;
constexpr size_t WS_WFFN = WS_WDIL + 2 * WDIL_STRIDE, WFFN_STRIDE = 66 * MiB, WFFN_UP = 0, WFFN_DOWN = 44 * MiB;
constexpr size_t WS_H = WS_WFFN + 4 * WFFN_STRIDE;
constexpr size_t WS_S = WS_H + 64 * MiB;
constexpr size_t S_QKVA = 0, S_QN = 80 * MiB, S_CKVN = 96 * MiB, S_KPE = 112 * MiB, S_Q = 114 * MiB, S_KV = 210 * MiB, S_AO_MLA = 338 * MiB;
constexpr size_t S_QKV = 0, S_OG = 576 * MiB, S_LSE = 768 * MiB, S_AO_DIL = 771 * MiB;
constexpr size_t S_U = 0, S_ACT = 352 * MiB;
constexpr size_t WS_HALO = WS_S + 835 * MiB, WS_FIX = WS_HALO + 6 * MiB;
constexpr size_t WS_END = WS_FIX + 6 * MiB;
static_assert(WS_H == 472 * MiB && WS_END == 1383 * MiB, "d_ws map");
constexpr int CW_BAR = 4096;
constexpr int RING_OFF = 0, RING_BYTES = 131072, LDSCTL_OFF = RING_BYTES, MISC_OFF = LDSCTL_OFF + 320, XH_OFF = RING_BYTES + 1024  , CWL_OFF = XH_OFF + 6144  , LDS_BYTES = 163840;
static_assert(CWL_OFF + 8192 <= LDS_BYTES, "LDS map");
static_assert(att::LDS_BYTES <= RING_BYTES && pg8::STAGE_BYTES <= RING_BYTES, "LDS map");

#define GAS __attribute__((address_space(1)))
#define LAS __attribute__((address_space(3)))
typedef unsigned short bf16;
typedef unsigned v4u __attribute__((ext_vector_type(4)));
typedef unsigned v2u __attribute__((ext_vector_type(2)));
typedef float f32x4 __attribute__((ext_vector_type(4)));
typedef GAS unsigned gu32;
#define RLX_AGENT __ATOMIC_RELAXED, __HIP_MEMORY_SCOPE_AGENT
#define LDS_WAIT() asm volatile("s_waitcnt lgkmcnt(0)" ::: "memory")
__device__ __forceinline__ unsigned pk2(float lo, float hi) { return pg8::cvt_pk_bf16(lo, hi); }
__device__ __forceinline__ float bf_lo(unsigned w) { return __uint_as_float(w << 16); }
__device__ __forceinline__ float bf_hi(unsigned w) { return __uint_as_float(w & 0xffff0000u); }

#define XB_TMO      128
#define XB_XCNT(j)  (256  + 64 * (j))
#define XB_XSUB(j)  (1280 + 64 * (j))
#define XB_XGEN(j)  (2304 + 64 * (j))
#define XB_TOP      3328
#define XB_TOPGEN   3392
#define XCD_BAR_WORDS 3456
#define XB_SPIN_CAP (1u << 18)

__device__ __forceinline__ unsigned xb_ld(unsigned* p)              { return __hip_atomic_load(p, __ATOMIC_RELAXED, __HIP_MEMORY_SCOPE_AGENT); }
__device__ __forceinline__ unsigned xb_add(unsigned* p, unsigned v) { return __hip_atomic_fetch_add(p, v, __ATOMIC_RELAXED, __HIP_MEMORY_SCOPE_AGENT); }
__device__ __forceinline__ unsigned xb_xcc_id() { return (unsigned)__builtin_amdgcn_s_getreg((3 << 11) | 20) & 0xFu; }
#define XB_SPIN(cond, bar) do { unsigned _sp = 0; while (cond) { __builtin_amdgcn_s_sleep(1); \
    if ((++_sp & 255u) == 0u) { if (xb_ld(&(bar)[XB_TMO])) break; if (_sp > XB_SPIN_CAP) { atomicAdd(&(bar)[XB_TMO], 1u); break; } } } } while (0)

struct XcdBarrier {
    unsigned* bar; unsigned x;
    volatile LAS unsigned* st;
};

__device__ __forceinline__ XcdBarrier xcd_barrier_post(unsigned* bar, volatile LAS unsigned* st) {
    XcdBarrier b; b.bar = bar; b.x = xb_xcc_id(); b.st = st;
    if (threadIdx.x == 0) (void)xb_add(&bar[XB_XCNT(b.x)], 1u);
    return b;
}
__device__ __forceinline__ void xcd_barrier_complete(unsigned* bar, unsigned x, unsigned& nloc, unsigned& nx) {
    const unsigned G = gridDim.x * gridDim.y * gridDim.z;
    unsigned sum, cnt, mine, sp = 0u;
    for (;;) {
        sum = 0u; cnt = 0u; mine = 0u;
#pragma unroll
        for (unsigned j = 0; j < 16; ++j) { const unsigned c = xb_ld(&bar[XB_XCNT(j)]); sum += c; cnt += (c > 0u) ? 1u : 0u; mine = (j == x) ? c : mine; }
        if (sum == G) break;
        __builtin_amdgcn_s_sleep(1);
        if ((++sp & 255u) == 0u) { if (xb_ld(&bar[XB_TMO])) break; if (sp > XB_SPIN_CAP) { atomicAdd(&bar[XB_TMO], 1u); break; } }
    }
    nloc = mine > 0u ? mine : 1u; nx = cnt > 0u ? cnt : 1u;
}

__device__ __forceinline__ void xcd_barrier(const XcdBarrier& b) {
    asm volatile("s_waitcnt vmcnt(0)" ::: "memory");
    __syncthreads();
    if (threadIdx.x == 0) {
        __attribute__((address_space(1))) unsigned* barg_ = (__attribute__((address_space(1))) unsigned*)b.bar; unsigned bx_ = b.x;
        asm volatile("" : "+s"(barg_), "+s"(bx_)); unsigned* bar = (unsigned*)barg_;
        __builtin_amdgcn_s_waitcnt(0);
        unsigned nloc = b.st[0], nx = b.st[1];
        if (nloc == 0u) { xcd_barrier_complete(bar, bx_, nloc, nx); b.st[0] = nloc; b.st[1] = nx; }
        const unsigned old = xb_add(&bar[XB_XSUB(bx_)], 1u);
        const unsigned gen = old / nloc;
        if (old + 1u == (gen + 1u) * nloc) {
            __builtin_amdgcn_fence(__ATOMIC_RELEASE, "agent");
            asm volatile("s_waitcnt vmcnt(0)" ::: "memory");
            const unsigned og = xb_add(&bar[XB_TOP], 1u);
            const unsigned tg = og / nx;
            if (og + 1u == (tg + 1u) * nx) xb_add(&bar[XB_TOPGEN], 1u);
            else XB_SPIN(xb_ld(&bar[XB_TOPGEN]) == tg, bar);
            __builtin_amdgcn_fence(__ATOMIC_ACQUIRE, "agent");
            xb_add(&bar[XB_XGEN(bx_)], 1u);
            asm volatile("s_waitcnt vmcnt(0)" ::: "memory");
        } else {
            XB_SPIN(xb_ld(&bar[XB_XGEN(bx_)]) == gen, bar);
            __builtin_amdgcn_fence(__ATOMIC_ACQUIRE, "agent");
            asm volatile("s_waitcnt vmcnt(0)" ::: "memory");
        }
    }
    __syncthreads();
}


__device__ __forceinline__ const void* karg(int k) {
    const __attribute__((address_space(4))) char* kp = (const __attribute__((address_space(4))) char*)__builtin_amdgcn_kernarg_segment_ptr();
    asm volatile("" : "+s"(kp));
    return *(const void* const __attribute__((address_space(4)))*)(kp + 8 * k);
}
#define LANE_IDS() int tid_ = threadIdx.x; asm volatile("" : "+v"(tid_)); const int tid = tid_, lane = tid & 63, wave = __builtin_amdgcn_readfirstlane(tid >> 6); (void)tid; (void)lane; (void)wave
struct Frame {
    LAS unsigned char* lds;
    volatile LAS unsigned* MISC;
    gu32* ctl;
    int vcu, G;
    float* out; unsigned char* wsb;
};
#define SWZ_XOR(v, m) __uint_as_float((unsigned)__builtin_amdgcn_ds_swizzle((int)__float_as_uint(v), (((m) << 10) | 0x1f)))
__device__ __forceinline__ float xor32(float v) { auto rr = __builtin_amdgcn_permlane32_swap(__float_as_uint(v), __float_as_uint(v), false, false); return __uint_as_float((threadIdx.x & 32) ? rr[0] : rr[1]); }
__device__ __forceinline__ float xor1(float v) { return __uint_as_float((unsigned)__builtin_amdgcn_update_dpp(0, (int)__float_as_uint(v), 0xB1, 0xF, 0xF, true)); }
__device__ __forceinline__ float wave_sum(float v) {
    v += SWZ_XOR(v, 1); v += SWZ_XOR(v, 2); v += SWZ_XOR(v, 4); v += SWZ_XOR(v, 8); v += SWZ_XOR(v, 16);
    auto rr = __builtin_amdgcn_permlane32_swap(__float_as_uint(v), __float_as_uint(v), false, false);
    return __uint_as_float(rr[0]) + __uint_as_float(rr[1]);
}
__device__ __forceinline__ float dot4(const f32x4 a) { return (a.x * a.x + a.y * a.y) + (a.z * a.z + a.w * a.w); }

template <int KIND> __device__ __forceinline__ int dest_row(int n) {
    if constexpr (KIND == 0) return n;
    else if constexpr (KIND == 3) return n < 544 ? n : n + 96;
    else if constexpr (KIND == 4) { const int v = n >= FF, c = v ? n - FF : n; return 256 * (c >> 7) + 128 * v + (c & 127); }
    else if constexpr (KIND == 1) {
        const int h = n / 192, d = n - h * 192;
        if (d < 128) return h * 128 + d;
        const int i = d - 128, t = h >> 2, hh = h & 3;
        return 2048 + 256 * t + 32 * hh + (i < 32 ? i : 128 + (i - 32));
    } else {
        const int g = n / 6144, r = n - g * 6144, t = r >> 11, r2 = r & 2047, h = r2 >> 7, d = r2 & 127;
        if (t == 2) return n;
        const int T = h >> 1, hh = h & 1;
        const int tc = d < 16 ? 16 * hh + d : (d < 32 ? 128 + 16 * hh + (d - 16) : hh * 128 + d);
        return g * 6144 + t * 2048 + T * 256 + tc;
    }
}
template <int KIND> __device__ __forceinline__ void p0_transpose_item(const float* W, int K, int N, bf16* WT, int row_off, LAS float* scr, int item, int lane) {
    const int nblk = N / 32, kb = item / nblk, nb = item - kb * nblk, k0 = 64 * kb, n0 = 32 * nb;
#pragma unroll 8
    for (int i = 0; i < 32; ++i) { const int kk = 2 * i + (lane >> 5); scr[kk * 33 + (lane & 31)] = W[(size_t)(k0 + kk) * N + n0 + (lane & 31)]; }
    LDS_WAIT(); asm volatile("" ::: "memory");
    const int c = lane & 7;
#pragma unroll
    for (int j = 0; j < 4; ++j) { const int n = (lane >> 3) + 8 * j; const LAS float* s = scr + (8 * c) * 33 + n;
        v4u o; o.x = pk2(s[0 * 33], s[1 * 33]); o.y = pk2(s[2 * 33], s[3 * 33]); o.z = pk2(s[4 * 33], s[5 * 33]); o.w = pk2(s[6 * 33], s[7 * 33]);
        *(GAS v4u*)(WT + (size_t)(row_off + dest_row<KIND>(n0 + n)) * K + k0 + 8 * c) = o; }
    LDS_WAIT(); asm volatile("" ::: "memory");
}
__device__ const double kRopeRev[32] = {
    0.15915494309189535, 0.10561541722123227, 0.0700865215877985, 0.046509502471476706, 0.03086376340470123, 0.020481231595318977, 0.013591370636193905, 0.009019250376164549,
    0.005985185712713705, 0.00397177664679776, 0.002635675898667414, 0.001749037788521446, 0.001160663641240061, 0.0007702178288757531, 0.0005111175045375439, 0.00033917820861925017,
    0.00022507907903927653, 0.00014936275542995963, 9.911730936901935e-05, 6.577436917438735e-05, 4.364795279280289e-05, 2.8964835496204437e-05, 1.9221100684944863e-05, 1.2755146204410543e-05,
    8.464330808241401e-06, 5.616940400618127e-06, 3.727408601915352e-06, 2.473512961630074e-06, 1.6414262627950345e-06, 1.0892524995776498e-06, 7.228293068832865e-07, 4.796704226907546e-07};

__device__ __forceinline__ void norm_rows_bf16(Frame& F, const float* src, const float* gain, bf16* dst) {
    LANE_IDS();
    const int gw = F.vcu * NWAVES + wave, NGW = F.G * NWAVES;
    f32x4 g[8];
#pragma unroll
    for (int j = 0; j < 8; ++j) g[j] = *(const f32x4*)(gain + 4 * lane + 256 * j);
    for (int m = gw; m < M; m += NGW) {
        const GAS f32x4* xr = (const GAS f32x4*)(src + (size_t)m * DM) + lane;
        f32x4 v[8]; float s = 0.f;
#pragma unroll
        for (int j = 0; j < 8; ++j) { v[j] = xr[64 * j]; s += dot4(v[j]); }
        const float r = 1.0f / sqrtf(wave_sum(s) * (1.0f / DM) + EPS);
        GAS v2u* o8 = (GAS v2u*)(dst + (size_t)m * DM) + lane;
#pragma unroll
        for (int j = 0; j < 8; ++j) { const f32x4 y = (v[j] * r) * g[j]; v2u w; w.x = pk2(y.x, y.y); w.y = pk2(y.z, y.w); o8[64 * j] = w; }
    }
}
__device__ __forceinline__ void norm_rows_f32_inplace(Frame& F, float* x, const float* gain) {
    LANE_IDS();
    const int gw = F.vcu * NWAVES + wave, NGW = F.G * NWAVES;
    f32x4 g[8];
#pragma unroll
    for (int j = 0; j < 8; ++j) g[j] = *(const f32x4*)(gain + 4 * lane + 256 * j);
    for (int m = gw; m < M; m += NGW) {
        GAS f32x4* xr = (GAS f32x4*)(x + (size_t)m * DM) + lane;
        f32x4 v[8]; float s = 0.f;
#pragma unroll
        for (int j = 0; j < 8; ++j) { v[j] = xr[64 * j]; s += dot4(v[j]); }
        const float r = 1.0f / sqrtf(wave_sum(s) * (1.0f / DM) + EPS);
#pragma unroll
        for (int j = 0; j < 8; ++j) xr[64 * j] = (v[j] * r) * g[j];
    }
}

__device__ __forceinline__ void p0_prologue(Frame& F) {
    LANE_IDS();
    LAS float* scr = (LAS float*)(F.lds + RING_OFF + wave * 16384);
    const int gw = F.vcu * NWAVES + wave, NGW = F.G * NWAVES;
    unsigned char* ws = F.wsb;
    constexpr int I0 = 32 * 16, I1 = 32 * 18, I2 = 8 * 96, I3 = 8 * 128, I4 = 32 * 64, I5 = 32 * 576, I6 = 32 * 64, I7 = 32 * 352, I8 = 88 * 64;
    constexpr int NITEMS = 2 * (I0 + I1 + I2 + I3 + I4 + I5 + I6) + 4 * (I7 + I8);
    for (int it = gw; it < NITEMS; it += NGW) {
        int r = it;
        if (r < 2 * I5) { const int l = r / I5; p0_transpose_item<2>((const float*)karg(12) + (size_t)l * DM * NDIL, DM, NDIL, (bf16*)(ws + WS_WDIL + l * WDIL_STRIDE + WDIL_IN), 0, scr, r - l * I5, lane); continue; } r -= 2 * I5;
        if (r < 4 * I7) { const int l = r / I7; p0_transpose_item<4>((const float*)karg(14) + (size_t)l * DM * NUP, DM, NUP, (bf16*)(ws + WS_WFFN + l * WFFN_STRIDE + WFFN_UP), 0, scr, r - l * I7, lane); continue; } r -= 4 * I7;
        if (r < 4 * I8) { const int l = r / I8; p0_transpose_item<0>((const float*)karg(17) + (size_t)l * FF * DM, FF, DM, (bf16*)(ws + WS_WFFN + l * WFFN_STRIDE + WFFN_DOWN), 0, scr, r - l * I8, lane); continue; } r -= 4 * I8;
        if (r < 2 * I6) { const int l = r / I6; p0_transpose_item<0>((const float*)karg(13) + (size_t)l * DM * DM, DM, DM, (bf16*)(ws + WS_WDIL + l * WDIL_STRIDE + WDIL_WO), 0, scr, r - l * I6, lane); continue; } r -= 2 * I6;
        if (r < 2 * I4) { const int l = r / I4; p0_transpose_item<0>((const float*)karg(11) + (size_t)l * DM * DM, DM, DM, (bf16*)(ws + WS_WMLA + l * WMLA_STRIDE + WMLA_WO), 0, scr, r - l * I4, lane); continue; } r -= 2 * I4;
        if (r < 2 * I3) { const int l = r / I3; p0_transpose_item<0>((const float*)karg(10) + (size_t)l * 512 * NKVB, 512, NKVB, (bf16*)(ws + WS_WMLA + l * WMLA_STRIDE + WMLA_KVB), 0, scr, r - l * I3, lane); continue; } r -= 2 * I3;
        if (r < 2 * I2) { const int l = r / I2; p0_transpose_item<1>((const float*)karg(7) + (size_t)l * 512 * NQB, 512, NQB, (bf16*)(ws + WS_WMLA + l * WMLA_STRIDE + WMLA_QB), 0, scr, r - l * I2, lane); continue; } r -= 2 * I2;
        if (r < 2 * I1) { const int l = r / I1; p0_transpose_item<3>((const float*)karg(8) + (size_t)l * DM * 576, DM, 576, (bf16*)(ws + WS_WMLA + l * WMLA_STRIDE + WMLA_QKVA), 512, scr, r - l * I1, lane); continue; } r -= 2 * I1;
        { const int l = r / I0; p0_transpose_item<0>((const float*)karg(5) + (size_t)l * DM * 512, DM, 512, (bf16*)(ws + WS_WMLA + l * WMLA_STRIDE + WMLA_QKVA), 0, scr, r - l * I0, lane); }
    }
    const int gt = F.vcu * (NWAVES * 64) + tid, NGT = F.G * NWAVES * 64;
    for (int i = gt; i < 2 * 192 * DM / 8; i += NGT) { const int l = i / (192 * DM / 8), e = i - l * (192 * DM / 8), rr = e / (DM / 8), cc = e - rr * (DM / 8), row = rr < 96 ? 1056 + rr : 1184 + (rr - 96);
        *((GAS v4u*)(ws + WS_WMLA + l * WMLA_STRIDE + WMLA_QKVA + (size_t)row * DM * 2) + cc) = (v4u){0u, 0u, 0u, 0u}; }
    const int* pos = (const int*)karg(1);
    for (int i = gt; i < M * 32; i += NGT) { const int row = i >> 5, k = i & 31;
        const double rev = (double)pos[row] * kRopeRev[k]; const float fr = (float)(rev - __builtin_rint(rev));
        const float c = __builtin_amdgcn_cosf(fr), s = __builtin_amdgcn_sinf(fr);
        ((float*)(ws + WS_COSM))[i] = c; ((float*)(ws + WS_SINM))[i] = s;
        if ((k & 1) == 0) { ((float*)(ws + WS_COSD))[row * 16 + (k >> 1)] = c; ((float*)(ws + WS_SIND))[row * 16 + (k >> 1)] = s; } }
    norm_rows_bf16(F, (const float*)karg(0), (const float*)karg(2), (bf16*)(ws + WS_H));
}

__device__ __forceinline__ void mla_mid(Frame& F, int j) {
    LANE_IDS();
    const int gw = ((int)blockIdx.x - 64) * NWAVES + wave, NGW = (F.G - 64) * NWAVES;
    unsigned char* ws = F.wsb;
    const float* qkva = (const float*)(ws + WS_S + S_QKVA);
    bf16* QN = (bf16*)(ws + WS_S + S_QN); bf16* CK = (bf16*)(ws + WS_S + S_CKVN);
    const float* gq = (const float*)karg(6) + j * 512; const float* gk = (const float*)karg(9) + j * 512;
    f32x4 g1[2], g2[2];
#pragma unroll
    for (int t = 0; t < 2; ++t) { g1[t] = *(const f32x4*)(gq + 4 * lane + 256 * t); g2[t] = *(const f32x4*)(gk + 4 * lane + 256 * t); }
    for (int m = gw; m < M; m += NGW) {
        const float* row = qkva + (size_t)m * NQKVA;
        f32x4 a[2], c[2];
#pragma unroll
        for (int t = 0; t < 2; ++t) { a[t] = *(const GAS f32x4*)(row + 4 * lane + 256 * t); c[t] = *(const GAS f32x4*)(row + 512 + 4 * lane + 256 * t); }
        const float ra = 1.0f / sqrtf(wave_sum(dot4(a[0]) + dot4(a[1])) * (1.0f / 512) + EPS);
        const float rc = 1.0f / sqrtf(wave_sum(dot4(c[0]) + dot4(c[1])) * (1.0f / 512) + EPS);
#pragma unroll
        for (int t = 0; t < 2; ++t) { const f32x4 y = (a[t] * ra) * g1[t], z = (c[t] * rc) * g2[t]; v2u w;
            w.x = pk2(y.x, y.y); w.y = pk2(y.z, y.w); *((GAS v2u*)(QN + (size_t)m * 512 + 256 * t) + lane) = w;
            w.x = pk2(z.x, z.y); w.y = pk2(z.z, z.w); *((GAS v2u*)(CK + (size_t)m * 512 + 256 * t) + lane) = w; }
    }
}

__device__ __forceinline__ void ffn_conv(Frame& F, int layer) {
    LANE_IDS();
    const int gw = F.vcu * NWAVES + wave, NGW = F.G * NWAVES;
    unsigned char* ws = F.wsb;
    const bf16* U = (const bf16*)(ws + WS_S + S_U); bf16* ACT = (bf16*)(ws + WS_S + S_ACT);
    const float* cw = (const float*)karg(15) + (size_t)layer * 3 * NUP; const float* cb = (const float*)karg(16) + (size_t)layer * NUP;
    constexpr int NSTRIP = M / 32, NCW = FF / 512, NIT = NSTRIP * NCW;
    for (int it = gw; it < NIT; it += NGW) {
        const int strip = it / NCW, cwv = it - strip * NCW, c0 = cwv * 512 + lane * 8, t0 = strip * 32;
        float wg[3][8], wv[3][8], bg[8], bv[8];
#pragma unroll
        for (int k = 0; k < 3; ++k)
#pragma unroll
            for (int e = 0; e < 8; e += 4) { const f32x4 a = *(const f32x4*)(cw + (size_t)k * NUP + c0 + e), b = *(const f32x4*)(cw + (size_t)k * NUP + FF + c0 + e);
                wg[k][e] = a.x; wg[k][e + 1] = a.y; wg[k][e + 2] = a.z; wg[k][e + 3] = a.w; wv[k][e] = b.x; wv[k][e + 1] = b.y; wv[k][e + 2] = b.z; wv[k][e + 3] = b.w; }
#pragma unroll
        for (int e = 0; e < 8; e += 4) { const f32x4 a = *(const f32x4*)(cb + c0 + e), b = *(const f32x4*)(cb + FF + c0 + e);
            bg[e] = a.x; bg[e + 1] = a.y; bg[e + 2] = a.z; bg[e + 3] = a.w; bv[e] = b.x; bv[e + 1] = b.y; bv[e + 2] = b.z; bv[e + 3] = b.w; }
        float g2[8], g1[8], v2[8], v1[8];
        if ((t0 & (SEQ - 1)) == 0) {
#pragma unroll
            for (int e = 0; e < 8; ++e) { g2[e] = 0.f; g1[e] = 0.f; v2[e] = 0.f; v1[e] = 0.f; }
        } else {
            const v4u a2 = *(const GAS v4u*)(U + (size_t)(t0 - 2) * NUP + c0), a1 = *(const GAS v4u*)(U + (size_t)(t0 - 1) * NUP + c0);
            const v4u b2 = *(const GAS v4u*)(U + (size_t)(t0 - 2) * NUP + FF + c0), b1 = *(const GAS v4u*)(U + (size_t)(t0 - 1) * NUP + FF + c0);
#pragma unroll
            for (int q = 0; q < 4; ++q) { g2[2 * q] = bf_lo(a2[q]); g2[2 * q + 1] = bf_hi(a2[q]); g1[2 * q] = bf_lo(a1[q]); g1[2 * q + 1] = bf_hi(a1[q]);
                                          v2[2 * q] = bf_lo(b2[q]); v2[2 * q + 1] = bf_hi(b2[q]); v1[2 * q] = bf_lo(b1[q]); v1[2 * q + 1] = bf_hi(b1[q]); }
        }
#pragma unroll 4
        for (int r = 0; r < 32; ++r) {
            const v4u a0 = *(const GAS v4u*)(U + (size_t)(t0 + r) * NUP + c0), b0 = *(const GAS v4u*)(U + (size_t)(t0 + r) * NUP + FF + c0);
            float g0[8], v0[8], o[8];
#pragma unroll
            for (int q = 0; q < 4; ++q) { g0[2 * q] = bf_lo(a0[q]); g0[2 * q + 1] = bf_hi(a0[q]); v0[2 * q] = bf_lo(b0[q]); v0[2 * q + 1] = bf_hi(b0[q]); }
#pragma unroll
            for (int e = 0; e < 8; ++e) {
                const float gt_ = bg[e] + wg[0][e] * g2[e] + wg[1][e] * g1[e] + wg[2][e] * g0[e];
                const float vl = bv[e] + wv[0][e] * v2[e] + wv[1][e] * v1[e] + wv[2][e] * v0[e];
                o[e] = gt_ / (1.0f + __expf(-gt_)) * vl;
                g2[e] = g1[e]; g1[e] = g0[e]; v2[e] = v1[e]; v1[e] = v0[e]; }
            v4u w; w.x = pk2(o[0], o[1]); w.y = pk2(o[2], o[3]); w.z = pk2(o[4], o[5]); w.w = pk2(o[6], o[7]);
            *(GAS v4u*)(ACT + (size_t)(t0 + r) * FF + c0) = w;
        }
    }
}

__device__ __forceinline__ void dil_merge(Frame& F) {
    LANE_IDS();
    const int gw = F.vcu * NWAVES + wave, NGW = F.G * NWAVES;
    unsigned char* ws = F.wsb;
    const bf16* OG = (const bf16*)(ws + WS_S + S_OG); const float* LSE = (const float*)(ws + WS_S + S_LSE); bf16* AO = (bf16*)(ws + WS_S + S_AO_DIL);
    for (int m = gw; m < M; m += NGW) {
        const int b = m >> 12, s = m & (SEQ - 1);
        const size_t sp0 = s, sp1 = (size_t)(s & 3) * (SEQ / 4) + (s >> 2), sp2 = (size_t)(s & 15) * (SEQ / 16) + (s >> 4);
#pragma unroll
        for (int j = 0; j < 4; ++j) { const int col = 8 * lane + 512 * j, head = col >> 7, dim = col & 127;
            const size_t r0 = ((size_t)(0 * 16 + head) * BATCH + b) * SEQ + sp0, r1 = ((size_t)(1 * 16 + head) * BATCH + b) * SEQ + sp1, r2 = ((size_t)(2 * 16 + head) * BATCH + b) * SEQ + sp2;
            const float l0 = LSE[r0], l1 = LSE[r1], l2 = LSE[r2];
            const float mx = fmaxf(l0, fmaxf(l1, l2)); float e0 = __expf(l0 - mx), e1 = __expf(l1 - mx), e2 = __expf(l2 - mx);
            const float inv = 1.0f / (e0 + e1 + e2); e0 *= inv; e1 *= inv; e2 *= inv;
            const v4u a = *(const GAS v4u*)(OG + r0 * 128 + dim), bb = *(const GAS v4u*)(OG + r1 * 128 + dim), c = *(const GAS v4u*)(OG + r2 * 128 + dim);
            v4u w;
#pragma unroll
            for (int q = 0; q < 4; ++q) w[q] = pk2(e0 * bf_lo(a[q]) + e1 * bf_lo(bb[q]) + e2 * bf_lo(c[q]), e0 * bf_hi(a[q]) + e1 * bf_hi(bb[q]) + e2 * bf_hi(c[q]));
            *(GAS v4u*)(AO + (size_t)m * DM + col) = w; }
    }
}

__device__ __forceinline__ void ffn_fixup(Frame& F, int layer, int pm) {
    LANE_IDS();
    if ((pm & 15) == 0) return;
    unsigned char* ws = F.wsb;
    const float* HALO = (const float*)(ws + WS_HALO); const float* FIX = (const float*)(ws + WS_FIX); bf16* ACT = (bf16*)(ws + WS_S + S_ACT);
    const float* cw = (const float*)karg(15) + (size_t)layer * 3 * NUP;
    for (int idx = tid; idx < 2 * (FF / 8); idx += NWAVES * 64) { const int rs = idx / (FF / 8), ch = (idx - rs * (FF / 8)) * 8;
        float o[8];
#pragma unroll
        for (int e = 0; e < 8; e += 4) {
            f32x4 cg = *(const GAS f32x4*)(FIX + ((size_t)pm * 2 + rs) * NUP + ch + e), cv = *(const GAS f32x4*)(FIX + ((size_t)pm * 2 + rs) * NUP + FF + ch + e);
            const f32x4 u1g = *(const GAS f32x4*)(HALO + ((size_t)(pm - 1) * 2 + 1) * NUP + ch + e), u1v = *(const GAS f32x4*)(HALO + ((size_t)(pm - 1) * 2 + 1) * NUP + FF + ch + e);
            const f32x4 u2g = *(const GAS f32x4*)(HALO + ((size_t)(pm - 1) * 2 + 0) * NUP + ch + e), u2v = *(const GAS f32x4*)(HALO + ((size_t)(pm - 1) * 2 + 0) * NUP + FF + ch + e);
            const f32x4 w0g = *(const f32x4*)(cw + ch + e), w0v = *(const f32x4*)(cw + FF + ch + e), w1g = *(const f32x4*)(cw + NUP + ch + e), w1v = *(const f32x4*)(cw + NUP + FF + ch + e);
            if (rs == 0) { cg = cg + w1g * u1g + w0g * u2g; cv = cv + w1v * u1v + w0v * u2v; } else { cg = cg + w0g * u1g; cv = cv + w0v * u1v; }
#pragma unroll
            for (int k = 0; k < 4; ++k) o[e + k] = cg[k] * __builtin_amdgcn_rcpf(1.0f + __builtin_amdgcn_exp2f(-1.4426950408889634f * cg[k])) * cv[k]; }
        v4u w; w.x = pk2(o[0], o[1]); w.y = pk2(o[2], o[3]); w.z = pk2(o[4], o[5]); w.w = pk2(o[6], o[7]);
        *(GAS v4u*)(ACT + ((size_t)pm * 256 + rs) * FF + ch) = w; }
}

struct MlaRef {
    const bf16* Q; const bf16* KV; const bf16* KPE; bf16* AO; int vcu;
    __device__ __forceinline__ att::BlockRef operator()(int i) const {
        const int I = vcu + 256 * (i >> 1), bh = I >> 3, x = I & 7, qb = (i & 1) ? 15 - x : x, b = bh >> 4, h = bh & 15;
        const size_t row0 = (size_t)b * SEQ + (size_t)qb * 256;
        att::BlockRef r; r.Q = Q + row0 * NQB + h * 128; r.Qpe = Q + row0 * NQB + 2048 + h * 64;
        r.K = KV + (size_t)bh * SEQ * 128; r.V = r.K + (size_t)M * DM; r.Kpe = KPE + (size_t)b * SEQ * 64;
        r.O = AO + row0 * DM + h * 128; r.Lse = nullptr; r.P0 = qb * 256; return r;
    }
};
struct DilRef {
    const bf16* QKV; bf16* OG; float* LSE; int vcu, g;
    __device__ __forceinline__ att::BlockRef operator()(int i) const {
        const int I = vcu + 256 * i, sh = 2 * g, d = 1 << sh, nqbs = 4 - sh;
        const int seq = I >> nqbs, qb = I & ((1 << nqbs) - 1), h = seq & 15, br = seq >> 4, rr = br & (d - 1), b = br >> sh;
        const size_t sp0 = (size_t)rr * (SEQ >> sh), spq = sp0 + (size_t)qb * 256;
        const size_t hb = ((size_t)(g * 3) * 16 + h) * BATCH + b, tstep = (size_t)16 * BATCH * SEQ * 128;
        att::BlockRef r; r.Q = QKV + (hb * SEQ + spq) * 128; r.Qpe = nullptr; r.Kpe = nullptr;
        r.K = QKV + tstep + (hb * SEQ + sp0) * 128; r.V = r.K + tstep;
        const size_t ob = ((size_t)g * 16 + h) * BATCH + b;
        r.O = OG + (ob * SEQ + spq) * 128; r.Lse = LSE + ob * SEQ + spq; r.P0 = qb * 256; return r;
    }
};
template <bool PE, bool SK, bool LSE, bool EARLY, class RefFn>
__device__ __forceinline__ void attn_run(char* lds, const att::Prm& P, int n, const RefFn& ref) {
    att::BlockRef cur = ref(0); att::Seam<PE> S;
    att::swa_prime<PE>(cur, P, lds, S);
    for (int i = 0;; ++i) {
        const bool last = i + 1 >= n;
        const att::BlockRef nxt = last ? cur : ref(i + 1);
        att::swa_block<PE, SK, LSE, EARLY>(cur, nxt, P, lds, S);
        if (last) break;
        cur = nxt;
    }
}

struct Args { const void* in[18]; float* out; unsigned char* ws; };
__global__ void __launch_bounds__(NWAVES * 64, 2) fwd_kernel(Args args) {
    extern __shared__ __attribute__((aligned(16))) unsigned char lds[];
    Frame F;
    F.lds = (LAS unsigned char*)lds;
    F.MISC = (volatile LAS unsigned*)(F.lds + MISC_OFF);
    F.G = gridDim.x; { const int bx = blockIdx.x; F.vcu = (F.G % 8 == 0) ? (bx % 8) * (F.G / 8) + bx / 8 : bx; }
        F.out = args.out; F.wsb = args.ws;
    F.ctl = (gu32*)(args.ws + WS_CTL);
#define ws F.wsb
#define RELAUNDER() asm volatile("" : "+s"(F.vcu), "+s"(F.wsb), "+s"(F.out))
    for (int u = threadIdx.x; u < (LDS_BYTES - LDSCTL_OFF) / 4; u += NWAVES * 64) ((LAS unsigned*)(F.lds + LDSCTL_OFF))[u] = 0u;
    __syncthreads();
    XcdBarrier bar = xcd_barrier_post((unsigned*)(F.ctl + CW_BAR), F.MISC + 8);
#if PROBE_DUP & 1024
#define GRID_BAR() do { xcd_barrier(bar); xcd_barrier(bar); } while (0)
#else
#define GRID_BAR() xcd_barrier(bar)
#endif
    typedef pg8::StaticOrder SO;
#define GEMMR(EpiT, Aptr, Bptr, N_, K_, Eobj, REP_) do { pg8::Gemm g_{(const bf16*)(Aptr), (const bf16*)(Bptr), M, (N_), (K_)}; SO S_; S_.init(M, (N_), F.G, (int)blockIdx.x); \
        pg8::gemm_phase<EpiT, SO, true, true, REP_>(F.lds + RING_OFF, g_, S_, (Eobj)); } while (0)
#define GEMM(EpiT, Aptr, Bptr, N_, K_, Eobj) GEMMR(EpiT, Aptr, Bptr, N_, K_, Eobj, 1)

    bf16* H = (bf16*)(ws + WS_H);
    const float* cosM = (const float*)(ws + WS_COSM); const float* sinM = (const float*)(ws + WS_SINM);
    const float* cosD = (const float*)(ws + WS_COSD); const float* sinD = (const float*)(ws + WS_SIND);

    p0_prologue(F);
#if PROBE_DUP & 64
    p0_prologue(F);
#endif
    GRID_BAR();

    for (int j = 0; j < 2; ++j) {
        {
            RELAUNDER();
            const unsigned char* wl = ws + WS_WMLA + j * WMLA_STRIDE;
            float* QKVA = (float*)(ws + WS_S + S_QKVA); bf16* QN = (bf16*)(ws + WS_S + S_QN); bf16* CK = (bf16*)(ws + WS_S + S_CKVN); bf16* KPE = (bf16*)(ws + WS_S + S_KPE);
            bf16* Q = (bf16*)(ws + WS_S + S_Q); bf16* KV = (bf16*)(ws + WS_S + S_KV); bf16* AO = (bf16*)(ws + WS_S + S_AO_MLA);
            if (j > 0) {
#if PROBE_DUP & 32
            norm_rows_bf16(F, F.out, (const float*)karg(2) + (2 * j) * DM, H);
#endif
            norm_rows_bf16(F, F.out, (const float*)karg(2) + (2 * j) * DM, H); GRID_BAR(); }
            { pg8::EpiF32Store E{QKVA, NQKVA}; GEMM(pg8::EpiF32Store, H, wl + WMLA_QKVA, 1024, DM, E); }
            GRID_BAR();
            if (blockIdx.x < 64) {
                pg8::Gemm g_{(const bf16*)H, (const bf16*)(wl + WMLA_QKVA), M, NQKVA, DM}; pg8::OneUnit S_{(int)blockIdx.x, 4}; pg8::EpiKpe E{KPE, cosM, sinM};
                pg8::gemm_phase<pg8::EpiKpe, pg8::OneUnit, true, true>(F.lds + RING_OFF, g_, S_, E);
            } else mla_mid(F, j);
            GRID_BAR();
            { pg8::EpiQMla E{Q, cosM, sinM}; GEMM(pg8::EpiQMla, QN, wl + WMLA_QB, NQB, 512, E); }
            { pg8::EpiKvMla E{KV, KV + (size_t)M * DM}; GEMM(pg8::EpiKvMla, CK, wl + WMLA_KVB, NKVB, 512, E); }
#if PROBE_DUP & 2048
            { pg8::EpiQMla E{Q, cosM, sinM}; GEMM(pg8::EpiQMla, QN, wl + WMLA_QB, NQB, 512, E); }
            { pg8::EpiKvMla E{KV, KV + (size_t)M * DM}; GEMM(pg8::EpiKvMla, CK, wl + WMLA_KVB, NKVB, 512, E); }
#endif
            GRID_BAR();
            RELAUNDER();
            { att::Prm P{NQB, 128, DM, NQB, 64, 0, SEQ, SEQ, 0.07216878364870322f};
              MlaRef R{Q, KV, KPE, AO, F.vcu};
              attn_run<true, false, false, false>((char*)lds + RING_OFF, P, 4, R);
#if PROBE_DUP & 1
              attn_run<true, false, false, false>((char*)lds + RING_OFF, P, 4, R);
#endif
            }
            GRID_BAR();
#if PROBE_DUP & 128
            { pg8::EpiRes E{(const float*)F.out, (float*)(ws + WS_S + S_KV), DM}; GEMM(pg8::EpiRes, AO, wl + WMLA_WO, DM, DM, E); }
#endif
            { pg8::EpiRes E{j == 0 ? (const float*)karg(0) : (const float*)F.out, F.out, DM}; GEMM(pg8::EpiRes, AO, wl + WMLA_WO, DM, DM, E); }
            GRID_BAR();
        }
        {
            RELAUNDER();
            const int layer = 2 * j; const unsigned char* wl = ws + WS_WFFN + layer * WFFN_STRIDE;
            bf16* ACT = (bf16*)(ws + WS_S + S_ACT);

#if PROBE_DUP & 32
            norm_rows_bf16(F, F.out, (const float*)karg(3) + layer * DM, H);
#endif
            norm_rows_bf16(F, F.out, (const float*)karg(3) + layer * DM, H); GRID_BAR();
            { pg8::EpiUpConv E{ACT, (float*)(ws + WS_HALO), (float*)(ws + WS_FIX), (const float*)karg(15) + (size_t)layer * 3 * NUP, (const float*)karg(16) + (size_t)layer * NUP,
                               (PG8_LAS float*)(F.lds + XH_OFF), (PG8_LAS float*)(F.lds + CWL_OFF)};
              GEMM(pg8::EpiUpConv, H, wl + WFFN_UP, NUP, DM, E);
#if PROBE_DUP & 4
              GEMM(pg8::EpiUpConv, H, wl + WFFN_UP, NUP, DM, E);
#endif
            }
            GRID_BAR();
            { SO S_; S_.init(M, DM, F.G, (int)blockIdx.x); pg8::Unit u_; for (int i = 0; S_.next(i, u_); ++i) ffn_fixup(F, layer, u_.pm);
              asm volatile("s_waitcnt vmcnt(0)" ::: "memory"); __syncthreads(); }
#if PROBE_DUP & 256
            { pg8::EpiRes E{F.out, (float*)(ws + WS_S + S_U), DM}; GEMM(pg8::EpiRes, ACT, wl + WFFN_DOWN, DM, FF, E); }
#endif
            { pg8::EpiRes E{F.out, F.out, DM}; GEMM(pg8::EpiRes, ACT, wl + WFFN_DOWN, DM, FF, E); }
            GRID_BAR();
        }
        {
            RELAUNDER();
            const unsigned char* wl = ws + WS_WDIL + j * WDIL_STRIDE;
            bf16* QKV = (bf16*)(ws + WS_S + S_QKV); bf16* OG = (bf16*)(ws + WS_S + S_OG); float* LSE = (float*)(ws + WS_S + S_LSE); bf16* AO = (bf16*)(ws + WS_S + S_AO_DIL);

#if PROBE_DUP & 32
            norm_rows_bf16(F, F.out, (const float*)karg(2) + (2 * j + 1) * DM, H);
#endif
            norm_rows_bf16(F, F.out, (const float*)karg(2) + (2 * j + 1) * DM, H); GRID_BAR();
            { pg8::EpiQkvDil E{QKV, cosD, sinD}; GEMM(pg8::EpiQkvDil, H, wl + WDIL_IN, NDIL, DM, E);
#if PROBE_DUP & 8
              GEMM(pg8::EpiQkvDil, H, wl + WDIL_IN, NDIL, DM, E);
#endif
            }
            GRID_BAR();
#pragma unroll 1
            for (int g = 0; g < 3; ++g) { const int d = 1 << (2 * g);
              att::Prm P{128, 128, 128, 0, 0, 1, SEQ / d, 129, 0.08838834764831845f};
              DilRef R{QKV, OG, LSE, F.vcu, g};
              attn_run<false, true, true, true>((char*)lds + RING_OFF, P, 4, R);
#if PROBE_DUP & 2
              attn_run<false, true, true, true>((char*)lds + RING_OFF, P, 4, R);
#endif
            }
            GRID_BAR();
            dil_merge(F);
#if PROBE_DUP & 32
            dil_merge(F);
#endif
            GRID_BAR();
#if PROBE_DUP & 128
            { pg8::EpiRes E{F.out, (float*)(ws + WS_S + S_QKV), DM}; GEMM(pg8::EpiRes, AO, wl + WDIL_WO, DM, DM, E); }
#endif
            { pg8::EpiRes E{F.out, F.out, DM}; GEMM(pg8::EpiRes, AO, wl + WDIL_WO, DM, DM, E); }
            GRID_BAR();
        }
        {
            RELAUNDER();
            const int layer = 2 * j + 1; const unsigned char* wl = ws + WS_WFFN + layer * WFFN_STRIDE;
            bf16* ACT = (bf16*)(ws + WS_S + S_ACT);

#if PROBE_DUP & 32
            norm_rows_bf16(F, F.out, (const float*)karg(3) + layer * DM, H);
#endif
            norm_rows_bf16(F, F.out, (const float*)karg(3) + layer * DM, H); GRID_BAR();
            { pg8::EpiUpConv E{ACT, (float*)(ws + WS_HALO), (float*)(ws + WS_FIX), (const float*)karg(15) + (size_t)layer * 3 * NUP, (const float*)karg(16) + (size_t)layer * NUP,
                               (PG8_LAS float*)(F.lds + XH_OFF), (PG8_LAS float*)(F.lds + CWL_OFF)};
              GEMM(pg8::EpiUpConv, H, wl + WFFN_UP, NUP, DM, E);
#if PROBE_DUP & 4
              GEMM(pg8::EpiUpConv, H, wl + WFFN_UP, NUP, DM, E);
#endif
            }
            GRID_BAR();
            { SO S_; S_.init(M, DM, F.G, (int)blockIdx.x); pg8::Unit u_; for (int i = 0; S_.next(i, u_); ++i) ffn_fixup(F, layer, u_.pm);
              asm volatile("s_waitcnt vmcnt(0)" ::: "memory"); __syncthreads(); }
#if PROBE_DUP & 256
            { pg8::EpiRes E{F.out, (float*)(ws + WS_S + S_U), DM}; GEMM(pg8::EpiRes, ACT, wl + WFFN_DOWN, DM, FF, E); }
#endif
            { pg8::EpiRes E{F.out, F.out, DM}; GEMM(pg8::EpiRes, ACT, wl + WFFN_DOWN, DM, FF, E); }
            GRID_BAR();
        }
    }
    RELAUNDER();
    norm_rows_f32_inplace(F, F.out, (const float*)karg(4));
#undef ws
#undef RELAUNDER
#undef GEMM
#undef GEMMR
#undef GRID_BAR
}

extern "C" void kernel_launch(void* const* d_in, const int* in_sizes, int n_in, void* d_out, int out_size, void* d_ws, size_t ws_size, hipStream_t stream) {
    static int grid = 0;
    if (grid == 0) {
        if (n_in != 18 || in_sizes[0] != M * DM || out_size != M * DM || ws_size < WS_END) {
            fprintf(stderr, "kernel_launch: shape / workspace mismatch (n_in %d, in0 %d, out %d, ws %zu, need %zu); nothing launched\n", n_in, n_in > 0 ? in_sizes[0] : -1, out_size, ws_size, (size_t)WS_END); grid = -1; return; }
        int dev = 0, cus = 0, per_cu = 0;
        if (hipGetDevice(&dev) != hipSuccess || hipDeviceGetAttribute(&cus, hipDeviceAttributeMultiprocessorCount, dev) != hipSuccess) { grid = -1; return; }
        if (hipFuncSetAttribute((const void*)fwd_kernel, hipFuncAttributeMaxDynamicSharedMemorySize, LDS_BYTES) != hipSuccess) { fprintf(stderr, "kernel_launch: hipFuncSetAttribute failed\n"); grid = -1; return; }
        if (hipOccupancyMaxActiveBlocksPerMultiprocessor(&per_cu, (const void*)fwd_kernel, NWAVES * 64, LDS_BYTES) != hipSuccess || per_cu < 1) fprintf(stderr, "kernel_launch: occupancy query reports %d\n", per_cu);
        (void)hipGetLastError();
        if (cus < 256) { fprintf(stderr, "kernel_launch: built for a 256-CU device, found %d CUs; nothing launched\n", cus); grid = -1; return; }
        grid = 256;
    }
    if (grid < 0) return;
    if (hipMemsetAsync((char*)d_ws + WS_CTL, 0, CTL_ZERO_BYTES, stream) != hipSuccess) return;
    Args a{};
    for (int i = 0; i < 18; ++i) a.in[i] = d_in[i];
    a.out = (float*)d_out; a.ws = (unsigned char*)d_ws;
    hipLaunchKernelGGL(fwd_kernel, dim3(grid), dim3(NWAVES * 64), LDS_BYTES, stream, a);
}
```

```cpp
#include <hip/hip_runtime.h>
#include <cstdio>
#include <cstdint>
namespace pg8 {
#define PG8_LAS __attribute__((address_space(3)))
typedef unsigned short bf16_t;
typedef short bf16x8 __attribute__((ext_vector_type(8)));
typedef float f32x4 __attribute__((ext_vector_type(4)));
typedef unsigned u32x4 __attribute__((ext_vector_type(4)));
constexpr int BM = 256, BK = 64, HALF = 128, HTB = HALF * BK * 2  , STAGE_BYTES = 8 * HTB, NXCD = 8, WGM = 8;

__host__ __device__ __forceinline__ int lds_byte(int r, int c) { const int st = (r >> 4) * 2 + (c >> 5), rr = r & 15, cc = c & 31, ob = rr * 64 + cc * 2; return st * 1024 + (ob ^ (((ob >> 9) & 1) << 5)); }
__host__ __device__ __forceinline__ void stage_rc(int b, int& R, int& C) { const int st = b / 1024, sb = b % 1024, swz = sb ^ (((sb >> 9) & 1) << 5); R = (st >> 1) * 16 + swz / 64; C = (st & 1) * 32 + (swz % 64) / 2; }
__host__ __device__ __forceinline__ int perm32(int rho) { const int n = rho >> 4, i = rho & 15; return 8 * (i >> 2) + 4 * n + (i & 3); }

struct Unit { int pm, pn; };
struct Gemm { const bf16_t* A; const bf16_t* Bt; int M, N, K; };

struct StaticOrder {
    int nM, nN, nwg, G, c;
    __host__ __device__ void init(int M, int N, int G_, int c_) { nM = M / BM; nN = N / BM; nwg = nM * nN; G = G_; c = c_; }
    __host__ __device__ __forceinline__ bool next(int i, Unit& u) const {
        const long L = (long)i * G + c; if (L >= nwg) return false;
        int wgid = (int)L; { const int q = nwg / NXCD, r = nwg % NXCD, xcd = wgid % NXCD, off = wgid / NXCD; wgid = (xcd < r ? xcd * (q + 1) : r * (q + 1) + (xcd - r) * q) + off; }
        const int nig = WGM * nN, gid = wgid / nig, fm = gid * WGM, gsz = (nM - fm) < WGM ? (nM - fm) : WGM;
        u.pm = fm + ((wgid % nig) % gsz); u.pn = (wgid % nig) / gsz; return true;
    }
    __device__ __forceinline__ void a_ready(const Unit&) const {}
    __device__ __forceinline__ void done(const Unit&) const {}
};

__device__ __forceinline__ unsigned cvt_pk_bf16(float lo, float hi) { unsigned r; asm volatile("v_cvt_pk_bf16_f32 %0, %1, %2" : "=v"(r) : "v"(lo), "v"(hi)); return r; }
typedef float f32x2 __attribute__((ext_vector_type(2)));
typedef unsigned u32x2 __attribute__((ext_vector_type(2)));
__device__ __forceinline__ u32x4 pack8bf(const f32x4 a, const f32x4 b) { u32x4 w; w.x = cvt_pk_bf16(a[0], a[1]); w.y = cvt_pk_bf16(a[2], a[3]); w.z = cvt_pk_bf16(b[0], b[1]); w.w = cvt_pk_bf16(b[2], b[3]); return w; }
#define PG8_NOPRE struct Pre {}; __device__ __forceinline__ void pre_issue(Pre&, const Unit&, int, int) const {} __device__ __forceinline__ void pre_finish(Pre&, int, int) const {}
struct EpiF32Store {
    PG8_NOPRE
    static constexpr bool PERM = false, AFTER_DRAIN = false;
    float* C; int ldc;
    __device__ __forceinline__ void operator()(const f32x4 (&acc)[2][2][4][2], const Unit& u, int wr, int wc, int fr, int fq, int ui) const {
        const int row0 = u.pm * BM + wr * 64 + fr, col0 = u.pn * BM + wc * 32 + 4 * fq;
#pragma unroll
        for (int ai = 0; ai < 2; ++ai)
#pragma unroll
            for (int m = 0; m < 4; ++m) { float* rowp = C + (size_t)(row0 + ai * HALF + m * 16) * ldc + col0;
#pragma unroll
                for (int bj = 0; bj < 2; ++bj)
#pragma unroll
                    for (int n = 0; n < 2; ++n) *(f32x4*)(rowp + bj * HALF + n * 16) = acc[ai][bj][m][n]; }
    }
};
struct EpiRes {
    PG8_NOPRE
    static constexpr bool PERM = false, AFTER_DRAIN = false;
    const float* base; float* out; int ldc;
    __device__ __forceinline__ void operator()(const f32x4 (&acc)[2][2][4][2], const Unit& u, int wr, int wc, int fr, int fq, int ui) const {
        const int row0 = u.pm * BM + wr * 64 + fr, col0 = u.pn * BM + wc * 32 + 4 * fq;
#pragma unroll
        for (int ai = 0; ai < 2; ++ai) {
            f32x4 bs[4][2][2];
#pragma unroll
            for (int m = 0; m < 4; ++m) { const size_t off = (size_t)(row0 + ai * HALF + m * 16) * ldc + col0;
#pragma unroll
                for (int bj = 0; bj < 2; ++bj)
#pragma unroll
                    for (int n = 0; n < 2; ++n) bs[m][bj][n] = *(const f32x4*)(base + off + bj * HALF + n * 16); }
#pragma unroll
            for (int m = 0; m < 4; ++m) { const size_t off = (size_t)(row0 + ai * HALF + m * 16) * ldc + col0;
#pragma unroll
                for (int bj = 0; bj < 2; ++bj)
#pragma unroll
                    for (int n = 0; n < 2; ++n) *(f32x4*)(out + off + bj * HALF + n * 16) = bs[m][bj][n] + acc[ai][bj][m][n]; }
            asm volatile("" ::: "memory"); }
    }
};

#define PG8_DPP(old_, src_, ctrl_) __uint_as_float((unsigned)__builtin_amdgcn_update_dpp((int)__float_as_uint(old_), (int)__float_as_uint(src_), (ctrl_), 0xF, 0xF, false))
struct EpiUpConv {
    static constexpr bool PERM = true, AFTER_DRAIN = false;
    bf16_t* ACT; float* HALO; float* FIX; const float* cw; const float* cb;
    PG8_LAS float* xh; PG8_LAS float* cwl;
    PG8_NOPRE
    __device__ __forceinline__ void operator()(const f32x4 (&acc)[2][2][4][2], const Unit& u, int wr, int wc, int fr_, int fq_, int ui) const {
        int fr = fr_, fq = fq_; asm volatile("" : "+v"(fr), "+v"(fq));
        const int ch0 = 128 * u.pn + 32 * wc + 8 * fq;
        f32x4 wv = {0.f, 0.f, 0.f, 0.f};
        if (wr == 0) { const int lane = fq * 16 + fr; wv = *(const f32x4*)((wc < 3 ? cw + (size_t)wc * 11264 : cb) + (lane < 32 ? 128 * u.pn + lane * 4 : 5632 + 128 * u.pn + (lane - 32) * 4)); }
        if (fr >= 14) {
#pragma unroll
            for (int ai = 0; ai < 2; ++ai) if (ai == 0 || wr == 0) { PG8_LAS float* b = xh + ((((ai == 0 ? wr : 2) * 4 + wc) * 2 + (fr - 14)) * 4 + fq) * 16;
#pragma unroll
                for (int bj = 0; bj < 2; ++bj)
#pragma unroll
                    for (int n = 0; n < 2; ++n) *(PG8_LAS f32x4*)(b + (bj * 2 + n) * 4) = acc[ai][bj][3][n]; }
            if (wr == 1) { float* hp = HALO + ((size_t)u.pm * 2 + (fr - 14)) * 11264 + ch0;
#pragma unroll
                for (int bj = 0; bj < 2; ++bj)
#pragma unroll
                    for (int n = 0; n < 2; ++n) *(f32x4*)(hp + bj * 5632 + n * 4) = acc[1][bj][3][n]; }
        }
        if (wr == 0) *(PG8_LAS f32x4*)(cwl + wc * 256 + (fq * 16 + fr) * 4) = wv;
        asm volatile("s_waitcnt lgkmcnt(0)" ::: "memory"); __builtin_amdgcn_s_barrier(); asm volatile("" ::: "memory");
        const bool fixtile = (u.pm & 15) != 0;
#pragma unroll
        for (int n = 0; n < 2; ++n) {
            const PG8_LAS float* cwb = cwl + wc * 32 + fq * 8 + n * 4;
#pragma unroll
            for (int ai = 0; ai < 2; ++ai)
#pragma unroll
                for (int m = 0; m < 4; ++m) {
                    f32x4 c[2];
#pragma unroll
                    for (int bj = 0; bj < 2; ++bj) {
                        f32x4 W[4];
#pragma unroll
                        for (int t = 0; t < 4; ++t) W[t] = *(const PG8_LAS f32x4*)(cwb + t * 256 + bj * 128);
                        f32x4 h1 = {0.f, 0.f, 0.f, 0.f}, h2 = {0.f, 0.f, 0.f, 0.f};
                        if (m == 0 && !(ai == 0 && wr == 0)) { const int slot = ai == 0 ? 0 : (wr == 0 ? 1 : 2); const PG8_LAS float* b = xh + (((slot * 4 + wc) * 2) * 4 + fq) * 16 + n * 4 + bj * 8;
                            h2 = *(const PG8_LAS f32x4*)b; h1 = *(const PG8_LAS f32x4*)(b + 64); }
#pragma unroll
                        for (int k = 0; k < 4; ++k) { const float cur = acc[ai][bj][m][n][k]; float x1, z;
                            if (m == 0) { x1 = h1[k]; z = fr == 0 ? h2[k] : h1[k]; }
                            else { const float p = acc[ai][bj][m > 0 ? m - 1 : 0][n][k]; x1 = PG8_DPP(0.f, p, 0x121); z = PG8_DPP(0.f, p, 0x122); }
                            const float t1 = PG8_DPP(x1, cur, 0x111), t2 = PG8_DPP(z, cur, 0x112);
                            c[bj][k] = W[3][k] + W[0][k] * t2 + W[1][k] * t1 + W[2][k] * cur; }
                        __builtin_amdgcn_sched_barrier(0);
                    }
                    const int row = u.pm * BM + ai * HALF + wr * 64 + m * 16 + fr;
                    if (ai == 0 && m == 0 && wr == 0 && fixtile && fr < 2) {
                        float* fp = FIX + ((size_t)u.pm * 2 + fr) * 11264 + ch0 + n * 4;
                        *(f32x4*)fp = c[0]; *(f32x4*)(fp + 5632) = c[1];
                    } else {
                        f32x4 a;
#pragma unroll
                        for (int k = 0; k < 4; ++k) { const float g = c[0][k]; a[k] = g * __builtin_amdgcn_rcpf(1.0f + __builtin_amdgcn_exp2f(-1.4426950408889634f * g)) * c[1][k]; }
                        u32x2 w; w.x = cvt_pk_bf16(a[0], a[1]); w.y = cvt_pk_bf16(a[2], a[3]);
                        *(u32x2*)(ACT + (size_t)row * 5632 + ch0 + n * 4) = w;
                    }
                    asm volatile("" ::: "memory"); __builtin_amdgcn_sched_barrier(0);
                }
        }
    }
};
struct EpiKpe {
    PG8_NOPRE
    static constexpr bool PERM = true, AFTER_DRAIN = false;
    bf16_t* KPE; const float* cosT; const float* sinT;
    __device__ __forceinline__ void operator()(const f32x4 (&acc)[2][2][4][2], const Unit& u, int wr, int wc, int fr, int fq, int ui) const {
        if (wc != 0) return;
        const int row0 = u.pm * BM + wr * 64 + fr, i0 = 8 * fq;
#pragma unroll
        for (int ai = 0; ai < 2; ++ai)
#pragma unroll
            for (int m = 0; m < 4; ++m) { const int row = row0 + ai * HALF + m * 16;
                const f32x4 c0 = *(const f32x4*)(cosT + (size_t)row * 32 + i0), c1 = *(const f32x4*)(cosT + (size_t)row * 32 + i0 + 4);
                const f32x4 s0 = *(const f32x4*)(sinT + (size_t)row * 32 + i0), s1 = *(const f32x4*)(sinT + (size_t)row * 32 + i0 + 4);
                const f32x4 x1a = acc[ai][0][m][0], x1b = acc[ai][0][m][1], x2a = acc[ai][1][m][0], x2b = acc[ai][1][m][1];
                const f32x4 y1a = x1a * c0 - x2a * s0, y1b = x1b * c1 - x2b * s1, y2a = x2a * c0 + x1a * s0, y2b = x2b * c1 + x1b * s1;
                bf16_t* dst = KPE + (size_t)row * 64 + i0;
                *(u32x4*)dst = pack8bf(y1a, y1b); *(u32x4*)(dst + 32) = pack8bf(y2a, y2b); }
    }
};
struct OneUnit { int pm, pn;
    __device__ __forceinline__ bool next(int i, Unit& u) const { if (i) return false; u.pm = pm; u.pn = pn; return true; }
    __device__ __forceinline__ void a_ready(const Unit&) const {}
    __device__ __forceinline__ void done(const Unit&) const {}
};
struct EpiKvMla {
    PG8_NOPRE
    static constexpr bool PERM = true, AFTER_DRAIN = false;
    bf16_t* KH; bf16_t* VH;
    __device__ __forceinline__ void operator()(const f32x4 (&acc)[2][2][4][2], const Unit& u, int wr, int wc, int fr, int fq, int ui) const {
        const int row0 = u.pm * BM + wr * 64 + fr, dim0 = wc * 32 + 8 * fq;
#pragma unroll
        for (int ai = 0; ai < 2; ++ai)
#pragma unroll
            for (int m = 0; m < 4; ++m) { const int row = row0 + ai * HALF + m * 16, b = row >> 12, s = row & 4095;
                const size_t o = (((size_t)b * 16 + u.pn) * 4096 + s) * 128 + dim0;
                *(u32x4*)(KH + o) = pack8bf(acc[ai][0][m][0], acc[ai][0][m][1]); *(u32x4*)(VH + o) = pack8bf(acc[ai][1][m][0], acc[ai][1][m][1]); }
    }
};
struct EpiQMla {
    PG8_NOPRE
    static constexpr bool PERM = true, AFTER_DRAIN = false;
    bf16_t* Q; const float* cosT; const float* sinT;
    __device__ __forceinline__ void operator()(const f32x4 (&acc)[2][2][4][2], const Unit& u, int wr, int wc, int fr, int fq, int ui) const {
        const int row0 = u.pm * BM + wr * 64 + fr;
        if (u.pn < 8) {
            const int col0 = u.pn * BM + wc * 32 + 8 * fq;
#pragma unroll
            for (int ai = 0; ai < 2; ++ai)
#pragma unroll
                for (int m = 0; m < 4; ++m) { bf16_t* rowp = Q + (size_t)(row0 + ai * HALF + m * 16) * 3072 + col0;
#pragma unroll
                    for (int bj = 0; bj < 2; ++bj) *(u32x4*)(rowp + bj * HALF) = pack8bf(acc[ai][bj][m][0], acc[ai][bj][m][1]); }
        } else {
            const int head = 4 * (u.pn - 8) + wc, i0 = 8 * fq;
#pragma unroll
            for (int ai = 0; ai < 2; ++ai)
#pragma unroll
                for (int m = 0; m < 4; ++m) { const int row = row0 + ai * HALF + m * 16;
                    const f32x4 c0 = *(const f32x4*)(cosT + (size_t)row * 32 + i0), c1 = *(const f32x4*)(cosT + (size_t)row * 32 + i0 + 4);
                    const f32x4 s0 = *(const f32x4*)(sinT + (size_t)row * 32 + i0), s1 = *(const f32x4*)(sinT + (size_t)row * 32 + i0 + 4);
                    const f32x4 x1a = acc[ai][0][m][0], x1b = acc[ai][0][m][1], x2a = acc[ai][1][m][0], x2b = acc[ai][1][m][1];
                    const f32x4 y1a = x1a * c0 - x2a * s0, y1b = x1b * c1 - x2b * s1, y2a = x2a * c0 + x1a * s0, y2b = x2b * c1 + x1b * s1;
                    bf16_t* dst = Q + (size_t)row * 3072 + 2048 + head * 64 + i0;
                    *(u32x4*)dst = pack8bf(y1a, y1b); *(u32x4*)(dst + 32) = pack8bf(y2a, y2b); }
        }
    }
};
struct EpiQkvDil {
    PG8_NOPRE
    static constexpr bool PERM = true, AFTER_DRAIN = false;
    bf16_t* O; const float* cosT; const float* sinT;
    __device__ __forceinline__ void operator()(const f32x4 (&acc)[2][2][4][2], const Unit& u, int wr, int wc, int fr, int fq, int ui) const {
        const int row0 = u.pm * BM + wr * 64 + fr;
        const int g = u.pn / 24, rem = u.pn - g * 24, t = rem >> 3, T = rem & 7, sh = 2 * g;
        const size_t plane = ((size_t)(g * 3 + t) * 16 + 2 * T) * 4;
        if (t == 2 || wc != 0) {
            const int dim0 = wc * 32 + 8 * fq;
#pragma unroll
            for (int ai = 0; ai < 2; ++ai)
#pragma unroll
                for (int m = 0; m < 4; ++m) { const int row = row0 + ai * HALF + m * 16, b = row >> 12, s = row & 4095, sp = ((s & ((1 << sh) - 1)) << (12 - sh)) + (s >> sh);
#pragma unroll
                    for (int bj = 0; bj < 2; ++bj) *(u32x4*)(O + ((plane + bj * 4 + b) * 4096 + sp) * 128 + dim0) = pack8bf(acc[ai][bj][m][0], acc[ai][bj][m][1]); }
        } else {
            const int hh = fq >> 1, i0 = 8 * (fq & 1);
#pragma unroll
            for (int ai = 0; ai < 2; ++ai)
#pragma unroll
                for (int m = 0; m < 4; ++m) { const int row = row0 + ai * HALF + m * 16, b = row >> 12, s = row & 4095, sp = ((s & ((1 << sh) - 1)) << (12 - sh)) + (s >> sh);
                    const f32x4 c0 = *(const f32x4*)(cosT + (size_t)row * 16 + i0), c1 = *(const f32x4*)(cosT + (size_t)row * 16 + i0 + 4);
                    const f32x4 s0 = *(const f32x4*)(sinT + (size_t)row * 16 + i0), s1 = *(const f32x4*)(sinT + (size_t)row * 16 + i0 + 4);
                    const f32x4 x1a = acc[ai][0][m][0], x1b = acc[ai][0][m][1], x2a = acc[ai][1][m][0], x2b = acc[ai][1][m][1];
                    const f32x4 y1a = x1a * c0 - x2a * s0, y1b = x1b * c1 - x2b * s1, y2a = x2a * c0 + x1a * s0, y2b = x2b * c1 + x1b * s1;
                    bf16_t* dst = O + ((plane + hh * 4 + b) * 4096 + sp) * 128 + i0;
                    *(u32x4*)dst = pack8bf(y1a, y1b); *(u32x4*)(dst + 16) = pack8bf(y2a, y2b); }
        }
    }
};

template <class Epi, class Sched, bool ALIGN_EPI = false, bool SP2 = false, int EPI_REP = 1>
__device__ __forceinline__ void gemm_phase(PG8_LAS unsigned char* lds, const Gemm g, const Sched& S, const Epi& E) {
    int tid_ = threadIdx.x; asm volatile("" : "+v"(tid_));
    const int tid = tid_, wid = __builtin_amdgcn_readfirstlane(tid >> 6), lane = tid & 63, wr = wid >> 2, wc = wid & 3, fr = lane & 15, fq = lane >> 4;
    const int K = g.K, nt = K / BK;
    unsigned voffA[2], voffB[2];
#pragma unroll
    for (int i = 0; i < 2; ++i) { int R, C; stage_rc(tid * 16 + i * 8192, R, C); const int Rb = Epi::PERM ? ((R & ~31) + perm32(R & 31)) : R;
        voffA[i] = (unsigned)(R * K + C) * 2u; voffB[i] = (unsigned)(Rb * K + C) * 2u; }
    const size_t kstep = (size_t)(BK * 2);
    const size_t hstep = (size_t)HALF * K * 2;
    const size_t tstep = 2 * hstep;
    const unsigned ldsw = (unsigned)wid * 1024u;
    const int aoff = lds_byte(wr * 64 + fr, fq * 8), boff = lds_byte(wc * 32 + fr, fq * 8);
#define PG8_SA(b, h) (((b) * 2 + (h)) * HTB)
#define PG8_SB(b, h) ((4 + (b) * 2 + (h)) * HTB)
#define PG8_STAGE(bufoff, gbase, voff) do { _Pragma("unroll") for (int _i = 0; _i < 2; ++_i) \
        __builtin_amdgcn_global_load_lds((const unsigned*)((const char*)(gbase) + (voff)[_i]), (PG8_LAS unsigned*)(lds + (bufoff) + ldsw + _i * 8192), 16, 0, 0); } while (0)
#define PG8_LDA(dst, b, h) do { _Pragma("unroll") for (int m = 0; m < 4; ++m) _Pragma("unroll") for (int k = 0; k < 2; ++k) dst[m][k] = *(const PG8_LAS bf16x8*)(lds + PG8_SA(b, h) + aoff + m * 2048 + k * 1024); } while (0)
#define PG8_LDB(dst, b, h) do { _Pragma("unroll") for (int n = 0; n < 2; ++n) _Pragma("unroll") for (int k = 0; k < 2; ++k) dst[n][k] = *(const PG8_LAS bf16x8*)(lds + PG8_SB(b, h) + boff + n * 2048 + k * 1024); } while (0)
#define PG8_MMA(ai, bj, At, Bt) do { __builtin_amdgcn_s_setprio(1); _Pragma("unroll") for (int m = 0; m < 4; ++m) _Pragma("unroll") for (int n = 0; n < 2; ++n) _Pragma("unroll") for (int k = 0; k < 2; ++k) \
        acc[ai][bj][m][n] = __builtin_amdgcn_mfma_f32_16x16x32_bf16(Bt[n][k], At[m][k], acc[ai][bj][m][n], 0, 0, 0); __builtin_amdgcn_s_setprio(0); } while (0)
#define PG8_WAIT_V(n) asm volatile("s_waitcnt vmcnt(" #n ")" ::: "memory")
#define PG8_WAIT_L(n) asm volatile("s_waitcnt lgkmcnt(" #n ")" ::: "memory")
#define PG8_BAR __builtin_amdgcn_s_barrier()
#define PG8_SCHED __builtin_amdgcn_sched_barrier(0)
    Unit cur, nxt; int ui = 0;
    typename Epi::Pre pre;
    if (!S.next(0, cur)) return;
    f32x4 acc[2][2][4][2];
#pragma unroll
    for (int a = 0; a < 2; ++a)
#pragma unroll
        for (int b = 0; b < 2; ++b)
#pragma unroll
            for (int m = 0; m < 4; ++m)
#pragma unroll
                for (int n = 0; n < 2; ++n) acc[a][b][m][n] = (f32x4){0.f, 0.f, 0.f, 0.f};
    bf16x8 At[4][2], B0[2][2], B1[2][2];
    const char* cA = (const char*)g.A + (size_t)cur.pm * tstep; const char* cB = (const char*)g.Bt + (size_t)cur.pn * tstep;
    S.a_ready(cur);
    if constexpr (SP2) {
        PG8_STAGE(PG8_SB(0, 0), cB, voffB); PG8_STAGE(PG8_SB(0, 1), cB + hstep, voffB); PG8_STAGE(PG8_SA(0, 0), cA, voffA); PG8_STAGE(PG8_SA(0, 1), cA + hstep, voffA);
        if (wr == 1) PG8_BAR;
        PG8_WAIT_V(2); PG8_BAR;
        PG8_STAGE(PG8_SB(1, 0), cB + kstep, voffB); PG8_STAGE(PG8_SA(1, 0), cA + kstep, voffA); PG8_STAGE(PG8_SB(1, 1), cB + hstep + kstep, voffB);
        PG8_WAIT_V(6); PG8_BAR;
    } else {
        PG8_STAGE(PG8_SB(0, 0), cB, voffB); PG8_STAGE(PG8_SA(0, 0), cA, voffA); PG8_STAGE(PG8_SB(0, 1), cB + hstep, voffB); PG8_STAGE(PG8_SA(0, 1), cA + hstep, voffA);
        if (wr == 1) PG8_BAR;
        PG8_WAIT_V(4); PG8_BAR;
        PG8_STAGE(PG8_SB(1, 0), cB + kstep, voffB); PG8_STAGE(PG8_SA(1, 0), cA + kstep, voffA); PG8_STAGE(PG8_SB(1, 1), cB + hstep + kstep, voffB);
        PG8_WAIT_V(6); PG8_BAR;
    }
    for (;;) {
        const bool has_next = S.next(ui + 1, nxt);
        const char* nA = has_next ? (const char*)g.A + (size_t)nxt.pm * tstep : cA; const char* nB = has_next ? (const char*)g.Bt + (size_t)nxt.pn * tstep : cB;
        for (int t = 0; t < nt; t += 2) {
            const bool last = (t == nt - 2);
            const char* a1 = cA + (size_t)(t + 1) * kstep;
            const char* a2 = last ? nA : cA + (size_t)(t + 2) * kstep; const char* b2 = last ? nB : cB + (size_t)(t + 2) * kstep;
            const char* a3 = a2 + kstep; const char* b3 = b2 + kstep;
            if (last && has_next) S.a_ready(nxt);
            if (t == 0) E.pre_issue(pre, cur, tid, ui); else if (t == 2) E.pre_finish(pre, tid, ui);
            if constexpr (SP2) {
            PG8_LDB(B0, 0, 0); PG8_LDB(B1, 0, 1); PG8_SCHED; PG8_LDA(At, 0, 0); PG8_STAGE(PG8_SA(1, 1), a1 + hstep, voffA);
            PG8_WAIT_V(8); PG8_WAIT_L(0); PG8_BAR; PG8_MMA(0, 0, At, B0); PG8_MMA(0, 1, At, B1); PG8_BAR; PG8_SCHED;
            PG8_LDA(At, 0, 1); PG8_STAGE(PG8_SB(0, 0), b2, voffB); PG8_STAGE(PG8_SB(0, 1), b2 + hstep, voffB); PG8_STAGE(PG8_SA(0, 0), a2, voffA);
            PG8_WAIT_V(8); PG8_WAIT_L(0); PG8_BAR; PG8_MMA(1, 0, At, B0); PG8_MMA(1, 1, At, B1); PG8_BAR; PG8_SCHED;
            PG8_LDB(B0, 1, 0); PG8_LDB(B1, 1, 1); PG8_SCHED; PG8_LDA(At, 1, 0); PG8_STAGE(PG8_SA(0, 1), a2 + hstep, voffA);
            PG8_WAIT_V(8); PG8_WAIT_L(0); PG8_BAR; PG8_MMA(0, 0, At, B0); PG8_MMA(0, 1, At, B1); PG8_BAR; PG8_SCHED;
            PG8_LDA(At, 1, 1); PG8_STAGE(PG8_SB(1, 0), b3, voffB); PG8_STAGE(PG8_SB(1, 1), b3 + hstep, voffB); PG8_STAGE(PG8_SA(1, 0), a3, voffA);
            PG8_WAIT_V(8); PG8_WAIT_L(0); PG8_BAR; PG8_MMA(1, 0, At, B0); PG8_MMA(1, 1, At, B1); PG8_BAR; PG8_SCHED;
            } else {
            PG8_LDB(B0, 0, 0); PG8_SCHED; PG8_LDA(At, 0, 0); PG8_STAGE(PG8_SA(1, 1), a1 + hstep, voffA);
            PG8_WAIT_L(8); PG8_BAR; PG8_WAIT_L(0); PG8_MMA(0, 0, At, B0); PG8_BAR; PG8_SCHED;
            PG8_LDB(B1, 0, 1); PG8_STAGE(PG8_SB(0, 0), b2, voffB);
            PG8_BAR; PG8_WAIT_L(0); PG8_MMA(0, 1, At, B1); PG8_BAR;
            PG8_LDA(At, 0, 1); PG8_STAGE(PG8_SA(0, 0), a2, voffA);
            PG8_BAR; PG8_WAIT_L(0); PG8_MMA(1, 0, At, B0); PG8_BAR; PG8_SCHED;
            PG8_STAGE(PG8_SB(0, 1), b2 + hstep, voffB);
            PG8_WAIT_V(6); PG8_BAR; PG8_MMA(1, 1, At, B1); PG8_BAR;
            PG8_LDB(B0, 1, 0); PG8_SCHED; PG8_LDA(At, 1, 0); PG8_STAGE(PG8_SA(0, 1), a2 + hstep, voffA);
            PG8_WAIT_L(8); PG8_BAR; PG8_WAIT_L(0); PG8_MMA(0, 0, At, B0); PG8_BAR; PG8_SCHED;
            PG8_LDB(B1, 1, 1); PG8_STAGE(PG8_SB(1, 0), b3, voffB);
            PG8_BAR; PG8_WAIT_L(0); PG8_MMA(0, 1, At, B1); PG8_BAR;
            PG8_LDA(At, 1, 1); PG8_STAGE(PG8_SA(1, 0), a3, voffA);
            PG8_BAR; PG8_WAIT_L(0); PG8_MMA(1, 0, At, B0); PG8_BAR; PG8_SCHED;
            PG8_STAGE(PG8_SB(1, 1), b3 + hstep, voffB);
            PG8_WAIT_V(6); PG8_BAR; PG8_MMA(1, 1, At, B1); PG8_BAR;
            }
        }
        if constexpr (ALIGN_EPI) { if (wr == 0) PG8_BAR; }
        if constexpr (!Epi::AFTER_DRAIN) { _Pragma("unroll") for (int rep_ = 0; rep_ < EPI_REP; ++rep_) E(acc, cur, wr, wc, fr, fq, ui); S.done(cur); }
        if (!has_next) break;
#pragma unroll
        for (int a = 0; a < 2; ++a)
#pragma unroll
            for (int b = 0; b < 2; ++b)
#pragma unroll
                for (int m = 0; m < 4; ++m)
#pragma unroll
                    for (int n = 0; n < 2; ++n) acc[a][b][m][n] = (f32x4){0.f, 0.f, 0.f, 0.f};
        cur = nxt; cA = nA; cB = nB; ++ui;
        if constexpr (ALIGN_EPI) { if (wr == 1) PG8_BAR; }
    }
    PG8_WAIT_V(0);
    if constexpr (!ALIGN_EPI) { if (wr == 0) PG8_BAR; }
    PG8_BAR;
    if constexpr (Epi::AFTER_DRAIN) { E.fused(acc, cur, wr, wc, fr, fq, lds, wid, lane); S.done(cur); }
#undef PG8_SA
#undef PG8_SB
#undef PG8_STAGE
#undef PG8_LDA
#undef PG8_LDB
#undef PG8_MMA
#undef PG8_WAIT_V
#undef PG8_WAIT_L
#undef PG8_BAR
#undef PG8_SCHED
}
}
namespace att {
typedef unsigned short bf16;
typedef short bf16x8 __attribute__((ext_vector_type(8)));
typedef short s16x4 __attribute__((ext_vector_type(4)));
typedef float f32x16 __attribute__((ext_vector_type(16)));
typedef float f32x4 __attribute__((ext_vector_type(4)));
typedef unsigned u32x4 __attribute__((ext_vector_type(4)));
constexpr int NW = 8, QBLK = 32, KVBLK = 64, QB = NW * QBLK;
constexpr int SHM_V = KVBLK * 128 * 2, SHM_K = KVBLK * 128 * 2, KPE_ROW = 144, SHM_KPE = KVBLK * KPE_ROW;
constexpr int OFF_V = 0, OFF_K = 2 * SHM_V, OFF_WS = OFF_K + 2 * SHM_K, OFF_KPE = OFF_WS + NW * 64 * 4, OFF_QPE = OFF_KPE + 2 * SHM_KPE, LDS_BYTES = OFF_QPE + NW * 4096;
constexpr float THR = 8.f;

#define KSWZ(row, colB) ((row) * 256 + ((colB) ^ (((row) & 7) << 4)))
#define SBAR() __builtin_amdgcn_sched_barrier(0)
__device__ __forceinline__ int v_st(int k, int c) { const int kk = (k & ~0xC) | ((k & 4) << 1) | ((k & 8) >> 1); return ((kk >> 3) * 4 + (c >> 5)) * 512 + ((kk & 7) * 32 + (c & 31)) * 2; }
__device__ __forceinline__ int v_rd_base(int lane) { return ((lane & 3) << 3) | (((lane >> 2) & 3) << 6) | (((lane >> 4) & 1) << 5) | (((lane >> 5) & 1) << 8); }
constexpr int v_rd_off(int d0, int ks, int half) { return d0 * 512 + ks * 4096 + half * 2048; }
__device__ __forceinline__ int crow(int r, int hi) { return (r & 3) + 8 * (r >> 2) + 4 * hi; }
__device__ __forceinline__ unsigned cvtpk(float lo, float hi) { unsigned r; asm volatile("v_cvt_pk_bf16_f32 %0, %1, %2" : "=v"(r) : "v"(lo), "v"(hi)); return r; }
__device__ __forceinline__ bf16x8 ld8(const bf16* p) { return *reinterpret_cast<const bf16x8*>(p); }
__device__ __forceinline__ void mask_tile(f32x16& p0, f32x16& p1, int dq, unsigned W) {
    const float NEG = -__builtin_inff();
#pragma unroll
    for (int r = 0; r < 16; ++r) {
        const int c = (r & 3) + 8 * (r >> 2);
        if ((unsigned)(dq - c) >= W) p0[r] = NEG;
        if ((unsigned)(dq - c - 32) >= W) p1[r] = NEG;
    }
}
__device__ __forceinline__ void partialSM(f32x16& p0, f32x16& p1, float& m_reg, float& mn, float& alpha, const float scale) {
    float pmax = p0[0]; for (int r = 1; r < 16; ++r) pmax = fmaxf(pmax, p0[r]); for (int r = 0; r < 16; ++r) pmax = fmaxf(pmax, p1[r]);
    { auto rr = __builtin_amdgcn_permlane32_swap(__float_as_uint(pmax), __float_as_uint(pmax), false, false);
      pmax = fmaxf(__uint_as_float(rr[0]), __uint_as_float(rr[1])); }
    const float C2 = 1.4426950408889634f * scale;
    if (__builtin_expect(__all((pmax - m_reg) * scale <= THR), 1)) { mn = m_reg; alpha = 1.f; }
    else { mn = fmaxf(m_reg, pmax); alpha = __builtin_amdgcn_exp2f((m_reg - mn) * C2); m_reg = mn; }
    const float mnL = -mn * C2;
    for (int r = 0; r < 16; ++r) p0[r] = fmaf(p0[r], C2, mnL); for (int r = 0; r < 16; ++r) p1[r] = fmaf(p1[r], C2, mnL);
    for (int r = 0; r < 16; ++r) p0[r] = __builtin_amdgcn_exp2f(p0[r]);
}
__device__ __forceinline__ void finishSM(f32x16& p0, f32x16& p1, float alpha, float& l_reg, bf16x8& pa0, bf16x8& pa1, bf16x8& pa2, bf16x8& pa3) {
    for (int r = 0; r < 16; ++r) p1[r] = __builtin_amdgcn_exp2f(p1[r]);
    float ps = 0; for (int r = 0; r < 16; ++r) ps += p0[r]; for (int r = 0; r < 16; ++r) ps += p1[r];
    { auto rr = __builtin_amdgcn_permlane32_swap(__float_as_uint(ps), __float_as_uint(ps), false, false);
      ps = __uint_as_float(rr[0]) + __uint_as_float(rr[1]); }
    l_reg = l_reg * alpha + ps;
#define PK4(P, B_, OUT) do { unsigned a0 = cvtpk(P[B_+0], P[B_+1]), a1 = cvtpk(P[B_+2], P[B_+3]);                          \
        unsigned b0 = cvtpk(P[B_+4], P[B_+5]), b1 = cvtpk(P[B_+6], P[B_+7]);                                             \
        auto r0 = __builtin_amdgcn_permlane32_swap(a0, b0, false, false); auto r1 = __builtin_amdgcn_permlane32_swap(a1, b1, false, false); \
        u32x4 w = {r0[0], r1[0], r0[1], r1[1]}; OUT = *reinterpret_cast<bf16x8*>(&w); } while (0)
    PK4(p0, 0, pa0); PK4(p0, 8, pa1); PK4(p1, 0, pa2); PK4(p1, 8, pa3);
#undef PK4
}
template <int KB, bool SK, bool PE>
__device__ __forceinline__ void qkt(f32x16& p0, f32x16& p1, const char* lds, int r32, int hi, int wid, int lane, const bf16x8* qr, bool act) {
    if (SK && !act) { const float NEG = -__builtin_inff();
#pragma unroll
        for (int r = 0; r < 16; ++r) { p0[r] = NEG; p1[r] = NEG; } return; }
    p0 = f32x16{}; p1 = f32x16{};
    const char* kb[4];
#pragma unroll
    for (int dd = 0; dd < 4; ++dd) kb[dd] = lds + OFF_K + KB * SHM_K + KSWZ(r32, (dd * 16 + hi * 8) * 2);
#pragma unroll
    for (int d0 = 0; d0 < 8; ++d0) { const char* a = kb[d0 & 3] + (d0 >> 2) * 128;
        bf16x8 b0 = *reinterpret_cast<const bf16x8*>(a);
        bf16x8 b1 = *reinterpret_cast<const bf16x8*>(a + 32 * 256);
        p0 = __builtin_amdgcn_mfma_f32_32x32x16_bf16(b0, qr[d0], p0, 0, 0, 0);
        p1 = __builtin_amdgcn_mfma_f32_32x32x16_bf16(b1, qr[d0], p1, 0, 0, 0); }
    if constexpr (PE) {
        const char* kp = lds + OFF_KPE + KB * SHM_KPE + r32 * KPE_ROW + hi * 16;
        const char* qp = lds + OFF_QPE + wid * 4096 + lane * 16;
#pragma unroll
        for (int d0 = 0; d0 < 4; ++d0) {
            bf16x8 b0 = *reinterpret_cast<const bf16x8*>(kp + d0 * 32);
            bf16x8 b1 = *reinterpret_cast<const bf16x8*>(kp + d0 * 32 + 32 * KPE_ROW);
            bf16x8 qf = *reinterpret_cast<const bf16x8*>(qp + d0 * 1024);
            p0 = __builtin_amdgcn_mfma_f32_32x32x16_bf16(b0, qf, p0, 0, 0, 0);
            p1 = __builtin_amdgcn_mfma_f32_32x32x16_bf16(b1, qf, p1, 0, 0, 0); }
    }
}
template <int VB, bool SK>
__device__ __forceinline__ void pv_tile(f32x16* o, int vb0, bf16x8 pa0, bf16x8 pa1, bf16x8 pa2, bf16x8 pa3, bool act) {
    if (SK && !act) return;
#define TRRD(dst, off) asm volatile("ds_read_b64_tr_b16 %0, %1 offset:%2" : "=&v"(dst) : "v"(vb0), "i"(off) : "memory")
#define PV_D0(d0) do { s16x4 l0, l1, l2, l3, h0, h1, h2, h3; constexpr int b_ = OFF_V + VB * SHM_V + v_rd_off(d0, 0, 0); \
        TRRD(l0, b_); TRRD(h0, b_ + 2048); TRRD(l1, b_ + 4096); TRRD(h1, b_ + 6144); TRRD(l2, b_ + 8192); TRRD(h2, b_ + 10240); TRRD(l3, b_ + 12288); TRRD(h3, b_ + 14336); \
        asm volatile("s_waitcnt lgkmcnt(0)" ::: "memory"); SBAR();   \
        o[d0] = __builtin_amdgcn_mfma_f32_32x32x16_bf16(pa0, (bf16x8){l0[0], l0[1], l0[2], l0[3], h0[0], h0[1], h0[2], h0[3]}, o[d0], 0, 0, 0);   \
        o[d0] = __builtin_amdgcn_mfma_f32_32x32x16_bf16(pa1, (bf16x8){l1[0], l1[1], l1[2], l1[3], h1[0], h1[1], h1[2], h1[3]}, o[d0], 0, 0, 0);   \
        o[d0] = __builtin_amdgcn_mfma_f32_32x32x16_bf16(pa2, (bf16x8){l2[0], l2[1], l2[2], l2[3], h2[0], h2[1], h2[2], h2[3]}, o[d0], 0, 0, 0);   \
        o[d0] = __builtin_amdgcn_mfma_f32_32x32x16_bf16(pa3, (bf16x8){l3[0], l3[1], l3[2], l3[3], h3[0], h3[1], h3[2], h3[3]}, o[d0], 0, 0, 0); } while (0)
    PV_D0(0); PV_D0(1); PV_D0(2); PV_D0(3);
#undef PV_D0
#undef TRRD
}

struct Prm { int qs, kvs, os, qpes, kpes, lses, skv, W; float scale; };
struct BlockRef { const bf16* Q; const bf16* K; const bf16* V; bf16* O; const bf16* Qpe; const bf16* Kpe; float* Lse; int P0; };
template <bool PE> struct Seam { bf16x8 qr[8]; bf16x8 st_v0, st_v1, st_k0, st_k1, st_kp; };
__device__ __forceinline__ int swa_jlo(int P0, int W) { const int lowk = P0 - W + 1; return lowk > 0 ? lowk / KVBLK : 0; }
#define VMW() asm volatile("s_waitcnt vmcnt(0)" ::: "memory")
#define LDG(base, off) (*(const bf16x8*)((const char*)(base) + (off)))
#define SLOAD_H(R_, k0) do { const char* kb__ = (const char*)(R_).K + (size_t)(k0) * P.kvs * 2; const char* vb__ = (const char*)(R_).V + (size_t)(k0) * P.kvs * 2; const size_t h__ = (size_t)32 * P.kvs * 2; \
                              S.st_v0 = LDG(vb__, kvoff); S.st_v1 = LDG(vb__ + h__, kvoff); S.st_k0 = LDG(kb__, kvoff); S.st_k1 = LDG(kb__ + h__, kvoff); \
                              if constexpr (PE) S.st_kp = LDG((const char*)(R_).Kpe + (size_t)(k0) * P.kpes * 2, kpoff); } while (0)
#define SWRITE_HK(bf) do { *(bf16x8*)(K_lds + (bf) * SHM_K + kws) = S.st_k0; *(bf16x8*)(K_lds + (bf) * SHM_K + kws + 32 * 256) = S.st_k1; \
                           if constexpr (PE) *(bf16x8*)(lds + OFF_KPE + (bf) * SHM_KPE + pws) = S.st_kp; } while (0)
#define SWRITE_HV(bf) do { *(bf16x8*)(V_lds + (bf) * SHM_V + vst0) = S.st_v0; *(bf16x8*)(V_lds + (bf) * SHM_V + vst1) = S.st_v1; } while (0)
#define SWRITE_H(bf) do { SWRITE_HV(bf); SWRITE_HK(bf); } while (0)
template <bool PE>
__device__ __forceinline__ void swa_prime(const BlockRef& cur, const Prm& P, char* lds, Seam<PE>& S) {
    int tid_ = threadIdx.x; asm volatile("" : "+v"(tid_));
    const int tid = tid_, wid = __builtin_amdgcn_readfirstlane(tid >> 6), lane = tid & 63, r32 = lane & 31, hi = lane >> 5;
    const int sr = tid >> 4, sc = (tid & 15) * 8, kws = KSWZ(sr, sc * 2); char* K_lds = lds + OFF_K;
    const int pr = tid >> 3, pc = (tid & 7) * 8, pws = pr * KPE_ROW + (tid & 7) * 16;
    const unsigned kvoff = (unsigned)(sr * P.kvs + sc) * 2u, kpoff = (unsigned)(pr * P.kpes + pc) * 2u, qoff = (unsigned)((wid * QBLK + r32) * P.qs + hi * 8) * 2u, qpoff = (unsigned)((wid * QBLK + r32) * P.qpes + hi * 8) * 2u;
    const int kb0 = swa_jlo(cur.P0, P.W) * KVBLK;
#pragma unroll
    for (int d0 = 0; d0 < 8; ++d0) S.qr[d0] = LDG(cur.Q, qoff + d0 * 32);
    if constexpr (PE) {
#pragma unroll
        for (int d0 = 0; d0 < 4; ++d0) *(bf16x8*)(lds + OFF_QPE + wid * 4096 + d0 * 1024 + lane * 16) = LDG(cur.Qpe, qpoff + d0 * 32);
    }
    SLOAD_H(cur, kb0); VMW(); SWRITE_HK(0);
    __syncthreads();
}
template <bool PE, bool SK, bool LSE, bool EARLY>
__device__ __forceinline__ void swa_block(const BlockRef& cur, const BlockRef& nxt, const Prm& P, char* lds, Seam<PE>& S) {
    int tid_ = threadIdx.x; asm volatile("" : "+v"(tid_));
    const int tid = tid_, wid = __builtin_amdgcn_readfirstlane(tid >> 6), lane = tid & 63, r32 = lane & 31, hi = lane >> 5;
    const int W = P.W;
    const int j_lo = swa_jlo(cur.P0, W);
    int j_hi = (cur.P0 + QB - 1) / KVBLK + 1; if (j_hi > P.skv / KVBLK) j_hi = P.skv / KVBLK;
    const int NT = j_hi - j_lo;
    const int kbn = swa_jlo(nxt.P0, W) * KVBLK;
    const int qlo = cur.P0 + wid * QBLK, qm = qlo + r32 - 4 * hi;
    char* V_lds = lds + OFF_V; char* K_lds = lds + OFF_K;
    float* ws = (float*)(lds + OFF_WS) + wid * 64; float* li_l = ws, * al_l = ws + 32;
    float m_reg = -1e30f, l_reg = 0; f32x16 o[4] = {};
    const int sr = tid >> 4, sc = (tid & 15) * 8, vst0 = v_st(sr, sc), vst1 = v_st(32 + sr, sc), kws = KSWZ(sr, sc * 2);
    const int pr = tid >> 3, pc = (tid & 7) * 8, pws = pr * KPE_ROW + (tid & 7) * 16;
    const unsigned kvoff = (unsigned)(sr * P.kvs + sc) * 2u, kpoff = (unsigned)(pr * P.kpes + pc) * 2u;
    const int vb0 = (int)(uintptr_t)lds + v_rd_base(lane);
#define RESC(a) do { if (__any((a) < 1.f)) { if (hi == 0) al_l[r32] = (a); asm volatile("s_waitcnt lgkmcnt(0)" ::: "memory");              \
                     for (int d_ = 0; d_ < 4; ++d_) for (int r = 0; r < 16; ++r) o[d_][r] *= al_l[crow(r, hi)]; } } while (0)
#define KBASE(t) ((j_lo + (t)) * KVBLK)
#define ACT(t) (KBASE(t) <= qlo + QBLK - 1 && KBASE(t) + KVBLK - 1 >= qlo - W + 1)
#define MASKT(P0_, P1_, t) do { const int kb_ = KBASE(t); if ((!SK || ACT(t)) && (kb_ + KVBLK - 1 > qlo || kb_ <= qlo + QBLK - 1 - W)) mask_tile(P0_, P1_, qm - kb_, (unsigned)W); } while (0)
    f32x16 pA0, pA1, pB0, pB1; float mnA, mnB, alA, alB; bf16x8 pa0, pa1, pa2, pa3;
    SWRITE_HV(0); SBAR();
    if (NT > 1) { SLOAD_H(cur, KBASE(1)); }
    SBAR(); qkt<0, SK, PE>(pA0, pA1, lds, r32, hi, wid, lane, S.qr, ACT(0));
    MASKT(pA0, pA1, 0); partialSM(pA0, pA1, m_reg, mnA, alA, P.scale);
    if (NT > 1) { VMW(); SWRITE_H(1); }
    __syncthreads();
#define HALF_STEP(PX0, PX1, mnX, alX, PY0, PY1, alY, t, KB, VB, SB) do {                                                      \
        SBAR(); if (EARLY && (t) + 1 < NT) { SLOAD_H(cur, KBASE((t) + 1)); SBAR(); }                                          \
        qkt<KB, SK, PE>(PX0, PX1, lds, r32, hi, wid, lane, S.qr, ACT(t));                                                     \
        finishSM(PY0, PY1, alY, l_reg, pa0, pa1, pa2, pa3); SBAR();                                                           \
        if (!EARLY && (t) + 1 < NT) { SLOAD_H(cur, KBASE((t) + 1)); SBAR(); }                                                 \
        pv_tile<VB, SK>(o, vb0, pa0, pa1, pa2, pa3, ACT((t) - 1)); MASKT(PX0, PX1, (t)); partialSM(PX0, PX1, m_reg, mnX, alX, P.scale); \
        __syncthreads();                                                                                                      \
        if ((t) + 1 < NT) { VMW(); SWRITE_H(SB); }                                                                            \
        RESC(alX); __syncthreads(); } while (0)
    for (int t = 1; t + 1 < NT; t += 2) {
        HALF_STEP(pB0, pB1, mnB, alB, pA0, pA1, alA, t, 1, 0, 0);
        HALF_STEP(pA0, pA1, mnA, alA, pB0, pB1, alB, t + 1, 0, 1, 1);
    }
    const bool even = (NT & 1) == 0;
    if (even) { SBAR(); qkt<1, SK, PE>(pB0, pB1, lds, r32, hi, wid, lane, S.qr, ACT(NT - 1)); SBAR(); }
    SLOAD_H(nxt, kbn); SBAR();
    { const unsigned qoff = (unsigned)((wid * QBLK + r32) * P.qs + hi * 8) * 2u;
#pragma unroll
      for (int d0 = 0; d0 < 8; ++d0) S.qr[d0] = LDG(nxt.Q, qoff + d0 * 32); }
    bf16x8 qpn[4];
    if constexpr (PE) { const unsigned qpoff = (unsigned)((wid * QBLK + r32) * P.qpes + hi * 8) * 2u;
#pragma unroll
        for (int d0 = 0; d0 < 4; ++d0) qpn[d0] = LDG(nxt.Qpe, qpoff + d0 * 32);
    }
    SBAR();
    finishSM(pA0, pA1, alA, l_reg, pa0, pa1, pa2, pa3); SBAR();
    pv_tile<0, SK>(o, vb0, pa0, pa1, pa2, pa3, ACT(even ? NT - 2 : NT - 1));
    if (even) { MASKT(pB0, pB1, NT - 1); partialSM(pB0, pB1, m_reg, mnB, alB, P.scale); __syncthreads(); RESC(alB);
        finishSM(pB0, pB1, alB, l_reg, pa0, pa1, pa2, pa3); SBAR(); pv_tile<1, SK>(o, vb0, pa0, pa1, pa2, pa3, ACT(NT - 1)); }
    SBAR();
    VMW(); SWRITE_HK(0);
    if constexpr (PE) {
#pragma unroll
        for (int d0 = 0; d0 < 4; ++d0) *(bf16x8*)(lds + OFF_QPE + wid * 4096 + d0 * 1024 + lane * 16) = qpn[d0];
    }
    SBAR();
    if (hi == 0) li_l[r32] = l_reg; asm volatile("s_waitcnt lgkmcnt(0)" ::: "memory");
    float rli[16];
#pragma unroll
    for (int r = 0; r < 16; ++r) rli[r] = __builtin_amdgcn_rcpf(li_l[crow(r, hi)]);
    const unsigned ooff = (unsigned)((wid * QBLK + 4 * hi) * P.os + r32) * 2u;
#pragma unroll
    for (int r = 0; r < 16; ++r) { char* ob = (char*)cur.O + (size_t)((r & 3) + 8 * (r >> 2)) * P.os * 2;
#pragma unroll
        for (int d0 = 0; d0 < 4; ++d0) { const float v = o[d0][r] * rli[r];
            const float vn = __uint_as_float((unsigned)__builtin_amdgcn_update_dpp(0, (int)__float_as_uint(v), 0xB1, 0xF, 0xF, true));
            if ((r32 & 1) == 0) *(unsigned*)(ob + ooff + d0 * 64) = cvtpk(v, vn); } }
    if constexpr (LSE) { if (hi == 0) *(float*)((char*)cur.Lse + (unsigned)((wid * QBLK + r32) * P.lses) * 4u) = m_reg * P.scale + __logf(l_reg); }
    __syncthreads();
#undef RESC
#undef KBASE
#undef ACT
#undef MASKT
#undef HALF_STEP
}
#undef LDG
#undef VMW
#undef SLOAD_H
#undef SWRITE_HK
#undef SWRITE_HV
#undef SWRITE_H
#undef KSWZ
#undef SBAR
}
constexpr int NWAVES = 8;
constexpr int BATCH = 4, SEQ = 4096, DM = 2048, M = BATCH * SEQ;
constexpr int NQKVA = 1280;
constexpr int NQB = 3072, NKVB = 4096, NDIL = 18432, FF = 5632, NUP = 2 * FF;
constexpr float EPS = 1e-6f;
constexpr size_t MiB = (size_t)1 << 20;
constexpr size_t WS_CTL = 0, CTL_ZERO_BYTES = 64 * 1024;
constexpr size_t WS_COSM = 1 * MiB, WS_SINM = 3 * MiB, WS_COSD = 5 * MiB, WS_SIND = 6 * MiB;
constexpr size_t WS_WMLA = 8 * MiB, WMLA_STRIDE = 20 * MiB, WMLA_QKVA = 0, WMLA_QB = 5 * MiB, WMLA_KVB = 8 * MiB, WMLA_WO = 12 * MiB;
constexpr size_t WS_WDIL = WS_WMLA + 2 * WMLA_STRIDE, WDIL_STRIDE = 80 * MiB, WDIL_IN = 0, WDIL_WO = 72 * MiB;
constexpr size_t WS_WFFN = WS_WDIL + 2 * WDIL_STRIDE, WFFN_STRIDE = 66 * MiB, WFFN_UP = 0, WFFN_DOWN = 44 * MiB;
constexpr size_t WS_H = WS_WFFN + 4 * WFFN_STRIDE;
constexpr size_t WS_S = WS_H + 64 * MiB;
constexpr size_t S_QKVA = 0, S_QN = 80 * MiB, S_CKVN = 96 * MiB, S_KPE = 112 * MiB, S_Q = 114 * MiB, S_KV = 210 * MiB, S_AO_MLA = 338 * MiB;
constexpr size_t S_QKV = 0, S_OG = 576 * MiB, S_LSE = 768 * MiB, S_AO_DIL = 771 * MiB;
constexpr size_t S_U = 0, S_ACT = 352 * MiB;
constexpr size_t WS_HALO = WS_S + 835 * MiB, WS_FIX = WS_HALO + 6 * MiB;
constexpr size_t WS_END = WS_FIX + 6 * MiB;
static_assert(WS_H == 472 * MiB && WS_END == 1383 * MiB, "d_ws map");
constexpr int CW_BAR = 4096;
constexpr int RING_OFF = 0, RING_BYTES = 131072, LDSCTL_OFF = RING_BYTES, MISC_OFF = LDSCTL_OFF + 320, XH_OFF = RING_BYTES + 1024  , CWL_OFF = XH_OFF + 6144  , LDS_BYTES = 163840;
static_assert(CWL_OFF + 8192 <= LDS_BYTES, "LDS map");
static_assert(att::LDS_BYTES <= RING_BYTES && pg8::STAGE_BYTES <= RING_BYTES, "LDS map");

#define GAS __attribute__((address_space(1)))
#define LAS __attribute__((address_space(3)))
typedef unsigned short bf16;
typedef unsigned v4u __attribute__((ext_vector_type(4)));
typedef unsigned v2u __attribute__((ext_vector_type(2)));
typedef float f32x4 __attribute__((ext_vector_type(4)));
typedef GAS unsigned gu32;
#define RLX_AGENT __ATOMIC_RELAXED, __HIP_MEMORY_SCOPE_AGENT
#define LDS_WAIT() asm volatile("s_waitcnt lgkmcnt(0)" ::: "memory")
__device__ __forceinline__ unsigned pk2(float lo, float hi) { return pg8::cvt_pk_bf16(lo, hi); }
__device__ __forceinline__ float bf_lo(unsigned w) { return __uint_as_float(w << 16); }
__device__ __forceinline__ float bf_hi(unsigned w) { return __uint_as_float(w & 0xffff0000u); }

#define XB_TMO      128
#define XB_XCNT(j)  (256  + 64 * (j))
#define XB_XSUB(j)  (1280 + 64 * (j))
#define XB_XGEN(j)  (2304 + 64 * (j))
#define XB_TOP      3328
#define XB_TOPGEN   3392
#define XCD_BAR_WORDS 3456
#define XB_SPIN_CAP (1u << 18)

__device__ __forceinline__ unsigned xb_ld(unsigned* p)              { return __hip_atomic_load(p, __ATOMIC_RELAXED, __HIP_MEMORY_SCOPE_AGENT); }
__device__ __forceinline__ unsigned xb_add(unsigned* p, unsigned v) { return __hip_atomic_fetch_add(p, v, __ATOMIC_RELAXED, __HIP_MEMORY_SCOPE_AGENT); }
__device__ __forceinline__ unsigned xb_xcc_id() { return (unsigned)__builtin_amdgcn_s_getreg((3 << 11) | 20) & 0xFu; }
#define XB_SPIN(cond, bar) do { unsigned _sp = 0; while (cond) { __builtin_amdgcn_s_sleep(1); \
    if ((++_sp & 255u) == 0u) { if (xb_ld(&(bar)[XB_TMO])) break; if (_sp > XB_SPIN_CAP) { atomicAdd(&(bar)[XB_TMO], 1u); break; } } } } while (0)

struct XcdBarrier {
    unsigned* bar; unsigned x;
    volatile LAS unsigned* st;
};

__device__ __forceinline__ XcdBarrier xcd_barrier_post(unsigned* bar, volatile LAS unsigned* st) {
    XcdBarrier b; b.bar = bar; b.x = xb_xcc_id(); b.st = st;
    if (threadIdx.x == 0) (void)xb_add(&bar[XB_XCNT(b.x)], 1u);
    return b;
}
__device__ __forceinline__ void xcd_barrier_complete(unsigned* bar, unsigned x, unsigned& nloc, unsigned& nx) {
    const unsigned G = gridDim.x * gridDim.y * gridDim.z;
    unsigned sum, cnt, mine, sp = 0u;
    for (;;) {
        sum = 0u; cnt = 0u; mine = 0u;
#pragma unroll
        for (unsigned j = 0; j < 16; ++j) { const unsigned c = xb_ld(&bar[XB_XCNT(j)]); sum += c; cnt += (c > 0u) ? 1u : 0u; mine = (j == x) ? c : mine; }
        if (sum == G) break;
        __builtin_amdgcn_s_sleep(1);
        if ((++sp & 255u) == 0u) { if (xb_ld(&bar[XB_TMO])) break; if (sp > XB_SPIN_CAP) { atomicAdd(&bar[XB_TMO], 1u); break; } }
    }
    nloc = mine > 0u ? mine : 1u; nx = cnt > 0u ? cnt : 1u;
}

__device__ __forceinline__ void xcd_barrier(const XcdBarrier& b) {
    asm volatile("s_waitcnt vmcnt(0)" ::: "memory");
    __syncthreads();
    if (threadIdx.x == 0) {
        __attribute__((address_space(1))) unsigned* barg_ = (__attribute__((address_space(1))) unsigned*)b.bar; unsigned bx_ = b.x;
        asm volatile("" : "+s"(barg_), "+s"(bx_)); unsigned* bar = (unsigned*)barg_;
        __builtin_amdgcn_s_waitcnt(0);
        unsigned nloc = b.st[0], nx = b.st[1];
        if (nloc == 0u) { xcd_barrier_complete(bar, bx_, nloc, nx); b.st[0] = nloc; b.st[1] = nx; }
        const unsigned old = xb_add(&bar[XB_XSUB(bx_)], 1u);
        const unsigned gen = old / nloc;
        if (old + 1u == (gen + 1u) * nloc) {
            __builtin_amdgcn_fence(__ATOMIC_RELEASE, "agent");
            asm volatile("s_waitcnt vmcnt(0)" ::: "memory");
            const unsigned og = xb_add(&bar[XB_TOP], 1u);
            const unsigned tg = og / nx;
            if (og + 1u == (tg + 1u) * nx) xb_add(&bar[XB_TOPGEN], 1u);
            else XB_SPIN(xb_ld(&bar[XB_TOPGEN]) == tg, bar);
            __builtin_amdgcn_fence(__ATOMIC_ACQUIRE, "agent");
            xb_add(&bar[XB_XGEN(bx_)], 1u);
            asm volatile("s_waitcnt vmcnt(0)" ::: "memory");
        } else {
            XB_SPIN(xb_ld(&bar[XB_XGEN(bx_)]) == gen, bar);
            __builtin_amdgcn_fence(__ATOMIC_ACQUIRE, "agent");
            asm volatile("s_waitcnt vmcnt(0)" ::: "memory");
        }
    }
    __syncthreads();
}


__device__ __forceinline__ const void* karg(int k) {
    const __attribute__((address_space(4))) char* kp = (const __attribute__((address_space(4))) char*)__builtin_amdgcn_kernarg_segment_ptr();
    asm volatile("" : "+s"(kp));
    return *(const void* const __attribute__((address_space(4)))*)(kp + 8 * k);
}
#define LANE_IDS() int tid_ = threadIdx.x; asm volatile("" : "+v"(tid_)); const int tid = tid_, lane = tid & 63, wave = __builtin_amdgcn_readfirstlane(tid >> 6); (void)tid; (void)lane; (void)wave
struct Frame {
    LAS unsigned char* lds;
    volatile LAS unsigned* MISC;
    gu32* ctl;
    int vcu, G;
    float* out; unsigned char* wsb;
};
#define SWZ_XOR(v, m) __uint_as_float((unsigned)__builtin_amdgcn_ds_swizzle((int)__float_as_uint(v), (((m) << 10) | 0x1f)))
__device__ __forceinline__ float xor32(float v) { auto rr = __builtin_amdgcn_permlane32_swap(__float_as_uint(v), __float_as_uint(v), false, false); return __uint_as_float((threadIdx.x & 32) ? rr[0] : rr[1]); }
__device__ __forceinline__ float xor1(float v) { return __uint_as_float((unsigned)__builtin_amdgcn_update_dpp(0, (int)__float_as_uint(v), 0xB1, 0xF, 0xF, true)); }
__device__ __forceinline__ float wave_sum(float v) {
    v += SWZ_XOR(v, 1); v += SWZ_XOR(v, 2); v += SWZ_XOR(v, 4); v += SWZ_XOR(v, 8); v += SWZ_XOR(v, 16);
    auto rr = __builtin_amdgcn_permlane32_swap(__float_as_uint(v), __float_as_uint(v), false, false);
    return __uint_as_float(rr[0]) + __uint_as_float(rr[1]);
}
__device__ __forceinline__ float dot4(const f32x4 a) { return (a.x * a.x + a.y * a.y) + (a.z * a.z + a.w * a.w); }

template <int KIND> __device__ __forceinline__ int dest_row(int n) {
    if constexpr (KIND == 0) return n;
    else if constexpr (KIND == 3) return n < 544 ? n : n + 96;
    else if constexpr (KIND == 4) { const int v = n >= FF, c = v ? n - FF : n; return 256 * (c >> 7) + 128 * v + (c & 127); }
    else if constexpr (KIND == 1) {
        const int h = n / 192, d = n - h * 192;
        if (d < 128) return h * 128 + d;
        const int i = d - 128, t = h >> 2, hh = h & 3;
        return 2048 + 256 * t + 32 * hh + (i < 32 ? i : 128 + (i - 32));
    } else {
        const int g = n / 6144, r = n - g * 6144, t = r >> 11, r2 = r & 2047, h = r2 >> 7, d = r2 & 127;
        if (t == 2) return n;
        const int T = h >> 1, hh = h & 1;
        const int tc = d < 16 ? 16 * hh + d : (d < 32 ? 128 + 16 * hh + (d - 16) : hh * 128 + d);
        return g * 6144 + t * 2048 + T * 256 + tc;
    }
}
template <int KIND> __device__ __forceinline__ void p0_transpose_item(const float* W, int K, int N, bf16* WT, int row_off, LAS float* scr, int item, int lane) {
    const int nblk = N / 32, kb = item / nblk, nb = item - kb * nblk, k0 = 64 * kb, n0 = 32 * nb;
#pragma unroll 8
    for (int i = 0; i < 32; ++i) { const int kk = 2 * i + (lane >> 5); scr[kk * 33 + (lane & 31)] = W[(size_t)(k0 + kk) * N + n0 + (lane & 31)]; }
    LDS_WAIT(); asm volatile("" ::: "memory");
    const int c = lane & 7;
#pragma unroll
    for (int j = 0; j < 4; ++j) { const int n = (lane >> 3) + 8 * j; const LAS float* s = scr + (8 * c) * 33 + n;
        v4u o; o.x = pk2(s[0 * 33], s[1 * 33]); o.y = pk2(s[2 * 33], s[3 * 33]); o.z = pk2(s[4 * 33], s[5 * 33]); o.w = pk2(s[6 * 33], s[7 * 33]);
        *(GAS v4u*)(WT + (size_t)(row_off + dest_row<KIND>(n0 + n)) * K + k0 + 8 * c) = o; }
    LDS_WAIT(); asm volatile("" ::: "memory");
}
__device__ const double kRopeRev[32] = {
    0.15915494309189535, 0.10561541722123227, 0.0700865215877985, 0.046509502471476706, 0.03086376340470123, 0.020481231595318977, 0.013591370636193905, 0.009019250376164549,
    0.005985185712713705, 0.00397177664679776, 0.002635675898667414, 0.001749037788521446, 0.001160663641240061, 0.0007702178288757531, 0.0005111175045375439, 0.00033917820861925017,
    0.00022507907903927653, 0.00014936275542995963, 9.911730936901935e-05, 6.577436917438735e-05, 4.364795279280289e-05, 2.8964835496204437e-05, 1.9221100684944863e-05, 1.2755146204410543e-05,
    8.464330808241401e-06, 5.616940400618127e-06, 3.727408601915352e-06, 2.473512961630074e-06, 1.6414262627950345e-06, 1.0892524995776498e-06, 7.228293068832865e-07, 4.796704226907546e-07};

__device__ __forceinline__ void norm_rows_bf16(Frame& F, const float* src, const float* gain, bf16* dst) {
    LANE_IDS();
    const int gw = F.vcu * NWAVES + wave, NGW = F.G * NWAVES;
    f32x4 g[8];
#pragma unroll
    for (int j = 0; j < 8; ++j) g[j] = *(const f32x4*)(gain + 4 * lane + 256 * j);
    for (int m = gw; m < M; m += NGW) {
        const GAS f32x4* xr = (const GAS f32x4*)(src + (size_t)m * DM) + lane;
        f32x4 v[8]; float s = 0.f;
#pragma unroll
        for (int j = 0; j < 8; ++j) { v[j] = xr[64 * j]; s += dot4(v[j]); }
        const float r = 1.0f / sqrtf(wave_sum(s) * (1.0f / DM) + EPS);
        GAS v2u* o8 = (GAS v2u*)(dst + (size_t)m * DM) + lane;
#pragma unroll
        for (int j = 0; j < 8; ++j) { const f32x4 y = (v[j] * r) * g[j]; v2u w; w.x = pk2(y.x, y.y); w.y = pk2(y.z, y.w); o8[64 * j] = w; }
    }
}
__device__ __forceinline__ void norm_rows_f32_inplace(Frame& F, float* x, const float* gain) {
    LANE_IDS();
    const int gw = F.vcu * NWAVES + wave, NGW = F.G * NWAVES;
    f32x4 g[8];
#pragma unroll
    for (int j = 0; j < 8; ++j) g[j] = *(const f32x4*)(gain + 4 * lane + 256 * j);
    for (int m = gw; m < M; m += NGW) {
        GAS f32x4* xr = (GAS f32x4*)(x + (size_t)m * DM) + lane;
        f32x4 v[8]; float s = 0.f;
#pragma unroll
        for (int j = 0; j < 8; ++j) { v[j] = xr[64 * j]; s += dot4(v[j]); }
        const float r = 1.0f / sqrtf(wave_sum(s) * (1.0f / DM) + EPS);
#pragma unroll
        for (int j = 0; j < 8; ++j) xr[64 * j] = (v[j] * r) * g[j];
    }
}

__device__ __forceinline__ void p0_prologue(Frame& F) {
    LANE_IDS();
    LAS float* scr = (LAS float*)(F.lds + RING_OFF + wave * 16384);
    const int gw = F.vcu * NWAVES + wave, NGW = F.G * NWAVES;
    unsigned char* ws = F.wsb;
    constexpr int I0 = 32 * 16, I1 = 32 * 18, I2 = 8 * 96, I3 = 8 * 128, I4 = 32 * 64, I5 = 32 * 576, I6 = 32 * 64, I7 = 32 * 352, I8 = 88 * 64;
    constexpr int NITEMS = 2 * (I0 + I1 + I2 + I3 + I4 + I5 + I6) + 4 * (I7 + I8);
    for (int it = gw; it < NITEMS; it += NGW) {
        int r = it;
        if (r < 2 * I5) { const int l = r / I5; p0_transpose_item<2>((const float*)karg(12) + (size_t)l * DM * NDIL, DM, NDIL, (bf16*)(ws + WS_WDIL + l * WDIL_STRIDE + WDIL_IN), 0, scr, r - l * I5, lane); continue; } r -= 2 * I5;
        if (r < 4 * I7) { const int l = r / I7; p0_transpose_item<4>((const float*)karg(14) + (size_t)l * DM * NUP, DM, NUP, (bf16*)(ws + WS_WFFN + l * WFFN_STRIDE + WFFN_UP), 0, scr, r - l * I7, lane); continue; } r -= 4 * I7;
        if (r < 4 * I8) { const int l = r / I8; p0_transpose_item<0>((const float*)karg(17) + (size_t)l * FF * DM, FF, DM, (bf16*)(ws + WS_WFFN + l * WFFN_STRIDE + WFFN_DOWN), 0, scr, r - l * I8, lane); continue; } r -= 4 * I8;
        if (r < 2 * I6) { const int l = r / I6; p0_transpose_item<0>((const float*)karg(13) + (size_t)l * DM * DM, DM, DM, (bf16*)(ws + WS_WDIL + l * WDIL_STRIDE + WDIL_WO), 0, scr, r - l * I6, lane); continue; } r -= 2 * I6;
        if (r < 2 * I4) { const int l = r / I4; p0_transpose_item<0>((const float*)karg(11) + (size_t)l * DM * DM, DM, DM, (bf16*)(ws + WS_WMLA + l * WMLA_STRIDE + WMLA_WO), 0, scr, r - l * I4, lane); continue; } r -= 2 * I4;
        if (r < 2 * I3) { const int l = r / I3; p0_transpose_item<0>((const float*)karg(10) + (size_t)l * 512 * NKVB, 512, NKVB, (bf16*)(ws + WS_WMLA + l * WMLA_STRIDE + WMLA_KVB), 0, scr, r - l * I3, lane); continue; } r -= 2 * I3;
        if (r < 2 * I2) { const int l = r / I2; p0_transpose_item<1>((const float*)karg(7) + (size_t)l * 512 * NQB, 512, NQB, (bf16*)(ws + WS_WMLA + l * WMLA_STRIDE + WMLA_QB), 0, scr, r - l * I2, lane); continue; } r -= 2 * I2;
        if (r < 2 * I1) { const int l = r / I1; p0_transpose_item<3>((const float*)karg(8) + (size_t)l * DM * 576, DM, 576, (bf16*)(ws + WS_WMLA + l * WMLA_STRIDE + WMLA_QKVA), 512, scr, r - l * I1, lane); continue; } r -= 2 * I1;
        { const int l = r / I0; p0_transpose_item<0>((const float*)karg(5) + (size_t)l * DM * 512, DM, 512, (bf16*)(ws + WS_WMLA + l * WMLA_STRIDE + WMLA_QKVA), 0, scr, r - l * I0, lane); }
    }
    const int gt = F.vcu * (NWAVES * 64) + tid, NGT = F.G * NWAVES * 64;
    for (int i = gt; i < 2 * 192 * DM / 8; i += NGT) { const int l = i / (192 * DM / 8), e = i - l * (192 * DM / 8), rr = e / (DM / 8), cc = e - rr * (DM / 8), row = rr < 96 ? 1056 + rr : 1184 + (rr - 96);
        *((GAS v4u*)(ws + WS_WMLA + l * WMLA_STRIDE + WMLA_QKVA + (size_t)row * DM * 2) + cc) = (v4u){0u, 0u, 0u, 0u}; }
    const int* pos = (const int*)karg(1);
    for (int i = gt; i < M * 32; i += NGT) { const int row = i >> 5, k = i & 31;
        const double rev = (double)pos[row] * kRopeRev[k]; const float fr = (float)(rev - __builtin_rint(rev));
        const float c = __builtin_amdgcn_cosf(fr), s = __builtin_amdgcn_sinf(fr);
        ((float*)(ws + WS_COSM))[i] = c; ((float*)(ws + WS_SINM))[i] = s;
        if ((k & 1) == 0) { ((float*)(ws + WS_COSD))[row * 16 + (k >> 1)] = c; ((float*)(ws + WS_SIND))[row * 16 + (k >> 1)] = s; } }
    norm_rows_bf16(F, (const float*)karg(0), (const float*)karg(2), (bf16*)(ws + WS_H));
}

__device__ __forceinline__ void mla_mid(Frame& F, int j) {
    LANE_IDS();
    const int gw = ((int)blockIdx.x - 64) * NWAVES + wave, NGW = (F.G - 64) * NWAVES;
    unsigned char* ws = F.wsb;
    const float* qkva = (const float*)(ws + WS_S + S_QKVA);
    bf16* QN = (bf16*)(ws + WS_S + S_QN); bf16* CK = (bf16*)(ws + WS_S + S_CKVN);
    const float* gq = (const float*)karg(6) + j * 512; const float* gk = (const float*)karg(9) + j * 512;
    f32x4 g1[2], g2[2];
#pragma unroll
    for (int t = 0; t < 2; ++t) { g1[t] = *(const f32x4*)(gq + 4 * lane + 256 * t); g2[t] = *(const f32x4*)(gk + 4 * lane + 256 * t); }
    for (int m = gw; m < M; m += NGW) {
        const float* row = qkva + (size_t)m * NQKVA;
        f32x4 a[2], c[2];
#pragma unroll
        for (int t = 0; t < 2; ++t) { a[t] = *(const GAS f32x4*)(row + 4 * lane + 256 * t); c[t] = *(const GAS f32x4*)(row + 512 + 4 * lane + 256 * t); }
        const float ra = 1.0f / sqrtf(wave_sum(dot4(a[0]) + dot4(a[1])) * (1.0f / 512) + EPS);
        const float rc = 1.0f / sqrtf(wave_sum(dot4(c[0]) + dot4(c[1])) * (1.0f / 512) + EPS);
#pragma unroll
        for (int t = 0; t < 2; ++t) { const f32x4 y = (a[t] * ra) * g1[t], z = (c[t] * rc) * g2[t]; v2u w;
            w.x = pk2(y.x, y.y); w.y = pk2(y.z, y.w); *((GAS v2u*)(QN + (size_t)m * 512 + 256 * t) + lane) = w;
            w.x = pk2(z.x, z.y); w.y = pk2(z.z, z.w); *((GAS v2u*)(CK + (size_t)m * 512 + 256 * t) + lane) = w; }
    }
}

__device__ __forceinline__ void dil_merge(Frame& F) {
    LANE_IDS();
    const int gw = F.vcu * NWAVES + wave, NGW = F.G * NWAVES;
    unsigned char* ws = F.wsb;
    const bf16* OG = (const bf16*)(ws + WS_S + S_OG); const float* LSE = (const float*)(ws + WS_S + S_LSE); bf16* AO = (bf16*)(ws + WS_S + S_AO_DIL);
    for (int m = gw; m < M; m += NGW) {
        const int b = m >> 12, s = m & (SEQ - 1);
        const size_t sp0 = s, sp1 = (size_t)(s & 3) * (SEQ / 4) + (s >> 2), sp2 = (size_t)(s & 15) * (SEQ / 16) + (s >> 4);
#pragma unroll
        for (int j = 0; j < 4; ++j) { const int col = 8 * lane + 512 * j, head = col >> 7, dim = col & 127;
            const size_t r0 = ((size_t)(0 * 16 + head) * BATCH + b) * SEQ + sp0, r1 = ((size_t)(1 * 16 + head) * BATCH + b) * SEQ + sp1, r2 = ((size_t)(2 * 16 + head) * BATCH + b) * SEQ + sp2;
            const float l0 = LSE[r0], l1 = LSE[r1], l2 = LSE[r2];
            const float mx = fmaxf(l0, fmaxf(l1, l2)); float e0 = __expf(l0 - mx), e1 = __expf(l1 - mx), e2 = __expf(l2 - mx);
            const float inv = 1.0f / (e0 + e1 + e2); e0 *= inv; e1 *= inv; e2 *= inv;
            const v4u a = *(const GAS v4u*)(OG + r0 * 128 + dim), bb = *(const GAS v4u*)(OG + r1 * 128 + dim), c = *(const GAS v4u*)(OG + r2 * 128 + dim);
            v4u w;
#pragma unroll
            for (int q = 0; q < 4; ++q) w[q] = pk2(e0 * bf_lo(a[q]) + e1 * bf_lo(bb[q]) + e2 * bf_lo(c[q]), e0 * bf_hi(a[q]) + e1 * bf_hi(bb[q]) + e2 * bf_hi(c[q]));
            *(GAS v4u*)(AO + (size_t)m * DM + col) = w; }
    }
}

__device__ __forceinline__ void ffn_fixup(Frame& F, int layer, int pm) {
    LANE_IDS();
    if ((pm & 15) == 0) return;
    unsigned char* ws = F.wsb;
    const float* HALO = (const float*)(ws + WS_HALO); const float* FIX = (const float*)(ws + WS_FIX); bf16* ACT = (bf16*)(ws + WS_S + S_ACT);
    const float* cw = (const float*)karg(15) + (size_t)layer * 3 * NUP;
    for (int idx = tid; idx < 2 * (FF / 8); idx += NWAVES * 64) { const int rs = idx / (FF / 8), ch = (idx - rs * (FF / 8)) * 8;
        float o[8];
#pragma unroll
        for (int e = 0; e < 8; e += 4) {
            f32x4 cg = *(const GAS f32x4*)(FIX + ((size_t)pm * 2 + rs) * NUP + ch + e), cv = *(const GAS f32x4*)(FIX + ((size_t)pm * 2 + rs) * NUP + FF + ch + e);
            const f32x4 u1g = *(const GAS f32x4*)(HALO + ((size_t)(pm - 1) * 2 + 1) * NUP + ch + e), u1v = *(const GAS f32x4*)(HALO + ((size_t)(pm - 1) * 2 + 1) * NUP + FF + ch + e);
            const f32x4 u2g = *(const GAS f32x4*)(HALO + ((size_t)(pm - 1) * 2 + 0) * NUP + ch + e), u2v = *(const GAS f32x4*)(HALO + ((size_t)(pm - 1) * 2 + 0) * NUP + FF + ch + e);
            const f32x4 w0g = *(const f32x4*)(cw + ch + e), w0v = *(const f32x4*)(cw + FF + ch + e), w1g = *(const f32x4*)(cw + NUP + ch + e), w1v = *(const f32x4*)(cw + NUP + FF + ch + e);
            if (rs == 0) { cg = cg + w1g * u1g + w0g * u2g; cv = cv + w1v * u1v + w0v * u2v; } else { cg = cg + w0g * u1g; cv = cv + w0v * u1v; }
#pragma unroll
            for (int k = 0; k < 4; ++k) o[e + k] = cg[k] * __builtin_amdgcn_rcpf(1.0f + __builtin_amdgcn_exp2f(-1.4426950408889634f * cg[k])) * cv[k]; }
        v4u w; w.x = pk2(o[0], o[1]); w.y = pk2(o[2], o[3]); w.z = pk2(o[4], o[5]); w.w = pk2(o[6], o[7]);
        *(GAS v4u*)(ACT + ((size_t)pm * 256 + rs) * FF + ch) = w; }
}

struct MlaRef {
    const bf16* Q; const bf16* KV; const bf16* KPE; bf16* AO; int vcu;
    __device__ __forceinline__ att::BlockRef operator()(int i) const {
        const int I = vcu + 256 * (i >> 1), bh = I >> 3, x = I & 7, qb = (i & 1) ? 15 - x : x, b = bh >> 4, h = bh & 15;
        const size_t row0 = (size_t)b * SEQ + (size_t)qb * 256;
        att::BlockRef r; r.Q = Q + row0 * NQB + h * 128; r.Qpe = Q + row0 * NQB + 2048 + h * 64;
        r.K = KV + (size_t)bh * SEQ * 128; r.V = r.K + (size_t)M * DM; r.Kpe = KPE + (size_t)b * SEQ * 64;
        r.O = AO + row0 * DM + h * 128; r.Lse = nullptr; r.P0 = qb * 256; return r;
    }
};
struct DilRef {
    const bf16* QKV; bf16* OG; float* LSE; int vcu, g;
    __device__ __forceinline__ att::BlockRef operator()(int i) const {
        const int I = vcu + 256 * i, sh = 2 * g, d = 1 << sh, nqbs = 4 - sh;
        const int seq = I >> nqbs, qb = I & ((1 << nqbs) - 1), h = seq & 15, br = seq >> 4, rr = br & (d - 1), b = br >> sh;
        const size_t sp0 = (size_t)rr * (SEQ >> sh), spq = sp0 + (size_t)qb * 256;
        const size_t hb = ((size_t)(g * 3) * 16 + h) * BATCH + b, tstep = (size_t)16 * BATCH * SEQ * 128;
        att::BlockRef r; r.Q = QKV + (hb * SEQ + spq) * 128; r.Qpe = nullptr; r.Kpe = nullptr;
        r.K = QKV + tstep + (hb * SEQ + sp0) * 128; r.V = r.K + tstep;
        const size_t ob = ((size_t)g * 16 + h) * BATCH + b;
        r.O = OG + (ob * SEQ + spq) * 128; r.Lse = LSE + ob * SEQ + spq; r.P0 = qb * 256; return r;
    }
};
template <bool PE, bool SK, bool LSE, bool EARLY, class RefFn>
__device__ __forceinline__ void attn_run(char* lds, const att::Prm& P, int n, const RefFn& ref) {
    att::BlockRef cur = ref(0); att::Seam<PE> S;
    att::swa_prime<PE>(cur, P, lds, S);
    for (int i = 0;; ++i) {
        const bool last = i + 1 >= n;
        const att::BlockRef nxt = last ? cur : ref(i + 1);
        att::swa_block<PE, SK, LSE, EARLY>(cur, nxt, P, lds, S);
        if (last) break;
        cur = nxt;
    }
}

struct Args { const void* in[18]; float* out; unsigned char* ws; };
__global__ void __launch_bounds__(NWAVES * 64, 2) fwd_kernel(Args args) {
    extern __shared__ __attribute__((aligned(16))) unsigned char lds[];
    Frame F;
    F.lds = (LAS unsigned char*)lds;
    F.MISC = (volatile LAS unsigned*)(F.lds + MISC_OFF);
    F.G = gridDim.x; { const int bx = blockIdx.x; F.vcu = (F.G % 8 == 0) ? (bx % 8) * (F.G / 8) + bx / 8 : bx; }
        F.out = args.out; F.wsb = args.ws;
    F.ctl = (gu32*)(args.ws + WS_CTL);
#define ws F.wsb
#define RELAUNDER() asm volatile("" : "+s"(F.vcu), "+s"(F.wsb), "+s"(F.out))
    for (int u = threadIdx.x; u < (LDS_BYTES - LDSCTL_OFF) / 4; u += NWAVES * 64) ((LAS unsigned*)(F.lds + LDSCTL_OFF))[u] = 0u;
    __syncthreads();
    XcdBarrier bar = xcd_barrier_post((unsigned*)(F.ctl + CW_BAR), F.MISC + 8);
#define GRID_BAR() xcd_barrier(bar)
    typedef pg8::StaticOrder SO;
#define GEMMR(EpiT, Aptr, Bptr, N_, K_, Eobj, REP_) do { pg8::Gemm g_{(const bf16*)(Aptr), (const bf16*)(Bptr), M, (N_), (K_)}; SO S_; S_.init(M, (N_), F.G, (int)blockIdx.x); \
        pg8::gemm_phase<EpiT, SO, true, true, REP_>(F.lds + RING_OFF, g_, S_, (Eobj)); } while (0)
#define GEMM(EpiT, Aptr, Bptr, N_, K_, Eobj) GEMMR(EpiT, Aptr, Bptr, N_, K_, Eobj, 1)

    bf16* H = (bf16*)(ws + WS_H);
    const float* cosM = (const float*)(ws + WS_COSM); const float* sinM = (const float*)(ws + WS_SINM);
    const float* cosD = (const float*)(ws + WS_COSD); const float* sinD = (const float*)(ws + WS_SIND);

    p0_prologue(F);
    GRID_BAR();

    for (int j = 0; j < 2; ++j) {
        {
            RELAUNDER();
            const unsigned char* wl = ws + WS_WMLA + j * WMLA_STRIDE;
            float* QKVA = (float*)(ws + WS_S + S_QKVA); bf16* QN = (bf16*)(ws + WS_S + S_QN); bf16* CK = (bf16*)(ws + WS_S + S_CKVN); bf16* KPE = (bf16*)(ws + WS_S + S_KPE);
            bf16* Q = (bf16*)(ws + WS_S + S_Q); bf16* KV = (bf16*)(ws + WS_S + S_KV); bf16* AO = (bf16*)(ws + WS_S + S_AO_MLA);
            if (j > 0) {
            norm_rows_bf16(F, F.out, (const float*)karg(2) + (2 * j) * DM, H); GRID_BAR(); }
            { pg8::EpiF32Store E{QKVA, NQKVA}; GEMM(pg8::EpiF32Store, H, wl + WMLA_QKVA, 1024, DM, E); }
            GRID_BAR();
            if (blockIdx.x < 64) {
                pg8::Gemm g_{(const bf16*)H, (const bf16*)(wl + WMLA_QKVA), M, NQKVA, DM}; pg8::OneUnit S_{(int)blockIdx.x, 4}; pg8::EpiKpe E{KPE, cosM, sinM};
                pg8::gemm_phase<pg8::EpiKpe, pg8::OneUnit, true, true>(F.lds + RING_OFF, g_, S_, E);
            } else mla_mid(F, j);
            GRID_BAR();
            { pg8::EpiQMla E{Q, cosM, sinM}; GEMM(pg8::EpiQMla, QN, wl + WMLA_QB, NQB, 512, E); }
            { pg8::EpiKvMla E{KV, KV + (size_t)M * DM}; GEMM(pg8::EpiKvMla, CK, wl + WMLA_KVB, NKVB, 512, E); }
            GRID_BAR();
            RELAUNDER();
            { att::Prm P{NQB, 128, DM, NQB, 64, 0, SEQ, SEQ, 0.07216878364870322f};
              MlaRef R{Q, KV, KPE, AO, F.vcu};
              attn_run<true, false, false, false>((char*)lds + RING_OFF, P, 4, R);
            }
            GRID_BAR();
            { pg8::EpiRes E{j == 0 ? (const float*)karg(0) : (const float*)F.out, F.out, DM}; GEMM(pg8::EpiRes, AO, wl + WMLA_WO, DM, DM, E); }
            GRID_BAR();
        }
        {
            RELAUNDER();
            const int layer = 2 * j; const unsigned char* wl = ws + WS_WFFN + layer * WFFN_STRIDE;
            bf16* ACT = (bf16*)(ws + WS_S + S_ACT);

            norm_rows_bf16(F, F.out, (const float*)karg(3) + layer * DM, H); GRID_BAR();
            { pg8::EpiUpConv E{ACT, (float*)(ws + WS_HALO), (float*)(ws + WS_FIX), (const float*)karg(15) + (size_t)layer * 3 * NUP, (const float*)karg(16) + (size_t)layer * NUP,
                               (PG8_LAS float*)(F.lds + XH_OFF), (PG8_LAS float*)(F.lds + CWL_OFF)};
              GEMM(pg8::EpiUpConv, H, wl + WFFN_UP, NUP, DM, E);
            }
            GRID_BAR();
            { SO S_; S_.init(M, DM, F.G, (int)blockIdx.x); pg8::Unit u_; for (int i = 0; S_.next(i, u_); ++i) ffn_fixup(F, layer, u_.pm);
              asm volatile("s_waitcnt vmcnt(0)" ::: "memory"); __syncthreads(); }
            { pg8::EpiRes E{F.out, F.out, DM}; GEMM(pg8::EpiRes, ACT, wl + WFFN_DOWN, DM, FF, E); }
            GRID_BAR();
        }
        {
            RELAUNDER();
            const unsigned char* wl = ws + WS_WDIL + j * WDIL_STRIDE;
            bf16* QKV = (bf16*)(ws + WS_S + S_QKV); bf16* OG = (bf16*)(ws + WS_S + S_OG); float* LSE = (float*)(ws + WS_S + S_LSE); bf16* AO = (bf16*)(ws + WS_S + S_AO_DIL);

            norm_rows_bf16(F, F.out, (const float*)karg(2) + (2 * j + 1) * DM, H); GRID_BAR();
            { pg8::EpiQkvDil E{QKV, cosD, sinD}; GEMM(pg8::EpiQkvDil, H, wl + WDIL_IN, NDIL, DM, E);
            }
            GRID_BAR();
#pragma unroll 1
            for (int g = 0; g < 3; ++g) { const int d = 1 << (2 * g);
              att::Prm P{128, 128, 128, 0, 0, 1, SEQ / d, 129, 0.08838834764831845f};
              DilRef R{QKV, OG, LSE, F.vcu, g};
              attn_run<false, true, true, true>((char*)lds + RING_OFF, P, 4, R);
            }
            GRID_BAR();
            dil_merge(F);
            GRID_BAR();
            { pg8::EpiRes E{F.out, F.out, DM}; GEMM(pg8::EpiRes, AO, wl + WDIL_WO, DM, DM, E); }
            GRID_BAR();
        }
        {
            RELAUNDER();
            const int layer = 2 * j + 1; const unsigned char* wl = ws + WS_WFFN + layer * WFFN_STRIDE;
            bf16* ACT = (bf16*)(ws + WS_S + S_ACT);

            norm_rows_bf16(F, F.out, (const float*)karg(3) + layer * DM, H); GRID_BAR();
            { pg8::EpiUpConv E{ACT, (float*)(ws + WS_HALO), (float*)(ws + WS_FIX), (const float*)karg(15) + (size_t)layer * 3 * NUP, (const float*)karg(16) + (size_t)layer * NUP,
                               (PG8_LAS float*)(F.lds + XH_OFF), (PG8_LAS float*)(F.lds + CWL_OFF)};
              GEMM(pg8::EpiUpConv, H, wl + WFFN_UP, NUP, DM, E);
            }
            GRID_BAR();
            { SO S_; S_.init(M, DM, F.G, (int)blockIdx.x); pg8::Unit u_; for (int i = 0; S_.next(i, u_); ++i) ffn_fixup(F, layer, u_.pm);
              asm volatile("s_waitcnt vmcnt(0)" ::: "memory"); __syncthreads(); }
            { pg8::EpiRes E{F.out, F.out, DM}; GEMM(pg8::EpiRes, ACT, wl + WFFN_DOWN, DM, FF, E); }
            GRID_BAR();
        }
    }
    RELAUNDER();
    norm_rows_f32_inplace(F, F.out, (const float*)karg(4));
#undef ws
#undef RELAUNDER
#undef GEMM
#undef GEMMR
#undef GRID_BAR
}

extern "C" void kernel_launch(void* const* d_in, const int* in_sizes, int n_in, void* d_out, int out_size, void* d_ws, size_t ws_size, hipStream_t stream) {
    static int grid = 0;
    if (grid == 0) {
        if (n_in != 18 || in_sizes[0] != M * DM || out_size != M * DM || ws_size < WS_END) {
            fprintf(stderr, "kernel_launch: shape / workspace mismatch (n_in %d, in0 %d, out %d, ws %zu, need %zu); nothing launched\n", n_in, n_in > 0 ? in_sizes[0] : -1, out_size, ws_size, (size_t)WS_END); grid = -1; return; }
        int dev = 0, cus = 0, per_cu = 0;
        if (hipGetDevice(&dev) != hipSuccess || hipDeviceGetAttribute(&cus, hipDeviceAttributeMultiprocessorCount, dev) != hipSuccess) { grid = -1; return; }
        if (hipFuncSetAttribute((const void*)fwd_kernel, hipFuncAttributeMaxDynamicSharedMemorySize, LDS_BYTES) != hipSuccess) { fprintf(stderr, "kernel_launch: hipFuncSetAttribute failed\n"); grid = -1; return; }
        if (hipOccupancyMaxActiveBlocksPerMultiprocessor(&per_cu, (const void*)fwd_kernel, NWAVES * 64, LDS_BYTES) != hipSuccess || per_cu < 1) fprintf(stderr, "kernel_launch: occupancy query reports %d\n", per_cu);
        (void)hipGetLastError();
        if (cus < 256) { fprintf(stderr, "kernel_launch: built for a 256-CU device, found %d CUs; nothing launched\n", cus); grid = -1; return; }
        grid = 256;
    }
    if (grid < 0) return;
    if (hipMemsetAsync((char*)d_ws + WS_CTL, 0, CTL_ZERO_BYTES, stream) != hipSuccess) return;
    Args a{};
    for (int i = 0; i < 18; ++i) a.in[i] = d_in[i];
    a.out = (float*)d_out; a.ws = (unsigned char*)d_ws;
    hipLaunchKernelGGL(fwd_kernel, dim3(grid), dim3(NWAVES * 64), LDS_BYTES, stream, a);
}
```

```cpp
#include <hip/hip_runtime.h>
#include <cstdio>
#include <cstdint>
namespace pg8 {
#define PG8_LAS __attribute__((address_space(3)))
typedef unsigned short bf16_t;
typedef short bf16x8 __attribute__((ext_vector_type(8)));
typedef float f32x4 __attribute__((ext_vector_type(4)));
typedef unsigned u32x4 __attribute__((ext_vector_type(4)));
constexpr int BM = 256, BK = 64, HALF = 128, HTB = HALF * BK * 2  , STAGE_BYTES = 8 * HTB, NXCD = 8, WGM = 8;

__host__ __device__ __forceinline__ int lds_byte(int r, int c) { const int st = (r >> 4) * 2 + (c >> 5), rr = r & 15, cc = c & 31, ob = rr * 64 + cc * 2; return st * 1024 + (ob ^ (((ob >> 9) & 1) << 5)); }
__host__ __device__ __forceinline__ void stage_rc(int b, int& R, int& C) { const int st = b / 1024, sb = b % 1024, swz = sb ^ (((sb >> 9) & 1) << 5); R = (st >> 1) * 16 + swz / 64; C = (st & 1) * 32 + (swz % 64) / 2; }
__host__ __device__ __forceinline__ int perm32(int rho) { const int n = rho >> 4, i = rho & 15; return 8 * (i >> 2) + 4 * n + (i & 3); }

struct Unit { int pm, pn; };
struct Gemm { const bf16_t* A; const bf16_t* Bt; int M, N, K; };

struct StaticOrder {
    int nM, nN, nwg, G, c;
    __host__ __device__ void init(int M, int N, int G_, int c_) { nM = M / BM; nN = N / BM; nwg = nM * nN; G = G_; c = c_; }
    __host__ __device__ __forceinline__ bool next(int i, Unit& u) const {
        const long L = (long)i * G + c; if (L >= nwg) return false;
        int wgid = (int)L; { const int q = nwg / NXCD, r = nwg % NXCD, xcd = wgid % NXCD, off = wgid / NXCD; wgid = (xcd < r ? xcd * (q + 1) : r * (q + 1) + (xcd - r) * q) + off; }
        const int nig = WGM * nN, gid = wgid / nig, fm = gid * WGM, gsz = (nM - fm) < WGM ? (nM - fm) : WGM;
        u.pm = fm + ((wgid % nig) % gsz); u.pn = (wgid % nig) / gsz; return true;
    }
    __device__ __forceinline__ void a_ready(const Unit&) const {}
    __device__ __forceinline__ void done(const Unit&) const {}
};

__device__ __forceinline__ unsigned cvt_pk_bf16(float lo, float hi) { unsigned r; asm volatile("v_cvt_pk_bf16_f32 %0, %1, %2" : "=v"(r) : "v"(lo), "v"(hi)); return r; }
typedef float f32x2 __attribute__((ext_vector_type(2)));
typedef unsigned u32x2 __attribute__((ext_vector_type(2)));
__device__ __forceinline__ u32x4 pack8bf(const f32x4 a, const f32x4 b) { u32x4 w; w.x = cvt_pk_bf16(a[0], a[1]); w.y = cvt_pk_bf16(a[2], a[3]); w.z = cvt_pk_bf16(b[0], b[1]); w.w = cvt_pk_bf16(b[2], b[3]); return w; }
#define PG8_NOPRE struct Pre {}; __device__ __forceinline__ void pre_issue(Pre&, const Unit&, int, int) const {} __device__ __forceinline__ void pre_finish(Pre&, int, int) const {}
struct EpiF32Store {
    PG8_NOPRE
    static constexpr bool PERM = false, AFTER_DRAIN = false;
    float* C; int ldc;
    __device__ __forceinline__ void operator()(const f32x4 (&acc)[2][2][4][2], const Unit& u, int wr, int wc, int fr, int fq, int ui) const {
        const int row0 = u.pm * BM + wr * 64 + fr, col0 = u.pn * BM + wc * 32 + 4 * fq;
#pragma unroll
        for (int ai = 0; ai < 2; ++ai)
#pragma unroll
            for (int m = 0; m < 4; ++m) { float* rowp = C + (size_t)(row0 + ai * HALF + m * 16) * ldc + col0;
#pragma unroll
                for (int bj = 0; bj < 2; ++bj)
#pragma unroll
                    for (int n = 0; n < 2; ++n) *(f32x4*)(rowp + bj * HALF + n * 16) = acc[ai][bj][m][n]; }
    }
};
struct EpiRes {
    PG8_NOPRE
    static constexpr bool PERM = false, AFTER_DRAIN = false;
    const float* base; float* out; int ldc;
    __device__ __forceinline__ void operator()(const f32x4 (&acc)[2][2][4][2], const Unit& u, int wr, int wc, int fr, int fq, int ui) const {
        const int row0 = u.pm * BM + wr * 64 + fr, col0 = u.pn * BM + wc * 32 + 4 * fq;
#pragma unroll
        for (int ai = 0; ai < 2; ++ai) {
            f32x4 bs[4][2][2];
#pragma unroll
            for (int m = 0; m < 4; ++m) { const size_t off = (size_t)(row0 + ai * HALF + m * 16) * ldc + col0;
#pragma unroll
                for (int bj = 0; bj < 2; ++bj)
#pragma unroll
                    for (int n = 0; n < 2; ++n) bs[m][bj][n] = *(const f32x4*)(base + off + bj * HALF + n * 16); }
#pragma unroll
            for (int m = 0; m < 4; ++m) { const size_t off = (size_t)(row0 + ai * HALF + m * 16) * ldc + col0;
#pragma unroll
                for (int bj = 0; bj < 2; ++bj)
#pragma unroll
                    for (int n = 0; n < 2; ++n) *(f32x4*)(out + off + bj * HALF + n * 16) = bs[m][bj][n] + acc[ai][bj][m][n]; }
            asm volatile("" ::: "memory"); }
    }
};

__device__ __forceinline__ float sum_fq(float v) {
    v += __uint_as_float((unsigned)__builtin_amdgcn_ds_swizzle((int)__float_as_uint(v), ((0x10 << 10) | 0x1f)));
    auto rr = __builtin_amdgcn_permlane32_swap(__float_as_uint(v), __float_as_uint(v), false, false);
    return __uint_as_float(rr[0]) + __uint_as_float(rr[1]);
}
__device__ __forceinline__ float sq4(const f32x4 a) { return (a[0] * a[0] + a[1] * a[1]) + (a[2] * a[2] + a[3] * a[3]); }
__device__ __forceinline__ void load_rs(float (&r)[2][4], const PG8_LAS float* rsl, int wr, int fr) {
#pragma unroll
    for (int ai = 0; ai < 2; ++ai)
#pragma unroll
        for (int m = 0; m < 4; ++m) r[ai][m] = rsl[ai * HALF + wr * 64 + m * 16 + fr]; }
struct EpiResN {
    PG8_NOPRE
    static constexpr bool PERM = true, AFTER_DRAIN = false;
    const float* base; float* out; bf16_t* xb; const float* gain; float* ps; int ldc;
    __device__ __forceinline__ void operator()(const f32x4 (&acc)[2][2][4][2], const Unit& u, int wr, int wc, int fr, int fq, int ui) const {
        const int row0 = u.pm * BM + wr * 64 + fr, col0 = u.pn * BM + wc * 32 + 8 * fq;
        f32x4 g[2][2];
#pragma unroll
        for (int bj = 0; bj < 2; ++bj)
#pragma unroll
            for (int n = 0; n < 2; ++n) g[bj][n] = *(const f32x4*)(gain + col0 + bj * HALF + n * 4);
#pragma unroll
        for (int ai = 0; ai < 2; ++ai) {
            f32x4 bs[4][2][2];
#pragma unroll
            for (int m = 0; m < 4; ++m) { const size_t off = (size_t)(row0 + ai * HALF + m * 16) * ldc + col0;
#pragma unroll
                for (int bj = 0; bj < 2; ++bj)
#pragma unroll
                    for (int n = 0; n < 2; ++n) bs[m][bj][n] = *(const f32x4*)(base + off + bj * HALF + n * 4); }
#pragma unroll
            for (int m = 0; m < 4; ++m) { const int row = row0 + ai * HALF + m * 16; const size_t off = (size_t)row * ldc + col0; float q = 0.f;
#pragma unroll
                for (int bj = 0; bj < 2; ++bj) { const f32x4 o0 = bs[m][bj][0] + acc[ai][bj][m][0], o1 = bs[m][bj][1] + acc[ai][bj][m][1]; q += sq4(o0) + sq4(o1);
                    *(f32x4*)(out + off + bj * HALF) = o0; *(f32x4*)(out + off + bj * HALF + 4) = o1;
                    *(u32x4*)(xb + off + bj * HALF) = pack8bf(o0 * g[bj][0], o1 * g[bj][1]); }
                q = sum_fq(q);
                if (fq == 0) ps[(size_t)row * 32 + u.pn * 4 + wc] = q; }
            asm volatile("" ::: "memory"); }
    }
};
struct EpiF32Scaled {
    PG8_NOPRE
    static constexpr bool PERM = false, AFTER_DRAIN = false;
    float* C; int ldc; const PG8_LAS float* rsl;
    __device__ __forceinline__ void operator()(const f32x4 (&acc)[2][2][4][2], const Unit& u, int wr, int wc, int fr, int fq, int ui) const {
        const int row0 = u.pm * BM + wr * 64 + fr, col0 = u.pn * BM + wc * 32 + 4 * fq;
        float r[2][4]; load_rs(r, rsl, wr, fr);
#pragma unroll
        for (int ai = 0; ai < 2; ++ai)
#pragma unroll
            for (int m = 0; m < 4; ++m) { float* rowp = C + (size_t)(row0 + ai * HALF + m * 16) * ldc + col0;
#pragma unroll
                for (int bj = 0; bj < 2; ++bj)
#pragma unroll
                    for (int n = 0; n < 2; ++n) *(f32x4*)(rowp + bj * HALF + n * 16) = acc[ai][bj][m][n] * r[ai][m]; }
    }
};

#define PG8_DPP(old_, src_, ctrl_) __uint_as_float((unsigned)__builtin_amdgcn_update_dpp((int)__float_as_uint(old_), (int)__float_as_uint(src_), (ctrl_), 0xF, 0xF, false))
struct EpiUpConv {
    static constexpr bool PERM = true, AFTER_DRAIN = false;
    bf16_t* ACT; float* HALO; float* FIX; const float* cw; const float* cb;
    PG8_LAS float* xh; PG8_LAS float* cwl; const PG8_LAS float* rsl;
    PG8_NOPRE
    __device__ __forceinline__ void operator()(const f32x4 (&acc_)[2][2][4][2], const Unit& u, int wr, int wc, int fr_, int fq_, int ui) const {
        int fr = fr_, fq = fq_; asm volatile("" : "+v"(fr), "+v"(fq));
        f32x4 (&acc)[2][2][4][2] = const_cast<f32x4 (&)[2][2][4][2]>(acc_);
        { float r[2][4]; load_rs(r, rsl, wr, fr);
#pragma unroll
          for (int ai = 0; ai < 2; ++ai)
#pragma unroll
            for (int bj = 0; bj < 2; ++bj)
#pragma unroll
                for (int m = 0; m < 4; ++m)
#pragma unroll
                    for (int n = 0; n < 2; ++n) acc[ai][bj][m][n] = acc[ai][bj][m][n] * r[ai][m]; }
        const int ch0 = 128 * u.pn + 32 * wc + 8 * fq;
        f32x4 wv = {0.f, 0.f, 0.f, 0.f};
        if (wr == 0) { const int lane = fq * 16 + fr; wv = *(const f32x4*)((wc < 3 ? cw + (size_t)wc * 11264 : cb) + (lane < 32 ? 128 * u.pn + lane * 4 : 5632 + 128 * u.pn + (lane - 32) * 4)); }
        if (fr >= 14) {
#pragma unroll
            for (int ai = 0; ai < 2; ++ai) if (ai == 0 || wr == 0) { PG8_LAS float* b = xh + ((((ai == 0 ? wr : 2) * 4 + wc) * 2 + (fr - 14)) * 4 + fq) * 16;
#pragma unroll
                for (int bj = 0; bj < 2; ++bj)
#pragma unroll
                    for (int n = 0; n < 2; ++n) *(PG8_LAS f32x4*)(b + (bj * 2 + n) * 4) = acc[ai][bj][3][n]; }
            if (wr == 1) { float* hp = HALO + ((size_t)u.pm * 2 + (fr - 14)) * 11264 + ch0;
#pragma unroll
                for (int bj = 0; bj < 2; ++bj)
#pragma unroll
                    for (int n = 0; n < 2; ++n) *(f32x4*)(hp + bj * 5632 + n * 4) = acc[1][bj][3][n]; }
        }
        if (wr == 0) *(PG8_LAS f32x4*)(cwl + wc * 256 + (fq * 16 + fr) * 4) = wv;
        asm volatile("s_waitcnt lgkmcnt(0)" ::: "memory"); __builtin_amdgcn_s_barrier(); asm volatile("" ::: "memory");
        const bool fixtile = (u.pm & 15) != 0;
#pragma unroll
        for (int n = 0; n < 2; ++n) {
            const PG8_LAS float* cwb = cwl + wc * 32 + fq * 8 + n * 4;
#pragma unroll
            for (int ai = 0; ai < 2; ++ai)
#pragma unroll
                for (int m = 0; m < 4; ++m) {
                    f32x4 c[2];
#pragma unroll
                    for (int bj = 0; bj < 2; ++bj) {
                        f32x4 W[4];
#pragma unroll
                        for (int t = 0; t < 4; ++t) W[t] = *(const PG8_LAS f32x4*)(cwb + t * 256 + bj * 128);
                        f32x4 h1 = {0.f, 0.f, 0.f, 0.f}, h2 = {0.f, 0.f, 0.f, 0.f};
                        if (m == 0 && !(ai == 0 && wr == 0)) { const int slot = ai == 0 ? 0 : (wr == 0 ? 1 : 2); const PG8_LAS float* b = xh + (((slot * 4 + wc) * 2) * 4 + fq) * 16 + n * 4 + bj * 8;
                            h2 = *(const PG8_LAS f32x4*)b; h1 = *(const PG8_LAS f32x4*)(b + 64); }
#pragma unroll
                        for (int k = 0; k < 4; ++k) { const float cur = acc[ai][bj][m][n][k]; float x1, z;
                            if (m == 0) { x1 = h1[k]; z = fr == 0 ? h2[k] : h1[k]; }
                            else { const float p = acc[ai][bj][m > 0 ? m - 1 : 0][n][k]; x1 = PG8_DPP(0.f, p, 0x121); z = PG8_DPP(0.f, p, 0x122); }
                            const float t1 = PG8_DPP(x1, cur, 0x111), t2 = PG8_DPP(z, cur, 0x112);
                            c[bj][k] = W[3][k] + W[0][k] * t2 + W[1][k] * t1 + W[2][k] * cur; }
                        __builtin_amdgcn_sched_barrier(0);
                    }
                    const int row = u.pm * BM + ai * HALF + wr * 64 + m * 16 + fr;
                    if (ai == 0 && m == 0 && wr == 0 && fixtile && fr < 2) {
                        float* fp = FIX + ((size_t)u.pm * 2 + fr) * 11264 + ch0 + n * 4;
                        *(f32x4*)fp = c[0]; *(f32x4*)(fp + 5632) = c[1];
                    } else {
                        f32x4 a;
#pragma unroll
                        for (int k = 0; k < 4; ++k) { const float g = c[0][k]; a[k] = g * __builtin_amdgcn_rcpf(1.0f + __builtin_amdgcn_exp2f(-1.4426950408889634f * g)) * c[1][k]; }
                        u32x2 w; w.x = cvt_pk_bf16(a[0], a[1]); w.y = cvt_pk_bf16(a[2], a[3]);
                        *(u32x2*)(ACT + (size_t)row * 5632 + ch0 + n * 4) = w;
                    }
                    asm volatile("" ::: "memory"); __builtin_amdgcn_sched_barrier(0);
                }
        }
    }
};
struct EpiKpe {
    PG8_NOPRE
    static constexpr bool PERM = true, AFTER_DRAIN = false;
    bf16_t* KPE; const float* cosT; const float* sinT; const PG8_LAS float* rsl;
    __device__ __forceinline__ void operator()(const f32x4 (&acc)[2][2][4][2], const Unit& u, int wr, int wc, int fr, int fq, int ui) const {
        if (wc != 0) return;
        const int row0 = u.pm * BM + wr * 64 + fr, i0 = 8 * fq;
        float r[2][4]; load_rs(r, rsl, wr, fr);
#pragma unroll
        for (int ai = 0; ai < 2; ++ai)
#pragma unroll
            for (int m = 0; m < 4; ++m) { const int row = row0 + ai * HALF + m * 16;
                const f32x4 c0 = *(const f32x4*)(cosT + (size_t)row * 32 + i0), c1 = *(const f32x4*)(cosT + (size_t)row * 32 + i0 + 4);
                const f32x4 s0 = *(const f32x4*)(sinT + (size_t)row * 32 + i0), s1 = *(const f32x4*)(sinT + (size_t)row * 32 + i0 + 4);
                const f32x4 x1a = acc[ai][0][m][0] * r[ai][m], x1b = acc[ai][0][m][1] * r[ai][m], x2a = acc[ai][1][m][0] * r[ai][m], x2b = acc[ai][1][m][1] * r[ai][m];
                const f32x4 y1a = x1a * c0 - x2a * s0, y1b = x1b * c1 - x2b * s1, y2a = x2a * c0 + x1a * s0, y2b = x2b * c1 + x1b * s1;
                bf16_t* dst = KPE + (size_t)row * 64 + i0;
                *(u32x4*)dst = pack8bf(y1a, y1b); *(u32x4*)(dst + 32) = pack8bf(y2a, y2b); }
    }
};
struct OneUnit { int pm, pn;
    __device__ __forceinline__ bool next(int i, Unit& u) const { if (i) return false; u.pm = pm; u.pn = pn; return true; }
    __device__ __forceinline__ void a_ready(const Unit&) const {}
    __device__ __forceinline__ void done(const Unit&) const {}
};
struct EpiKvMla {
    PG8_NOPRE
    static constexpr bool PERM = true, AFTER_DRAIN = false;
    bf16_t* KH; bf16_t* VH;
    __device__ __forceinline__ void operator()(const f32x4 (&acc)[2][2][4][2], const Unit& u, int wr, int wc, int fr, int fq, int ui) const {
        const int row0 = u.pm * BM + wr * 64 + fr, dim0 = wc * 32 + 8 * fq;
#pragma unroll
        for (int ai = 0; ai < 2; ++ai)
#pragma unroll
            for (int m = 0; m < 4; ++m) { const int row = row0 + ai * HALF + m * 16, b = row >> 12, s = row & 4095;
                const size_t o = (((size_t)b * 16 + u.pn) * 4096 + s) * 128 + dim0;
                *(u32x4*)(KH + o) = pack8bf(acc[ai][0][m][0], acc[ai][0][m][1]); *(u32x4*)(VH + o) = pack8bf(acc[ai][1][m][0], acc[ai][1][m][1]); }
    }
};
struct EpiQMla {
    PG8_NOPRE
    static constexpr bool PERM = true, AFTER_DRAIN = false;
    bf16_t* Q; const float* cosT; const float* sinT;
    __device__ __forceinline__ void operator()(const f32x4 (&acc)[2][2][4][2], const Unit& u, int wr, int wc, int fr, int fq, int ui) const {
        const int row0 = u.pm * BM + wr * 64 + fr;
        if (u.pn < 8) {
            const int col0 = u.pn * BM + wc * 32 + 8 * fq;
#pragma unroll
            for (int ai = 0; ai < 2; ++ai)
#pragma unroll
                for (int m = 0; m < 4; ++m) { bf16_t* rowp = Q + (size_t)(row0 + ai * HALF + m * 16) * 3072 + col0;
#pragma unroll
                    for (int bj = 0; bj < 2; ++bj) *(u32x4*)(rowp + bj * HALF) = pack8bf(acc[ai][bj][m][0], acc[ai][bj][m][1]); }
        } else {
            const int head = 4 * (u.pn - 8) + wc, i0 = 8 * fq;
#pragma unroll
            for (int ai = 0; ai < 2; ++ai)
#pragma unroll
                for (int m = 0; m < 4; ++m) { const int row = row0 + ai * HALF + m * 16;
                    const f32x4 c0 = *(const f32x4*)(cosT + (size_t)row * 32 + i0), c1 = *(const f32x4*)(cosT + (size_t)row * 32 + i0 + 4);
                    const f32x4 s0 = *(const f32x4*)(sinT + (size_t)row * 32 + i0), s1 = *(const f32x4*)(sinT + (size_t)row * 32 + i0 + 4);
                    const f32x4 x1a = acc[ai][0][m][0], x1b = acc[ai][0][m][1], x2a = acc[ai][1][m][0], x2b = acc[ai][1][m][1];
                    const f32x4 y1a = x1a * c0 - x2a * s0, y1b = x1b * c1 - x2b * s1, y2a = x2a * c0 + x1a * s0, y2b = x2b * c1 + x1b * s1;
                    bf16_t* dst = Q + (size_t)row * 3072 + 2048 + head * 64 + i0;
                    *(u32x4*)dst = pack8bf(y1a, y1b); *(u32x4*)(dst + 32) = pack8bf(y2a, y2b); }
        }
    }
};
struct EpiQkvDil {
    PG8_NOPRE
    static constexpr bool PERM = true, AFTER_DRAIN = false;
    bf16_t* O; const float* cosT; const float* sinT; const PG8_LAS float* rsl;
    __device__ __forceinline__ void operator()(const f32x4 (&acc)[2][2][4][2], const Unit& u, int wr, int wc, int fr, int fq, int ui) const {
        const int row0 = u.pm * BM + wr * 64 + fr;
        const int g = u.pn / 24, rem = u.pn - g * 24, t = rem >> 3, T = rem & 7, sh = 2 * g;
        float r[2][4]; load_rs(r, rsl, wr, fr);
        const size_t plane = ((size_t)(g * 3 + t) * 16 + 2 * T) * 4;
        if (t == 2 || wc != 0) {
            const int dim0 = wc * 32 + 8 * fq;
#pragma unroll
            for (int ai = 0; ai < 2; ++ai)
#pragma unroll
                for (int m = 0; m < 4; ++m) { const int row = row0 + ai * HALF + m * 16, b = row >> 12, s = row & 4095, sp = ((s & ((1 << sh) - 1)) << (12 - sh)) + (s >> sh);
#pragma unroll
                    for (int bj = 0; bj < 2; ++bj) *(u32x4*)(O + ((plane + bj * 4 + b) * 4096 + sp) * 128 + dim0) = pack8bf(acc[ai][bj][m][0] * r[ai][m], acc[ai][bj][m][1] * r[ai][m]); }
        } else {
            const int hh = fq >> 1, i0 = 8 * (fq & 1);
#pragma unroll
            for (int ai = 0; ai < 2; ++ai)
#pragma unroll
                for (int m = 0; m < 4; ++m) { const int row = row0 + ai * HALF + m * 16, b = row >> 12, s = row & 4095, sp = ((s & ((1 << sh) - 1)) << (12 - sh)) + (s >> sh);
                    const f32x4 c0 = *(const f32x4*)(cosT + (size_t)row * 16 + i0), c1 = *(const f32x4*)(cosT + (size_t)row * 16 + i0 + 4);
                    const f32x4 s0 = *(const f32x4*)(sinT + (size_t)row * 16 + i0), s1 = *(const f32x4*)(sinT + (size_t)row * 16 + i0 + 4);
                    const f32x4 x1a = acc[ai][0][m][0] * r[ai][m], x1b = acc[ai][0][m][1] * r[ai][m], x2a = acc[ai][1][m][0] * r[ai][m], x2b = acc[ai][1][m][1] * r[ai][m];
                    const f32x4 y1a = x1a * c0 - x2a * s0, y1b = x1b * c1 - x2b * s1, y2a = x2a * c0 + x1a * s0, y2b = x2b * c1 + x1b * s1;
                    bf16_t* dst = O + ((plane + hh * 4 + b) * 4096 + sp) * 128 + i0;
                    *(u32x4*)dst = pack8bf(y1a, y1b); *(u32x4*)(dst + 16) = pack8bf(y2a, y2b); }
        }
    }
};

template <class Epi, class Sched, bool ALIGN_EPI = false, bool SP2 = false, int EPI_REP = 1>
__device__ __forceinline__ void gemm_phase(PG8_LAS unsigned char* lds, const Gemm g, const Sched& S, const Epi& E) {
    int tid_ = threadIdx.x; asm volatile("" : "+v"(tid_));
    const int tid = tid_, wid = __builtin_amdgcn_readfirstlane(tid >> 6), lane = tid & 63, wr = wid >> 2, wc = wid & 3, fr = lane & 15, fq = lane >> 4;
    const int K = g.K, nt = K / BK;
    unsigned voffA[2], voffB[2];
#pragma unroll
    for (int i = 0; i < 2; ++i) { int R, C; stage_rc(tid * 16 + i * 8192, R, C); const int Rb = Epi::PERM ? ((R & ~31) + perm32(R & 31)) : R;
        voffA[i] = (unsigned)(R * K + C) * 2u; voffB[i] = (unsigned)(Rb * K + C) * 2u; }
    const size_t kstep = (size_t)(BK * 2);
    const size_t hstep = (size_t)HALF * K * 2;
    const size_t tstep = 2 * hstep;
    const unsigned ldsw = (unsigned)wid * 1024u;
    const int aoff = lds_byte(wr * 64 + fr, fq * 8), boff = lds_byte(wc * 32 + fr, fq * 8);
#define PG8_SA(b, h) (((b) * 2 + (h)) * HTB)
#define PG8_SB(b, h) ((4 + (b) * 2 + (h)) * HTB)
#define PG8_STAGE(bufoff, gbase, voff) do { _Pragma("unroll") for (int _i = 0; _i < 2; ++_i) \
        __builtin_amdgcn_global_load_lds((const unsigned*)((const char*)(gbase) + (voff)[_i]), (PG8_LAS unsigned*)(lds + (bufoff) + ldsw + _i * 8192), 16, 0, 0); } while (0)
#define PG8_LDA(dst, b, h) do { _Pragma("unroll") for (int m = 0; m < 4; ++m) _Pragma("unroll") for (int k = 0; k < 2; ++k) dst[m][k] = *(const PG8_LAS bf16x8*)(lds + PG8_SA(b, h) + aoff + m * 2048 + k * 1024); } while (0)
#define PG8_LDB(dst, b, h) do { _Pragma("unroll") for (int n = 0; n < 2; ++n) _Pragma("unroll") for (int k = 0; k < 2; ++k) dst[n][k] = *(const PG8_LAS bf16x8*)(lds + PG8_SB(b, h) + boff + n * 2048 + k * 1024); } while (0)
#define PG8_MMA(ai, bj, At, Bt) do { __builtin_amdgcn_s_setprio(1); _Pragma("unroll") for (int m = 0; m < 4; ++m) _Pragma("unroll") for (int n = 0; n < 2; ++n) _Pragma("unroll") for (int k = 0; k < 2; ++k) \
        acc[ai][bj][m][n] = __builtin_amdgcn_mfma_f32_16x16x32_bf16(Bt[n][k], At[m][k], acc[ai][bj][m][n], 0, 0, 0); __builtin_amdgcn_s_setprio(0); } while (0)
#define PG8_WAIT_V(n) asm volatile("s_waitcnt vmcnt(" #n ")" ::: "memory")
#define PG8_WAIT_L(n) asm volatile("s_waitcnt lgkmcnt(" #n ")" ::: "memory")
#define PG8_BAR __builtin_amdgcn_s_barrier()
#define PG8_SCHED __builtin_amdgcn_sched_barrier(0)
    Unit cur, nxt; int ui = 0;
    typename Epi::Pre pre;
    if (!S.next(0, cur)) return;
    f32x4 acc[2][2][4][2];
#pragma unroll
    for (int a = 0; a < 2; ++a)
#pragma unroll
        for (int b = 0; b < 2; ++b)
#pragma unroll
            for (int m = 0; m < 4; ++m)
#pragma unroll
                for (int n = 0; n < 2; ++n) acc[a][b][m][n] = (f32x4){0.f, 0.f, 0.f, 0.f};
    bf16x8 At[4][2], B0[2][2], B1[2][2];
    const char* cA = (const char*)g.A + (size_t)cur.pm * tstep; const char* cB = (const char*)g.Bt + (size_t)cur.pn * tstep;
    S.a_ready(cur);
    if constexpr (SP2) {
        PG8_STAGE(PG8_SB(0, 0), cB, voffB); PG8_STAGE(PG8_SB(0, 1), cB + hstep, voffB); PG8_STAGE(PG8_SA(0, 0), cA, voffA); PG8_STAGE(PG8_SA(0, 1), cA + hstep, voffA);
        if (wr == 1) PG8_BAR;
        PG8_WAIT_V(2); PG8_BAR;
        PG8_STAGE(PG8_SB(1, 0), cB + kstep, voffB); PG8_STAGE(PG8_SA(1, 0), cA + kstep, voffA); PG8_STAGE(PG8_SB(1, 1), cB + hstep + kstep, voffB);
        PG8_WAIT_V(6); PG8_BAR;
    } else {
        PG8_STAGE(PG8_SB(0, 0), cB, voffB); PG8_STAGE(PG8_SA(0, 0), cA, voffA); PG8_STAGE(PG8_SB(0, 1), cB + hstep, voffB); PG8_STAGE(PG8_SA(0, 1), cA + hstep, voffA);
        if (wr == 1) PG8_BAR;
        PG8_WAIT_V(4); PG8_BAR;
        PG8_STAGE(PG8_SB(1, 0), cB + kstep, voffB); PG8_STAGE(PG8_SA(1, 0), cA + kstep, voffA); PG8_STAGE(PG8_SB(1, 1), cB + hstep + kstep, voffB);
        PG8_WAIT_V(6); PG8_BAR;
    }
    for (;;) {
        const bool has_next = S.next(ui + 1, nxt);
        const char* nA = has_next ? (const char*)g.A + (size_t)nxt.pm * tstep : cA; const char* nB = has_next ? (const char*)g.Bt + (size_t)nxt.pn * tstep : cB;
        for (int t = 0; t < nt; t += 2) {
            const bool last = (t == nt - 2);
            const char* a1 = cA + (size_t)(t + 1) * kstep;
            const char* a2 = last ? nA : cA + (size_t)(t + 2) * kstep; const char* b2 = last ? nB : cB + (size_t)(t + 2) * kstep;
            const char* a3 = a2 + kstep; const char* b3 = b2 + kstep;
            if (last && has_next) S.a_ready(nxt);
            if (t == 0) E.pre_issue(pre, cur, tid, ui); else if (t == 2) E.pre_finish(pre, tid, ui);
            if constexpr (SP2) {
            PG8_LDB(B0, 0, 0); PG8_LDB(B1, 0, 1); PG8_SCHED; PG8_LDA(At, 0, 0); PG8_STAGE(PG8_SA(1, 1), a1 + hstep, voffA);
            PG8_WAIT_V(8); PG8_WAIT_L(0); PG8_BAR; PG8_MMA(0, 0, At, B0); PG8_MMA(0, 1, At, B1); PG8_BAR; PG8_SCHED;
            PG8_LDA(At, 0, 1); PG8_STAGE(PG8_SB(0, 0), b2, voffB); PG8_STAGE(PG8_SB(0, 1), b2 + hstep, voffB); PG8_STAGE(PG8_SA(0, 0), a2, voffA);
            PG8_WAIT_V(8); PG8_WAIT_L(0); PG8_BAR; PG8_MMA(1, 0, At, B0); PG8_MMA(1, 1, At, B1); PG8_BAR; PG8_SCHED;
            PG8_LDB(B0, 1, 0); PG8_LDB(B1, 1, 1); PG8_SCHED; PG8_LDA(At, 1, 0); PG8_STAGE(PG8_SA(0, 1), a2 + hstep, voffA);
            PG8_WAIT_V(8); PG8_WAIT_L(0); PG8_BAR; PG8_MMA(0, 0, At, B0); PG8_MMA(0, 1, At, B1); PG8_BAR; PG8_SCHED;
            PG8_LDA(At, 1, 1); PG8_STAGE(PG8_SB(1, 0), b3, voffB); PG8_STAGE(PG8_SB(1, 1), b3 + hstep, voffB); PG8_STAGE(PG8_SA(1, 0), a3, voffA);
            PG8_WAIT_V(8); PG8_WAIT_L(0); PG8_BAR; PG8_MMA(1, 0, At, B0); PG8_MMA(1, 1, At, B1); PG8_BAR; PG8_SCHED;
            } else {
            PG8_LDB(B0, 0, 0); PG8_SCHED; PG8_LDA(At, 0, 0); PG8_STAGE(PG8_SA(1, 1), a1 + hstep, voffA);
            PG8_WAIT_L(8); PG8_BAR; PG8_WAIT_L(0); PG8_MMA(0, 0, At, B0); PG8_BAR; PG8_SCHED;
            PG8_LDB(B1, 0, 1); PG8_STAGE(PG8_SB(0, 0), b2, voffB);
            PG8_BAR; PG8_WAIT_L(0); PG8_MMA(0, 1, At, B1); PG8_BAR;
            PG8_LDA(At, 0, 1); PG8_STAGE(PG8_SA(0, 0), a2, voffA);
            PG8_BAR; PG8_WAIT_L(0); PG8_MMA(1, 0, At, B0); PG8_BAR; PG8_SCHED;
            PG8_STAGE(PG8_SB(0, 1), b2 + hstep, voffB);
            PG8_WAIT_V(6); PG8_BAR; PG8_MMA(1, 1, At, B1); PG8_BAR;
            PG8_LDB(B0, 1, 0); PG8_SCHED; PG8_LDA(At, 1, 0); PG8_STAGE(PG8_SA(0, 1), a2 + hstep, voffA);
            PG8_WAIT_L(8); PG8_BAR; PG8_WAIT_L(0); PG8_MMA(0, 0, At, B0); PG8_BAR; PG8_SCHED;
            PG8_LDB(B1, 1, 1); PG8_STAGE(PG8_SB(1, 0), b3, voffB);
            PG8_BAR; PG8_WAIT_L(0); PG8_MMA(0, 1, At, B1); PG8_BAR;
            PG8_LDA(At, 1, 1); PG8_STAGE(PG8_SA(1, 0), a3, voffA);
            PG8_BAR; PG8_WAIT_L(0); PG8_MMA(1, 0, At, B0); PG8_BAR; PG8_SCHED;
            PG8_STAGE(PG8_SB(1, 1), b3 + hstep, voffB);
            PG8_WAIT_V(6); PG8_BAR; PG8_MMA(1, 1, At, B1); PG8_BAR;
            }
        }
        if constexpr (ALIGN_EPI) { if (wr == 0) PG8_BAR; }
        if constexpr (!Epi::AFTER_DRAIN) { _Pragma("unroll") for (int rep_ = 0; rep_ < EPI_REP; ++rep_) E(acc, cur, wr, wc, fr, fq, ui); S.done(cur); }
        if (!has_next) break;
#pragma unroll
        for (int a = 0; a < 2; ++a)
#pragma unroll
            for (int b = 0; b < 2; ++b)
#pragma unroll
                for (int m = 0; m < 4; ++m)
#pragma unroll
                    for (int n = 0; n < 2; ++n) acc[a][b][m][n] = (f32x4){0.f, 0.f, 0.f, 0.f};
        cur = nxt; cA = nA; cB = nB; ++ui;
        if constexpr (ALIGN_EPI) { if (wr == 1) PG8_BAR; }
    }
    PG8_WAIT_V(0);
    if constexpr (!ALIGN_EPI) { if (wr == 0) PG8_BAR; }
    PG8_BAR;
    if constexpr (Epi::AFTER_DRAIN) { E.fused(acc, cur, wr, wc, fr, fq, lds, wid, lane); S.done(cur); }
#undef PG8_SA
#undef PG8_SB
#undef PG8_STAGE
#undef PG8_LDA
#undef PG8_LDB
#undef PG8_MMA
#undef PG8_WAIT_V
#undef PG8_WAIT_L
#undef PG8_BAR
#undef PG8_SCHED
}
}
namespace att {
typedef unsigned short bf16;
typedef short bf16x8 __attribute__((ext_vector_type(8)));
typedef short s16x4 __attribute__((ext_vector_type(4)));
typedef float f32x16 __attribute__((ext_vector_type(16)));
typedef float f32x4 __attribute__((ext_vector_type(4)));
typedef unsigned u32x4 __attribute__((ext_vector_type(4)));
constexpr int NW = 8, QBLK = 32, KVBLK = 64, QB = NW * QBLK;
constexpr int SHM_V = KVBLK * 128 * 2, SHM_K = KVBLK * 128 * 2, KPE_ROW = 144, SHM_KPE = KVBLK * KPE_ROW;
constexpr int OFF_V = 0, OFF_K = 2 * SHM_V, OFF_WS = OFF_K + 2 * SHM_K, OFF_KPE = OFF_WS + NW * 64 * 4, OFF_QPE = OFF_KPE + 2 * SHM_KPE, LDS_BYTES = OFF_QPE + NW * 4096;
constexpr float THR = 8.f;

#define KSWZ(row, colB) ((row) * 256 + ((colB) ^ (((row) & 7) << 4)))
#define SBAR() __builtin_amdgcn_sched_barrier(0)
__device__ __forceinline__ int v_st(int k, int c) { const int kk = (k & ~0xC) | ((k & 4) << 1) | ((k & 8) >> 1); return ((kk >> 3) * 4 + (c >> 5)) * 512 + ((kk & 7) * 32 + (c & 31)) * 2; }
__device__ __forceinline__ int v_rd_base(int lane) { return ((lane & 3) << 3) | (((lane >> 2) & 3) << 6) | (((lane >> 4) & 1) << 5) | (((lane >> 5) & 1) << 8); }
constexpr int v_rd_off(int d0, int ks, int half) { return d0 * 512 + ks * 4096 + half * 2048; }
__device__ __forceinline__ int crow(int r, int hi) { return (r & 3) + 8 * (r >> 2) + 4 * hi; }
__device__ __forceinline__ unsigned cvtpk(float lo, float hi) { unsigned r; asm volatile("v_cvt_pk_bf16_f32 %0, %1, %2" : "=v"(r) : "v"(lo), "v"(hi)); return r; }
__device__ __forceinline__ bf16x8 ld8(const bf16* p) { return *reinterpret_cast<const bf16x8*>(p); }
__device__ __forceinline__ void mask_tile(f32x16& p0, f32x16& p1, int dq, unsigned W) {
    const float NEG = -__builtin_inff();
#pragma unroll
    for (int r = 0; r < 16; ++r) {
        const int c = (r & 3) + 8 * (r >> 2);
        if ((unsigned)(dq - c) >= W) p0[r] = NEG;
        if ((unsigned)(dq - c - 32) >= W) p1[r] = NEG;
    }
}
__device__ __forceinline__ void partialSM(f32x16& p0, f32x16& p1, float& m_reg, float& mn, float& alpha, const float scale) {
    float pmax = p0[0]; for (int r = 1; r < 16; ++r) pmax = fmaxf(pmax, p0[r]); for (int r = 0; r < 16; ++r) pmax = fmaxf(pmax, p1[r]);
    { auto rr = __builtin_amdgcn_permlane32_swap(__float_as_uint(pmax), __float_as_uint(pmax), false, false);
      pmax = fmaxf(__uint_as_float(rr[0]), __uint_as_float(rr[1])); }
    const float C2 = 1.4426950408889634f * scale;
    if (__builtin_expect(__all((pmax - m_reg) * scale <= THR), 1)) { mn = m_reg; alpha = 1.f; }
    else { mn = fmaxf(m_reg, pmax); alpha = __builtin_amdgcn_exp2f((m_reg - mn) * C2); m_reg = mn; }
    const float mnL = -mn * C2;
    for (int r = 0; r < 16; ++r) p0[r] = fmaf(p0[r], C2, mnL); for (int r = 0; r < 16; ++r) p1[r] = fmaf(p1[r], C2, mnL);
    for (int r = 0; r < 16; ++r) p0[r] = __builtin_amdgcn_exp2f(p0[r]);
}
__device__ __forceinline__ void finishSM(f32x16& p0, f32x16& p1, float alpha, float& l_reg, bf16x8& pa0, bf16x8& pa1, bf16x8& pa2, bf16x8& pa3) {
    for (int r = 0; r < 16; ++r) p1[r] = __builtin_amdgcn_exp2f(p1[r]);
    float ps = 0; for (int r = 0; r < 16; ++r) ps += p0[r]; for (int r = 0; r < 16; ++r) ps += p1[r];
    { auto rr = __builtin_amdgcn_permlane32_swap(__float_as_uint(ps), __float_as_uint(ps), false, false);
      ps = __uint_as_float(rr[0]) + __uint_as_float(rr[1]); }
    l_reg = l_reg * alpha + ps;
#define PK4(P, B_, OUT) do { unsigned a0 = cvtpk(P[B_+0], P[B_+1]), a1 = cvtpk(P[B_+2], P[B_+3]);                          \
        unsigned b0 = cvtpk(P[B_+4], P[B_+5]), b1 = cvtpk(P[B_+6], P[B_+7]);                                             \
        auto r0 = __builtin_amdgcn_permlane32_swap(a0, b0, false, false); auto r1 = __builtin_amdgcn_permlane32_swap(a1, b1, false, false); \
        u32x4 w = {r0[0], r1[0], r0[1], r1[1]}; OUT = *reinterpret_cast<bf16x8*>(&w); } while (0)
    PK4(p0, 0, pa0); PK4(p0, 8, pa1); PK4(p1, 0, pa2); PK4(p1, 8, pa3);
#undef PK4
}
template <int KB, bool SK, bool PE>
__device__ __forceinline__ void qkt(f32x16& p0, f32x16& p1, const char* lds, int r32, int hi, int wid, int lane, const bf16x8* qr, bool act) {
    if (SK && !act) { const float NEG = -__builtin_inff();
#pragma unroll
        for (int r = 0; r < 16; ++r) { p0[r] = NEG; p1[r] = NEG; } return; }
    p0 = f32x16{}; p1 = f32x16{};
    const char* kb[4];
#pragma unroll
    for (int dd = 0; dd < 4; ++dd) kb[dd] = lds + OFF_K + KB * SHM_K + KSWZ(r32, (dd * 16 + hi * 8) * 2);
#pragma unroll
    for (int d0 = 0; d0 < 8; ++d0) { const char* a = kb[d0 & 3] + (d0 >> 2) * 128;
        bf16x8 b0 = *reinterpret_cast<const bf16x8*>(a);
        bf16x8 b1 = *reinterpret_cast<const bf16x8*>(a + 32 * 256);
        p0 = __builtin_amdgcn_mfma_f32_32x32x16_bf16(b0, qr[d0], p0, 0, 0, 0);
        p1 = __builtin_amdgcn_mfma_f32_32x32x16_bf16(b1, qr[d0], p1, 0, 0, 0); }
    if constexpr (PE) {
        const char* kp = lds + OFF_KPE + KB * SHM_KPE + r32 * KPE_ROW + hi * 16;
        const char* qp = lds + OFF_QPE + wid * 4096 + lane * 16;
#pragma unroll
        for (int d0 = 0; d0 < 4; ++d0) {
            bf16x8 b0 = *reinterpret_cast<const bf16x8*>(kp + d0 * 32);
            bf16x8 b1 = *reinterpret_cast<const bf16x8*>(kp + d0 * 32 + 32 * KPE_ROW);
            bf16x8 qf = *reinterpret_cast<const bf16x8*>(qp + d0 * 1024);
            p0 = __builtin_amdgcn_mfma_f32_32x32x16_bf16(b0, qf, p0, 0, 0, 0);
            p1 = __builtin_amdgcn_mfma_f32_32x32x16_bf16(b1, qf, p1, 0, 0, 0); }
    }
}
template <int VB, bool SK>
__device__ __forceinline__ void pv_tile(f32x16* o, int vb0, bf16x8 pa0, bf16x8 pa1, bf16x8 pa2, bf16x8 pa3, bool act) {
    if (SK && !act) return;
#define TRRD(dst, off) asm volatile("ds_read_b64_tr_b16 %0, %1 offset:%2" : "=&v"(dst) : "v"(vb0), "i"(off) : "memory")
#define PV_D0(d0) do { s16x4 l0, l1, l2, l3, h0, h1, h2, h3; constexpr int b_ = OFF_V + VB * SHM_V + v_rd_off(d0, 0, 0); \
        TRRD(l0, b_); TRRD(h0, b_ + 2048); TRRD(l1, b_ + 4096); TRRD(h1, b_ + 6144); TRRD(l2, b_ + 8192); TRRD(h2, b_ + 10240); TRRD(l3, b_ + 12288); TRRD(h3, b_ + 14336); \
        asm volatile("s_waitcnt lgkmcnt(0)" ::: "memory"); SBAR();   \
        o[d0] = __builtin_amdgcn_mfma_f32_32x32x16_bf16(pa0, (bf16x8){l0[0], l0[1], l0[2], l0[3], h0[0], h0[1], h0[2], h0[3]}, o[d0], 0, 0, 0);   \
        o[d0] = __builtin_amdgcn_mfma_f32_32x32x16_bf16(pa1, (bf16x8){l1[0], l1[1], l1[2], l1[3], h1[0], h1[1], h1[2], h1[3]}, o[d0], 0, 0, 0);   \
        o[d0] = __builtin_amdgcn_mfma_f32_32x32x16_bf16(pa2, (bf16x8){l2[0], l2[1], l2[2], l2[3], h2[0], h2[1], h2[2], h2[3]}, o[d0], 0, 0, 0);   \
        o[d0] = __builtin_amdgcn_mfma_f32_32x32x16_bf16(pa3, (bf16x8){l3[0], l3[1], l3[2], l3[3], h3[0], h3[1], h3[2], h3[3]}, o[d0], 0, 0, 0); } while (0)
    PV_D0(0); PV_D0(1); PV_D0(2); PV_D0(3);
#undef PV_D0
#undef TRRD
}

struct Prm { int qs, kvs, os, qpes, kpes, lses, skv, W; float scale; };
struct BlockRef { const bf16* Q; const bf16* K; const bf16* V; bf16* O; const bf16* Qpe; const bf16* Kpe; float* Lse; int P0; };
template <bool PE> struct Seam { bf16x8 qr[8]; bf16x8 st_v0, st_v1, st_k0, st_k1, st_kp; };
__device__ __forceinline__ int swa_jlo(int P0, int W) { const int lowk = P0 - W + 1; return lowk > 0 ? lowk / KVBLK : 0; }
#define VMW() asm volatile("s_waitcnt vmcnt(0)" ::: "memory")
#define LDG(base, off) (*(const bf16x8*)((const char*)(base) + (off)))
#define SLOAD_H(R_, k0) do { const char* kb__ = (const char*)(R_).K + (size_t)(k0) * P.kvs * 2; const char* vb__ = (const char*)(R_).V + (size_t)(k0) * P.kvs * 2; const size_t h__ = (size_t)32 * P.kvs * 2; \
                              S.st_v0 = LDG(vb__, kvoff); S.st_v1 = LDG(vb__ + h__, kvoff); S.st_k0 = LDG(kb__, kvoff); S.st_k1 = LDG(kb__ + h__, kvoff); \
                              if constexpr (PE) S.st_kp = LDG((const char*)(R_).Kpe + (size_t)(k0) * P.kpes * 2, kpoff); } while (0)
#define SWRITE_HK(bf) do { *(bf16x8*)(K_lds + (bf) * SHM_K + kws) = S.st_k0; *(bf16x8*)(K_lds + (bf) * SHM_K + kws + 32 * 256) = S.st_k1; \
                           if constexpr (PE) *(bf16x8*)(lds + OFF_KPE + (bf) * SHM_KPE + pws) = S.st_kp; } while (0)
#define SWRITE_HV(bf) do { *(bf16x8*)(V_lds + (bf) * SHM_V + vst0) = S.st_v0; *(bf16x8*)(V_lds + (bf) * SHM_V + vst1) = S.st_v1; } while (0)
#define SWRITE_H(bf) do { SWRITE_HV(bf); SWRITE_HK(bf); } while (0)
template <bool PE>
__device__ __forceinline__ void swa_prime(const BlockRef& cur, const Prm& P, char* lds, Seam<PE>& S) {
    int tid_ = threadIdx.x; asm volatile("" : "+v"(tid_));
    const int tid = tid_, wid = __builtin_amdgcn_readfirstlane(tid >> 6), lane = tid & 63, r32 = lane & 31, hi = lane >> 5;
    const int sr = tid >> 4, sc = (tid & 15) * 8, kws = KSWZ(sr, sc * 2); char* K_lds = lds + OFF_K;
    const int pr = tid >> 3, pc = (tid & 7) * 8, pws = pr * KPE_ROW + (tid & 7) * 16;
    const unsigned kvoff = (unsigned)(sr * P.kvs + sc) * 2u, kpoff = (unsigned)(pr * P.kpes + pc) * 2u, qoff = (unsigned)((wid * QBLK + r32) * P.qs + hi * 8) * 2u, qpoff = (unsigned)((wid * QBLK + r32) * P.qpes + hi * 8) * 2u;
    const int kb0 = swa_jlo(cur.P0, P.W) * KVBLK;
#pragma unroll
    for (int d0 = 0; d0 < 8; ++d0) S.qr[d0] = LDG(cur.Q, qoff + d0 * 32);
    if constexpr (PE) {
#pragma unroll
        for (int d0 = 0; d0 < 4; ++d0) *(bf16x8*)(lds + OFF_QPE + wid * 4096 + d0 * 1024 + lane * 16) = LDG(cur.Qpe, qpoff + d0 * 32);
    }
    SLOAD_H(cur, kb0); VMW(); SWRITE_HK(0);
    __syncthreads();
}
template <bool PE, bool SK, bool LSE, bool EARLY>
__device__ __forceinline__ void swa_block(const BlockRef& cur, const BlockRef& nxt, const Prm& P, char* lds, Seam<PE>& S) {
    int tid_ = threadIdx.x; asm volatile("" : "+v"(tid_));
    const int tid = tid_, wid = __builtin_amdgcn_readfirstlane(tid >> 6), lane = tid & 63, r32 = lane & 31, hi = lane >> 5;
    const int W = P.W;
    const int j_lo = swa_jlo(cur.P0, W);
    int j_hi = (cur.P0 + QB - 1) / KVBLK + 1; if (j_hi > P.skv / KVBLK) j_hi = P.skv / KVBLK;
    const int NT = j_hi - j_lo;
    const int kbn = swa_jlo(nxt.P0, W) * KVBLK;
    const int qlo = cur.P0 + wid * QBLK, qm = qlo + r32 - 4 * hi;
    char* V_lds = lds + OFF_V; char* K_lds = lds + OFF_K;
    float* ws = (float*)(lds + OFF_WS) + wid * 64; float* li_l = ws, * al_l = ws + 32;
    float m_reg = -1e30f, l_reg = 0; f32x16 o[4] = {};
    const int sr = tid >> 4, sc = (tid & 15) * 8, vst0 = v_st(sr, sc), vst1 = v_st(32 + sr, sc), kws = KSWZ(sr, sc * 2);
    const int pr = tid >> 3, pc = (tid & 7) * 8, pws = pr * KPE_ROW + (tid & 7) * 16;
    const unsigned kvoff = (unsigned)(sr * P.kvs + sc) * 2u, kpoff = (unsigned)(pr * P.kpes + pc) * 2u;
    const int vb0 = (int)(uintptr_t)lds + v_rd_base(lane);
#define RESC(a) do { if (__any((a) < 1.f)) { if (hi == 0) al_l[r32] = (a); asm volatile("s_waitcnt lgkmcnt(0)" ::: "memory");              \
                     for (int d_ = 0; d_ < 4; ++d_) for (int r = 0; r < 16; ++r) o[d_][r] *= al_l[crow(r, hi)]; } } while (0)
#define KBASE(t) ((j_lo + (t)) * KVBLK)
#define ACT(t) (KBASE(t) <= qlo + QBLK - 1 && KBASE(t) + KVBLK - 1 >= qlo - W + 1)
#define MASKT(P0_, P1_, t) do { const int kb_ = KBASE(t); if ((!SK || ACT(t)) && (kb_ + KVBLK - 1 > qlo || kb_ <= qlo + QBLK - 1 - W)) mask_tile(P0_, P1_, qm - kb_, (unsigned)W); } while (0)
    f32x16 pA0, pA1, pB0, pB1; float mnA, mnB, alA, alB; bf16x8 pa0, pa1, pa2, pa3;
    SWRITE_HV(0); SBAR();
    if (NT > 1) { SLOAD_H(cur, KBASE(1)); }
    SBAR(); qkt<0, SK, PE>(pA0, pA1, lds, r32, hi, wid, lane, S.qr, ACT(0));
    MASKT(pA0, pA1, 0); partialSM(pA0, pA1, m_reg, mnA, alA, P.scale);
    if (NT > 1) { VMW(); SWRITE_H(1); }
    __syncthreads();
#define HALF_STEP(PX0, PX1, mnX, alX, PY0, PY1, alY, t, KB, VB, SB) do {                                                      \
        SBAR(); if (EARLY && (t) + 1 < NT) { SLOAD_H(cur, KBASE((t) + 1)); SBAR(); }                                          \
        qkt<KB, SK, PE>(PX0, PX1, lds, r32, hi, wid, lane, S.qr, ACT(t));                                                     \
        finishSM(PY0, PY1, alY, l_reg, pa0, pa1, pa2, pa3); SBAR();                                                           \
        if (!EARLY && (t) + 1 < NT) { SLOAD_H(cur, KBASE((t) + 1)); SBAR(); }                                                 \
        pv_tile<VB, SK>(o, vb0, pa0, pa1, pa2, pa3, ACT((t) - 1)); MASKT(PX0, PX1, (t)); partialSM(PX0, PX1, m_reg, mnX, alX, P.scale); \
        __syncthreads();                                                                                                      \
        if ((t) + 1 < NT) { VMW(); SWRITE_H(SB); }                                                                            \
        RESC(alX); __syncthreads(); } while (0)
    for (int t = 1; t + 1 < NT; t += 2) {
        HALF_STEP(pB0, pB1, mnB, alB, pA0, pA1, alA, t, 1, 0, 0);
        HALF_STEP(pA0, pA1, mnA, alA, pB0, pB1, alB, t + 1, 0, 1, 1);
    }
    const bool even = (NT & 1) == 0;
    if (even) { SBAR(); qkt<1, SK, PE>(pB0, pB1, lds, r32, hi, wid, lane, S.qr, ACT(NT - 1)); SBAR(); }
    SLOAD_H(nxt, kbn); SBAR();
    { const unsigned qoff = (unsigned)((wid * QBLK + r32) * P.qs + hi * 8) * 2u;
#pragma unroll
      for (int d0 = 0; d0 < 8; ++d0) S.qr[d0] = LDG(nxt.Q, qoff + d0 * 32); }
    bf16x8 qpn[4];
    if constexpr (PE) { const unsigned qpoff = (unsigned)((wid * QBLK + r32) * P.qpes + hi * 8) * 2u;
#pragma unroll
        for (int d0 = 0; d0 < 4; ++d0) qpn[d0] = LDG(nxt.Qpe, qpoff + d0 * 32);
    }
    SBAR();
    finishSM(pA0, pA1, alA, l_reg, pa0, pa1, pa2, pa3); SBAR();
    pv_tile<0, SK>(o, vb0, pa0, pa1, pa2, pa3, ACT(even ? NT - 2 : NT - 1));
    if (even) { MASKT(pB0, pB1, NT - 1); partialSM(pB0, pB1, m_reg, mnB, alB, P.scale); __syncthreads(); RESC(alB);
        finishSM(pB0, pB1, alB, l_reg, pa0, pa1, pa2, pa3); SBAR(); pv_tile<1, SK>(o, vb0, pa0, pa1, pa2, pa3, ACT(NT - 1)); }
    SBAR();
    VMW(); SWRITE_HK(0);
    if constexpr (PE) {
#pragma unroll
        for (int d0 = 0; d0 < 4; ++d0) *(bf16x8*)(lds + OFF_QPE + wid * 4096 + d0 * 1024 + lane * 16) = qpn[d0];
    }
    SBAR();
    if (hi == 0) li_l[r32] = l_reg; asm volatile("s_waitcnt lgkmcnt(0)" ::: "memory");
    float rli[16];
#pragma unroll
    for (int r = 0; r < 16; ++r) rli[r] = __builtin_amdgcn_rcpf(li_l[crow(r, hi)]);
    const unsigned ooff = (unsigned)((wid * QBLK + 4 * hi) * P.os + r32) * 2u;
#pragma unroll
    for (int r = 0; r < 16; ++r) { char* ob = (char*)cur.O + (size_t)((r & 3) + 8 * (r >> 2)) * P.os * 2;
#pragma unroll
        for (int d0 = 0; d0 < 4; ++d0) { const float v = o[d0][r] * rli[r];
            const float vn = __uint_as_float((unsigned)__builtin_amdgcn_update_dpp(0, (int)__float_as_uint(v), 0xB1, 0xF, 0xF, true));
            if ((r32 & 1) == 0) *(unsigned*)(ob + ooff + d0 * 64) = cvtpk(v, vn); } }
    if constexpr (LSE) { if (hi == 0) *(float*)((char*)cur.Lse + (unsigned)((wid * QBLK + r32) * P.lses) * 4u) = m_reg * P.scale + __logf(l_reg); }
    __syncthreads();
#undef RESC
#undef KBASE
#undef ACT
#undef MASKT
#undef HALF_STEP
}
#undef LDG
#undef VMW
#undef SLOAD_H
#undef SWRITE_HK
#undef SWRITE_HV
#undef SWRITE_H
#undef KSWZ
#undef SBAR
}
constexpr int NWAVES = 8;
constexpr int BATCH = 4, SEQ = 4096, DM = 2048, M = BATCH * SEQ;
constexpr int NQKVA = 1280;
constexpr int NQB = 3072, NKVB = 4096, NDIL = 18432, FF = 5632, NUP = 2 * FF;
constexpr float EPS = 1e-6f;
constexpr size_t MiB = (size_t)1 << 20;
constexpr size_t WS_CTL = 0, CTL_ZERO_BYTES = 64 * 1024;
constexpr size_t WS_COSM = 1 * MiB, WS_SINM = 3 * MiB, WS_COSD = 5 * MiB, WS_SIND = 6 * MiB;
constexpr size_t WS_WMLA = 8 * MiB, WMLA_STRIDE = 20 * MiB, WMLA_QKVA = 0, WMLA_QB = 5 * MiB, WMLA_KVB = 8 * MiB, WMLA_WO = 12 * MiB;
constexpr size_t WS_WDIL = WS_WMLA + 2 * WMLA_STRIDE, WDIL_STRIDE = 80 * MiB, WDIL_IN = 0, WDIL_WO = 72 * MiB;
constexpr size_t WS_WFFN = WS_WDIL + 2 * WDIL_STRIDE, WFFN_STRIDE = 66 * MiB, WFFN_UP = 0, WFFN_DOWN = 44 * MiB;
constexpr size_t WS_H = WS_WFFN + 4 * WFFN_STRIDE;
constexpr size_t WS_S = WS_H + 64 * MiB;
constexpr size_t S_QKVA = 0, S_QN = 80 * MiB, S_CKVN = 96 * MiB, S_KPE = 112 * MiB, S_Q = 114 * MiB, S_KV = 210 * MiB, S_AO_MLA = 338 * MiB;
constexpr size_t S_QKV = 0, S_OG = 576 * MiB, S_LSE = 768 * MiB, S_AO_DIL = 771 * MiB;
constexpr size_t S_U = 0, S_ACT = 352 * MiB;
constexpr size_t WS_HALO = WS_S + 835 * MiB, WS_FIX = WS_HALO + 6 * MiB;
constexpr size_t WS_PS = WS_FIX + 6 * MiB, PS_STRIDE = 2 * MiB;
constexpr size_t WS_END = WS_PS + 8 * PS_STRIDE;
static_assert(WS_H == 472 * MiB && WS_END == 1399 * MiB, "d_ws map");
constexpr int CW_BAR = 4096;
constexpr int RING_OFF = 0, RING_BYTES = 131072, LDSCTL_OFF = RING_BYTES, MISC_OFF = LDSCTL_OFF + 320, XH_OFF = RING_BYTES + 1024  , CWL_OFF = XH_OFF + 6144  , RSL_OFF = CWL_OFF + 4096  , LDS_BYTES = 163840;
static_assert(CWL_OFF + 8192 <= LDS_BYTES, "LDS map");
static_assert(att::LDS_BYTES <= RING_BYTES && pg8::STAGE_BYTES <= RING_BYTES, "LDS map");

#define GAS __attribute__((address_space(1)))
#define LAS __attribute__((address_space(3)))
typedef unsigned short bf16;
typedef unsigned v4u __attribute__((ext_vector_type(4)));
typedef unsigned v2u __attribute__((ext_vector_type(2)));
typedef float f32x4 __attribute__((ext_vector_type(4)));
typedef GAS unsigned gu32;
#define RLX_AGENT __ATOMIC_RELAXED, __HIP_MEMORY_SCOPE_AGENT
#define LDS_WAIT() asm volatile("s_waitcnt lgkmcnt(0)" ::: "memory")
__device__ __forceinline__ unsigned pk2(float lo, float hi) { return pg8::cvt_pk_bf16(lo, hi); }
__device__ __forceinline__ float bf_lo(unsigned w) { return __uint_as_float(w << 16); }
__device__ __forceinline__ float bf_hi(unsigned w) { return __uint_as_float(w & 0xffff0000u); }

#define XB_TMO      128
#define XB_XCNT(j)  (256  + 64 * (j))
#define XB_XSUB(j)  (1280 + 64 * (j))
#define XB_XGEN(j)  (2304 + 64 * (j))
#define XB_TOP      3328
#define XB_TOPGEN   3392
#define XCD_BAR_WORDS 3456
#define XB_SPIN_CAP (1u << 18)

__device__ __forceinline__ unsigned xb_ld(unsigned* p)              { return __hip_atomic_load(p, __ATOMIC_RELAXED, __HIP_MEMORY_SCOPE_AGENT); }
__device__ __forceinline__ unsigned xb_add(unsigned* p, unsigned v) { return __hip_atomic_fetch_add(p, v, __ATOMIC_RELAXED, __HIP_MEMORY_SCOPE_AGENT); }
__device__ __forceinline__ unsigned xb_xcc_id() { return (unsigned)__builtin_amdgcn_s_getreg((3 << 11) | 20) & 0xFu; }
#define XB_SPIN(cond, bar) do { unsigned _sp = 0; while (cond) { __builtin_amdgcn_s_sleep(1); \
    if ((++_sp & 255u) == 0u) { if (xb_ld(&(bar)[XB_TMO])) break; if (_sp > XB_SPIN_CAP) { atomicAdd(&(bar)[XB_TMO], 1u); break; } } } } while (0)

struct XcdBarrier {
    unsigned* bar; unsigned x;
    volatile LAS unsigned* st;
};

__device__ __forceinline__ XcdBarrier xcd_barrier_post(unsigned* bar, volatile LAS unsigned* st) {
    XcdBarrier b; b.bar = bar; b.x = xb_xcc_id(); b.st = st;
    if (threadIdx.x == 0) (void)xb_add(&bar[XB_XCNT(b.x)], 1u);
    return b;
}
__device__ __forceinline__ void xcd_barrier_complete(unsigned* bar, unsigned x, unsigned& nloc, unsigned& nx) {
    const unsigned G = gridDim.x * gridDim.y * gridDim.z;
    unsigned sum, cnt, mine, sp = 0u;
    for (;;) {
        sum = 0u; cnt = 0u; mine = 0u;
#pragma unroll
        for (unsigned j = 0; j < 16; ++j) { const unsigned c = xb_ld(&bar[XB_XCNT(j)]); sum += c; cnt += (c > 0u) ? 1u : 0u; mine = (j == x) ? c : mine; }
        if (sum == G) break;
        __builtin_amdgcn_s_sleep(1);
        if ((++sp & 255u) == 0u) { if (xb_ld(&bar[XB_TMO])) break; if (sp > XB_SPIN_CAP) { atomicAdd(&bar[XB_TMO], 1u); break; } }
    }
    nloc = mine > 0u ? mine : 1u; nx = cnt > 0u ? cnt : 1u;
}

__device__ __forceinline__ void xcd_barrier(const XcdBarrier& b) {
    asm volatile("s_waitcnt vmcnt(0)" ::: "memory");
    __syncthreads();
    if (threadIdx.x == 0) {
        __attribute__((address_space(1))) unsigned* barg_ = (__attribute__((address_space(1))) unsigned*)b.bar; unsigned bx_ = b.x;
        asm volatile("" : "+s"(barg_), "+s"(bx_)); unsigned* bar = (unsigned*)barg_;
        __builtin_amdgcn_s_waitcnt(0);
        unsigned nloc = b.st[0], nx = b.st[1];
        if (nloc == 0u) { xcd_barrier_complete(bar, bx_, nloc, nx); b.st[0] = nloc; b.st[1] = nx; }
        const unsigned old = xb_add(&bar[XB_XSUB(bx_)], 1u);
        const unsigned gen = old / nloc;
        if (old + 1u == (gen + 1u) * nloc) {
            __builtin_amdgcn_fence(__ATOMIC_RELEASE, "agent");
            asm volatile("s_waitcnt vmcnt(0)" ::: "memory");
            const unsigned og = xb_add(&bar[XB_TOP], 1u);
            const unsigned tg = og / nx;
            if (og + 1u == (tg + 1u) * nx) xb_add(&bar[XB_TOPGEN], 1u);
            else XB_SPIN(xb_ld(&bar[XB_TOPGEN]) == tg, bar);
            __builtin_amdgcn_fence(__ATOMIC_ACQUIRE, "agent");
            xb_add(&bar[XB_XGEN(bx_)], 1u);
            asm volatile("s_waitcnt vmcnt(0)" ::: "memory");
        } else {
            XB_SPIN(xb_ld(&bar[XB_XGEN(bx_)]) == gen, bar);
            __builtin_amdgcn_fence(__ATOMIC_ACQUIRE, "agent");
            asm volatile("s_waitcnt vmcnt(0)" ::: "memory");
        }
    }
    __syncthreads();
}


__device__ __forceinline__ const void* karg(int k) {
    const __attribute__((address_space(4))) char* kp = (const __attribute__((address_space(4))) char*)__builtin_amdgcn_kernarg_segment_ptr();
    asm volatile("" : "+s"(kp));
    return *(const void* const __attribute__((address_space(4)))*)(kp + 8 * k);
}
#define LANE_IDS() int tid_ = threadIdx.x; asm volatile("" : "+v"(tid_)); const int tid = tid_, lane = tid & 63, wave = __builtin_amdgcn_readfirstlane(tid >> 6); (void)tid; (void)lane; (void)wave
struct Frame {
    LAS unsigned char* lds;
    volatile LAS unsigned* MISC;
    gu32* ctl;
    int vcu, G;
    float* out; unsigned char* wsb;
};
#define SWZ_XOR(v, m) __uint_as_float((unsigned)__builtin_amdgcn_ds_swizzle((int)__float_as_uint(v), (((m) << 10) | 0x1f)))
__device__ __forceinline__ float xor32(float v) { auto rr = __builtin_amdgcn_permlane32_swap(__float_as_uint(v), __float_as_uint(v), false, false); return __uint_as_float((threadIdx.x & 32) ? rr[0] : rr[1]); }
__device__ __forceinline__ float xor1(float v) { return __uint_as_float((unsigned)__builtin_amdgcn_update_dpp(0, (int)__float_as_uint(v), 0xB1, 0xF, 0xF, true)); }
__device__ __forceinline__ float wave_sum(float v) {
    v += SWZ_XOR(v, 1); v += SWZ_XOR(v, 2); v += SWZ_XOR(v, 4); v += SWZ_XOR(v, 8); v += SWZ_XOR(v, 16);
    auto rr = __builtin_amdgcn_permlane32_swap(__float_as_uint(v), __float_as_uint(v), false, false);
    return __uint_as_float(rr[0]) + __uint_as_float(rr[1]);
}
__device__ __forceinline__ float dot4(const f32x4 a) { return (a.x * a.x + a.y * a.y) + (a.z * a.z + a.w * a.w); }

template <int KIND> __device__ __forceinline__ int dest_row(int n) {
    if constexpr (KIND == 0) return n;
    else if constexpr (KIND == 3) return n < 544 ? n : n + 96;
    else if constexpr (KIND == 4) { const int v = n >= FF, c = v ? n - FF : n; return 256 * (c >> 7) + 128 * v + (c & 127); }
    else if constexpr (KIND == 1) {
        const int h = n / 192, d = n - h * 192;
        if (d < 128) return h * 128 + d;
        const int i = d - 128, t = h >> 2, hh = h & 3;
        return 2048 + 256 * t + 32 * hh + (i < 32 ? i : 128 + (i - 32));
    } else {
        const int g = n / 6144, r = n - g * 6144, t = r >> 11, r2 = r & 2047, h = r2 >> 7, d = r2 & 127;
        if (t == 2) return n;
        const int T = h >> 1, hh = h & 1;
        const int tc = d < 16 ? 16 * hh + d : (d < 32 ? 128 + 16 * hh + (d - 16) : hh * 128 + d);
        return g * 6144 + t * 2048 + T * 256 + tc;
    }
}
template <int KIND> __device__ __forceinline__ void p0_transpose_item(const float* W, int K, int N, bf16* WT, int row_off, LAS float* scr, int item, int lane) {
    const int nblk = N / 32, kb = item / nblk, nb = item - kb * nblk, k0 = 64 * kb, n0 = 32 * nb;
#pragma unroll 8
    for (int i = 0; i < 32; ++i) { const int kk = 2 * i + (lane >> 5); scr[kk * 33 + (lane & 31)] = W[(size_t)(k0 + kk) * N + n0 + (lane & 31)]; }
    LDS_WAIT(); asm volatile("" ::: "memory");
    const int c = lane & 7;
#pragma unroll
    for (int j = 0; j < 4; ++j) { const int n = (lane >> 3) + 8 * j; const LAS float* s = scr + (8 * c) * 33 + n;
        v4u o; o.x = pk2(s[0 * 33], s[1 * 33]); o.y = pk2(s[2 * 33], s[3 * 33]); o.z = pk2(s[4 * 33], s[5 * 33]); o.w = pk2(s[6 * 33], s[7 * 33]);
        *(GAS v4u*)(WT + (size_t)(row_off + dest_row<KIND>(n0 + n)) * K + k0 + 8 * c) = o; }
    LDS_WAIT(); asm volatile("" ::: "memory");
}
__device__ const double kRopeRev[32] = {
    0.15915494309189535, 0.10561541722123227, 0.0700865215877985, 0.046509502471476706, 0.03086376340470123, 0.020481231595318977, 0.013591370636193905, 0.009019250376164549,
    0.005985185712713705, 0.00397177664679776, 0.002635675898667414, 0.001749037788521446, 0.001160663641240061, 0.0007702178288757531, 0.0005111175045375439, 0.00033917820861925017,
    0.00022507907903927653, 0.00014936275542995963, 9.911730936901935e-05, 6.577436917438735e-05, 4.364795279280289e-05, 2.8964835496204437e-05, 1.9221100684944863e-05, 1.2755146204410543e-05,
    8.464330808241401e-06, 5.616940400618127e-06, 3.727408601915352e-06, 2.473512961630074e-06, 1.6414262627950345e-06, 1.0892524995776498e-06, 7.228293068832865e-07, 4.796704226907546e-07};

__device__ __forceinline__ void norm_rows_bf16(Frame& F, const float* src, const float* gain, bf16* dst) {
    LANE_IDS();
    const int gw = F.vcu * NWAVES + wave, NGW = F.G * NWAVES;
    f32x4 g[8];
#pragma unroll
    for (int j = 0; j < 8; ++j) g[j] = *(const f32x4*)(gain + 4 * lane + 256 * j);
    for (int m = gw; m < M; m += NGW) {
        const GAS f32x4* xr = (const GAS f32x4*)(src + (size_t)m * DM) + lane;
        f32x4 v[8]; float s = 0.f;
#pragma unroll
        for (int j = 0; j < 8; ++j) { v[j] = xr[64 * j]; s += dot4(v[j]); }
        const float r = 1.0f / sqrtf(wave_sum(s) * (1.0f / DM) + EPS);
        GAS v2u* o8 = (GAS v2u*)(dst + (size_t)m * DM) + lane;
#pragma unroll
        for (int j = 0; j < 8; ++j) { const f32x4 y = (v[j] * r) * g[j]; v2u w; w.x = pk2(y.x, y.y); w.y = pk2(y.z, y.w); o8[64 * j] = w; }
    }
}
__device__ __forceinline__ void norm_rows_f32_inplace(Frame& F, float* x, const float* gain) {
    LANE_IDS();
    const int gw = F.vcu * NWAVES + wave, NGW = F.G * NWAVES;
    f32x4 g[8];
#pragma unroll
    for (int j = 0; j < 8; ++j) g[j] = *(const f32x4*)(gain + 4 * lane + 256 * j);
    for (int m = gw; m < M; m += NGW) {
        GAS f32x4* xr = (GAS f32x4*)(x + (size_t)m * DM) + lane;
        f32x4 v[8]; float s = 0.f;
#pragma unroll
        for (int j = 0; j < 8; ++j) { v[j] = xr[64 * j]; s += dot4(v[j]); }
        const float r = 1.0f / sqrtf(wave_sum(s) * (1.0f / DM) + EPS);
#pragma unroll
        for (int j = 0; j < 8; ++j) xr[64 * j] = (v[j] * r) * g[j];
    }
}

__device__ __forceinline__ void p0_prologue(Frame& F) {
    LANE_IDS();
    LAS float* scr = (LAS float*)(F.lds + RING_OFF + wave * 16384);
    const int gw = F.vcu * NWAVES + wave, NGW = F.G * NWAVES;
    unsigned char* ws = F.wsb;
    constexpr int I0 = 32 * 16, I1 = 32 * 18, I2 = 8 * 96, I3 = 8 * 128, I4 = 32 * 64, I5 = 32 * 576, I6 = 32 * 64, I7 = 32 * 352, I8 = 88 * 64;
    constexpr int NITEMS = 2 * (I0 + I1 + I2 + I3 + I4 + I5 + I6) + 4 * (I7 + I8);
    for (int it = gw; it < NITEMS; it += NGW) {
        int r = it;
        if (r < 2 * I5) { const int l = r / I5; p0_transpose_item<2>((const float*)karg(12) + (size_t)l * DM * NDIL, DM, NDIL, (bf16*)(ws + WS_WDIL + l * WDIL_STRIDE + WDIL_IN), 0, scr, r - l * I5, lane); continue; } r -= 2 * I5;
        if (r < 4 * I7) { const int l = r / I7; p0_transpose_item<4>((const float*)karg(14) + (size_t)l * DM * NUP, DM, NUP, (bf16*)(ws + WS_WFFN + l * WFFN_STRIDE + WFFN_UP), 0, scr, r - l * I7, lane); continue; } r -= 4 * I7;
        if (r < 4 * I8) { const int l = r / I8; p0_transpose_item<0>((const float*)karg(17) + (size_t)l * FF * DM, FF, DM, (bf16*)(ws + WS_WFFN + l * WFFN_STRIDE + WFFN_DOWN), 0, scr, r - l * I8, lane); continue; } r -= 4 * I8;
        if (r < 2 * I6) { const int l = r / I6; p0_transpose_item<0>((const float*)karg(13) + (size_t)l * DM * DM, DM, DM, (bf16*)(ws + WS_WDIL + l * WDIL_STRIDE + WDIL_WO), 0, scr, r - l * I6, lane); continue; } r -= 2 * I6;
        if (r < 2 * I4) { const int l = r / I4; p0_transpose_item<0>((const float*)karg(11) + (size_t)l * DM * DM, DM, DM, (bf16*)(ws + WS_WMLA + l * WMLA_STRIDE + WMLA_WO), 0, scr, r - l * I4, lane); continue; } r -= 2 * I4;
        if (r < 2 * I3) { const int l = r / I3; p0_transpose_item<0>((const float*)karg(10) + (size_t)l * 512 * NKVB, 512, NKVB, (bf16*)(ws + WS_WMLA + l * WMLA_STRIDE + WMLA_KVB), 0, scr, r - l * I3, lane); continue; } r -= 2 * I3;
        if (r < 2 * I2) { const int l = r / I2; p0_transpose_item<1>((const float*)karg(7) + (size_t)l * 512 * NQB, 512, NQB, (bf16*)(ws + WS_WMLA + l * WMLA_STRIDE + WMLA_QB), 0, scr, r - l * I2, lane); continue; } r -= 2 * I2;
        if (r < 2 * I1) { const int l = r / I1; p0_transpose_item<3>((const float*)karg(8) + (size_t)l * DM * 576, DM, 576, (bf16*)(ws + WS_WMLA + l * WMLA_STRIDE + WMLA_QKVA), 512, scr, r - l * I1, lane); continue; } r -= 2 * I1;
        { const int l = r / I0; p0_transpose_item<0>((const float*)karg(5) + (size_t)l * DM * 512, DM, 512, (bf16*)(ws + WS_WMLA + l * WMLA_STRIDE + WMLA_QKVA), 0, scr, r - l * I0, lane); }
    }
    const int gt = F.vcu * (NWAVES * 64) + tid, NGT = F.G * NWAVES * 64;
    for (int i = gt; i < 2 * 192 * DM / 8; i += NGT) { const int l = i / (192 * DM / 8), e = i - l * (192 * DM / 8), rr = e / (DM / 8), cc = e - rr * (DM / 8), row = rr < 96 ? 1056 + rr : 1184 + (rr - 96);
        *((GAS v4u*)(ws + WS_WMLA + l * WMLA_STRIDE + WMLA_QKVA + (size_t)row * DM * 2) + cc) = (v4u){0u, 0u, 0u, 0u}; }
    const int* pos = (const int*)karg(1);
    for (int i = gt; i < M * 32; i += NGT) { const int row = i >> 5, k = i & 31;
        const double rev = (double)pos[row] * kRopeRev[k]; const float fr = (float)(rev - __builtin_rint(rev));
        const float c = __builtin_amdgcn_cosf(fr), s = __builtin_amdgcn_sinf(fr);
        ((float*)(ws + WS_COSM))[i] = c; ((float*)(ws + WS_SINM))[i] = s;
        if ((k & 1) == 0) { ((float*)(ws + WS_COSD))[row * 16 + (k >> 1)] = c; ((float*)(ws + WS_SIND))[row * 16 + (k >> 1)] = s; } }
    { const int gwv = F.vcu * NWAVES + wave, NGWv = F.G * NWAVES; const float* x = (const float*)karg(0); const float* gain = (const float*)karg(2); bf16* XB = (bf16*)(ws + WS_H); float* ps0 = (float*)(ws + WS_PS);
      f32x4 g[8];
#pragma unroll
      for (int j = 0; j < 8; ++j) g[j] = *(const f32x4*)(gain + 4 * lane + 256 * j);
      for (int m = gwv; m < M; m += NGWv) {
        const GAS f32x4* xr = (const GAS f32x4*)(x + (size_t)m * DM) + lane; f32x4 v[8]; float s = 0.f;
#pragma unroll
        for (int j = 0; j < 8; ++j) { v[j] = xr[64 * j]; s += dot4(v[j]); }
        s = wave_sum(s);
        GAS v2u* o8 = (GAS v2u*)(XB + (size_t)m * DM) + lane;
#pragma unroll
        for (int j = 0; j < 8; ++j) { const f32x4 y = v[j] * g[j]; v2u w; w.x = pk2(y.x, y.y); w.y = pk2(y.z, y.w); o8[64 * j] = w; }
        if (lane < 32) ps0[(size_t)m * 32 + lane] = lane == 0 ? s : 0.f; } }
}

__device__ __forceinline__ void mla_mid(Frame& F, int j) {
    LANE_IDS();
    const int gw = ((int)blockIdx.x - 64) * NWAVES + wave, NGW = (F.G - 64) * NWAVES;
    unsigned char* ws = F.wsb;
    const float* qkva = (const float*)(ws + WS_S + S_QKVA);
    bf16* QN = (bf16*)(ws + WS_S + S_QN); bf16* CK = (bf16*)(ws + WS_S + S_CKVN);
    const float* gq = (const float*)karg(6) + j * 512; const float* gk = (const float*)karg(9) + j * 512;
    f32x4 g1[2], g2[2];
#pragma unroll
    for (int t = 0; t < 2; ++t) { g1[t] = *(const f32x4*)(gq + 4 * lane + 256 * t); g2[t] = *(const f32x4*)(gk + 4 * lane + 256 * t); }
    for (int m = gw; m < M; m += NGW) {
        const float* row = qkva + (size_t)m * NQKVA;
        f32x4 a[2], c[2];
#pragma unroll
        for (int t = 0; t < 2; ++t) { a[t] = *(const GAS f32x4*)(row + 4 * lane + 256 * t); c[t] = *(const GAS f32x4*)(row + 512 + 4 * lane + 256 * t); }
        const float ra = 1.0f / sqrtf(wave_sum(dot4(a[0]) + dot4(a[1])) * (1.0f / 512) + EPS);
        const float rc = 1.0f / sqrtf(wave_sum(dot4(c[0]) + dot4(c[1])) * (1.0f / 512) + EPS);
#pragma unroll
        for (int t = 0; t < 2; ++t) { const f32x4 y = (a[t] * ra) * g1[t], z = (c[t] * rc) * g2[t]; v2u w;
            w.x = pk2(y.x, y.y); w.y = pk2(y.z, y.w); *((GAS v2u*)(QN + (size_t)m * 512 + 256 * t) + lane) = w;
            w.x = pk2(z.x, z.y); w.y = pk2(z.z, z.w); *((GAS v2u*)(CK + (size_t)m * 512 + 256 * t) + lane) = w; }
    }
}

__device__ __forceinline__ void dil_merge(Frame& F) {
    LANE_IDS();
    const int gw = F.vcu * NWAVES + wave, NGW = F.G * NWAVES;
    unsigned char* ws = F.wsb;
    const bf16* OG = (const bf16*)(ws + WS_S + S_OG); const float* LSE = (const float*)(ws + WS_S + S_LSE); bf16* AO = (bf16*)(ws + WS_S + S_AO_DIL);
    for (int m = gw; m < M; m += NGW) {
        const int b = m >> 12, s = m & (SEQ - 1);
        const size_t sp0 = s, sp1 = (size_t)(s & 3) * (SEQ / 4) + (s >> 2), sp2 = (size_t)(s & 15) * (SEQ / 16) + (s >> 4);
#pragma unroll
        for (int j = 0; j < 4; ++j) { const int col = 8 * lane + 512 * j, head = col >> 7, dim = col & 127;
            const size_t r0 = ((size_t)(0 * 16 + head) * BATCH + b) * SEQ + sp0, r1 = ((size_t)(1 * 16 + head) * BATCH + b) * SEQ + sp1, r2 = ((size_t)(2 * 16 + head) * BATCH + b) * SEQ + sp2;
            const float l0 = LSE[r0], l1 = LSE[r1], l2 = LSE[r2];
            const float mx = fmaxf(l0, fmaxf(l1, l2)); float e0 = __expf(l0 - mx), e1 = __expf(l1 - mx), e2 = __expf(l2 - mx);
            const float inv = 1.0f / (e0 + e1 + e2); e0 *= inv; e1 *= inv; e2 *= inv;
            const v4u a = *(const GAS v4u*)(OG + r0 * 128 + dim), bb = *(const GAS v4u*)(OG + r1 * 128 + dim), c = *(const GAS v4u*)(OG + r2 * 128 + dim);
            v4u w;
#pragma unroll
            for (int q = 0; q < 4; ++q) w[q] = pk2(e0 * bf_lo(a[q]) + e1 * bf_lo(bb[q]) + e2 * bf_lo(c[q]), e0 * bf_hi(a[q]) + e1 * bf_hi(bb[q]) + e2 * bf_hi(c[q]));
            *(GAS v4u*)(AO + (size_t)m * DM + col) = w; }
    }
}

__device__ __forceinline__ void ffn_fixup(Frame& F, int layer, int pm) {
    LANE_IDS();
    if ((pm & 15) == 0) return;
    unsigned char* ws = F.wsb;
    const float* HALO = (const float*)(ws + WS_HALO); const float* FIX = (const float*)(ws + WS_FIX); bf16* ACT = (bf16*)(ws + WS_S + S_ACT);
    const float* cw = (const float*)karg(15) + (size_t)layer * 3 * NUP;
    for (int idx = tid; idx < 2 * (FF / 8); idx += NWAVES * 64) { const int rs = idx / (FF / 8), ch = (idx - rs * (FF / 8)) * 8;
        float o[8];
#pragma unroll
        for (int e = 0; e < 8; e += 4) {
            f32x4 cg = *(const GAS f32x4*)(FIX + ((size_t)pm * 2 + rs) * NUP + ch + e), cv = *(const GAS f32x4*)(FIX + ((size_t)pm * 2 + rs) * NUP + FF + ch + e);
            const f32x4 u1g = *(const GAS f32x4*)(HALO + ((size_t)(pm - 1) * 2 + 1) * NUP + ch + e), u1v = *(const GAS f32x4*)(HALO + ((size_t)(pm - 1) * 2 + 1) * NUP + FF + ch + e);
            const f32x4 u2g = *(const GAS f32x4*)(HALO + ((size_t)(pm - 1) * 2 + 0) * NUP + ch + e), u2v = *(const GAS f32x4*)(HALO + ((size_t)(pm - 1) * 2 + 0) * NUP + FF + ch + e);
            const f32x4 w0g = *(const f32x4*)(cw + ch + e), w0v = *(const f32x4*)(cw + FF + ch + e), w1g = *(const f32x4*)(cw + NUP + ch + e), w1v = *(const f32x4*)(cw + NUP + FF + ch + e);
            if (rs == 0) { cg = cg + w1g * u1g + w0g * u2g; cv = cv + w1v * u1v + w0v * u2v; } else { cg = cg + w0g * u1g; cv = cv + w0v * u1v; }
#pragma unroll
            for (int k = 0; k < 4; ++k) o[e + k] = cg[k] * __builtin_amdgcn_rcpf(1.0f + __builtin_amdgcn_exp2f(-1.4426950408889634f * cg[k])) * cv[k]; }
        v4u w; w.x = pk2(o[0], o[1]); w.y = pk2(o[2], o[3]); w.z = pk2(o[4], o[5]); w.w = pk2(o[6], o[7]);
        *(GAS v4u*)(ACT + ((size_t)pm * 256 + rs) * FF + ch) = w; }
}

__device__ __forceinline__ void row_scale_table(Frame& F, const float* ps, int pm) {
    LANE_IDS();
    LAS float* rsl = (LAS float*)(F.lds + RSL_OFF);
    if (tid < 256) { const GAS f32x4* p = (const GAS f32x4*)(ps + ((size_t)pm * 256 + tid) * 32); float s = 0.f;
#pragma unroll
        for (int i = 0; i < 8; ++i) { const f32x4 a = p[i]; s += (a.x + a.y) + (a.z + a.w); }
        rsl[tid] = __builtin_amdgcn_rsqf(s * (1.0f / DM) + EPS); }
    __syncthreads();
}

struct MlaRef {
    const bf16* Q; const bf16* KV; const bf16* KPE; bf16* AO; int vcu;
    __device__ __forceinline__ att::BlockRef operator()(int i) const {
        const int I = vcu + 256 * (i >> 1), bh = I >> 3, x = I & 7, qb = (i & 1) ? 15 - x : x, b = bh >> 4, h = bh & 15;
        const size_t row0 = (size_t)b * SEQ + (size_t)qb * 256;
        att::BlockRef r; r.Q = Q + row0 * NQB + h * 128; r.Qpe = Q + row0 * NQB + 2048 + h * 64;
        r.K = KV + (size_t)bh * SEQ * 128; r.V = r.K + (size_t)M * DM; r.Kpe = KPE + (size_t)b * SEQ * 64;
        r.O = AO + row0 * DM + h * 128; r.Lse = nullptr; r.P0 = qb * 256; return r;
    }
};
struct DilRef {
    const bf16* QKV; bf16* OG; float* LSE; int vcu, g;
    __device__ __forceinline__ att::BlockRef operator()(int i) const {
        const int I = vcu + 256 * i, sh = 2 * g, d = 1 << sh, nqbs = 4 - sh;
        const int seq = I >> nqbs, qb = I & ((1 << nqbs) - 1), h = seq & 15, br = seq >> 4, rr = br & (d - 1), b = br >> sh;
        const size_t sp0 = (size_t)rr * (SEQ >> sh), spq = sp0 + (size_t)qb * 256;
        const size_t hb = ((size_t)(g * 3) * 16 + h) * BATCH + b, tstep = (size_t)16 * BATCH * SEQ * 128;
        att::BlockRef r; r.Q = QKV + (hb * SEQ + spq) * 128; r.Qpe = nullptr; r.Kpe = nullptr;
        r.K = QKV + tstep + (hb * SEQ + sp0) * 128; r.V = r.K + tstep;
        const size_t ob = ((size_t)g * 16 + h) * BATCH + b;
        r.O = OG + (ob * SEQ + spq) * 128; r.Lse = LSE + ob * SEQ + spq; r.P0 = qb * 256; return r;
    }
};
template <bool PE, bool SK, bool LSE, bool EARLY, class RefFn>
__device__ __forceinline__ void attn_run(char* lds, const att::Prm& P, int n, const RefFn& ref) {
    att::BlockRef cur = ref(0); att::Seam<PE> S;
    att::swa_prime<PE>(cur, P, lds, S);
    for (int i = 0;; ++i) {
        const bool last = i + 1 >= n;
        const att::BlockRef nxt = last ? cur : ref(i + 1);
        att::swa_block<PE, SK, LSE, EARLY>(cur, nxt, P, lds, S);
        if (last) break;
        cur = nxt;
    }
}

struct Args { const void* in[18]; float* out; unsigned char* ws; };
__global__ void __launch_bounds__(NWAVES * 64, 2) fwd_kernel(Args args) {
    extern __shared__ __attribute__((aligned(16))) unsigned char lds[];
    Frame F;
    F.lds = (LAS unsigned char*)lds;
    F.MISC = (volatile LAS unsigned*)(F.lds + MISC_OFF);
    F.G = gridDim.x; { const int bx = blockIdx.x; F.vcu = (F.G % 8 == 0) ? (bx % 8) * (F.G / 8) + bx / 8 : bx; }
        F.out = args.out; F.wsb = args.ws;
    F.ctl = (gu32*)(args.ws + WS_CTL);
#define ws F.wsb
#define RELAUNDER() asm volatile("" : "+s"(F.vcu), "+s"(F.wsb), "+s"(F.out))
    for (int u = threadIdx.x; u < (LDS_BYTES - LDSCTL_OFF) / 4; u += NWAVES * 64) ((LAS unsigned*)(F.lds + LDSCTL_OFF))[u] = 0u;
    __syncthreads();
    XcdBarrier bar = xcd_barrier_post((unsigned*)(F.ctl + CW_BAR), F.MISC + 8);
#define GRID_BAR() xcd_barrier(bar)
    typedef pg8::StaticOrder SO;
#define GEMMR(EpiT, Aptr, Bptr, N_, K_, Eobj, REP_) do { pg8::Gemm g_{(const bf16*)(Aptr), (const bf16*)(Bptr), M, (N_), (K_)}; SO S_; S_.init(M, (N_), F.G, (int)blockIdx.x); \
        pg8::gemm_phase<EpiT, SO, true, true, REP_>(F.lds + RING_OFF, g_, S_, (Eobj)); } while (0)
#define GEMM(EpiT, Aptr, Bptr, N_, K_, Eobj) GEMMR(EpiT, Aptr, Bptr, N_, K_, Eobj, 1)

    bf16* H = (bf16*)(ws + WS_H);
    const float* cosM = (const float*)(ws + WS_COSM); const float* sinM = (const float*)(ws + WS_SINM);
    const float* cosD = (const float*)(ws + WS_COSD); const float* sinD = (const float*)(ws + WS_SIND);

    p0_prologue(F);
    GRID_BAR();

#define PSP(i) ((float*)(ws + WS_PS + (size_t)(i) * PS_STRIDE))
    const PG8_LAS float* rsl = (const PG8_LAS float*)(F.lds + RSL_OFF);
    const int my_pm = 8 * ((int)blockIdx.x & 7) + (((int)blockIdx.x >> 3) & 7);
    for (int j = 0; j < 2; ++j) {
        {
            RELAUNDER();
            const unsigned char* wl = ws + WS_WMLA + j * WMLA_STRIDE;
            float* QKVA = (float*)(ws + WS_S + S_QKVA); bf16* QN = (bf16*)(ws + WS_S + S_QN); bf16* CK = (bf16*)(ws + WS_S + S_CKVN); bf16* KPE = (bf16*)(ws + WS_S + S_KPE);
            bf16* Q = (bf16*)(ws + WS_S + S_Q); bf16* KV = (bf16*)(ws + WS_S + S_KV); bf16* AO = (bf16*)(ws + WS_S + S_AO_MLA);
            row_scale_table(F, PSP(4 * j), my_pm);
            { pg8::EpiF32Scaled E{QKVA, NQKVA, rsl}; GEMM(pg8::EpiF32Scaled, H, wl + WMLA_QKVA, 1024, DM, E); }
            GRID_BAR();
            if (blockIdx.x < 64) {
                row_scale_table(F, PSP(4 * j), (int)blockIdx.x);
                pg8::Gemm g_{(const bf16*)H, (const bf16*)(wl + WMLA_QKVA), M, NQKVA, DM}; pg8::OneUnit S_{(int)blockIdx.x, 4}; pg8::EpiKpe E{KPE, cosM, sinM, rsl};
                pg8::gemm_phase<pg8::EpiKpe, pg8::OneUnit, true, true>(F.lds + RING_OFF, g_, S_, E);
            } else mla_mid(F, j);
            GRID_BAR();
            { pg8::EpiQMla E{Q, cosM, sinM}; GEMM(pg8::EpiQMla, QN, wl + WMLA_QB, NQB, 512, E); }
            { pg8::EpiKvMla E{KV, KV + (size_t)M * DM}; GEMM(pg8::EpiKvMla, CK, wl + WMLA_KVB, NKVB, 512, E); }
            GRID_BAR();
            RELAUNDER();
            { att::Prm P{NQB, 128, DM, NQB, 64, 0, SEQ, SEQ, 0.07216878364870322f};
              MlaRef R{Q, KV, KPE, AO, F.vcu};
              attn_run<true, false, false, false>((char*)lds + RING_OFF, P, 4, R);
            }
            GRID_BAR();
            { pg8::EpiResN E{j == 0 ? (const float*)karg(0) : (const float*)F.out, F.out, H, (const float*)karg(3) + (2 * j) * DM, PSP(1 + 4 * j), DM}; GEMM(pg8::EpiResN, AO, wl + WMLA_WO, DM, DM, E); }
            GRID_BAR();
        }
        {
            RELAUNDER();
            const int layer = 2 * j; const unsigned char* wl = ws + WS_WFFN + layer * WFFN_STRIDE;
            bf16* ACT = (bf16*)(ws + WS_S + S_ACT);
            row_scale_table(F, PSP(1 + 4 * j), my_pm);
            { pg8::EpiUpConv E{ACT, (float*)(ws + WS_HALO), (float*)(ws + WS_FIX), (const float*)karg(15) + (size_t)layer * 3 * NUP, (const float*)karg(16) + (size_t)layer * NUP,
                               (PG8_LAS float*)(F.lds + XH_OFF), (PG8_LAS float*)(F.lds + CWL_OFF), rsl};
              GEMM(pg8::EpiUpConv, H, wl + WFFN_UP, NUP, DM, E); }
            GRID_BAR();
            { SO S_; S_.init(M, DM, F.G, (int)blockIdx.x); pg8::Unit u_; for (int i = 0; S_.next(i, u_); ++i) ffn_fixup(F, layer, u_.pm);
              asm volatile("s_waitcnt vmcnt(0)" ::: "memory"); __syncthreads(); }
            { pg8::EpiResN E{F.out, F.out, H, (const float*)karg(2) + (2 * j + 1) * DM, PSP(2 + 4 * j), DM}; GEMM(pg8::EpiResN, ACT, wl + WFFN_DOWN, DM, FF, E); }
            GRID_BAR();
        }
        {
            RELAUNDER();
            const unsigned char* wl = ws + WS_WDIL + j * WDIL_STRIDE;
            bf16* QKV = (bf16*)(ws + WS_S + S_QKV); bf16* OG = (bf16*)(ws + WS_S + S_OG); float* LSE = (float*)(ws + WS_S + S_LSE); bf16* AO = (bf16*)(ws + WS_S + S_AO_DIL);
            row_scale_table(F, PSP(2 + 4 * j), my_pm);
            { pg8::EpiQkvDil E{QKV, cosD, sinD, rsl}; GEMM(pg8::EpiQkvDil, H, wl + WDIL_IN, NDIL, DM, E); }
            GRID_BAR();
#pragma unroll 1
            for (int g = 0; g < 3; ++g) { const int d = 1 << (2 * g);
              att::Prm P{128, 128, 128, 0, 0, 1, SEQ / d, 129, 0.08838834764831845f};
              DilRef R{QKV, OG, LSE, F.vcu, g};
              attn_run<false, true, true, true>((char*)lds + RING_OFF, P, 4, R);
            }
            GRID_BAR();
            dil_merge(F);
            GRID_BAR();
            { pg8::EpiResN E{F.out, F.out, H, (const float*)karg(3) + (2 * j + 1) * DM, PSP(3 + 4 * j), DM}; GEMM(pg8::EpiResN, AO, wl + WDIL_WO, DM, DM, E); }
            GRID_BAR();
        }
        {
            RELAUNDER();
            const int layer = 2 * j + 1; const unsigned char* wl = ws + WS_WFFN + layer * WFFN_STRIDE;
            bf16* ACT = (bf16*)(ws + WS_S + S_ACT);
            row_scale_table(F, PSP(3 + 4 * j), my_pm);
            { pg8::EpiUpConv E{ACT, (float*)(ws + WS_HALO), (float*)(ws + WS_FIX), (const float*)karg(15) + (size_t)layer * 3 * NUP, (const float*)karg(16) + (size_t)layer * NUP,
                               (PG8_LAS float*)(F.lds + XH_OFF), (PG8_LAS float*)(F.lds + CWL_OFF), rsl};
              GEMM(pg8::EpiUpConv, H, wl + WFFN_UP, NUP, DM, E); }
            GRID_BAR();
            { SO S_; S_.init(M, DM, F.G, (int)blockIdx.x); pg8::Unit u_; for (int i = 0; S_.next(i, u_); ++i) ffn_fixup(F, layer, u_.pm);
              asm volatile("s_waitcnt vmcnt(0)" ::: "memory"); __syncthreads(); }
            if (j == 0) { pg8::EpiResN E{F.out, F.out, H, (const float*)karg(2) + 2 * DM, PSP(4), DM}; GEMM(pg8::EpiResN, ACT, wl + WFFN_DOWN, DM, FF, E); }
            else { pg8::EpiRes E{F.out, F.out, DM}; GEMM(pg8::EpiRes, ACT, wl + WFFN_DOWN, DM, FF, E); }
            GRID_BAR();
        }
    }
    RELAUNDER();
    norm_rows_f32_inplace(F, F.out, (const float*)karg(4));
#undef PSP
#undef ws
#undef RELAUNDER
#undef GEMM
#undef GEMMR
#undef GRID_BAR
}

extern "C" void kernel_launch(void* const* d_in, const int* in_sizes, int n_in, void* d_out, int out_size, void* d_ws, size_t ws_size, hipStream_t stream) {
    static int grid = 0;
    if (grid == 0) {
        if (n_in != 18 || in_sizes[0] != M * DM || out_size != M * DM || ws_size < WS_END) {
            fprintf(stderr, "kernel_launch: shape / workspace mismatch (n_in %d, in0 %d, out %d, ws %zu, need %zu); nothing launched\n", n_in, n_in > 0 ? in_sizes[0] : -1, out_size, ws_size, (size_t)WS_END); grid = -1; return; }
        int dev = 0, cus = 0, per_cu = 0;
        if (hipGetDevice(&dev) != hipSuccess || hipDeviceGetAttribute(&cus, hipDeviceAttributeMultiprocessorCount, dev) != hipSuccess) { grid = -1; return; }
        if (hipFuncSetAttribute((const void*)fwd_kernel, hipFuncAttributeMaxDynamicSharedMemorySize, LDS_BYTES) != hipSuccess) { fprintf(stderr, "kernel_launch: hipFuncSetAttribute failed\n"); grid = -1; return; }
        if (hipOccupancyMaxActiveBlocksPerMultiprocessor(&per_cu, (const void*)fwd_kernel, NWAVES * 64, LDS_BYTES) != hipSuccess || per_cu < 1) fprintf(stderr, "kernel_launch: occupancy query reports %d\n", per_cu);
        (void)hipGetLastError();
        if (cus < 256) { fprintf(stderr, "kernel_launch: built for a 256-CU device, found %d CUs; nothing launched\n", cus); grid = -1; return; }
        grid = 256;
    }
    if (grid < 0) return;
    if (hipMemsetAsync((char*)d_ws + WS_CTL, 0, CTL_ZERO_BYTES, stream) != hipSuccess) return;
    Args a{};
    for (int i = 0; i < 18; ++i) a.in[i] = d_in[i];
    a.out = (float*)d_out; a.ws = (unsigned char*)d_ws;
    hipLaunchKernelGGL(fwd_kernel, dim3(grid), dim3(NWAVES * 64), LDS_BYTES, stream, a);
}
```

```cpp
#include <hip/hip_runtime.h>
#include <cstdio>
#include <cstdint>
namespace pg8 {
#define PG8_LAS __attribute__((address_space(3)))
typedef unsigned short bf16_t;
typedef short bf16x8 __attribute__((ext_vector_type(8)));
typedef float f32x4 __attribute__((ext_vector_type(4)));
typedef unsigned u32x4 __attribute__((ext_vector_type(4)));
constexpr int BM = 256, BK = 64, HALF = 128, HTB = HALF * BK * 2  , STAGE_BYTES = 8 * HTB, NXCD = 8, WGM = 8;

__host__ __device__ __forceinline__ int lds_byte(int r, int c) { const int st = (r >> 4) * 2 + (c >> 5), rr = r & 15, cc = c & 31, ob = rr * 64 + cc * 2; return st * 1024 + (ob ^ (((ob >> 9) & 1) << 5)); }
__host__ __device__ __forceinline__ void stage_rc(int b, int& R, int& C) { const int st = b / 1024, sb = b % 1024, swz = sb ^ (((sb >> 9) & 1) << 5); R = (st >> 1) * 16 + swz / 64; C = (st & 1) * 32 + (swz % 64) / 2; }
__host__ __device__ __forceinline__ int perm32(int rho) { const int n = rho >> 4, i = rho & 15; return 8 * (i >> 2) + 4 * n + (i & 3); }

struct Unit { int pm, pn; };
struct Gemm { const bf16_t* A; const bf16_t* Bt; int M, N, K; };

struct StaticOrder {
    int nM, nN, nwg, G, c;
    __host__ __device__ void init(int M, int N, int G_, int c_) { nM = M / BM; nN = N / BM; nwg = nM * nN; G = G_; c = c_; }
    __host__ __device__ __forceinline__ bool next(int i, Unit& u) const {
        const long L = (long)i * G + c; if (L >= nwg) return false;
        int wgid = (int)L; { const int q = nwg / NXCD, r = nwg % NXCD, xcd = wgid % NXCD, off = wgid / NXCD; wgid = (xcd < r ? xcd * (q + 1) : r * (q + 1) + (xcd - r) * q) + off; }
        const int nig = WGM * nN, gid = wgid / nig, fm = gid * WGM, gsz = (nM - fm) < WGM ? (nM - fm) : WGM;
        u.pm = fm + ((wgid % nig) % gsz); u.pn = (wgid % nig) / gsz; return true;
    }
    __device__ __forceinline__ void a_ready(const Unit&) const {}
    __device__ __forceinline__ void done(const Unit&) const {}
};

__device__ __forceinline__ unsigned cvt_pk_bf16(float lo, float hi) { unsigned r; asm volatile("v_cvt_pk_bf16_f32 %0, %1, %2" : "=v"(r) : "v"(lo), "v"(hi)); return r; }
typedef float f32x2 __attribute__((ext_vector_type(2)));
typedef unsigned u32x2 __attribute__((ext_vector_type(2)));
__device__ __forceinline__ u32x4 pack8bf(const f32x4 a, const f32x4 b) { u32x4 w; w.x = cvt_pk_bf16(a[0], a[1]); w.y = cvt_pk_bf16(a[2], a[3]); w.z = cvt_pk_bf16(b[0], b[1]); w.w = cvt_pk_bf16(b[2], b[3]); return w; }
#define PG8_NOPRE struct Pre {}; __device__ __forceinline__ void pre_issue(Pre&, const Unit&, int, int) const {} __device__ __forceinline__ void pre_finish(Pre&, int, int) const {}
struct EpiF32Store {
    PG8_NOPRE
    static constexpr bool PERM = false, AFTER_DRAIN = false;
    float* C; int ldc;
    __device__ __forceinline__ void operator()(const f32x4 (&acc)[2][2][4][2], const Unit& u, int wr, int wc, int fr, int fq, int ui) const {
        const int row0 = u.pm * BM + wr * 64 + fr, col0 = u.pn * BM + wc * 32 + 4 * fq;
#pragma unroll
        for (int ai = 0; ai < 2; ++ai)
#pragma unroll
            for (int m = 0; m < 4; ++m) { float* rowp = C + (size_t)(row0 + ai * HALF + m * 16) * ldc + col0;
#pragma unroll
                for (int bj = 0; bj < 2; ++bj)
#pragma unroll
                    for (int n = 0; n < 2; ++n) *(f32x4*)(rowp + bj * HALF + n * 16) = acc[ai][bj][m][n]; }
    }
};

__device__ __forceinline__ float sum_fq(float v) {
    v += __uint_as_float((unsigned)__builtin_amdgcn_ds_swizzle((int)__float_as_uint(v), ((0x10 << 10) | 0x1f)));
    auto rr = __builtin_amdgcn_permlane32_swap(__float_as_uint(v), __float_as_uint(v), false, false);
    return __uint_as_float(rr[0]) + __uint_as_float(rr[1]);
}
__device__ __forceinline__ float sq4(const f32x4 a) { return (a[0] * a[0] + a[1] * a[1]) + (a[2] * a[2] + a[3] * a[3]); }
__device__ __forceinline__ void load_rs(float (&r)[2][4], const PG8_LAS float* rsl, int wr, int fr) {
#pragma unroll
    for (int ai = 0; ai < 2; ++ai)
#pragma unroll
        for (int m = 0; m < 4; ++m) r[ai][m] = rsl[ai * HALF + wr * 64 + m * 16 + fr]; }
__device__ __forceinline__ void unpack8bf(const u32x4 w, f32x4& a, f32x4& b) {
    a = (f32x4){__uint_as_float(w.x << 16), __uint_as_float(w.x & 0xffff0000u), __uint_as_float(w.y << 16), __uint_as_float(w.y & 0xffff0000u)};
    b = (f32x4){__uint_as_float(w.z << 16), __uint_as_float(w.z & 0xffff0000u), __uint_as_float(w.w << 16), __uint_as_float(w.w & 0xffff0000u)}; }
template <bool BASE_F32> struct EpiResB {
    PG8_NOPRE
    static constexpr bool PERM = true, AFTER_DRAIN = false;
    const float* basef; bf16_t* X; float* ps; int ldc;
    __device__ __forceinline__ void operator()(const f32x4 (&acc)[2][2][4][2], const Unit& u, int wr, int wc, int fr, int fq, int ui) const {
        const int row0 = u.pm * BM + wr * 64 + fr, col0 = u.pn * BM + wc * 32 + 8 * fq;
#pragma unroll
        for (int ai = 0; ai < 2; ++ai) {
            f32x4 bs[4][2][2]; u32x4 bx[4][2];
#pragma unroll
            for (int m = 0; m < 4; ++m) { const size_t off = (size_t)(row0 + ai * HALF + m * 16) * ldc + col0;
#pragma unroll
                for (int bj = 0; bj < 2; ++bj) {
                    if constexpr (BASE_F32) { bs[m][bj][0] = *(const f32x4*)(basef + off + bj * HALF); bs[m][bj][1] = *(const f32x4*)(basef + off + bj * HALF + 4); }
                    else bx[m][bj] = *(const u32x4*)(X + off + bj * HALF); } }
#pragma unroll
            for (int m = 0; m < 4; ++m) { const int row = row0 + ai * HALF + m * 16; const size_t off = (size_t)row * ldc + col0; float q = 0.f;
#pragma unroll
                for (int bj = 0; bj < 2; ++bj) { f32x4 x0, x1;
                    if constexpr (BASE_F32) { x0 = bs[m][bj][0]; x1 = bs[m][bj][1]; } else unpack8bf(bx[m][bj], x0, x1);
                    const f32x4 o0 = x0 + acc[ai][bj][m][0], o1 = x1 + acc[ai][bj][m][1]; q += sq4(o0) + sq4(o1);
                    *(u32x4*)(X + off + bj * HALF) = pack8bf(o0, o1); }
                q = sum_fq(q);
                if (fq == 0) ps[(size_t)row * 32 + u.pn * 4 + wc] = q; }
            asm volatile("" ::: "memory"); }
    }
};
struct EpiResLast {
    PG8_NOPRE
    static constexpr bool PERM = true, AFTER_DRAIN = false;
    const bf16_t* X; float* out; int ldc;
    __device__ __forceinline__ void operator()(const f32x4 (&acc)[2][2][4][2], const Unit& u, int wr, int wc, int fr, int fq, int ui) const {
        const int row0 = u.pm * BM + wr * 64 + fr, col0 = u.pn * BM + wc * 32 + 8 * fq;
#pragma unroll
        for (int ai = 0; ai < 2; ++ai) {
            u32x4 bx[4][2];
#pragma unroll
            for (int m = 0; m < 4; ++m) { const size_t off = (size_t)(row0 + ai * HALF + m * 16) * ldc + col0;
#pragma unroll
                for (int bj = 0; bj < 2; ++bj) bx[m][bj] = *(const u32x4*)(X + off + bj * HALF); }
#pragma unroll
            for (int m = 0; m < 4; ++m) { const size_t off = (size_t)(row0 + ai * HALF + m * 16) * ldc + col0;
#pragma unroll
                for (int bj = 0; bj < 2; ++bj) { f32x4 x0, x1; unpack8bf(bx[m][bj], x0, x1);
                    *(f32x4*)(out + off + bj * HALF) = x0 + acc[ai][bj][m][0]; *(f32x4*)(out + off + bj * HALF + 4) = x1 + acc[ai][bj][m][1]; } }
            asm volatile("" ::: "memory"); }
    }
};
struct EpiF32Scaled {
    PG8_NOPRE
    static constexpr bool PERM = false, AFTER_DRAIN = false;
    float* C; int ldc; const PG8_LAS float* rsl;
    __device__ __forceinline__ void operator()(const f32x4 (&acc)[2][2][4][2], const Unit& u, int wr, int wc, int fr, int fq, int ui) const {
        const int row0 = u.pm * BM + wr * 64 + fr, col0 = u.pn * BM + wc * 32 + 4 * fq;
        float r[2][4]; load_rs(r, rsl, wr, fr);
#pragma unroll
        for (int ai = 0; ai < 2; ++ai)
#pragma unroll
            for (int m = 0; m < 4; ++m) { float* rowp = C + (size_t)(row0 + ai * HALF + m * 16) * ldc + col0;
#pragma unroll
                for (int bj = 0; bj < 2; ++bj)
#pragma unroll
                    for (int n = 0; n < 2; ++n) *(f32x4*)(rowp + bj * HALF + n * 16) = acc[ai][bj][m][n] * r[ai][m]; }
    }
};

#define PG8_DPP(old_, src_, ctrl_) __uint_as_float((unsigned)__builtin_amdgcn_update_dpp((int)__float_as_uint(old_), (int)__float_as_uint(src_), (ctrl_), 0xF, 0xF, false))
struct EpiUpConv {
    static constexpr bool PERM = true, AFTER_DRAIN = false;
    bf16_t* ACT; float* HALO; float* FIX; const float* cw; const float* cb;
    PG8_LAS float* xh; PG8_LAS float* cwl; const PG8_LAS float* rsl;
    PG8_NOPRE
    __device__ __forceinline__ void operator()(const f32x4 (&acc_)[2][2][4][2], const Unit& u, int wr, int wc, int fr_, int fq_, int ui) const {
        int fr = fr_, fq = fq_; asm volatile("" : "+v"(fr), "+v"(fq));
        f32x4 (&acc)[2][2][4][2] = const_cast<f32x4 (&)[2][2][4][2]>(acc_);
        { float r[2][4]; load_rs(r, rsl, wr, fr);
#pragma unroll
          for (int ai = 0; ai < 2; ++ai)
#pragma unroll
            for (int bj = 0; bj < 2; ++bj)
#pragma unroll
                for (int m = 0; m < 4; ++m)
#pragma unroll
                    for (int n = 0; n < 2; ++n) acc[ai][bj][m][n] = acc[ai][bj][m][n] * r[ai][m]; }
        const int ch0 = 128 * u.pn + 32 * wc + 8 * fq;
        f32x4 wv = {0.f, 0.f, 0.f, 0.f};
        if (wr == 0) { const int lane = fq * 16 + fr; wv = *(const f32x4*)((wc < 3 ? cw + (size_t)wc * 11264 : cb) + (lane < 32 ? 128 * u.pn + lane * 4 : 5632 + 128 * u.pn + (lane - 32) * 4)); }
        if (fr >= 14) {
#pragma unroll
            for (int ai = 0; ai < 2; ++ai) if (ai == 0 || wr == 0) { PG8_LAS float* b = xh + ((((ai == 0 ? wr : 2) * 4 + wc) * 2 + (fr - 14)) * 4 + fq) * 16;
#pragma unroll
                for (int bj = 0; bj < 2; ++bj)
#pragma unroll
                    for (int n = 0; n < 2; ++n) *(PG8_LAS f32x4*)(b + (bj * 2 + n) * 4) = acc[ai][bj][3][n]; }
            if (wr == 1) { float* hp = HALO + ((size_t)u.pm * 2 + (fr - 14)) * 11264 + ch0;
#pragma unroll
                for (int bj = 0; bj < 2; ++bj)
#pragma unroll
                    for (int n = 0; n < 2; ++n) *(f32x4*)(hp + bj * 5632 + n * 4) = acc[1][bj][3][n]; }
        }
        if (wr == 0) *(PG8_LAS f32x4*)(cwl + wc * 256 + (fq * 16 + fr) * 4) = wv;
        asm volatile("s_waitcnt lgkmcnt(0)" ::: "memory"); __builtin_amdgcn_s_barrier(); asm volatile("" ::: "memory");
        const bool fixtile = (u.pm & 15) != 0;
#pragma unroll
        for (int n = 0; n < 2; ++n) {
            const PG8_LAS float* cwb = cwl + wc * 32 + fq * 8 + n * 4;
#pragma unroll
            for (int ai = 0; ai < 2; ++ai)
#pragma unroll
                for (int m = 0; m < 4; ++m) {
                    f32x4 c[2];
#pragma unroll
                    for (int bj = 0; bj < 2; ++bj) {
                        f32x4 W[4];
#pragma unroll
                        for (int t = 0; t < 4; ++t) W[t] = *(const PG8_LAS f32x4*)(cwb + t * 256 + bj * 128);
                        f32x4 h1 = {0.f, 0.f, 0.f, 0.f}, h2 = {0.f, 0.f, 0.f, 0.f};
                        if (m == 0 && !(ai == 0 && wr == 0)) { const int slot = ai == 0 ? 0 : (wr == 0 ? 1 : 2); const PG8_LAS float* b = xh + (((slot * 4 + wc) * 2) * 4 + fq) * 16 + n * 4 + bj * 8;
                            h2 = *(const PG8_LAS f32x4*)b; h1 = *(const PG8_LAS f32x4*)(b + 64); }
#pragma unroll
                        for (int k = 0; k < 4; ++k) { const float cur = acc[ai][bj][m][n][k]; float x1, z;
                            if (m == 0) { x1 = h1[k]; z = fr == 0 ? h2[k] : h1[k]; }
                            else { const float p = acc[ai][bj][m > 0 ? m - 1 : 0][n][k]; x1 = PG8_DPP(0.f, p, 0x121); z = PG8_DPP(0.f, p, 0x122); }
                            const float t1 = PG8_DPP(x1, cur, 0x111), t2 = PG8_DPP(z, cur, 0x112);
                            c[bj][k] = W[3][k] + W[0][k] * t2 + W[1][k] * t1 + W[2][k] * cur; }
                        __builtin_amdgcn_sched_barrier(0);
                    }
                    const int row = u.pm * BM + ai * HALF + wr * 64 + m * 16 + fr;
                    if (ai == 0 && m == 0 && wr == 0 && fixtile && fr < 2) {
                        float* fp = FIX + ((size_t)u.pm * 2 + fr) * 11264 + ch0 + n * 4;
                        *(f32x4*)fp = c[0]; *(f32x4*)(fp + 5632) = c[1];
                    } else {
                        f32x4 a;
#pragma unroll
                        for (int k = 0; k < 4; ++k) { const float g = c[0][k]; a[k] = g * __builtin_amdgcn_rcpf(1.0f + __builtin_amdgcn_exp2f(-1.4426950408889634f * g)) * c[1][k]; }
                        u32x2 w; w.x = cvt_pk_bf16(a[0], a[1]); w.y = cvt_pk_bf16(a[2], a[3]);
                        *(u32x2*)(ACT + (size_t)row * 5632 + ch0 + n * 4) = w;
                    }
                    asm volatile("" ::: "memory"); __builtin_amdgcn_sched_barrier(0);
                }
        }
    }
};
struct EpiKpe {
    PG8_NOPRE
    static constexpr bool PERM = true, AFTER_DRAIN = false;
    bf16_t* KPE; const float* cosT; const float* sinT; const PG8_LAS float* rsl;
    __device__ __forceinline__ void operator()(const f32x4 (&acc)[2][2][4][2], const Unit& u, int wr, int wc, int fr, int fq, int ui) const {
        if (wc != 0) return;
        const int row0 = u.pm * BM + wr * 64 + fr, i0 = 8 * fq;
        float r[2][4]; load_rs(r, rsl, wr, fr);
#pragma unroll
        for (int ai = 0; ai < 2; ++ai)
#pragma unroll
            for (int m = 0; m < 4; ++m) { const int row = row0 + ai * HALF + m * 16;
                const f32x4 c0 = *(const f32x4*)(cosT + (size_t)row * 32 + i0), c1 = *(const f32x4*)(cosT + (size_t)row * 32 + i0 + 4);
                const f32x4 s0 = *(const f32x4*)(sinT + (size_t)row * 32 + i0), s1 = *(const f32x4*)(sinT + (size_t)row * 32 + i0 + 4);
                const f32x4 x1a = acc[ai][0][m][0] * r[ai][m], x1b = acc[ai][0][m][1] * r[ai][m], x2a = acc[ai][1][m][0] * r[ai][m], x2b = acc[ai][1][m][1] * r[ai][m];
                const f32x4 y1a = x1a * c0 - x2a * s0, y1b = x1b * c1 - x2b * s1, y2a = x2a * c0 + x1a * s0, y2b = x2b * c1 + x1b * s1;
                bf16_t* dst = KPE + (size_t)row * 64 + i0;
                *(u32x4*)dst = pack8bf(y1a, y1b); *(u32x4*)(dst + 32) = pack8bf(y2a, y2b); }
    }
};
struct OneUnit { int pm, pn;
    __device__ __forceinline__ bool next(int i, Unit& u) const { if (i) return false; u.pm = pm; u.pn = pn; return true; }
    __device__ __forceinline__ void a_ready(const Unit&) const {}
    __device__ __forceinline__ void done(const Unit&) const {}
};
struct EpiKvMla {
    PG8_NOPRE
    static constexpr bool PERM = true, AFTER_DRAIN = false;
    bf16_t* KH; bf16_t* VH;
    __device__ __forceinline__ void operator()(const f32x4 (&acc)[2][2][4][2], const Unit& u, int wr, int wc, int fr, int fq, int ui) const {
        const int row0 = u.pm * BM + wr * 64 + fr, dim0 = wc * 32 + 8 * fq;
#pragma unroll
        for (int ai = 0; ai < 2; ++ai)
#pragma unroll
            for (int m = 0; m < 4; ++m) { const int row = row0 + ai * HALF + m * 16, b = row >> 12, s = row & 4095;
                const size_t o = (((size_t)b * 16 + u.pn) * 4096 + s) * 128 + dim0;
                *(u32x4*)(KH + o) = pack8bf(acc[ai][0][m][0], acc[ai][0][m][1]); *(u32x4*)(VH + o) = pack8bf(acc[ai][1][m][0], acc[ai][1][m][1]); }
    }
};
struct EpiQMla {
    PG8_NOPRE
    static constexpr bool PERM = true, AFTER_DRAIN = false;
    bf16_t* Q; const float* cosT; const float* sinT;
    __device__ __forceinline__ void operator()(const f32x4 (&acc)[2][2][4][2], const Unit& u, int wr, int wc, int fr, int fq, int ui) const {
        const int row0 = u.pm * BM + wr * 64 + fr;
        if (u.pn < 8) {
            const int col0 = u.pn * BM + wc * 32 + 8 * fq;
#pragma unroll
            for (int ai = 0; ai < 2; ++ai)
#pragma unroll
                for (int m = 0; m < 4; ++m) { bf16_t* rowp = Q + (size_t)(row0 + ai * HALF + m * 16) * 3072 + col0;
#pragma unroll
                    for (int bj = 0; bj < 2; ++bj) *(u32x4*)(rowp + bj * HALF) = pack8bf(acc[ai][bj][m][0], acc[ai][bj][m][1]); }
        } else {
            const int head = 4 * (u.pn - 8) + wc, i0 = 8 * fq;
#pragma unroll
            for (int ai = 0; ai < 2; ++ai)
#pragma unroll
                for (int m = 0; m < 4; ++m) { const int row = row0 + ai * HALF + m * 16;
                    const f32x4 c0 = *(const f32x4*)(cosT + (size_t)row * 32 + i0), c1 = *(const f32x4*)(cosT + (size_t)row * 32 + i0 + 4);
                    const f32x4 s0 = *(const f32x4*)(sinT + (size_t)row * 32 + i0), s1 = *(const f32x4*)(sinT + (size_t)row * 32 + i0 + 4);
                    const f32x4 x1a = acc[ai][0][m][0], x1b = acc[ai][0][m][1], x2a = acc[ai][1][m][0], x2b = acc[ai][1][m][1];
                    const f32x4 y1a = x1a * c0 - x2a * s0, y1b = x1b * c1 - x2b * s1, y2a = x2a * c0 + x1a * s0, y2b = x2b * c1 + x1b * s1;
                    bf16_t* dst = Q + (size_t)row * 3072 + 2048 + head * 64 + i0;
                    *(u32x4*)dst = pack8bf(y1a, y1b); *(u32x4*)(dst + 32) = pack8bf(y2a, y2b); }
        }
    }
};
struct EpiQkvDil {
    PG8_NOPRE
    static constexpr bool PERM = true, AFTER_DRAIN = false;
    bf16_t* O; const float* cosT; const float* sinT; const PG8_LAS float* rsl;
    __device__ __forceinline__ void operator()(const f32x4 (&acc)[2][2][4][2], const Unit& u, int wr, int wc, int fr, int fq, int ui) const {
        const int row0 = u.pm * BM + wr * 64 + fr;
        const int g = u.pn / 24, rem = u.pn - g * 24, t = rem >> 3, T = rem & 7, sh = 2 * g;
        float r[2][4]; load_rs(r, rsl, wr, fr);
        const size_t plane = ((size_t)(g * 3 + t) * 16 + 2 * T) * 4;
        if (t == 2 || wc != 0) {
            const int dim0 = wc * 32 + 8 * fq;
#pragma unroll
            for (int ai = 0; ai < 2; ++ai)
#pragma unroll
                for (int m = 0; m < 4; ++m) { const int row = row0 + ai * HALF + m * 16, b = row >> 12, s = row & 4095, sp = ((s & ((1 << sh) - 1)) << (12 - sh)) + (s >> sh);
#pragma unroll
                    for (int bj = 0; bj < 2; ++bj) *(u32x4*)(O + ((plane + bj * 4 + b) * 4096 + sp) * 128 + dim0) = pack8bf(acc[ai][bj][m][0] * r[ai][m], acc[ai][bj][m][1] * r[ai][m]); }
        } else {
            const int hh = fq >> 1, i0 = 8 * (fq & 1);
#pragma unroll
            for (int ai = 0; ai < 2; ++ai)
#pragma unroll
                for (int m = 0; m < 4; ++m) { const int row = row0 + ai * HALF + m * 16, b = row >> 12, s = row & 4095, sp = ((s & ((1 << sh) - 1)) << (12 - sh)) + (s >> sh);
                    const f32x4 c0 = *(const f32x4*)(cosT + (size_t)row * 16 + i0), c1 = *(const f32x4*)(cosT + (size_t)row * 16 + i0 + 4);
                    const f32x4 s0 = *(const f32x4*)(sinT + (size_t)row * 16 + i0), s1 = *(const f32x4*)(sinT + (size_t)row * 16 + i0 + 4);
                    const f32x4 x1a = acc[ai][0][m][0] * r[ai][m], x1b = acc[ai][0][m][1] * r[ai][m], x2a = acc[ai][1][m][0] * r[ai][m], x2b = acc[ai][1][m][1] * r[ai][m];
                    const f32x4 y1a = x1a * c0 - x2a * s0, y1b = x1b * c1 - x2b * s1, y2a = x2a * c0 + x1a * s0, y2b = x2b * c1 + x1b * s1;
                    bf16_t* dst = O + ((plane + hh * 4 + b) * 4096 + sp) * 128 + i0;
                    *(u32x4*)dst = pack8bf(y1a, y1b); *(u32x4*)(dst + 16) = pack8bf(y2a, y2b); }
        }
    }
};

template <class Epi, class Sched, bool ALIGN_EPI = false, bool SP2 = false, int EPI_REP = 1>
__device__ __forceinline__ void gemm_phase(PG8_LAS unsigned char* lds, const Gemm g, const Sched& S, const Epi& E) {
    int tid_ = threadIdx.x; asm volatile("" : "+v"(tid_));
    const int tid = tid_, wid = __builtin_amdgcn_readfirstlane(tid >> 6), lane = tid & 63, wr = wid >> 2, wc = wid & 3, fr = lane & 15, fq = lane >> 4;
    const int K = g.K, nt = K / BK;
    unsigned voffA[2], voffB[2];
#pragma unroll
    for (int i = 0; i < 2; ++i) { int R, C; stage_rc(tid * 16 + i * 8192, R, C); const int Rb = Epi::PERM ? ((R & ~31) + perm32(R & 31)) : R;
        voffA[i] = (unsigned)(R * K + C) * 2u; voffB[i] = (unsigned)(Rb * K + C) * 2u; }
    const size_t kstep = (size_t)(BK * 2);
    const size_t hstep = (size_t)HALF * K * 2;
    const size_t tstep = 2 * hstep;
    const unsigned ldsw = (unsigned)wid * 1024u;
    const int aoff = lds_byte(wr * 64 + fr, fq * 8), boff = lds_byte(wc * 32 + fr, fq * 8);
#define PG8_SA(b, h) (((b) * 2 + (h)) * HTB)
#define PG8_SB(b, h) ((4 + (b) * 2 + (h)) * HTB)
#define PG8_STAGE(bufoff, gbase, voff) do { _Pragma("unroll") for (int _i = 0; _i < 2; ++_i) \
        __builtin_amdgcn_global_load_lds((const unsigned*)((const char*)(gbase) + (voff)[_i]), (PG8_LAS unsigned*)(lds + (bufoff) + ldsw + _i * 8192), 16, 0, 0); } while (0)
#define PG8_LDA(dst, b, h) do { _Pragma("unroll") for (int m = 0; m < 4; ++m) _Pragma("unroll") for (int k = 0; k < 2; ++k) dst[m][k] = *(const PG8_LAS bf16x8*)(lds + PG8_SA(b, h) + aoff + m * 2048 + k * 1024); } while (0)
#define PG8_LDB(dst, b, h) do { _Pragma("unroll") for (int n = 0; n < 2; ++n) _Pragma("unroll") for (int k = 0; k < 2; ++k) dst[n][k] = *(const PG8_LAS bf16x8*)(lds + PG8_SB(b, h) + boff + n * 2048 + k * 1024); } while (0)
#define PG8_MMA(ai, bj, At, Bt) do { __builtin_amdgcn_s_setprio(1); _Pragma("unroll") for (int m = 0; m < 4; ++m) _Pragma("unroll") for (int n = 0; n < 2; ++n) _Pragma("unroll") for (int k = 0; k < 2; ++k) \
        acc[ai][bj][m][n] = __builtin_amdgcn_mfma_f32_16x16x32_bf16(Bt[n][k], At[m][k], acc[ai][bj][m][n], 0, 0, 0); __builtin_amdgcn_s_setprio(0); } while (0)
#define PG8_WAIT_V(n) asm volatile("s_waitcnt vmcnt(" #n ")" ::: "memory")
#define PG8_WAIT_L(n) asm volatile("s_waitcnt lgkmcnt(" #n ")" ::: "memory")
#define PG8_BAR __builtin_amdgcn_s_barrier()
#define PG8_SCHED __builtin_amdgcn_sched_barrier(0)
    Unit cur, nxt; int ui = 0;
    typename Epi::Pre pre;
    if (!S.next(0, cur)) return;
    f32x4 acc[2][2][4][2];
#pragma unroll
    for (int a = 0; a < 2; ++a)
#pragma unroll
        for (int b = 0; b < 2; ++b)
#pragma unroll
            for (int m = 0; m < 4; ++m)
#pragma unroll
                for (int n = 0; n < 2; ++n) acc[a][b][m][n] = (f32x4){0.f, 0.f, 0.f, 0.f};
    bf16x8 At[4][2], B0[2][2], B1[2][2];
    const char* cA = (const char*)g.A + (size_t)cur.pm * tstep; const char* cB = (const char*)g.Bt + (size_t)cur.pn * tstep;
    S.a_ready(cur);
    if constexpr (SP2) {
        PG8_STAGE(PG8_SB(0, 0), cB, voffB); PG8_STAGE(PG8_SB(0, 1), cB + hstep, voffB); PG8_STAGE(PG8_SA(0, 0), cA, voffA); PG8_STAGE(PG8_SA(0, 1), cA + hstep, voffA);
        if (wr == 1) PG8_BAR;
        PG8_WAIT_V(2); PG8_BAR;
        PG8_STAGE(PG8_SB(1, 0), cB + kstep, voffB); PG8_STAGE(PG8_SA(1, 0), cA + kstep, voffA); PG8_STAGE(PG8_SB(1, 1), cB + hstep + kstep, voffB);
        PG8_WAIT_V(6); PG8_BAR;
    } else {
        PG8_STAGE(PG8_SB(0, 0), cB, voffB); PG8_STAGE(PG8_SA(0, 0), cA, voffA); PG8_STAGE(PG8_SB(0, 1), cB + hstep, voffB); PG8_STAGE(PG8_SA(0, 1), cA + hstep, voffA);
        if (wr == 1) PG8_BAR;
        PG8_WAIT_V(4); PG8_BAR;
        PG8_STAGE(PG8_SB(1, 0), cB + kstep, voffB); PG8_STAGE(PG8_SA(1, 0), cA + kstep, voffA); PG8_STAGE(PG8_SB(1, 1), cB + hstep + kstep, voffB);
        PG8_WAIT_V(6); PG8_BAR;
    }
    for (;;) {
        const bool has_next = S.next(ui + 1, nxt);
        const char* nA = has_next ? (const char*)g.A + (size_t)nxt.pm * tstep : cA; const char* nB = has_next ? (const char*)g.Bt + (size_t)nxt.pn * tstep : cB;
        for (int t = 0; t < nt; t += 2) {
            const bool last = (t == nt - 2);
            const char* a1 = cA + (size_t)(t + 1) * kstep;
            const char* a2 = last ? nA : cA + (size_t)(t + 2) * kstep; const char* b2 = last ? nB : cB + (size_t)(t + 2) * kstep;
            const char* a3 = a2 + kstep; const char* b3 = b2 + kstep;
            if (last && has_next) S.a_ready(nxt);
            if (t == 0) E.pre_issue(pre, cur, tid, ui); else if (t == 2) E.pre_finish(pre, tid, ui);
            if constexpr (SP2) {
            PG8_LDB(B0, 0, 0); PG8_LDB(B1, 0, 1); PG8_SCHED; PG8_LDA(At, 0, 0); PG8_STAGE(PG8_SA(1, 1), a1 + hstep, voffA);
            PG8_WAIT_V(8); PG8_WAIT_L(0); PG8_BAR; PG8_MMA(0, 0, At, B0); PG8_MMA(0, 1, At, B1); PG8_BAR; PG8_SCHED;
            PG8_LDA(At, 0, 1); PG8_STAGE(PG8_SB(0, 0), b2, voffB); PG8_STAGE(PG8_SB(0, 1), b2 + hstep, voffB); PG8_STAGE(PG8_SA(0, 0), a2, voffA);
            PG8_WAIT_V(8); PG8_WAIT_L(0); PG8_BAR; PG8_MMA(1, 0, At, B0); PG8_MMA(1, 1, At, B1); PG8_BAR; PG8_SCHED;
            PG8_LDB(B0, 1, 0); PG8_LDB(B1, 1, 1); PG8_SCHED; PG8_LDA(At, 1, 0); PG8_STAGE(PG8_SA(0, 1), a2 + hstep, voffA);
            PG8_WAIT_V(8); PG8_WAIT_L(0); PG8_BAR; PG8_MMA(0, 0, At, B0); PG8_MMA(0, 1, At, B1); PG8_BAR; PG8_SCHED;
            PG8_LDA(At, 1, 1); PG8_STAGE(PG8_SB(1, 0), b3, voffB); PG8_STAGE(PG8_SB(1, 1), b3 + hstep, voffB); PG8_STAGE(PG8_SA(1, 0), a3, voffA);
            PG8_WAIT_V(8); PG8_WAIT_L(0); PG8_BAR; PG8_MMA(1, 0, At, B0); PG8_MMA(1, 1, At, B1); PG8_BAR; PG8_SCHED;
            } else {
            PG8_LDB(B0, 0, 0); PG8_SCHED; PG8_LDA(At, 0, 0); PG8_STAGE(PG8_SA(1, 1), a1 + hstep, voffA);
            PG8_WAIT_L(8); PG8_BAR; PG8_WAIT_L(0); PG8_MMA(0, 0, At, B0); PG8_BAR; PG8_SCHED;
            PG8_LDB(B1, 0, 1); PG8_STAGE(PG8_SB(0, 0), b2, voffB);
            PG8_BAR; PG8_WAIT_L(0); PG8_MMA(0, 1, At, B1); PG8_BAR;
            PG8_LDA(At, 0, 1); PG8_STAGE(PG8_SA(0, 0), a2, voffA);
            PG8_BAR; PG8_WAIT_L(0); PG8_MMA(1, 0, At, B0); PG8_BAR; PG8_SCHED;
            PG8_STAGE(PG8_SB(0, 1), b2 + hstep, voffB);
            PG8_WAIT_V(6); PG8_BAR; PG8_MMA(1, 1, At, B1); PG8_BAR;
            PG8_LDB(B0, 1, 0); PG8_SCHED; PG8_LDA(At, 1, 0); PG8_STAGE(PG8_SA(0, 1), a2 + hstep, voffA);
            PG8_WAIT_L(8); PG8_BAR; PG8_WAIT_L(0); PG8_MMA(0, 0, At, B0); PG8_BAR; PG8_SCHED;
            PG8_LDB(B1, 1, 1); PG8_STAGE(PG8_SB(1, 0), b3, voffB);
            PG8_BAR; PG8_WAIT_L(0); PG8_MMA(0, 1, At, B1); PG8_BAR;
            PG8_LDA(At, 1, 1); PG8_STAGE(PG8_SA(1, 0), a3, voffA);
            PG8_BAR; PG8_WAIT_L(0); PG8_MMA(1, 0, At, B0); PG8_BAR; PG8_SCHED;
            PG8_STAGE(PG8_SB(1, 1), b3 + hstep, voffB);
            PG8_WAIT_V(6); PG8_BAR; PG8_MMA(1, 1, At, B1); PG8_BAR;
            }
        }
        if constexpr (ALIGN_EPI) { if (wr == 0) PG8_BAR; }
        if constexpr (!Epi::AFTER_DRAIN) { _Pragma("unroll") for (int rep_ = 0; rep_ < EPI_REP; ++rep_) E(acc, cur, wr, wc, fr, fq, ui); S.done(cur); }
        if (!has_next) break;
#pragma unroll
        for (int a = 0; a < 2; ++a)
#pragma unroll
            for (int b = 0; b < 2; ++b)
#pragma unroll
                for (int m = 0; m < 4; ++m)
#pragma unroll
                    for (int n = 0; n < 2; ++n) acc[a][b][m][n] = (f32x4){0.f, 0.f, 0.f, 0.f};
        cur = nxt; cA = nA; cB = nB; ++ui;
        if constexpr (ALIGN_EPI) { if (wr == 1) PG8_BAR; }
    }
    PG8_WAIT_V(0);
    if constexpr (!ALIGN_EPI) { if (wr == 0) PG8_BAR; }
    PG8_BAR;
    if constexpr (Epi::AFTER_DRAIN) { E.fused(acc, cur, wr, wc, fr, fq, lds, wid, lane); S.done(cur); }
#undef PG8_SA
#undef PG8_SB
#undef PG8_STAGE
#undef PG8_LDA
#undef PG8_LDB
#undef PG8_MMA
#undef PG8_WAIT_V
#undef PG8_WAIT_L
#undef PG8_BAR
#undef PG8_SCHED
}
}
namespace att {
typedef unsigned short bf16;
typedef short bf16x8 __attribute__((ext_vector_type(8)));
typedef short s16x4 __attribute__((ext_vector_type(4)));
typedef float f32x16 __attribute__((ext_vector_type(16)));
typedef float f32x4 __attribute__((ext_vector_type(4)));
typedef unsigned u32x4 __attribute__((ext_vector_type(4)));
constexpr int NW = 8, QBLK = 32, KVBLK = 64, QB = NW * QBLK;
constexpr int SHM_V = KVBLK * 128 * 2, SHM_K = KVBLK * 128 * 2, KPE_ROW = 144, SHM_KPE = KVBLK * KPE_ROW;
constexpr int OFF_V = 0, OFF_K = 2 * SHM_V, OFF_WS = OFF_K + 2 * SHM_K, OFF_KPE = OFF_WS + NW * 64 * 4, OFF_QPE = OFF_KPE + 2 * SHM_KPE, LDS_BYTES = OFF_QPE + NW * 4096;
constexpr float THR = 8.f;

#define KSWZ(row, colB) ((row) * 256 + ((colB) ^ (((row) & 7) << 4)))
#define SBAR() __builtin_amdgcn_sched_barrier(0)
__device__ __forceinline__ int v_st(int k, int c) { const int kk = (k & ~0xC) | ((k & 4) << 1) | ((k & 8) >> 1); return ((kk >> 3) * 4 + (c >> 5)) * 512 + ((kk & 7) * 32 + (c & 31)) * 2; }
__device__ __forceinline__ int v_rd_base(int lane) { return ((lane & 3) << 3) | (((lane >> 2) & 3) << 6) | (((lane >> 4) & 1) << 5) | (((lane >> 5) & 1) << 8); }
constexpr int v_rd_off(int d0, int ks, int half) { return d0 * 512 + ks * 4096 + half * 2048; }
__device__ __forceinline__ int crow(int r, int hi) { return (r & 3) + 8 * (r >> 2) + 4 * hi; }
__device__ __forceinline__ unsigned cvtpk(float lo, float hi) { unsigned r; asm volatile("v_cvt_pk_bf16_f32 %0, %1, %2" : "=v"(r) : "v"(lo), "v"(hi)); return r; }
__device__ __forceinline__ bf16x8 ld8(const bf16* p) { return *reinterpret_cast<const bf16x8*>(p); }
__device__ __forceinline__ void mask_tile(f32x16& p0, f32x16& p1, int dq, unsigned W) {
    const float NEG = -__builtin_inff();
#pragma unroll
    for (int r = 0; r < 16; ++r) {
        const int c = (r & 3) + 8 * (r >> 2);
        if ((unsigned)(dq - c) >= W) p0[r] = NEG;
        if ((unsigned)(dq - c - 32) >= W) p1[r] = NEG;
    }
}
__device__ __forceinline__ void partialSM(f32x16& p0, f32x16& p1, float& m_reg, float& mn, float& alpha, const float scale) {
    float pmax = p0[0]; for (int r = 1; r < 16; ++r) pmax = fmaxf(pmax, p0[r]); for (int r = 0; r < 16; ++r) pmax = fmaxf(pmax, p1[r]);
    { auto rr = __builtin_amdgcn_permlane32_swap(__float_as_uint(pmax), __float_as_uint(pmax), false, false);
      pmax = fmaxf(__uint_as_float(rr[0]), __uint_as_float(rr[1])); }
    const float C2 = 1.4426950408889634f * scale;
    if (__builtin_expect(__all((pmax - m_reg) * scale <= THR), 1)) { mn = m_reg; alpha = 1.f; }
    else { mn = fmaxf(m_reg, pmax); alpha = __builtin_amdgcn_exp2f((m_reg - mn) * C2); m_reg = mn; }
    const float mnL = -mn * C2;
    for (int r = 0; r < 16; ++r) p0[r] = fmaf(p0[r], C2, mnL); for (int r = 0; r < 16; ++r) p1[r] = fmaf(p1[r], C2, mnL);
    for (int r = 0; r < 16; ++r) p0[r] = __builtin_amdgcn_exp2f(p0[r]);
}
__device__ __forceinline__ void finishSM(f32x16& p0, f32x16& p1, float alpha, float& l_reg, bf16x8& pa0, bf16x8& pa1, bf16x8& pa2, bf16x8& pa3) {
    for (int r = 0; r < 16; ++r) p1[r] = __builtin_amdgcn_exp2f(p1[r]);
    float ps = 0; for (int r = 0; r < 16; ++r) ps += p0[r]; for (int r = 0; r < 16; ++r) ps += p1[r];
    { auto rr = __builtin_amdgcn_permlane32_swap(__float_as_uint(ps), __float_as_uint(ps), false, false);
      ps = __uint_as_float(rr[0]) + __uint_as_float(rr[1]); }
    l_reg = l_reg * alpha + ps;
#define PK4(P, B_, OUT) do { unsigned a0 = cvtpk(P[B_+0], P[B_+1]), a1 = cvtpk(P[B_+2], P[B_+3]);                          \
        unsigned b0 = cvtpk(P[B_+4], P[B_+5]), b1 = cvtpk(P[B_+6], P[B_+7]);                                             \
        auto r0 = __builtin_amdgcn_permlane32_swap(a0, b0, false, false); auto r1 = __builtin_amdgcn_permlane32_swap(a1, b1, false, false); \
        u32x4 w = {r0[0], r1[0], r0[1], r1[1]}; OUT = *reinterpret_cast<bf16x8*>(&w); } while (0)
    PK4(p0, 0, pa0); PK4(p0, 8, pa1); PK4(p1, 0, pa2); PK4(p1, 8, pa3);
#undef PK4
}
template <int KB, bool SK, bool PE>
__device__ __forceinline__ void qkt(f32x16& p0, f32x16& p1, const char* lds, int r32, int hi, int wid, int lane, const bf16x8* qr, bool act) {
    if (SK && !act) { const float NEG = -__builtin_inff();
#pragma unroll
        for (int r = 0; r < 16; ++r) { p0[r] = NEG; p1[r] = NEG; } return; }
    p0 = f32x16{}; p1 = f32x16{};
    const char* kb[4];
#pragma unroll
    for (int dd = 0; dd < 4; ++dd) kb[dd] = lds + OFF_K + KB * SHM_K + KSWZ(r32, (dd * 16 + hi * 8) * 2);
#pragma unroll
    for (int d0 = 0; d0 < 8; ++d0) { const char* a = kb[d0 & 3] + (d0 >> 2) * 128;
        bf16x8 b0 = *reinterpret_cast<const bf16x8*>(a);
        bf16x8 b1 = *reinterpret_cast<const bf16x8*>(a + 32 * 256);
        p0 = __builtin_amdgcn_mfma_f32_32x32x16_bf16(b0, qr[d0], p0, 0, 0, 0);
        p1 = __builtin_amdgcn_mfma_f32_32x32x16_bf16(b1, qr[d0], p1, 0, 0, 0); }
    if constexpr (PE) {
        const char* kp = lds + OFF_KPE + KB * SHM_KPE + r32 * KPE_ROW + hi * 16;
        const char* qp = lds + OFF_QPE + wid * 4096 + lane * 16;
#pragma unroll
        for (int d0 = 0; d0 < 4; ++d0) {
            bf16x8 b0 = *reinterpret_cast<const bf16x8*>(kp + d0 * 32);
            bf16x8 b1 = *reinterpret_cast<const bf16x8*>(kp + d0 * 32 + 32 * KPE_ROW);
            bf16x8 qf = *reinterpret_cast<const bf16x8*>(qp + d0 * 1024);
            p0 = __builtin_amdgcn_mfma_f32_32x32x16_bf16(b0, qf, p0, 0, 0, 0);
            p1 = __builtin_amdgcn_mfma_f32_32x32x16_bf16(b1, qf, p1, 0, 0, 0); }
    }
}
template <int VB, bool SK>
__device__ __forceinline__ void pv_tile(f32x16* o, int vb0, bf16x8 pa0, bf16x8 pa1, bf16x8 pa2, bf16x8 pa3, bool act) {
    if (SK && !act) return;
#define TRRD(dst, off) asm volatile("ds_read_b64_tr_b16 %0, %1 offset:%2" : "=&v"(dst) : "v"(vb0), "i"(off) : "memory")
#define PV_D0(d0) do { s16x4 l0, l1, l2, l3, h0, h1, h2, h3; constexpr int b_ = OFF_V + VB * SHM_V + v_rd_off(d0, 0, 0); \
        TRRD(l0, b_); TRRD(h0, b_ + 2048); TRRD(l1, b_ + 4096); TRRD(h1, b_ + 6144); TRRD(l2, b_ + 8192); TRRD(h2, b_ + 10240); TRRD(l3, b_ + 12288); TRRD(h3, b_ + 14336); \
        asm volatile("s_waitcnt lgkmcnt(0)" ::: "memory"); SBAR();   \
        o[d0] = __builtin_amdgcn_mfma_f32_32x32x16_bf16(pa0, (bf16x8){l0[0], l0[1], l0[2], l0[3], h0[0], h0[1], h0[2], h0[3]}, o[d0], 0, 0, 0);   \
        o[d0] = __builtin_amdgcn_mfma_f32_32x32x16_bf16(pa1, (bf16x8){l1[0], l1[1], l1[2], l1[3], h1[0], h1[1], h1[2], h1[3]}, o[d0], 0, 0, 0);   \
        o[d0] = __builtin_amdgcn_mfma_f32_32x32x16_bf16(pa2, (bf16x8){l2[0], l2[1], l2[2], l2[3], h2[0], h2[1], h2[2], h2[3]}, o[d0], 0, 0, 0);   \
        o[d0] = __builtin_amdgcn_mfma_f32_32x32x16_bf16(pa3, (bf16x8){l3[0], l3[1], l3[2], l3[3], h3[0], h3[1], h3[2], h3[3]}, o[d0], 0, 0, 0); } while (0)
    PV_D0(0); PV_D0(1); PV_D0(2); PV_D0(3);
#undef PV_D0
#undef TRRD
}

struct Prm { int qs, kvs, os, qpes, kpes, lses, skv, W; float scale; };
struct BlockRef { const bf16* Q; const bf16* K; const bf16* V; bf16* O; const bf16* Qpe; const bf16* Kpe; float* Lse; int P0; };
template <bool PE> struct Seam { bf16x8 qr[8]; bf16x8 st_v0, st_v1, st_k0, st_k1, st_kp; };
__device__ __forceinline__ int swa_jlo(int P0, int W) { const int lowk = P0 - W + 1; return lowk > 0 ? lowk / KVBLK : 0; }
#define VMW() asm volatile("s_waitcnt vmcnt(0)" ::: "memory")
#define LDG(base, off) (*(const bf16x8*)((const char*)(base) + (off)))
#define SLOAD_H(R_, k0) do { const char* kb__ = (const char*)(R_).K + (size_t)(k0) * P.kvs * 2; const char* vb__ = (const char*)(R_).V + (size_t)(k0) * P.kvs * 2; const size_t h__ = (size_t)32 * P.kvs * 2; \
                              S.st_v0 = LDG(vb__, kvoff); S.st_v1 = LDG(vb__ + h__, kvoff); S.st_k0 = LDG(kb__, kvoff); S.st_k1 = LDG(kb__ + h__, kvoff); \
                              if constexpr (PE) S.st_kp = LDG((const char*)(R_).Kpe + (size_t)(k0) * P.kpes * 2, kpoff); } while (0)
#define SWRITE_HK(bf) do { *(bf16x8*)(K_lds + (bf) * SHM_K + kws) = S.st_k0; *(bf16x8*)(K_lds + (bf) * SHM_K + kws + 32 * 256) = S.st_k1; \
                           if constexpr (PE) *(bf16x8*)(lds + OFF_KPE + (bf) * SHM_KPE + pws) = S.st_kp; } while (0)
#define SWRITE_HV(bf) do { *(bf16x8*)(V_lds + (bf) * SHM_V + vst0) = S.st_v0; *(bf16x8*)(V_lds + (bf) * SHM_V + vst1) = S.st_v1; } while (0)
#define SWRITE_H(bf) do { SWRITE_HV(bf); SWRITE_HK(bf); } while (0)
template <bool PE>
__device__ __forceinline__ void swa_prime(const BlockRef& cur, const Prm& P, char* lds, Seam<PE>& S) {
    int tid_ = threadIdx.x; asm volatile("" : "+v"(tid_));
    const int tid = tid_, wid = __builtin_amdgcn_readfirstlane(tid >> 6), lane = tid & 63, r32 = lane & 31, hi = lane >> 5;
    const int sr = tid >> 4, sc = (tid & 15) * 8, kws = KSWZ(sr, sc * 2); char* K_lds = lds + OFF_K;
    const int pr = tid >> 3, pc = (tid & 7) * 8, pws = pr * KPE_ROW + (tid & 7) * 16;
    const unsigned kvoff = (unsigned)(sr * P.kvs + sc) * 2u, kpoff = (unsigned)(pr * P.kpes + pc) * 2u, qoff = (unsigned)((wid * QBLK + r32) * P.qs + hi * 8) * 2u, qpoff = (unsigned)((wid * QBLK + r32) * P.qpes + hi * 8) * 2u;
    const int kb0 = swa_jlo(cur.P0, P.W) * KVBLK;
#pragma unroll
    for (int d0 = 0; d0 < 8; ++d0) S.qr[d0] = LDG(cur.Q, qoff + d0 * 32);
    if constexpr (PE) {
#pragma unroll
        for (int d0 = 0; d0 < 4; ++d0) *(bf16x8*)(lds + OFF_QPE + wid * 4096 + d0 * 1024 + lane * 16) = LDG(cur.Qpe, qpoff + d0 * 32);
    }
    SLOAD_H(cur, kb0); VMW(); SWRITE_HK(0);
    __syncthreads();
}
template <bool PE, bool SK, bool LSE, bool EARLY>
__device__ __forceinline__ void swa_block(const BlockRef& cur, const BlockRef& nxt, const Prm& P, char* lds, Seam<PE>& S) {
    int tid_ = threadIdx.x; asm volatile("" : "+v"(tid_));
    const int tid = tid_, wid = __builtin_amdgcn_readfirstlane(tid >> 6), lane = tid & 63, r32 = lane & 31, hi = lane >> 5;
    const int W = P.W;
    const int j_lo = swa_jlo(cur.P0, W);
    int j_hi = (cur.P0 + QB - 1) / KVBLK + 1; if (j_hi > P.skv / KVBLK) j_hi = P.skv / KVBLK;
    const int NT = j_hi - j_lo;
    const int kbn = swa_jlo(nxt.P0, W) * KVBLK;
    const int qlo = cur.P0 + wid * QBLK, qm = qlo + r32 - 4 * hi;
    char* V_lds = lds + OFF_V; char* K_lds = lds + OFF_K;
    float* ws = (float*)(lds + OFF_WS) + wid * 64; float* li_l = ws, * al_l = ws + 32;
    float m_reg = -1e30f, l_reg = 0; f32x16 o[4] = {};
    const int sr = tid >> 4, sc = (tid & 15) * 8, vst0 = v_st(sr, sc), vst1 = v_st(32 + sr, sc), kws = KSWZ(sr, sc * 2);
    const int pr = tid >> 3, pc = (tid & 7) * 8, pws = pr * KPE_ROW + (tid & 7) * 16;
    const unsigned kvoff = (unsigned)(sr * P.kvs + sc) * 2u, kpoff = (unsigned)(pr * P.kpes + pc) * 2u;
    const int vb0 = (int)(uintptr_t)lds + v_rd_base(lane);
#define RESC(a) do { if (__any((a) < 1.f)) { if (hi == 0) al_l[r32] = (a); asm volatile("s_waitcnt lgkmcnt(0)" ::: "memory");              \
                     for (int d_ = 0; d_ < 4; ++d_) for (int r = 0; r < 16; ++r) o[d_][r] *= al_l[crow(r, hi)]; } } while (0)
#define KBASE(t) ((j_lo + (t)) * KVBLK)
#define ACT(t) (KBASE(t) <= qlo + QBLK - 1 && KBASE(t) + KVBLK - 1 >= qlo - W + 1)
#define MASKT(P0_, P1_, t) do { const int kb_ = KBASE(t); if ((!SK || ACT(t)) && (kb_ + KVBLK - 1 > qlo || kb_ <= qlo + QBLK - 1 - W)) mask_tile(P0_, P1_, qm - kb_, (unsigned)W); } while (0)
    f32x16 pA0, pA1, pB0, pB1; float mnA, mnB, alA, alB; bf16x8 pa0, pa1, pa2, pa3;
    SWRITE_HV(0); SBAR();
    if (NT > 1) { SLOAD_H(cur, KBASE(1)); }
    SBAR(); qkt<0, SK, PE>(pA0, pA1, lds, r32, hi, wid, lane, S.qr, ACT(0));
    MASKT(pA0, pA1, 0); partialSM(pA0, pA1, m_reg, mnA, alA, P.scale);
    if (NT > 1) { VMW(); SWRITE_H(1); }
    __syncthreads();
#define HALF_STEP(PX0, PX1, mnX, alX, PY0, PY1, alY, t, KB, VB, SB) do {                                                      \
        SBAR(); if (EARLY && (t) + 1 < NT) { SLOAD_H(cur, KBASE((t) + 1)); SBAR(); }                                          \
        qkt<KB, SK, PE>(PX0, PX1, lds, r32, hi, wid, lane, S.qr, ACT(t));                                                     \
        finishSM(PY0, PY1, alY, l_reg, pa0, pa1, pa2, pa3); SBAR();                                                           \
        if (!EARLY && (t) + 1 < NT) { SLOAD_H(cur, KBASE((t) + 1)); SBAR(); }                                                 \
        pv_tile<VB, SK>(o, vb0, pa0, pa1, pa2, pa3, ACT((t) - 1)); MASKT(PX0, PX1, (t)); partialSM(PX0, PX1, m_reg, mnX, alX, P.scale); \
        __syncthreads();                                                                                                      \
        if ((t) + 1 < NT) { VMW(); SWRITE_H(SB); }                                                                            \
        RESC(alX); __syncthreads(); } while (0)
    for (int t = 1; t + 1 < NT; t += 2) {
        HALF_STEP(pB0, pB1, mnB, alB, pA0, pA1, alA, t, 1, 0, 0);
        HALF_STEP(pA0, pA1, mnA, alA, pB0, pB1, alB, t + 1, 0, 1, 1);
    }
    const bool even = (NT & 1) == 0;
    if (even) { SBAR(); qkt<1, SK, PE>(pB0, pB1, lds, r32, hi, wid, lane, S.qr, ACT(NT - 1)); SBAR(); }
    SLOAD_H(nxt, kbn); SBAR();
    { const unsigned qoff = (unsigned)((wid * QBLK + r32) * P.qs + hi * 8) * 2u;
#pragma unroll
      for (int d0 = 0; d0 < 8; ++d0) S.qr[d0] = LDG(nxt.Q, qoff + d0 * 32); }
    bf16x8 qpn[4];
    if constexpr (PE) { const unsigned qpoff = (unsigned)((wid * QBLK + r32) * P.qpes + hi * 8) * 2u;
#pragma unroll
        for (int d0 = 0; d0 < 4; ++d0) qpn[d0] = LDG(nxt.Qpe, qpoff + d0 * 32);
    }
    SBAR();
    finishSM(pA0, pA1, alA, l_reg, pa0, pa1, pa2, pa3); SBAR();
    pv_tile<0, SK>(o, vb0, pa0, pa1, pa2, pa3, ACT(even ? NT - 2 : NT - 1));
    if (even) { MASKT(pB0, pB1, NT - 1); partialSM(pB0, pB1, m_reg, mnB, alB, P.scale); __syncthreads(); RESC(alB);
        finishSM(pB0, pB1, alB, l_reg, pa0, pa1, pa2, pa3); SBAR(); pv_tile<1, SK>(o, vb0, pa0, pa1, pa2, pa3, ACT(NT - 1)); }
    SBAR();
    VMW(); SWRITE_HK(0);
    if constexpr (PE) {
#pragma unroll
        for (int d0 = 0; d0 < 4; ++d0) *(bf16x8*)(lds + OFF_QPE + wid * 4096 + d0 * 1024 + lane * 16) = qpn[d0];
    }
    SBAR();
    if (hi == 0) li_l[r32] = l_reg; asm volatile("s_waitcnt lgkmcnt(0)" ::: "memory");
    float rli[16];
#pragma unroll
    for (int r = 0; r < 16; ++r) rli[r] = __builtin_amdgcn_rcpf(li_l[crow(r, hi)]);
    const unsigned ooff = (unsigned)((wid * QBLK + 4 * hi) * P.os + r32) * 2u;
#pragma unroll
    for (int r = 0; r < 16; ++r) { char* ob = (char*)cur.O + (size_t)((r & 3) + 8 * (r >> 2)) * P.os * 2;
#pragma unroll
        for (int d0 = 0; d0 < 4; ++d0) { const float v = o[d0][r] * rli[r];
            const float vn = __uint_as_float((unsigned)__builtin_amdgcn_update_dpp(0, (int)__float_as_uint(v), 0xB1, 0xF, 0xF, true));
            if ((r32 & 1) == 0) *(unsigned*)(ob + ooff + d0 * 64) = cvtpk(v, vn); } }
    if constexpr (LSE) { if (hi == 0) *(float*)((char*)cur.Lse + (unsigned)((wid * QBLK + r32) * P.lses) * 4u) = m_reg * P.scale + __logf(l_reg); }
    __syncthreads();
#undef RESC
#undef KBASE
#undef ACT
#undef MASKT
#undef HALF_STEP
}
#undef LDG
#undef VMW
#undef SLOAD_H
#undef SWRITE_HK
#undef SWRITE_HV
#undef SWRITE_H
#undef KSWZ
#undef SBAR
}
constexpr int NWAVES = 8;
constexpr int BATCH = 4, SEQ = 4096, DM = 2048, M = BATCH * SEQ;
constexpr int NQKVA = 1280;
constexpr int NQB = 3072, NKVB = 4096, NDIL = 18432, FF = 5632, NUP = 2 * FF;
constexpr float EPS = 1e-6f;
constexpr size_t MiB = (size_t)1 << 20;
constexpr size_t WS_CTL = 0, CTL_ZERO_BYTES = 64 * 1024;
constexpr size_t WS_COSM = 1 * MiB, WS_SINM = 3 * MiB, WS_COSD = 5 * MiB, WS_SIND = 6 * MiB;
constexpr size_t WS_WMLA = 8 * MiB, WMLA_STRIDE = 20 * MiB, WMLA_QKVA = 0, WMLA_QB = 5 * MiB, WMLA_KVB = 8 * MiB, WMLA_WO = 12 * MiB;
constexpr size_t WS_WDIL = WS_WMLA + 2 * WMLA_STRIDE, WDIL_STRIDE = 80 * MiB, WDIL_IN = 0, WDIL_WO = 72 * MiB;
constexpr size_t WS_WFFN = WS_WDIL + 2 * WDIL_STRIDE, WFFN_STRIDE = 66 * MiB, WFFN_UP = 0, WFFN_DOWN = 44 * MiB;
constexpr size_t WS_H = WS_WFFN + 4 * WFFN_STRIDE;
constexpr size_t WS_S = WS_H + 64 * MiB;
constexpr size_t S_QKVA = 0, S_QN = 80 * MiB, S_CKVN = 96 * MiB, S_KPE = 112 * MiB, S_Q = 114 * MiB, S_KV = 210 * MiB, S_AO_MLA = 338 * MiB;
constexpr size_t S_QKV = 0, S_OG = 576 * MiB, S_LSE = 768 * MiB, S_AO_DIL = 771 * MiB;
constexpr size_t S_U = 0, S_ACT = 352 * MiB;
constexpr size_t WS_HALO = WS_S + 835 * MiB, WS_FIX = WS_HALO + 6 * MiB;
constexpr size_t WS_PS = WS_FIX + 6 * MiB, PS_STRIDE = 2 * MiB;
constexpr size_t WS_END = WS_PS + 8 * PS_STRIDE;
static_assert(WS_H == 472 * MiB && WS_END == 1399 * MiB, "d_ws map");
constexpr int CW_BAR = 4096;
constexpr int RING_OFF = 0, RING_BYTES = 131072, LDSCTL_OFF = RING_BYTES, MISC_OFF = LDSCTL_OFF + 320, XH_OFF = RING_BYTES + 1024  , CWL_OFF = XH_OFF + 6144  , RSL_OFF = CWL_OFF + 4096  , LDS_BYTES = 163840;
static_assert(CWL_OFF + 8192 <= LDS_BYTES, "LDS map");
static_assert(att::LDS_BYTES <= RING_BYTES && pg8::STAGE_BYTES <= RING_BYTES, "LDS map");

#define GAS __attribute__((address_space(1)))
#define LAS __attribute__((address_space(3)))
typedef unsigned short bf16;
typedef unsigned v4u __attribute__((ext_vector_type(4)));
typedef unsigned v2u __attribute__((ext_vector_type(2)));
typedef float f32x4 __attribute__((ext_vector_type(4)));
typedef GAS unsigned gu32;
#define RLX_AGENT __ATOMIC_RELAXED, __HIP_MEMORY_SCOPE_AGENT
#define LDS_WAIT() asm volatile("s_waitcnt lgkmcnt(0)" ::: "memory")
__device__ __forceinline__ unsigned pk2(float lo, float hi) { return pg8::cvt_pk_bf16(lo, hi); }
__device__ __forceinline__ float bf_lo(unsigned w) { return __uint_as_float(w << 16); }
__device__ __forceinline__ float bf_hi(unsigned w) { return __uint_as_float(w & 0xffff0000u); }

#define XB_TMO      128
#define XB_XCNT(j)  (256  + 64 * (j))
#define XB_XSUB(j)  (1280 + 64 * (j))
#define XB_XGEN(j)  (2304 + 64 * (j))
#define XB_TOP      3328
#define XB_TOPGEN   3392
#define XCD_BAR_WORDS 3456
#define XB_SPIN_CAP (1u << 18)

__device__ __forceinline__ unsigned xb_ld(unsigned* p)              { return __hip_atomic_load(p, __ATOMIC_RELAXED, __HIP_MEMORY_SCOPE_AGENT); }
__device__ __forceinline__ unsigned xb_add(unsigned* p, unsigned v) { return __hip_atomic_fetch_add(p, v, __ATOMIC_RELAXED, __HIP_MEMORY_SCOPE_AGENT); }
__device__ __forceinline__ unsigned xb_xcc_id() { return (unsigned)__builtin_amdgcn_s_getreg((3 << 11) | 20) & 0xFu; }
#define XB_SPIN(cond, bar) do { unsigned _sp = 0; while (cond) { __builtin_amdgcn_s_sleep(1); \
    if ((++_sp & 255u) == 0u) { if (xb_ld(&(bar)[XB_TMO])) break; if (_sp > XB_SPIN_CAP) { atomicAdd(&(bar)[XB_TMO], 1u); break; } } } } while (0)

struct XcdBarrier {
    unsigned* bar; unsigned x;
    volatile LAS unsigned* st;
};

__device__ __forceinline__ XcdBarrier xcd_barrier_post(unsigned* bar, volatile LAS unsigned* st) {
    XcdBarrier b; b.bar = bar; b.x = xb_xcc_id(); b.st = st;
    if (threadIdx.x == 0) (void)xb_add(&bar[XB_XCNT(b.x)], 1u);
    return b;
}
__device__ __forceinline__ void xcd_barrier_complete(unsigned* bar, unsigned x, unsigned& nloc, unsigned& nx) {
    const unsigned G = gridDim.x * gridDim.y * gridDim.z;
    unsigned sum, cnt, mine, sp = 0u;
    for (;;) {
        sum = 0u; cnt = 0u; mine = 0u;
#pragma unroll
        for (unsigned j = 0; j < 16; ++j) { const unsigned c = xb_ld(&bar[XB_XCNT(j)]); sum += c; cnt += (c > 0u) ? 1u : 0u; mine = (j == x) ? c : mine; }
        if (sum == G) break;
        __builtin_amdgcn_s_sleep(1);
        if ((++sp & 255u) == 0u) { if (xb_ld(&bar[XB_TMO])) break; if (sp > XB_SPIN_CAP) { atomicAdd(&bar[XB_TMO], 1u); break; } }
    }
    nloc = mine > 0u ? mine : 1u; nx = cnt > 0u ? cnt : 1u;
}

__device__ __forceinline__ void xcd_barrier(const XcdBarrier& b) {
    asm volatile("s_waitcnt vmcnt(0)" ::: "memory");
    __syncthreads();
    if (threadIdx.x == 0) {
        __attribute__((address_space(1))) unsigned* barg_ = (__attribute__((address_space(1))) unsigned*)b.bar; unsigned bx_ = b.x;
        asm volatile("" : "+s"(barg_), "+s"(bx_)); unsigned* bar = (unsigned*)barg_;
        __builtin_amdgcn_s_waitcnt(0);
        unsigned nloc = b.st[0], nx = b.st[1];
        if (nloc == 0u) { xcd_barrier_complete(bar, bx_, nloc, nx); b.st[0] = nloc; b.st[1] = nx; }
        const unsigned old = xb_add(&bar[XB_XSUB(bx_)], 1u);
        const unsigned gen = old / nloc;
        if (old + 1u == (gen + 1u) * nloc) {
            __builtin_amdgcn_fence(__ATOMIC_RELEASE, "agent");
            asm volatile("s_waitcnt vmcnt(0)" ::: "memory");
            const unsigned og = xb_add(&bar[XB_TOP], 1u);
            const unsigned tg = og / nx;
            if (og + 1u == (tg + 1u) * nx) xb_add(&bar[XB_TOPGEN], 1u);
            else XB_SPIN(xb_ld(&bar[XB_TOPGEN]) == tg, bar);
            __builtin_amdgcn_fence(__ATOMIC_ACQUIRE, "agent");
            xb_add(&bar[XB_XGEN(bx_)], 1u);
            asm volatile("s_waitcnt vmcnt(0)" ::: "memory");
        } else {
            XB_SPIN(xb_ld(&bar[XB_XGEN(bx_)]) == gen, bar);
            __builtin_amdgcn_fence(__ATOMIC_ACQUIRE, "agent");
            asm volatile("s_waitcnt vmcnt(0)" ::: "memory");
        }
    }
    __syncthreads();
}


__device__ __forceinline__ const void* karg(int k) {
    const __attribute__((address_space(4))) char* kp = (const __attribute__((address_space(4))) char*)__builtin_amdgcn_kernarg_segment_ptr();
    asm volatile("" : "+s"(kp));
    return *(const void* const __attribute__((address_space(4)))*)(kp + 8 * k);
}
#define LANE_IDS() int tid_ = threadIdx.x; asm volatile("" : "+v"(tid_)); const int tid = tid_, lane = tid & 63, wave = __builtin_amdgcn_readfirstlane(tid >> 6); (void)tid; (void)lane; (void)wave
struct Frame {
    LAS unsigned char* lds;
    volatile LAS unsigned* MISC;
    gu32* ctl;
    int vcu, G;
    float* out; unsigned char* wsb;
};
#define SWZ_XOR(v, m) __uint_as_float((unsigned)__builtin_amdgcn_ds_swizzle((int)__float_as_uint(v), (((m) << 10) | 0x1f)))
__device__ __forceinline__ float xor32(float v) { auto rr = __builtin_amdgcn_permlane32_swap(__float_as_uint(v), __float_as_uint(v), false, false); return __uint_as_float((threadIdx.x & 32) ? rr[0] : rr[1]); }
__device__ __forceinline__ float xor1(float v) { return __uint_as_float((unsigned)__builtin_amdgcn_update_dpp(0, (int)__float_as_uint(v), 0xB1, 0xF, 0xF, true)); }
__device__ __forceinline__ float wave_sum(float v) {
    v += SWZ_XOR(v, 1); v += SWZ_XOR(v, 2); v += SWZ_XOR(v, 4); v += SWZ_XOR(v, 8); v += SWZ_XOR(v, 16);
    auto rr = __builtin_amdgcn_permlane32_swap(__float_as_uint(v), __float_as_uint(v), false, false);
    return __uint_as_float(rr[0]) + __uint_as_float(rr[1]);
}
__device__ __forceinline__ float dot4(const f32x4 a) { return (a.x * a.x + a.y * a.y) + (a.z * a.z + a.w * a.w); }

template <int KIND> __device__ __forceinline__ int dest_row(int n) {
    if constexpr (KIND == 0) return n;
    else if constexpr (KIND == 3) return n < 544 ? n : n + 96;
    else if constexpr (KIND == 4) { const int v = n >= FF, c = v ? n - FF : n; return 256 * (c >> 7) + 128 * v + (c & 127); }
    else if constexpr (KIND == 1) {
        const int h = n / 192, d = n - h * 192;
        if (d < 128) return h * 128 + d;
        const int i = d - 128, t = h >> 2, hh = h & 3;
        return 2048 + 256 * t + 32 * hh + (i < 32 ? i : 128 + (i - 32));
    } else {
        const int g = n / 6144, r = n - g * 6144, t = r >> 11, r2 = r & 2047, h = r2 >> 7, d = r2 & 127;
        if (t == 2) return n;
        const int T = h >> 1, hh = h & 1;
        const int tc = d < 16 ? 16 * hh + d : (d < 32 ? 128 + 16 * hh + (d - 16) : hh * 128 + d);
        return g * 6144 + t * 2048 + T * 256 + tc;
    }
}
template <int KIND, bool GAIN> __device__ __forceinline__ void p0_transpose_item(const float* W, const float* gain, int K, int N, bf16* WT, int row_off, LAS float* scr, int item, int lane) {
    const int nblk = N / 32, kb = item / nblk, nb = item - kb * nblk, k0 = 64 * kb, n0 = 32 * nb;
#pragma unroll 8
    for (int i = 0; i < 32; ++i) { const int kk = 2 * i + (lane >> 5); scr[kk * 33 + (lane & 31)] = W[(size_t)(k0 + kk) * N + n0 + (lane & 31)]; }
    LDS_WAIT(); asm volatile("" ::: "memory");
    const int c = lane & 7;
    f32x4 g0 = {1.f, 1.f, 1.f, 1.f}, g1 = g0;
    if constexpr (GAIN) { g0 = *(const f32x4*)(gain + k0 + 8 * c); g1 = *(const f32x4*)(gain + k0 + 8 * c + 4); }
#pragma unroll
    for (int j = 0; j < 4; ++j) { const int n = (lane >> 3) + 8 * j; const LAS float* s = scr + (8 * c) * 33 + n;
        v4u o; o.x = pk2(s[0 * 33] * g0.x, s[1 * 33] * g0.y); o.y = pk2(s[2 * 33] * g0.z, s[3 * 33] * g0.w); o.z = pk2(s[4 * 33] * g1.x, s[5 * 33] * g1.y); o.w = pk2(s[6 * 33] * g1.z, s[7 * 33] * g1.w);
        *(GAS v4u*)(WT + (size_t)(row_off + dest_row<KIND>(n0 + n)) * K + k0 + 8 * c) = o; }
    LDS_WAIT(); asm volatile("" ::: "memory");
}
__device__ const double kRopeRev[32] = {
    0.15915494309189535, 0.10561541722123227, 0.0700865215877985, 0.046509502471476706, 0.03086376340470123, 0.020481231595318977, 0.013591370636193905, 0.009019250376164549,
    0.005985185712713705, 0.00397177664679776, 0.002635675898667414, 0.001749037788521446, 0.001160663641240061, 0.0007702178288757531, 0.0005111175045375439, 0.00033917820861925017,
    0.00022507907903927653, 0.00014936275542995963, 9.911730936901935e-05, 6.577436917438735e-05, 4.364795279280289e-05, 2.8964835496204437e-05, 1.9221100684944863e-05, 1.2755146204410543e-05,
    8.464330808241401e-06, 5.616940400618127e-06, 3.727408601915352e-06, 2.473512961630074e-06, 1.6414262627950345e-06, 1.0892524995776498e-06, 7.228293068832865e-07, 4.796704226907546e-07};

__device__ __forceinline__ void norm_rows_bf16(Frame& F, const float* src, const float* gain, bf16* dst) {
    LANE_IDS();
    const int gw = F.vcu * NWAVES + wave, NGW = F.G * NWAVES;
    f32x4 g[8];
#pragma unroll
    for (int j = 0; j < 8; ++j) g[j] = *(const f32x4*)(gain + 4 * lane + 256 * j);
    for (int m = gw; m < M; m += NGW) {
        const GAS f32x4* xr = (const GAS f32x4*)(src + (size_t)m * DM) + lane;
        f32x4 v[8]; float s = 0.f;
#pragma unroll
        for (int j = 0; j < 8; ++j) { v[j] = xr[64 * j]; s += dot4(v[j]); }
        const float r = 1.0f / sqrtf(wave_sum(s) * (1.0f / DM) + EPS);
        GAS v2u* o8 = (GAS v2u*)(dst + (size_t)m * DM) + lane;
#pragma unroll
        for (int j = 0; j < 8; ++j) { const f32x4 y = (v[j] * r) * g[j]; v2u w; w.x = pk2(y.x, y.y); w.y = pk2(y.z, y.w); o8[64 * j] = w; }
    }
}
__device__ __forceinline__ void norm_rows_f32_inplace(Frame& F, float* x, const float* gain) {
    LANE_IDS();
    const int gw = F.vcu * NWAVES + wave, NGW = F.G * NWAVES;
    f32x4 g[8];
#pragma unroll
    for (int j = 0; j < 8; ++j) g[j] = *(const f32x4*)(gain + 4 * lane + 256 * j);
    for (int m = gw; m < M; m += NGW) {
        GAS f32x4* xr = (GAS f32x4*)(x + (size_t)m * DM) + lane;
        f32x4 v[8]; float s = 0.f;
#pragma unroll
        for (int j = 0; j < 8; ++j) { v[j] = xr[64 * j]; s += dot4(v[j]); }
        const float r = 1.0f / sqrtf(wave_sum(s) * (1.0f / DM) + EPS);
#pragma unroll
        for (int j = 0; j < 8; ++j) xr[64 * j] = (v[j] * r) * g[j];
    }
}

__device__ __forceinline__ void p0_prologue(Frame& F) {
    LANE_IDS();
    LAS float* scr = (LAS float*)(F.lds + RING_OFF + wave * 16384);
    const int gw = F.vcu * NWAVES + wave, NGW = F.G * NWAVES;
    unsigned char* ws = F.wsb;
    constexpr int I0 = 32 * 16, I1 = 32 * 18, I2 = 8 * 96, I3 = 8 * 128, I4 = 32 * 64, I5 = 32 * 576, I6 = 32 * 64, I7 = 32 * 352, I8 = 88 * 64;
    constexpr int NITEMS = 2 * (I0 + I1 + I2 + I3 + I4 + I5 + I6) + 4 * (I7 + I8);
    for (int it = gw; it < NITEMS; it += NGW) {
        int r = it;
        if (r < 2 * I5) { const int l = r / I5; p0_transpose_item<2, true>((const float*)karg(12) + (size_t)l * DM * NDIL, (const float*)karg(2) + (2 * l + 1) * DM, DM, NDIL, (bf16*)(ws + WS_WDIL + l * WDIL_STRIDE + WDIL_IN), 0, scr, r - l * I5, lane); continue; } r -= 2 * I5;
        if (r < 4 * I7) { const int l = r / I7; p0_transpose_item<4, true>((const float*)karg(14) + (size_t)l * DM * NUP, (const float*)karg(3) + l * DM, DM, NUP, (bf16*)(ws + WS_WFFN + l * WFFN_STRIDE + WFFN_UP), 0, scr, r - l * I7, lane); continue; } r -= 4 * I7;
        if (r < 4 * I8) { const int l = r / I8; p0_transpose_item<0, false>((const float*)karg(17) + (size_t)l * FF * DM, nullptr, FF, DM, (bf16*)(ws + WS_WFFN + l * WFFN_STRIDE + WFFN_DOWN), 0, scr, r - l * I8, lane); continue; } r -= 4 * I8;
        if (r < 2 * I6) { const int l = r / I6; p0_transpose_item<0, false>((const float*)karg(13) + (size_t)l * DM * DM, nullptr, DM, DM, (bf16*)(ws + WS_WDIL + l * WDIL_STRIDE + WDIL_WO), 0, scr, r - l * I6, lane); continue; } r -= 2 * I6;
        if (r < 2 * I4) { const int l = r / I4; p0_transpose_item<0, false>((const float*)karg(11) + (size_t)l * DM * DM, nullptr, DM, DM, (bf16*)(ws + WS_WMLA + l * WMLA_STRIDE + WMLA_WO), 0, scr, r - l * I4, lane); continue; } r -= 2 * I4;
        if (r < 2 * I3) { const int l = r / I3; p0_transpose_item<0, false>((const float*)karg(10) + (size_t)l * 512 * NKVB, nullptr, 512, NKVB, (bf16*)(ws + WS_WMLA + l * WMLA_STRIDE + WMLA_KVB), 0, scr, r - l * I3, lane); continue; } r -= 2 * I3;
        if (r < 2 * I2) { const int l = r / I2; p0_transpose_item<1, false>((const float*)karg(7) + (size_t)l * 512 * NQB, nullptr, 512, NQB, (bf16*)(ws + WS_WMLA + l * WMLA_STRIDE + WMLA_QB), 0, scr, r - l * I2, lane); continue; } r -= 2 * I2;
        if (r < 2 * I1) { const int l = r / I1; p0_transpose_item<3, true>((const float*)karg(8) + (size_t)l * DM * 576, (const float*)karg(2) + (2 * l) * DM, DM, 576, (bf16*)(ws + WS_WMLA + l * WMLA_STRIDE + WMLA_QKVA), 512, scr, r - l * I1, lane); continue; } r -= 2 * I1;
        { const int l = r / I0; p0_transpose_item<0, true>((const float*)karg(5) + (size_t)l * DM * 512, (const float*)karg(2) + (2 * l) * DM, DM, 512, (bf16*)(ws + WS_WMLA + l * WMLA_STRIDE + WMLA_QKVA), 0, scr, r - l * I0, lane); }
    }
    const int gt = F.vcu * (NWAVES * 64) + tid, NGT = F.G * NWAVES * 64;
    for (int i = gt; i < 2 * 192 * DM / 8; i += NGT) { const int l = i / (192 * DM / 8), e = i - l * (192 * DM / 8), rr = e / (DM / 8), cc = e - rr * (DM / 8), row = rr < 96 ? 1056 + rr : 1184 + (rr - 96);
        *((GAS v4u*)(ws + WS_WMLA + l * WMLA_STRIDE + WMLA_QKVA + (size_t)row * DM * 2) + cc) = (v4u){0u, 0u, 0u, 0u}; }
    const int* pos = (const int*)karg(1);
    for (int i = gt; i < M * 32; i += NGT) { const int row = i >> 5, k = i & 31;
        const double rev = (double)pos[row] * kRopeRev[k]; const float fr = (float)(rev - __builtin_rint(rev));
        const float c = __builtin_amdgcn_cosf(fr), s = __builtin_amdgcn_sinf(fr);
        ((float*)(ws + WS_COSM))[i] = c; ((float*)(ws + WS_SINM))[i] = s;
        if ((k & 1) == 0) { ((float*)(ws + WS_COSD))[row * 16 + (k >> 1)] = c; ((float*)(ws + WS_SIND))[row * 16 + (k >> 1)] = s; } }
    { const int gwv = F.vcu * NWAVES + wave, NGWv = F.G * NWAVES; const float* x = (const float*)karg(0); bf16* XB = (bf16*)(ws + WS_H); float* ps0 = (float*)(ws + WS_PS);
      for (int m = gwv; m < M; m += NGWv) {
        const GAS f32x4* xr = (const GAS f32x4*)(x + (size_t)m * DM) + lane; f32x4 v[8]; float s = 0.f;
#pragma unroll
        for (int j = 0; j < 8; ++j) { v[j] = xr[64 * j]; s += dot4(v[j]); }
        s = wave_sum(s);
        GAS v2u* o8 = (GAS v2u*)(XB + (size_t)m * DM) + lane;
#pragma unroll
        for (int j = 0; j < 8; ++j) { v2u w; w.x = pk2(v[j].x, v[j].y); w.y = pk2(v[j].z, v[j].w); o8[64 * j] = w; }
        if (lane < 32) ps0[(size_t)m * 32 + lane] = lane == 0 ? s : 0.f; } }
}

__device__ __forceinline__ void mla_mid(Frame& F, int j) {
    LANE_IDS();
    const int gw = ((int)blockIdx.x - 64) * NWAVES + wave, NGW = (F.G - 64) * NWAVES;
    unsigned char* ws = F.wsb;
    const float* qkva = (const float*)(ws + WS_S + S_QKVA);
    bf16* QN = (bf16*)(ws + WS_S + S_QN); bf16* CK = (bf16*)(ws + WS_S + S_CKVN);
    const float* gq = (const float*)karg(6) + j * 512; const float* gk = (const float*)karg(9) + j * 512;
    f32x4 g1[2], g2[2];
#pragma unroll
    for (int t = 0; t < 2; ++t) { g1[t] = *(const f32x4*)(gq + 4 * lane + 256 * t); g2[t] = *(const f32x4*)(gk + 4 * lane + 256 * t); }
    for (int m = gw; m < M; m += NGW) {
        const float* row = qkva + (size_t)m * NQKVA;
        f32x4 a[2], c[2];
#pragma unroll
        for (int t = 0; t < 2; ++t) { a[t] = *(const GAS f32x4*)(row + 4 * lane + 256 * t); c[t] = *(const GAS f32x4*)(row + 512 + 4 * lane + 256 * t); }
        const float ra = 1.0f / sqrtf(wave_sum(dot4(a[0]) + dot4(a[1])) * (1.0f / 512) + EPS);
        const float rc = 1.0f / sqrtf(wave_sum(dot4(c[0]) + dot4(c[1])) * (1.0f / 512) + EPS);
#pragma unroll
        for (int t = 0; t < 2; ++t) { const f32x4 y = (a[t] * ra) * g1[t], z = (c[t] * rc) * g2[t]; v2u w;
            w.x = pk2(y.x, y.y); w.y = pk2(y.z, y.w); *((GAS v2u*)(QN + (size_t)m * 512 + 256 * t) + lane) = w;
            w.x = pk2(z.x, z.y); w.y = pk2(z.z, z.w); *((GAS v2u*)(CK + (size_t)m * 512 + 256 * t) + lane) = w; }
    }
}

__device__ __forceinline__ void dil_merge(Frame& F) {
    LANE_IDS();
    const int gw = F.vcu * NWAVES + wave, NGW = F.G * NWAVES;
    unsigned char* ws = F.wsb;
    const bf16* OG = (const bf16*)(ws + WS_S + S_OG); const float* LSE = (const float*)(ws + WS_S + S_LSE); bf16* AO = (bf16*)(ws + WS_S + S_AO_DIL);
    for (int m = gw; m < M; m += NGW) {
        const int b = m >> 12, s = m & (SEQ - 1);
        const size_t sp0 = s, sp1 = (size_t)(s & 3) * (SEQ / 4) + (s >> 2), sp2 = (size_t)(s & 15) * (SEQ / 16) + (s >> 4);
#pragma unroll
        for (int j = 0; j < 4; ++j) { const int col = 8 * lane + 512 * j, head = col >> 7, dim = col & 127;
            const size_t r0 = ((size_t)(0 * 16 + head) * BATCH + b) * SEQ + sp0, r1 = ((size_t)(1 * 16 + head) * BATCH + b) * SEQ + sp1, r2 = ((size_t)(2 * 16 + head) * BATCH + b) * SEQ + sp2;
            const float l0 = LSE[r0], l1 = LSE[r1], l2 = LSE[r2];
            const float mx = fmaxf(l0, fmaxf(l1, l2)); float e0 = __expf(l0 - mx), e1 = __expf(l1 - mx), e2 = __expf(l2 - mx);
            const float inv = 1.0f / (e0 + e1 + e2); e0 *= inv; e1 *= inv; e2 *= inv;
            const v4u a = *(const GAS v4u*)(OG + r0 * 128 + dim), bb = *(const GAS v4u*)(OG + r1 * 128 + dim), c = *(const GAS v4u*)(OG + r2 * 128 + dim);
            v4u w;
#pragma unroll
            for (int q = 0; q < 4; ++q) w[q] = pk2(e0 * bf_lo(a[q]) + e1 * bf_lo(bb[q]) + e2 * bf_lo(c[q]), e0 * bf_hi(a[q]) + e1 * bf_hi(bb[q]) + e2 * bf_hi(c[q]));
            *(GAS v4u*)(AO + (size_t)m * DM + col) = w; }
    }
}

__device__ __forceinline__ void ffn_fixup(Frame& F, int layer, int pm) {
    LANE_IDS();
    if ((pm & 15) == 0) return;
    unsigned char* ws = F.wsb;
    const float* HALO = (const float*)(ws + WS_HALO); const float* FIX = (const float*)(ws + WS_FIX); bf16* ACT = (bf16*)(ws + WS_S + S_ACT);
    const float* cw = (const float*)karg(15) + (size_t)layer * 3 * NUP;
    for (int idx = tid; idx < 2 * (FF / 8); idx += NWAVES * 64) { const int rs = idx / (FF / 8), ch = (idx - rs * (FF / 8)) * 8;
        float o[8];
#pragma unroll
        for (int e = 0; e < 8; e += 4) {
            f32x4 cg = *(const GAS f32x4*)(FIX + ((size_t)pm * 2 + rs) * NUP + ch + e), cv = *(const GAS f32x4*)(FIX + ((size_t)pm * 2 + rs) * NUP + FF + ch + e);
            const f32x4 u1g = *(const GAS f32x4*)(HALO + ((size_t)(pm - 1) * 2 + 1) * NUP + ch + e), u1v = *(const GAS f32x4*)(HALO + ((size_t)(pm - 1) * 2 + 1) * NUP + FF + ch + e);
            const f32x4 u2g = *(const GAS f32x4*)(HALO + ((size_t)(pm - 1) * 2 + 0) * NUP + ch + e), u2v = *(const GAS f32x4*)(HALO + ((size_t)(pm - 1) * 2 + 0) * NUP + FF + ch + e);
            const f32x4 w0g = *(const f32x4*)(cw + ch + e), w0v = *(const f32x4*)(cw + FF + ch + e), w1g = *(const f32x4*)(cw + NUP + ch + e), w1v = *(const f32x4*)(cw + NUP + FF + ch + e);
            if (rs == 0) { cg = cg + w1g * u1g + w0g * u2g; cv = cv + w1v * u1v + w0v * u2v; } else { cg = cg + w0g * u1g; cv = cv + w0v * u1v; }
#pragma unroll
            for (int k = 0; k < 4; ++k) o[e + k] = cg[k] * __builtin_amdgcn_rcpf(1.0f + __builtin_amdgcn_exp2f(-1.4426950408889634f * cg[k])) * cv[k]; }
        v4u w; w.x = pk2(o[0], o[1]); w.y = pk2(o[2], o[3]); w.z = pk2(o[4], o[5]); w.w = pk2(o[6], o[7]);
        *(GAS v4u*)(ACT + ((size_t)pm * 256 + rs) * FF + ch) = w; }
}

__device__ __forceinline__ void row_scale_table(Frame& F, const float* ps, int pm) {
    LANE_IDS();
    LAS float* rsl = (LAS float*)(F.lds + RSL_OFF);
    if (tid < 256) { const GAS f32x4* p = (const GAS f32x4*)(ps + ((size_t)pm * 256 + tid) * 32); float s = 0.f;
#pragma unroll
        for (int i = 0; i < 8; ++i) { const f32x4 a = p[i]; s += (a.x + a.y) + (a.z + a.w); }
        rsl[tid] = __builtin_amdgcn_rsqf(s * (1.0f / DM) + EPS); }
    __syncthreads();
}

struct MlaRef {
    const bf16* Q; const bf16* KV; const bf16* KPE; bf16* AO; int vcu;
    __device__ __forceinline__ att::BlockRef operator()(int i) const {
        const int I = vcu + 256 * (i >> 1), bh = I >> 3, x = I & 7, qb = (i & 1) ? 15 - x : x, b = bh >> 4, h = bh & 15;
        const size_t row0 = (size_t)b * SEQ + (size_t)qb * 256;
        att::BlockRef r; r.Q = Q + row0 * NQB + h * 128; r.Qpe = Q + row0 * NQB + 2048 + h * 64;
        r.K = KV + (size_t)bh * SEQ * 128; r.V = r.K + (size_t)M * DM; r.Kpe = KPE + (size_t)b * SEQ * 64;
        r.O = AO + row0 * DM + h * 128; r.Lse = nullptr; r.P0 = qb * 256; return r;
    }
};
struct DilRef {
    const bf16* QKV; bf16* OG; float* LSE; int vcu, g;
    __device__ __forceinline__ att::BlockRef operator()(int i) const {
        const int I = vcu + 256 * i, sh = 2 * g, d = 1 << sh, nqbs = 4 - sh;
        const int seq = I >> nqbs, qb = I & ((1 << nqbs) - 1), h = seq & 15, br = seq >> 4, rr = br & (d - 1), b = br >> sh;
        const size_t sp0 = (size_t)rr * (SEQ >> sh), spq = sp0 + (size_t)qb * 256;
        const size_t hb = ((size_t)(g * 3) * 16 + h) * BATCH + b, tstep = (size_t)16 * BATCH * SEQ * 128;
        att::BlockRef r; r.Q = QKV + (hb * SEQ + spq) * 128; r.Qpe = nullptr; r.Kpe = nullptr;
        r.K = QKV + tstep + (hb * SEQ + sp0) * 128; r.V = r.K + tstep;
        const size_t ob = ((size_t)g * 16 + h) * BATCH + b;
        r.O = OG + (ob * SEQ + spq) * 128; r.Lse = LSE + ob * SEQ + spq; r.P0 = qb * 256; return r;
    }
};
template <bool PE, bool SK, bool LSE, bool EARLY, class RefFn>
__device__ __forceinline__ void attn_run(char* lds, const att::Prm& P, int n, const RefFn& ref) {
    att::BlockRef cur = ref(0); att::Seam<PE> S;
    att::swa_prime<PE>(cur, P, lds, S);
    for (int i = 0;; ++i) {
        const bool last = i + 1 >= n;
        const att::BlockRef nxt = last ? cur : ref(i + 1);
        att::swa_block<PE, SK, LSE, EARLY>(cur, nxt, P, lds, S);
        if (last) break;
        cur = nxt;
    }
}

struct Args { const void* in[18]; float* out; unsigned char* ws; };
__global__ void __launch_bounds__(NWAVES * 64, 2) fwd_kernel(Args args) {
    extern __shared__ __attribute__((aligned(16))) unsigned char lds[];
    Frame F;
    F.lds = (LAS unsigned char*)lds;
    F.MISC = (volatile LAS unsigned*)(F.lds + MISC_OFF);
    F.G = gridDim.x; { const int bx = blockIdx.x; F.vcu = (F.G % 8 == 0) ? (bx % 8) * (F.G / 8) + bx / 8 : bx; }
        F.out = args.out; F.wsb = args.ws;
    F.ctl = (gu32*)(args.ws + WS_CTL);
#define ws F.wsb
#define RELAUNDER() asm volatile("" : "+s"(F.vcu), "+s"(F.wsb), "+s"(F.out))
    for (int u = threadIdx.x; u < (LDS_BYTES - LDSCTL_OFF) / 4; u += NWAVES * 64) ((LAS unsigned*)(F.lds + LDSCTL_OFF))[u] = 0u;
    __syncthreads();
    XcdBarrier bar = xcd_barrier_post((unsigned*)(F.ctl + CW_BAR), F.MISC + 8);
#define GRID_BAR() xcd_barrier(bar)
    typedef pg8::StaticOrder SO;
#define GEMMR(EpiT, Aptr, Bptr, N_, K_, Eobj, REP_) do { pg8::Gemm g_{(const bf16*)(Aptr), (const bf16*)(Bptr), M, (N_), (K_)}; SO S_; S_.init(M, (N_), F.G, (int)blockIdx.x); \
        pg8::gemm_phase<EpiT, SO, true, true, REP_>(F.lds + RING_OFF, g_, S_, (Eobj)); } while (0)
#define GEMM(EpiT, Aptr, Bptr, N_, K_, Eobj) GEMMR(EpiT, Aptr, Bptr, N_, K_, Eobj, 1)

    bf16* H = (bf16*)(ws + WS_H);
    const float* cosM = (const float*)(ws + WS_COSM); const float* sinM = (const float*)(ws + WS_SINM);
    const float* cosD = (const float*)(ws + WS_COSD); const float* sinD = (const float*)(ws + WS_SIND);

    p0_prologue(F);
    GRID_BAR();

#define PSP(i) ((float*)(ws + WS_PS + (size_t)(i) * PS_STRIDE))
    const PG8_LAS float* rsl = (const PG8_LAS float*)(F.lds + RSL_OFF);
    const int my_pm = 8 * ((int)blockIdx.x & 7) + (((int)blockIdx.x >> 3) & 7);
    for (int j = 0; j < 2; ++j) {
        {
            RELAUNDER();
            const unsigned char* wl = ws + WS_WMLA + j * WMLA_STRIDE;
            float* QKVA = (float*)(ws + WS_S + S_QKVA); bf16* QN = (bf16*)(ws + WS_S + S_QN); bf16* CK = (bf16*)(ws + WS_S + S_CKVN); bf16* KPE = (bf16*)(ws + WS_S + S_KPE);
            bf16* Q = (bf16*)(ws + WS_S + S_Q); bf16* KV = (bf16*)(ws + WS_S + S_KV); bf16* AO = (bf16*)(ws + WS_S + S_AO_MLA);
            row_scale_table(F, PSP(4 * j), my_pm);
            { pg8::EpiF32Scaled E{QKVA, NQKVA, rsl}; GEMM(pg8::EpiF32Scaled, H, wl + WMLA_QKVA, 1024, DM, E); }
            GRID_BAR();
            if (blockIdx.x < 64) {
                row_scale_table(F, PSP(4 * j), (int)blockIdx.x);
                pg8::Gemm g_{(const bf16*)H, (const bf16*)(wl + WMLA_QKVA), M, NQKVA, DM}; pg8::OneUnit S_{(int)blockIdx.x, 4}; pg8::EpiKpe E{KPE, cosM, sinM, rsl};
                pg8::gemm_phase<pg8::EpiKpe, pg8::OneUnit, true, true>(F.lds + RING_OFF, g_, S_, E);
            } else mla_mid(F, j);
            GRID_BAR();
            { pg8::EpiQMla E{Q, cosM, sinM}; GEMM(pg8::EpiQMla, QN, wl + WMLA_QB, NQB, 512, E); }
            { pg8::EpiKvMla E{KV, KV + (size_t)M * DM}; GEMM(pg8::EpiKvMla, CK, wl + WMLA_KVB, NKVB, 512, E); }
            GRID_BAR();
            RELAUNDER();
            { att::Prm P{NQB, 128, DM, NQB, 64, 0, SEQ, SEQ, 0.07216878364870322f};
              MlaRef R{Q, KV, KPE, AO, F.vcu};
              attn_run<true, false, false, false>((char*)lds + RING_OFF, P, 4, R);
            }
            GRID_BAR();
            if (j == 0) { pg8::EpiResB<true> E{(const float*)karg(0), H, PSP(1), DM}; GEMM(pg8::EpiResB<true>, AO, wl + WMLA_WO, DM, DM, E); }
            else { pg8::EpiResB<false> E{nullptr, H, PSP(5), DM}; GEMM(pg8::EpiResB<false>, AO, wl + WMLA_WO, DM, DM, E); }
            GRID_BAR();
        }
        {
            RELAUNDER();
            const int layer = 2 * j; const unsigned char* wl = ws + WS_WFFN + layer * WFFN_STRIDE;
            bf16* ACT = (bf16*)(ws + WS_S + S_ACT);
            row_scale_table(F, PSP(1 + 4 * j), my_pm);
            { pg8::EpiUpConv E{ACT, (float*)(ws + WS_HALO), (float*)(ws + WS_FIX), (const float*)karg(15) + (size_t)layer * 3 * NUP, (const float*)karg(16) + (size_t)layer * NUP,
                               (PG8_LAS float*)(F.lds + XH_OFF), (PG8_LAS float*)(F.lds + CWL_OFF), rsl};
              GEMM(pg8::EpiUpConv, H, wl + WFFN_UP, NUP, DM, E); }
            GRID_BAR();
            { SO S_; S_.init(M, DM, F.G, (int)blockIdx.x); pg8::Unit u_; for (int i = 0; S_.next(i, u_); ++i) ffn_fixup(F, layer, u_.pm);
              asm volatile("s_waitcnt vmcnt(0)" ::: "memory"); __syncthreads(); }
            { pg8::EpiResB<false> E{nullptr, H, PSP(2 + 4 * j), DM}; GEMM(pg8::EpiResB<false>, ACT, wl + WFFN_DOWN, DM, FF, E); }
            GRID_BAR();
        }
        {
            RELAUNDER();
            const unsigned char* wl = ws + WS_WDIL + j * WDIL_STRIDE;
            bf16* QKV = (bf16*)(ws + WS_S + S_QKV); bf16* OG = (bf16*)(ws + WS_S + S_OG); float* LSE = (float*)(ws + WS_S + S_LSE); bf16* AO = (bf16*)(ws + WS_S + S_AO_DIL);
            row_scale_table(F, PSP(2 + 4 * j), my_pm);
            { pg8::EpiQkvDil E{QKV, cosD, sinD, rsl}; GEMM(pg8::EpiQkvDil, H, wl + WDIL_IN, NDIL, DM, E); }
            GRID_BAR();
#pragma unroll 1
            for (int g = 0; g < 3; ++g) { const int d = 1 << (2 * g);
              att::Prm P{128, 128, 128, 0, 0, 1, SEQ / d, 129, 0.08838834764831845f};
              DilRef R{QKV, OG, LSE, F.vcu, g};
              attn_run<false, true, true, true>((char*)lds + RING_OFF, P, 4, R);
            }
            GRID_BAR();
            dil_merge(F);
            GRID_BAR();
            { pg8::EpiResB<false> E{nullptr, H, PSP(3 + 4 * j), DM}; GEMM(pg8::EpiResB<false>, AO, wl + WDIL_WO, DM, DM, E); }
            GRID_BAR();
        }
        {
            RELAUNDER();
            const int layer = 2 * j + 1; const unsigned char* wl = ws + WS_WFFN + layer * WFFN_STRIDE;
            bf16* ACT = (bf16*)(ws + WS_S + S_ACT);
            row_scale_table(F, PSP(3 + 4 * j), my_pm);
            { pg8::EpiUpConv E{ACT, (float*)(ws + WS_HALO), (float*)(ws + WS_FIX), (const float*)karg(15) + (size_t)layer * 3 * NUP, (const float*)karg(16) + (size_t)layer * NUP,
                               (PG8_LAS float*)(F.lds + XH_OFF), (PG8_LAS float*)(F.lds + CWL_OFF), rsl};
              GEMM(pg8::EpiUpConv, H, wl + WFFN_UP, NUP, DM, E); }
            GRID_BAR();
            { SO S_; S_.init(M, DM, F.G, (int)blockIdx.x); pg8::Unit u_; for (int i = 0; S_.next(i, u_); ++i) ffn_fixup(F, layer, u_.pm);
              asm volatile("s_waitcnt vmcnt(0)" ::: "memory"); __syncthreads(); }
            if (j == 0) { pg8::EpiResB<false> E{nullptr, H, PSP(4), DM}; GEMM(pg8::EpiResB<false>, ACT, wl + WFFN_DOWN, DM, FF, E); }
            else { pg8::EpiResLast E{H, F.out, DM}; GEMM(pg8::EpiResLast, ACT, wl + WFFN_DOWN, DM, FF, E); }
            GRID_BAR();
        }
    }
    RELAUNDER();
    norm_rows_f32_inplace(F, F.out, (const float*)karg(4));
#undef PSP
#undef ws
#undef RELAUNDER
#undef GEMM
#undef GEMMR
#undef GRID_BAR
}

extern "C" void kernel_launch(void* const* d_in, const int* in_sizes, int n_in, void* d_out, int out_size, void* d_ws, size_t ws_size, hipStream_t stream) {
    static int grid = 0;
    if (grid == 0) {
        if (n_in != 18 || in_sizes[0] != M * DM || out_size != M * DM || ws_size < WS_END) {
            fprintf(stderr, "kernel_launch: shape / workspace mismatch (n_in %d, in0 %d, out %d, ws %zu, need %zu); nothing launched\n", n_in, n_in > 0 ? in_sizes[0] : -1, out_size, ws_size, (size_t)WS_END); grid = -1; return; }
        int dev = 0, cus = 0, per_cu = 0;
        if (hipGetDevice(&dev) != hipSuccess || hipDeviceGetAttribute(&cus, hipDeviceAttributeMultiprocessorCount, dev) != hipSuccess) { grid = -1; return; }
        if (hipFuncSetAttribute((const void*)fwd_kernel, hipFuncAttributeMaxDynamicSharedMemorySize, LDS_BYTES) != hipSuccess) { fprintf(stderr, "kernel_launch: hipFuncSetAttribute failed\n"); grid = -1; return; }
        if (hipOccupancyMaxActiveBlocksPerMultiprocessor(&per_cu, (const void*)fwd_kernel, NWAVES * 64, LDS_BYTES) != hipSuccess || per_cu < 1) fprintf(stderr, "kernel_launch: occupancy query reports %d\n", per_cu);
        (void)hipGetLastError();
        if (cus < 256) { fprintf(stderr, "kernel_launch: built for a 256-CU device, found %d CUs; nothing launched\n", cus); grid = -1; return; }
        grid = 256;
    }
    if (grid < 0) return;
    if (hipMemsetAsync((char*)d_ws + WS_CTL, 0, CTL_ZERO_BYTES, stream) != hipSuccess) return;
    Args a{};
    for (int i = 0; i < 18; ++i) a.in[i] = d_in[i];
    a.out = (float*)d_out; a.ws = (unsigned char*)d_ws;
    hipLaunchKernelGGL(fwd_kernel, dim3(grid), dim3(NWAVES * 64), LDS_BYTES, stream, a);
}
```

```cpp
#include <hip/hip_runtime.h>
#include <cstdio>
#include <cstdint>
namespace pg8 {
#define PG8_LAS __attribute__((address_space(3)))
typedef unsigned short bf16_t;
typedef short bf16x8 __attribute__((ext_vector_type(8)));
typedef float f32x4 __attribute__((ext_vector_type(4)));
typedef unsigned u32x4 __attribute__((ext_vector_type(4)));
constexpr int BM = 256, BK = 64, HALF = 128, HTB = HALF * BK * 2  , STAGE_BYTES = 8 * HTB, NXCD = 8, WGM = 8;

__host__ __device__ __forceinline__ int lds_byte(int r, int c) { const int st = (r >> 4) * 2 + (c >> 5), rr = r & 15, cc = c & 31, ob = rr * 64 + cc * 2; return st * 1024 + (ob ^ (((ob >> 9) & 1) << 5)); }
__host__ __device__ __forceinline__ void stage_rc(int b, int& R, int& C) { const int st = b / 1024, sb = b % 1024, swz = sb ^ (((sb >> 9) & 1) << 5); R = (st >> 1) * 16 + swz / 64; C = (st & 1) * 32 + (swz % 64) / 2; }
__host__ __device__ __forceinline__ int perm32(int rho) { const int n = rho >> 4, i = rho & 15; return 8 * (i >> 2) + 4 * n + (i & 3); }

struct Unit { int pm, pn; };
struct Gemm { const bf16_t* A; const bf16_t* Bt; int M, N, K; };

struct StaticOrder {
    int nM, nN, nwg, G, c;
    __host__ __device__ void init(int M, int N, int G_, int c_) { nM = M / BM; nN = N / BM; nwg = nM * nN; G = G_; c = c_; }
    __host__ __device__ __forceinline__ bool next(int i, Unit& u) const {
        const long L = (long)i * G + c; if (L >= nwg) return false;
        int wgid = (int)L; { const int q = nwg / NXCD, r = nwg % NXCD, xcd = wgid % NXCD, off = wgid / NXCD; wgid = (xcd < r ? xcd * (q + 1) : r * (q + 1) + (xcd - r) * q) + off; }
        const int nig = WGM * nN, gid = wgid / nig, fm = gid * WGM, gsz = (nM - fm) < WGM ? (nM - fm) : WGM;
        u.pm = fm + ((wgid % nig) % gsz); u.pn = (wgid % nig) / gsz; return true;
    }
    __device__ __forceinline__ void a_ready(const Unit&) const {}
    __device__ __forceinline__ void done(const Unit&) const {}
};

__device__ __forceinline__ unsigned cvt_pk_bf16(float lo, float hi) { unsigned r; asm volatile("v_cvt_pk_bf16_f32 %0, %1, %2" : "=v"(r) : "v"(lo), "v"(hi)); return r; }
typedef float f32x2 __attribute__((ext_vector_type(2)));
typedef unsigned u32x2 __attribute__((ext_vector_type(2)));
__device__ __forceinline__ u32x4 pack8bf(const f32x4 a, const f32x4 b) { u32x4 w; w.x = cvt_pk_bf16(a[0], a[1]); w.y = cvt_pk_bf16(a[2], a[3]); w.z = cvt_pk_bf16(b[0], b[1]); w.w = cvt_pk_bf16(b[2], b[3]); return w; }
#define PG8_NOPRE struct Pre {}; __device__ __forceinline__ void pre_issue(Pre&, const Unit&, int, int) const {} __device__ __forceinline__ void pre_finish(Pre&, int, int) const {}
struct EpiF32Store {
    PG8_NOPRE
    static constexpr bool PERM = false, AFTER_DRAIN = false;
    float* C; int ldc;
    __device__ __forceinline__ void operator()(const f32x4 (&acc)[2][2][4][2], const Unit& u, int wr, int wc, int fr, int fq, int ui) const {
        const int row0 = u.pm * BM + wr * 64 + fr, col0 = u.pn * BM + wc * 32 + 4 * fq;
#pragma unroll
        for (int ai = 0; ai < 2; ++ai)
#pragma unroll
            for (int m = 0; m < 4; ++m) { float* rowp = C + (size_t)(row0 + ai * HALF + m * 16) * ldc + col0;
#pragma unroll
                for (int bj = 0; bj < 2; ++bj)
#pragma unroll
                    for (int n = 0; n < 2; ++n) *(f32x4*)(rowp + bj * HALF + n * 16) = acc[ai][bj][m][n]; }
    }
};

__device__ __forceinline__ float sum_fq(float v) {
    v += __uint_as_float((unsigned)__builtin_amdgcn_ds_swizzle((int)__float_as_uint(v), ((0x10 << 10) | 0x1f)));
    auto rr = __builtin_amdgcn_permlane32_swap(__float_as_uint(v), __float_as_uint(v), false, false);
    return __uint_as_float(rr[0]) + __uint_as_float(rr[1]);
}
__device__ __forceinline__ float sq4(const f32x4 a) { return (a[0] * a[0] + a[1] * a[1]) + (a[2] * a[2] + a[3] * a[3]); }
__device__ __forceinline__ void load_rs(float (&r)[2][4], const PG8_LAS float* rsl, int wr, int fr) {
#pragma unroll
    for (int ai = 0; ai < 2; ++ai)
#pragma unroll
        for (int m = 0; m < 4; ++m) r[ai][m] = rsl[ai * HALF + wr * 64 + m * 16 + fr]; }
__device__ __forceinline__ void unpack8bf(const u32x4 w, f32x4& a, f32x4& b) {
    a = (f32x4){__uint_as_float(w.x << 16), __uint_as_float(w.x & 0xffff0000u), __uint_as_float(w.y << 16), __uint_as_float(w.y & 0xffff0000u)};
    b = (f32x4){__uint_as_float(w.z << 16), __uint_as_float(w.z & 0xffff0000u), __uint_as_float(w.w << 16), __uint_as_float(w.w & 0xffff0000u)}; }
template <bool BASE_F32> struct EpiResB {
    PG8_NOPRE
    static constexpr bool PERM = true, AFTER_DRAIN = false;
    const float* basef; bf16_t* X; float* ps; int ldc;
    __device__ __forceinline__ void operator()(const f32x4 (&acc)[2][2][4][2], const Unit& u, int wr, int wc, int fr, int fq, int ui) const {
        const int row0 = u.pm * BM + wr * 64 + fr, col0 = u.pn * BM + wc * 32 + 8 * fq;
#pragma unroll
        for (int ai = 0; ai < 2; ++ai) {
            f32x4 bs[4][2][2]; u32x4 bx[4][2];
#pragma unroll
            for (int m = 0; m < 4; ++m) { const size_t off = (size_t)(row0 + ai * HALF + m * 16) * ldc + col0;
#pragma unroll
                for (int bj = 0; bj < 2; ++bj) {
                    if constexpr (BASE_F32) { bs[m][bj][0] = *(const f32x4*)(basef + off + bj * HALF); bs[m][bj][1] = *(const f32x4*)(basef + off + bj * HALF + 4); }
                    else bx[m][bj] = *(const u32x4*)(X + off + bj * HALF); } }
#pragma unroll
            for (int m = 0; m < 4; ++m) { const int row = row0 + ai * HALF + m * 16; const size_t off = (size_t)row * ldc + col0; float q = 0.f;
#pragma unroll
                for (int bj = 0; bj < 2; ++bj) { f32x4 x0, x1;
                    if constexpr (BASE_F32) { x0 = bs[m][bj][0]; x1 = bs[m][bj][1]; } else unpack8bf(bx[m][bj], x0, x1);
                    const f32x4 o0 = x0 + acc[ai][bj][m][0], o1 = x1 + acc[ai][bj][m][1]; q += sq4(o0) + sq4(o1);
                    *(u32x4*)(X + off + bj * HALF) = pack8bf(o0, o1); }
                q = sum_fq(q);
                if (fq == 0) ps[(size_t)row * 32 + u.pn * 4 + wc] = q; }
            asm volatile("" ::: "memory"); }
    }
};
struct EpiResLast {
    PG8_NOPRE
    static constexpr bool PERM = true, AFTER_DRAIN = false;
    const bf16_t* X; float* out; int ldc;
    __device__ __forceinline__ void operator()(const f32x4 (&acc)[2][2][4][2], const Unit& u, int wr, int wc, int fr, int fq, int ui) const {
        const int row0 = u.pm * BM + wr * 64 + fr, col0 = u.pn * BM + wc * 32 + 8 * fq;
#pragma unroll
        for (int ai = 0; ai < 2; ++ai) {
            u32x4 bx[4][2];
#pragma unroll
            for (int m = 0; m < 4; ++m) { const size_t off = (size_t)(row0 + ai * HALF + m * 16) * ldc + col0;
#pragma unroll
                for (int bj = 0; bj < 2; ++bj) bx[m][bj] = *(const u32x4*)(X + off + bj * HALF); }
#pragma unroll
            for (int m = 0; m < 4; ++m) { const size_t off = (size_t)(row0 + ai * HALF + m * 16) * ldc + col0;
#pragma unroll
                for (int bj = 0; bj < 2; ++bj) { f32x4 x0, x1; unpack8bf(bx[m][bj], x0, x1);
                    *(f32x4*)(out + off + bj * HALF) = x0 + acc[ai][bj][m][0]; *(f32x4*)(out + off + bj * HALF + 4) = x1 + acc[ai][bj][m][1]; } }
            asm volatile("" ::: "memory"); }
    }
};
struct EpiF32Scaled {
    PG8_NOPRE
    static constexpr bool PERM = false, AFTER_DRAIN = false;
    float* C; int ldc; const PG8_LAS float* rsl;
    __device__ __forceinline__ void operator()(const f32x4 (&acc)[2][2][4][2], const Unit& u, int wr, int wc, int fr, int fq, int ui) const {
        const int row0 = u.pm * BM + wr * 64 + fr, col0 = u.pn * BM + wc * 32 + 4 * fq;
        float r[2][4]; load_rs(r, rsl, wr, fr);
#pragma unroll
        for (int ai = 0; ai < 2; ++ai)
#pragma unroll
            for (int m = 0; m < 4; ++m) { float* rowp = C + (size_t)(row0 + ai * HALF + m * 16) * ldc + col0;
#pragma unroll
                for (int bj = 0; bj < 2; ++bj)
#pragma unroll
                    for (int n = 0; n < 2; ++n) *(f32x4*)(rowp + bj * HALF + n * 16) = acc[ai][bj][m][n] * r[ai][m]; }
    }
};

struct EpiQaCkv {
    PG8_NOPRE
    static constexpr bool PERM = true, AFTER_DRAIN = false;
    bf16_t* QA; bf16_t* CK; float* pq; const PG8_LAS float* rsl;
    __device__ __forceinline__ void operator()(const f32x4 (&acc)[2][2][4][2], const Unit& u, int wr, int wc, int fr_, int fq_, int ui) const {
        int fr = fr_, fq = fq_; asm volatile("" : "+v"(fr), "+v"(fq));
        const int row0 = u.pm * BM + wr * 64 + fr, col0 = (u.pn & 1) * BM + wc * 32 + 8 * fq;
        bf16_t* D = u.pn < 2 ? QA : CK;
        float r[2][4]; load_rs(r, rsl, wr, fr);
#pragma unroll
        for (int ai = 0; ai < 2; ++ai)
#pragma unroll
            for (int m = 0; m < 4; ++m) { const int row = row0 + ai * HALF + m * 16; float q = 0.f;
#pragma unroll
                for (int bj = 0; bj < 2; ++bj) { const f32x4 o0 = acc[ai][bj][m][0] * r[ai][m], o1 = acc[ai][bj][m][1] * r[ai][m]; q += sq4(o0) + sq4(o1);
                    *(u32x4*)(D + (size_t)row * 512 + col0 + bj * HALF) = pack8bf(o0, o1); }
                q = sum_fq(q);
                if (fq == 0) pq[(size_t)row * 16 + u.pn * 4 + wc] = q; }
    }
};

#define PG8_DPP(old_, src_, ctrl_) __uint_as_float((unsigned)__builtin_amdgcn_update_dpp((int)__float_as_uint(old_), (int)__float_as_uint(src_), (ctrl_), 0xF, 0xF, false))
struct EpiUpConv {
    static constexpr bool PERM = true, AFTER_DRAIN = false;
    bf16_t* ACT; float* HALO; float* FIX; const float* cw; const float* cb;
    PG8_LAS float* xh; PG8_LAS float* cwl; const PG8_LAS float* rsl;
    PG8_NOPRE
    __device__ __forceinline__ void operator()(const f32x4 (&acc_)[2][2][4][2], const Unit& u, int wr, int wc, int fr_, int fq_, int ui) const {
        int fr = fr_, fq = fq_; asm volatile("" : "+v"(fr), "+v"(fq));
        f32x4 (&acc)[2][2][4][2] = const_cast<f32x4 (&)[2][2][4][2]>(acc_);
        { float r[2][4]; load_rs(r, rsl, wr, fr);
#pragma unroll
          for (int ai = 0; ai < 2; ++ai)
#pragma unroll
            for (int bj = 0; bj < 2; ++bj)
#pragma unroll
                for (int m = 0; m < 4; ++m)
#pragma unroll
                    for (int n = 0; n < 2; ++n) acc[ai][bj][m][n] = acc[ai][bj][m][n] * r[ai][m]; }
        const int ch0 = 128 * u.pn + 32 * wc + 8 * fq;
        f32x4 wv = {0.f, 0.f, 0.f, 0.f};
        if (wr == 0) { const int lane = fq * 16 + fr; wv = *(const f32x4*)((wc < 3 ? cw + (size_t)wc * 11264 : cb) + (lane < 32 ? 128 * u.pn + lane * 4 : 5632 + 128 * u.pn + (lane - 32) * 4)); }
        if (fr >= 14) {
#pragma unroll
            for (int ai = 0; ai < 2; ++ai) if (ai == 0 || wr == 0) { PG8_LAS float* b = xh + ((((ai == 0 ? wr : 2) * 4 + wc) * 2 + (fr - 14)) * 4 + fq) * 16;
#pragma unroll
                for (int bj = 0; bj < 2; ++bj)
#pragma unroll
                    for (int n = 0; n < 2; ++n) *(PG8_LAS f32x4*)(b + (bj * 2 + n) * 4) = acc[ai][bj][3][n]; }
            if (wr == 1) { float* hp = HALO + ((size_t)u.pm * 2 + (fr - 14)) * 11264 + ch0;
#pragma unroll
                for (int bj = 0; bj < 2; ++bj)
#pragma unroll
                    for (int n = 0; n < 2; ++n) *(f32x4*)(hp + bj * 5632 + n * 4) = acc[1][bj][3][n]; }
        }
        if (wr == 0) *(PG8_LAS f32x4*)(cwl + wc * 256 + (fq * 16 + fr) * 4) = wv;
        asm volatile("s_waitcnt lgkmcnt(0)" ::: "memory"); __builtin_amdgcn_s_barrier(); asm volatile("" ::: "memory");
        const bool fixtile = (u.pm & 15) != 0;
#pragma unroll
        for (int n = 0; n < 2; ++n) {
            const PG8_LAS float* cwb = cwl + wc * 32 + fq * 8 + n * 4;
#pragma unroll
            for (int ai = 0; ai < 2; ++ai)
#pragma unroll
                for (int m = 0; m < 4; ++m) {
                    f32x4 c[2];
#pragma unroll
                    for (int bj = 0; bj < 2; ++bj) {
                        f32x4 W[4];
#pragma unroll
                        for (int t = 0; t < 4; ++t) W[t] = *(const PG8_LAS f32x4*)(cwb + t * 256 + bj * 128);
                        f32x4 h1 = {0.f, 0.f, 0.f, 0.f}, h2 = {0.f, 0.f, 0.f, 0.f};
                        if (m == 0 && !(ai == 0 && wr == 0)) { const int slot = ai == 0 ? 0 : (wr == 0 ? 1 : 2); const PG8_LAS float* b = xh + (((slot * 4 + wc) * 2) * 4 + fq) * 16 + n * 4 + bj * 8;
                            h2 = *(const PG8_LAS f32x4*)b; h1 = *(const PG8_LAS f32x4*)(b + 64); }
#pragma unroll
                        for (int k = 0; k < 4; ++k) { const float cur = acc[ai][bj][m][n][k]; float x1, z;
                            if (m == 0) { x1 = h1[k]; z = fr == 0 ? h2[k] : h1[k]; }
                            else { const float p = acc[ai][bj][m > 0 ? m - 1 : 0][n][k]; x1 = PG8_DPP(0.f, p, 0x121); z = PG8_DPP(0.f, p, 0x122); }
                            const float t1 = PG8_DPP(x1, cur, 0x111), t2 = PG8_DPP(z, cur, 0x112);
                            c[bj][k] = W[3][k] + W[0][k] * t2 + W[1][k] * t1 + W[2][k] * cur; }
                        __builtin_amdgcn_sched_barrier(0);
                    }
                    const int row = u.pm * BM + ai * HALF + wr * 64 + m * 16 + fr;
                    if (ai == 0 && m == 0 && wr == 0 && fixtile && fr < 2) {
                        float* fp = FIX + ((size_t)u.pm * 2 + fr) * 11264 + ch0 + n * 4;
                        *(f32x4*)fp = c[0]; *(f32x4*)(fp + 5632) = c[1];
                    } else {
                        f32x4 a;
#pragma unroll
                        for (int k = 0; k < 4; ++k) { const float g = c[0][k]; a[k] = g * __builtin_amdgcn_rcpf(1.0f + __builtin_amdgcn_exp2f(-1.4426950408889634f * g)) * c[1][k]; }
                        u32x2 w; w.x = cvt_pk_bf16(a[0], a[1]); w.y = cvt_pk_bf16(a[2], a[3]);
                        *(u32x2*)(ACT + (size_t)row * 5632 + ch0 + n * 4) = w;
                    }
                    asm volatile("" ::: "memory"); __builtin_amdgcn_sched_barrier(0);
                }
        }
    }
};
struct EpiKpe {
    PG8_NOPRE
    static constexpr bool PERM = true, AFTER_DRAIN = false;
    bf16_t* KPE; const float* cosT; const float* sinT; const PG8_LAS float* rsl;
    __device__ __forceinline__ void operator()(const f32x4 (&acc)[2][2][4][2], const Unit& u, int wr, int wc, int fr_, int fq_, int ui) const {
        int fr = fr_, fq = fq_; asm volatile("" : "+v"(fr), "+v"(fq));
        if (wc != 0) return;
        const int row0 = u.pm * BM + wr * 64 + fr, i0 = 8 * fq;
        float r[2][4]; load_rs(r, rsl, wr, fr);
#pragma unroll
        for (int ai = 0; ai < 2; ++ai)
#pragma unroll
            for (int m = 0; m < 4; ++m) { const int row = row0 + ai * HALF + m * 16;
                const f32x4 c0 = *(const f32x4*)(cosT + (size_t)row * 32 + i0), c1 = *(const f32x4*)(cosT + (size_t)row * 32 + i0 + 4);
                const f32x4 s0 = *(const f32x4*)(sinT + (size_t)row * 32 + i0), s1 = *(const f32x4*)(sinT + (size_t)row * 32 + i0 + 4);
                const f32x4 x1a = acc[ai][0][m][0] * r[ai][m], x1b = acc[ai][0][m][1] * r[ai][m], x2a = acc[ai][1][m][0] * r[ai][m], x2b = acc[ai][1][m][1] * r[ai][m];
                const f32x4 y1a = x1a * c0 - x2a * s0, y1b = x1b * c1 - x2b * s1, y2a = x2a * c0 + x1a * s0, y2b = x2b * c1 + x1b * s1;
                bf16_t* dst = KPE + (size_t)row * 64 + i0;
                *(u32x4*)dst = pack8bf(y1a, y1b); *(u32x4*)(dst + 32) = pack8bf(y2a, y2b); }
    }
};
struct PanelUnits { int pm, pn0, n;
    __device__ __forceinline__ bool next(int i, Unit& u) const { if (i >= n) return false; u.pm = pm; u.pn = pn0 + i; return true; }
    __device__ __forceinline__ void a_ready(const Unit&) const {}
    __device__ __forceinline__ void done(const Unit&) const {}
};
struct OneUnit { int pm, pn;
    __device__ __forceinline__ bool next(int i, Unit& u) const { if (i) return false; u.pm = pm; u.pn = pn; return true; }
    __device__ __forceinline__ void a_ready(const Unit&) const {}
    __device__ __forceinline__ void done(const Unit&) const {}
};
struct EpiKvMla {
    PG8_NOPRE
    static constexpr bool PERM = true, AFTER_DRAIN = false;
    bf16_t* KH; bf16_t* VH; const PG8_LAS float* rsl;
    __device__ __forceinline__ void operator()(const f32x4 (&acc)[2][2][4][2], const Unit& u, int wr, int wc, int fr_, int fq_, int ui) const {
        int fr = fr_, fq = fq_; asm volatile("" : "+v"(fr), "+v"(fq));
        const int row0 = u.pm * BM + wr * 64 + fr, dim0 = wc * 32 + 8 * fq;
        float r[2][4]; load_rs(r, rsl, wr, fr);
#pragma unroll
        for (int ai = 0; ai < 2; ++ai)
#pragma unroll
            for (int m = 0; m < 4; ++m) { const int row = row0 + ai * HALF + m * 16, b = row >> 12, s = row & 4095;
                const size_t o = (((size_t)b * 16 + u.pn) * 4096 + s) * 128 + dim0;
                *(u32x4*)(KH + o) = pack8bf(acc[ai][0][m][0] * r[ai][m], acc[ai][0][m][1] * r[ai][m]); *(u32x4*)(VH + o) = pack8bf(acc[ai][1][m][0] * r[ai][m], acc[ai][1][m][1] * r[ai][m]); }
    }
};
struct EpiQMla {
    PG8_NOPRE
    static constexpr bool PERM = true, AFTER_DRAIN = false;
    bf16_t* Q; const float* cosT; const float* sinT; const PG8_LAS float* rsl;
    __device__ __forceinline__ void operator()(const f32x4 (&acc)[2][2][4][2], const Unit& u, int wr, int wc, int fr_, int fq_, int ui) const {
        int fr = fr_, fq = fq_; asm volatile("" : "+v"(fr), "+v"(fq));
        const int row0 = u.pm * BM + wr * 64 + fr;
        float r[2][4]; load_rs(r, rsl, wr, fr);
        if (u.pn < 8) {
            const int col0 = u.pn * BM + wc * 32 + 8 * fq;
#pragma unroll
            for (int ai = 0; ai < 2; ++ai)
#pragma unroll
                for (int m = 0; m < 4; ++m) { bf16_t* rowp = Q + (size_t)(row0 + ai * HALF + m * 16) * 3072 + col0;
#pragma unroll
                    for (int bj = 0; bj < 2; ++bj) *(u32x4*)(rowp + bj * HALF) = pack8bf(acc[ai][bj][m][0] * r[ai][m], acc[ai][bj][m][1] * r[ai][m]); }
        } else {
            const int head = 4 * (u.pn - 8) + wc, i0 = 8 * fq;
#pragma unroll
            for (int ai = 0; ai < 2; ++ai)
#pragma unroll
                for (int m = 0; m < 4; ++m) { const int row = row0 + ai * HALF + m * 16;
                    const f32x4 c0 = *(const f32x4*)(cosT + (size_t)row * 32 + i0), c1 = *(const f32x4*)(cosT + (size_t)row * 32 + i0 + 4);
                    const f32x4 s0 = *(const f32x4*)(sinT + (size_t)row * 32 + i0), s1 = *(const f32x4*)(sinT + (size_t)row * 32 + i0 + 4);
                    const f32x4 x1a = acc[ai][0][m][0] * r[ai][m], x1b = acc[ai][0][m][1] * r[ai][m], x2a = acc[ai][1][m][0] * r[ai][m], x2b = acc[ai][1][m][1] * r[ai][m];
                    const f32x4 y1a = x1a * c0 - x2a * s0, y1b = x1b * c1 - x2b * s1, y2a = x2a * c0 + x1a * s0, y2b = x2b * c1 + x1b * s1;
                    bf16_t* dst = Q + (size_t)row * 3072 + 2048 + head * 64 + i0;
                    *(u32x4*)dst = pack8bf(y1a, y1b); *(u32x4*)(dst + 32) = pack8bf(y2a, y2b); }
        }
    }
};
struct EpiQkvDil {
    PG8_NOPRE
    static constexpr bool PERM = true, AFTER_DRAIN = false;
    bf16_t* O; const float* cosT; const float* sinT; const PG8_LAS float* rsl;
    __device__ __forceinline__ void operator()(const f32x4 (&acc)[2][2][4][2], const Unit& u, int wr, int wc, int fr, int fq, int ui) const {
        const int row0 = u.pm * BM + wr * 64 + fr;
        const int g = u.pn / 24, rem = u.pn - g * 24, t = rem >> 3, T = rem & 7, sh = 2 * g;
        float r[2][4]; load_rs(r, rsl, wr, fr);
        const size_t plane = ((size_t)(g * 3 + t) * 16 + 2 * T) * 4;
        if (t == 2 || wc != 0) {
            const int dim0 = wc * 32 + 8 * fq;
#pragma unroll
            for (int ai = 0; ai < 2; ++ai)
#pragma unroll
                for (int m = 0; m < 4; ++m) { const int row = row0 + ai * HALF + m * 16, b = row >> 12, s = row & 4095, sp = ((s & ((1 << sh) - 1)) << (12 - sh)) + (s >> sh);
#pragma unroll
                    for (int bj = 0; bj < 2; ++bj) *(u32x4*)(O + ((plane + bj * 4 + b) * 4096 + sp) * 128 + dim0) = pack8bf(acc[ai][bj][m][0] * r[ai][m], acc[ai][bj][m][1] * r[ai][m]); }
        } else {
            const int hh = fq >> 1, i0 = 8 * (fq & 1);
#pragma unroll
            for (int ai = 0; ai < 2; ++ai)
#pragma unroll
                for (int m = 0; m < 4; ++m) { const int row = row0 + ai * HALF + m * 16, b = row >> 12, s = row & 4095, sp = ((s & ((1 << sh) - 1)) << (12 - sh)) + (s >> sh);
                    const f32x4 c0 = *(const f32x4*)(cosT + (size_t)row * 16 + i0), c1 = *(const f32x4*)(cosT + (size_t)row * 16 + i0 + 4);
                    const f32x4 s0 = *(const f32x4*)(sinT + (size_t)row * 16 + i0), s1 = *(const f32x4*)(sinT + (size_t)row * 16 + i0 + 4);
                    const f32x4 x1a = acc[ai][0][m][0] * r[ai][m], x1b = acc[ai][0][m][1] * r[ai][m], x2a = acc[ai][1][m][0] * r[ai][m], x2b = acc[ai][1][m][1] * r[ai][m];
                    const f32x4 y1a = x1a * c0 - x2a * s0, y1b = x1b * c1 - x2b * s1, y2a = x2a * c0 + x1a * s0, y2b = x2b * c1 + x1b * s1;
                    bf16_t* dst = O + ((plane + hh * 4 + b) * 4096 + sp) * 128 + i0;
                    *(u32x4*)dst = pack8bf(y1a, y1b); *(u32x4*)(dst + 16) = pack8bf(y2a, y2b); }
        }
    }
};

template <class Epi, class Sched, bool ALIGN_EPI = false, bool SP2 = false, int EPI_REP = 1>
__device__ __forceinline__ void gemm_phase(PG8_LAS unsigned char* lds, const Gemm g, const Sched& S, const Epi& E) {
    int tid_ = threadIdx.x; asm volatile("" : "+v"(tid_));
    const int tid = tid_, wid = __builtin_amdgcn_readfirstlane(tid >> 6), lane = tid & 63, wr = wid >> 2, wc = wid & 3, fr = lane & 15, fq = lane >> 4;
    const int K = g.K, nt = K / BK;
    unsigned voffA[2], voffB[2];
#pragma unroll
    for (int i = 0; i < 2; ++i) { int R, C; stage_rc(tid * 16 + i * 8192, R, C); const int Rb = Epi::PERM ? ((R & ~31) + perm32(R & 31)) : R;
        voffA[i] = (unsigned)(R * K + C) * 2u; voffB[i] = (unsigned)(Rb * K + C) * 2u; }
    const size_t kstep = (size_t)(BK * 2);
    const size_t hstep = (size_t)HALF * K * 2;
    const size_t tstep = 2 * hstep;
    const unsigned ldsw = (unsigned)wid * 1024u;
    const int aoff = lds_byte(wr * 64 + fr, fq * 8), boff = lds_byte(wc * 32 + fr, fq * 8);
#define PG8_SA(b, h) (((b) * 2 + (h)) * HTB)
#define PG8_SB(b, h) ((4 + (b) * 2 + (h)) * HTB)
#define PG8_STAGE(bufoff, gbase, voff) do { _Pragma("unroll") for (int _i = 0; _i < 2; ++_i) \
        __builtin_amdgcn_global_load_lds((const unsigned*)((const char*)(gbase) + (voff)[_i]), (PG8_LAS unsigned*)(lds + (bufoff) + ldsw + _i * 8192), 16, 0, 0); } while (0)
#define PG8_LDA(dst, b, h) do { _Pragma("unroll") for (int m = 0; m < 4; ++m) _Pragma("unroll") for (int k = 0; k < 2; ++k) dst[m][k] = *(const PG8_LAS bf16x8*)(lds + PG8_SA(b, h) + aoff + m * 2048 + k * 1024); } while (0)
#define PG8_LDB(dst, b, h) do { _Pragma("unroll") for (int n = 0; n < 2; ++n) _Pragma("unroll") for (int k = 0; k < 2; ++k) dst[n][k] = *(const PG8_LAS bf16x8*)(lds + PG8_SB(b, h) + boff + n * 2048 + k * 1024); } while (0)
#define PG8_MMA(ai, bj, At, Bt) do { __builtin_amdgcn_s_setprio(1); _Pragma("unroll") for (int m = 0; m < 4; ++m) _Pragma("unroll") for (int n = 0; n < 2; ++n) _Pragma("unroll") for (int k = 0; k < 2; ++k) \
        acc[ai][bj][m][n] = __builtin_amdgcn_mfma_f32_16x16x32_bf16(Bt[n][k], At[m][k], acc[ai][bj][m][n], 0, 0, 0); __builtin_amdgcn_s_setprio(0); } while (0)
#define PG8_WAIT_V(n) asm volatile("s_waitcnt vmcnt(" #n ")" ::: "memory")
#define PG8_WAIT_L(n) asm volatile("s_waitcnt lgkmcnt(" #n ")" ::: "memory")
#define PG8_BAR __builtin_amdgcn_s_barrier()
#define PG8_SCHED __builtin_amdgcn_sched_barrier(0)
    Unit cur, nxt; int ui = 0;
    typename Epi::Pre pre;
    if (!S.next(0, cur)) return;
    f32x4 acc[2][2][4][2];
#pragma unroll
    for (int a = 0; a < 2; ++a)
#pragma unroll
        for (int b = 0; b < 2; ++b)
#pragma unroll
            for (int m = 0; m < 4; ++m)
#pragma unroll
                for (int n = 0; n < 2; ++n) acc[a][b][m][n] = (f32x4){0.f, 0.f, 0.f, 0.f};
    bf16x8 At[4][2], B0[2][2], B1[2][2];
    const char* cA = (const char*)g.A + (size_t)cur.pm * tstep; const char* cB = (const char*)g.Bt + (size_t)cur.pn * tstep;
    S.a_ready(cur);
    if constexpr (SP2) {
        PG8_STAGE(PG8_SB(0, 0), cB, voffB); PG8_STAGE(PG8_SB(0, 1), cB + hstep, voffB); PG8_STAGE(PG8_SA(0, 0), cA, voffA); PG8_STAGE(PG8_SA(0, 1), cA + hstep, voffA);
        if (wr == 1) PG8_BAR;
        PG8_WAIT_V(2); PG8_BAR;
        PG8_STAGE(PG8_SB(1, 0), cB + kstep, voffB); PG8_STAGE(PG8_SA(1, 0), cA + kstep, voffA); PG8_STAGE(PG8_SB(1, 1), cB + hstep + kstep, voffB);
        PG8_WAIT_V(6); PG8_BAR;
    } else {
        PG8_STAGE(PG8_SB(0, 0), cB, voffB); PG8_STAGE(PG8_SA(0, 0), cA, voffA); PG8_STAGE(PG8_SB(0, 1), cB + hstep, voffB); PG8_STAGE(PG8_SA(0, 1), cA + hstep, voffA);
        if (wr == 1) PG8_BAR;
        PG8_WAIT_V(4); PG8_BAR;
        PG8_STAGE(PG8_SB(1, 0), cB + kstep, voffB); PG8_STAGE(PG8_SA(1, 0), cA + kstep, voffA); PG8_STAGE(PG8_SB(1, 1), cB + hstep + kstep, voffB);
        PG8_WAIT_V(6); PG8_BAR;
    }
    for (;;) {
        const bool has_next = S.next(ui + 1, nxt);
        const char* nA = has_next ? (const char*)g.A + (size_t)nxt.pm * tstep : cA; const char* nB = has_next ? (const char*)g.Bt + (size_t)nxt.pn * tstep : cB;
        for (int t = 0; t < nt; t += 2) {
            const bool last = (t == nt - 2);
            const char* a1 = cA + (size_t)(t + 1) * kstep;
            const char* a2 = last ? nA : cA + (size_t)(t + 2) * kstep; const char* b2 = last ? nB : cB + (size_t)(t + 2) * kstep;
            const char* a3 = a2 + kstep; const char* b3 = b2 + kstep;
            if (last && has_next) S.a_ready(nxt);
            if (t == 0) E.pre_issue(pre, cur, tid, ui); else if (t == 2) E.pre_finish(pre, tid, ui);
            if constexpr (SP2) {
            PG8_LDB(B0, 0, 0); PG8_LDB(B1, 0, 1); PG8_SCHED; PG8_LDA(At, 0, 0); PG8_STAGE(PG8_SA(1, 1), a1 + hstep, voffA);
            PG8_WAIT_V(8); PG8_WAIT_L(0); PG8_BAR; PG8_MMA(0, 0, At, B0); PG8_MMA(0, 1, At, B1); PG8_BAR; PG8_SCHED;
            PG8_LDA(At, 0, 1); PG8_STAGE(PG8_SB(0, 0), b2, voffB); PG8_STAGE(PG8_SB(0, 1), b2 + hstep, voffB); PG8_STAGE(PG8_SA(0, 0), a2, voffA);
            PG8_WAIT_V(8); PG8_WAIT_L(0); PG8_BAR; PG8_MMA(1, 0, At, B0); PG8_MMA(1, 1, At, B1); PG8_BAR; PG8_SCHED;
            PG8_LDB(B0, 1, 0); PG8_LDB(B1, 1, 1); PG8_SCHED; PG8_LDA(At, 1, 0); PG8_STAGE(PG8_SA(0, 1), a2 + hstep, voffA);
            PG8_WAIT_V(8); PG8_WAIT_L(0); PG8_BAR; PG8_MMA(0, 0, At, B0); PG8_MMA(0, 1, At, B1); PG8_BAR; PG8_SCHED;
            PG8_LDA(At, 1, 1); PG8_STAGE(PG8_SB(1, 0), b3, voffB); PG8_STAGE(PG8_SB(1, 1), b3 + hstep, voffB); PG8_STAGE(PG8_SA(1, 0), a3, voffA);
            PG8_WAIT_V(8); PG8_WAIT_L(0); PG8_BAR; PG8_MMA(1, 0, At, B0); PG8_MMA(1, 1, At, B1); PG8_BAR; PG8_SCHED;
            } else {
            PG8_LDB(B0, 0, 0); PG8_SCHED; PG8_LDA(At, 0, 0); PG8_STAGE(PG8_SA(1, 1), a1 + hstep, voffA);
            PG8_WAIT_L(8); PG8_BAR; PG8_WAIT_L(0); PG8_MMA(0, 0, At, B0); PG8_BAR; PG8_SCHED;
            PG8_LDB(B1, 0, 1); PG8_STAGE(PG8_SB(0, 0), b2, voffB);
            PG8_BAR; PG8_WAIT_L(0); PG8_MMA(0, 1, At, B1); PG8_BAR;
            PG8_LDA(At, 0, 1); PG8_STAGE(PG8_SA(0, 0), a2, voffA);
            PG8_BAR; PG8_WAIT_L(0); PG8_MMA(1, 0, At, B0); PG8_BAR; PG8_SCHED;
            PG8_STAGE(PG8_SB(0, 1), b2 + hstep, voffB);
            PG8_WAIT_V(6); PG8_BAR; PG8_MMA(1, 1, At, B1); PG8_BAR;
            PG8_LDB(B0, 1, 0); PG8_SCHED; PG8_LDA(At, 1, 0); PG8_STAGE(PG8_SA(0, 1), a2 + hstep, voffA);
            PG8_WAIT_L(8); PG8_BAR; PG8_WAIT_L(0); PG8_MMA(0, 0, At, B0); PG8_BAR; PG8_SCHED;
            PG8_LDB(B1, 1, 1); PG8_STAGE(PG8_SB(1, 0), b3, voffB);
            PG8_BAR; PG8_WAIT_L(0); PG8_MMA(0, 1, At, B1); PG8_BAR;
            PG8_LDA(At, 1, 1); PG8_STAGE(PG8_SA(1, 0), a3, voffA);
            PG8_BAR; PG8_WAIT_L(0); PG8_MMA(1, 0, At, B0); PG8_BAR; PG8_SCHED;
            PG8_STAGE(PG8_SB(1, 1), b3 + hstep, voffB);
            PG8_WAIT_V(6); PG8_BAR; PG8_MMA(1, 1, At, B1); PG8_BAR;
            }
        }
        if constexpr (ALIGN_EPI) { if (wr == 0) PG8_BAR; }
        if constexpr (!Epi::AFTER_DRAIN) { _Pragma("unroll") for (int rep_ = 0; rep_ < EPI_REP; ++rep_) E(acc, cur, wr, wc, fr, fq, ui); S.done(cur); }
        if (!has_next) break;
#pragma unroll
        for (int a = 0; a < 2; ++a)
#pragma unroll
            for (int b = 0; b < 2; ++b)
#pragma unroll
                for (int m = 0; m < 4; ++m)
#pragma unroll
                    for (int n = 0; n < 2; ++n) acc[a][b][m][n] = (f32x4){0.f, 0.f, 0.f, 0.f};
        cur = nxt; cA = nA; cB = nB; ++ui;
        if constexpr (ALIGN_EPI) { if (wr == 1) PG8_BAR; }
    }
    PG8_WAIT_V(0);
    if constexpr (!ALIGN_EPI) { if (wr == 0) PG8_BAR; }
    PG8_BAR;
    if constexpr (Epi::AFTER_DRAIN) { E.fused(acc, cur, wr, wc, fr, fq, lds, wid, lane); S.done(cur); }
#undef PG8_SA
#undef PG8_SB
#undef PG8_STAGE
#undef PG8_LDA
#undef PG8_LDB
#undef PG8_MMA
#undef PG8_WAIT_V
#undef PG8_WAIT_L
#undef PG8_BAR
#undef PG8_SCHED
}
}
namespace att {
typedef unsigned short bf16;
typedef short bf16x8 __attribute__((ext_vector_type(8)));
typedef short s16x4 __attribute__((ext_vector_type(4)));
typedef float f32x16 __attribute__((ext_vector_type(16)));
typedef float f32x4 __attribute__((ext_vector_type(4)));
typedef unsigned u32x4 __attribute__((ext_vector_type(4)));
constexpr int NW = 8, QBLK = 32, KVBLK = 64, QB = NW * QBLK;
constexpr int SHM_V = KVBLK * 128 * 2, SHM_K = KVBLK * 128 * 2, KPE_ROW = 144, SHM_KPE = KVBLK * KPE_ROW;
constexpr int OFF_V = 0, OFF_K = 2 * SHM_V, OFF_WS = OFF_K + 2 * SHM_K, OFF_KPE = OFF_WS + NW * 64 * 4, OFF_QPE = OFF_KPE + 2 * SHM_KPE, LDS_BYTES = OFF_QPE + NW * 4096;
constexpr float THR = 8.f;

#define KSWZ(row, colB) ((row) * 256 + ((colB) ^ (((row) & 7) << 4)))
#define SBAR() __builtin_amdgcn_sched_barrier(0)
__device__ __forceinline__ int v_st(int k, int c) { const int kk = (k & ~0xC) | ((k & 4) << 1) | ((k & 8) >> 1); return ((kk >> 3) * 4 + (c >> 5)) * 512 + ((kk & 7) * 32 + (c & 31)) * 2; }
__device__ __forceinline__ int v_rd_base(int lane) { return ((lane & 3) << 3) | (((lane >> 2) & 3) << 6) | (((lane >> 4) & 1) << 5) | (((lane >> 5) & 1) << 8); }
constexpr int v_rd_off(int d0, int ks, int half) { return d0 * 512 + ks * 4096 + half * 2048; }
__device__ __forceinline__ int crow(int r, int hi) { return (r & 3) + 8 * (r >> 2) + 4 * hi; }
__device__ __forceinline__ unsigned cvtpk(float lo, float hi) { unsigned r; asm volatile("v_cvt_pk_bf16_f32 %0, %1, %2" : "=v"(r) : "v"(lo), "v"(hi)); return r; }
__device__ __forceinline__ bf16x8 ld8(const bf16* p) { return *reinterpret_cast<const bf16x8*>(p); }
__device__ __forceinline__ void mask_tile(f32x16& p0, f32x16& p1, int dq, unsigned W) {
    const float NEG = -__builtin_inff();
#pragma unroll
    for (int r = 0; r < 16; ++r) {
        const int c = (r & 3) + 8 * (r >> 2);
        if ((unsigned)(dq - c) >= W) p0[r] = NEG;
        if ((unsigned)(dq - c - 32) >= W) p1[r] = NEG;
    }
}
__device__ __forceinline__ void partialSM(f32x16& p0, f32x16& p1, float& m_reg, float& mn, float& alpha, const float scale) {
    float pmax = p0[0]; for (int r = 1; r < 16; ++r) pmax = fmaxf(pmax, p0[r]); for (int r = 0; r < 16; ++r) pmax = fmaxf(pmax, p1[r]);
    { auto rr = __builtin_amdgcn_permlane32_swap(__float_as_uint(pmax), __float_as_uint(pmax), false, false);
      pmax = fmaxf(__uint_as_float(rr[0]), __uint_as_float(rr[1])); }
    const float C2 = 1.4426950408889634f * scale;
    if (__builtin_expect(__all((pmax - m_reg) * scale <= THR), 1)) { mn = m_reg; alpha = 1.f; }
    else { mn = fmaxf(m_reg, pmax); alpha = __builtin_amdgcn_exp2f((m_reg - mn) * C2); m_reg = mn; }
    const float mnL = -mn * C2;
    for (int r = 0; r < 16; ++r) p0[r] = fmaf(p0[r], C2, mnL); for (int r = 0; r < 16; ++r) p1[r] = fmaf(p1[r], C2, mnL);
    for (int r = 0; r < 16; ++r) p0[r] = __builtin_amdgcn_exp2f(p0[r]);
}
__device__ __forceinline__ void finishSM(f32x16& p0, f32x16& p1, float alpha, float& l_reg, bf16x8& pa0, bf16x8& pa1, bf16x8& pa2, bf16x8& pa3) {
    for (int r = 0; r < 16; ++r) p1[r] = __builtin_amdgcn_exp2f(p1[r]);
    float ps = 0; for (int r = 0; r < 16; ++r) ps += p0[r]; for (int r = 0; r < 16; ++r) ps += p1[r];
    { auto rr = __builtin_amdgcn_permlane32_swap(__float_as_uint(ps), __float_as_uint(ps), false, false);
      ps = __uint_as_float(rr[0]) + __uint_as_float(rr[1]); }
    l_reg = l_reg * alpha + ps;
#define PK4(P, B_, OUT) do { unsigned a0 = cvtpk(P[B_+0], P[B_+1]), a1 = cvtpk(P[B_+2], P[B_+3]);                          \
        unsigned b0 = cvtpk(P[B_+4], P[B_+5]), b1 = cvtpk(P[B_+6], P[B_+7]);                                             \
        auto r0 = __builtin_amdgcn_permlane32_swap(a0, b0, false, false); auto r1 = __builtin_amdgcn_permlane32_swap(a1, b1, false, false); \
        u32x4 w = {r0[0], r1[0], r0[1], r1[1]}; OUT = *reinterpret_cast<bf16x8*>(&w); } while (0)
    PK4(p0, 0, pa0); PK4(p0, 8, pa1); PK4(p1, 0, pa2); PK4(p1, 8, pa3);
#undef PK4
}
template <int KB, bool SK, bool PE>
__device__ __forceinline__ void qkt(f32x16& p0, f32x16& p1, const char* lds, int r32, int hi, int wid, int lane, const bf16x8* qr, bool act) {
    if (SK && !act) { const float NEG = -__builtin_inff();
#pragma unroll
        for (int r = 0; r < 16; ++r) { p0[r] = NEG; p1[r] = NEG; } return; }
    p0 = f32x16{}; p1 = f32x16{};
    const char* kb[4];
#pragma unroll
    for (int dd = 0; dd < 4; ++dd) kb[dd] = lds + OFF_K + KB * SHM_K + KSWZ(r32, (dd * 16 + hi * 8) * 2);
#pragma unroll
    for (int d0 = 0; d0 < 8; ++d0) { const char* a = kb[d0 & 3] + (d0 >> 2) * 128;
        bf16x8 b0 = *reinterpret_cast<const bf16x8*>(a);
        bf16x8 b1 = *reinterpret_cast<const bf16x8*>(a + 32 * 256);
        p0 = __builtin_amdgcn_mfma_f32_32x32x16_bf16(b0, qr[d0], p0, 0, 0, 0);
        p1 = __builtin_amdgcn_mfma_f32_32x32x16_bf16(b1, qr[d0], p1, 0, 0, 0); }
    if constexpr (PE) {
        const char* kp = lds + OFF_KPE + KB * SHM_KPE + r32 * KPE_ROW + hi * 16;
        const char* qp = lds + OFF_QPE + wid * 4096 + lane * 16;
#pragma unroll
        for (int d0 = 0; d0 < 4; ++d0) {
            bf16x8 b0 = *reinterpret_cast<const bf16x8*>(kp + d0 * 32);
            bf16x8 b1 = *reinterpret_cast<const bf16x8*>(kp + d0 * 32 + 32 * KPE_ROW);
            bf16x8 qf = *reinterpret_cast<const bf16x8*>(qp + d0 * 1024);
            p0 = __builtin_amdgcn_mfma_f32_32x32x16_bf16(b0, qf, p0, 0, 0, 0);
            p1 = __builtin_amdgcn_mfma_f32_32x32x16_bf16(b1, qf, p1, 0, 0, 0); }
    }
}
template <int VB, bool SK>
__device__ __forceinline__ void pv_tile(f32x16* o, int vb0, bf16x8 pa0, bf16x8 pa1, bf16x8 pa2, bf16x8 pa3, bool act) {
    if (SK && !act) return;
#define TRRD(dst, off) asm volatile("ds_read_b64_tr_b16 %0, %1 offset:%2" : "=&v"(dst) : "v"(vb0), "i"(off) : "memory")
#define PV_D0(d0) do { s16x4 l0, l1, l2, l3, h0, h1, h2, h3; constexpr int b_ = OFF_V + VB * SHM_V + v_rd_off(d0, 0, 0); \
        TRRD(l0, b_); TRRD(h0, b_ + 2048); TRRD(l1, b_ + 4096); TRRD(h1, b_ + 6144); TRRD(l2, b_ + 8192); TRRD(h2, b_ + 10240); TRRD(l3, b_ + 12288); TRRD(h3, b_ + 14336); \
        asm volatile("s_waitcnt lgkmcnt(0)" ::: "memory"); SBAR();   \
        o[d0] = __builtin_amdgcn_mfma_f32_32x32x16_bf16(pa0, (bf16x8){l0[0], l0[1], l0[2], l0[3], h0[0], h0[1], h0[2], h0[3]}, o[d0], 0, 0, 0);   \
        o[d0] = __builtin_amdgcn_mfma_f32_32x32x16_bf16(pa1, (bf16x8){l1[0], l1[1], l1[2], l1[3], h1[0], h1[1], h1[2], h1[3]}, o[d0], 0, 0, 0);   \
        o[d0] = __builtin_amdgcn_mfma_f32_32x32x16_bf16(pa2, (bf16x8){l2[0], l2[1], l2[2], l2[3], h2[0], h2[1], h2[2], h2[3]}, o[d0], 0, 0, 0);   \
        o[d0] = __builtin_amdgcn_mfma_f32_32x32x16_bf16(pa3, (bf16x8){l3[0], l3[1], l3[2], l3[3], h3[0], h3[1], h3[2], h3[3]}, o[d0], 0, 0, 0); } while (0)
    PV_D0(0); PV_D0(1); PV_D0(2); PV_D0(3);
#undef PV_D0
#undef TRRD
}

struct Prm { int qs, kvs, os, qpes, kpes, lses, skv, W; float scale; };
struct BlockRef { const bf16* Q; const bf16* K; const bf16* V; bf16* O; const bf16* Qpe; const bf16* Kpe; float* Lse; int P0; };
template <bool PE> struct Seam { bf16x8 qr[8]; bf16x8 st_v0, st_v1, st_k0, st_k1, st_kp; };
__device__ __forceinline__ int swa_jlo(int P0, int W) { const int lowk = P0 - W + 1; return lowk > 0 ? lowk / KVBLK : 0; }
#define VMW() asm volatile("s_waitcnt vmcnt(0)" ::: "memory")
#define LDG(base, off) (*(const bf16x8*)((const char*)(base) + (off)))
#define SLOAD_H(R_, k0) do { const char* kb__ = (const char*)(R_).K + (size_t)(k0) * P.kvs * 2; const char* vb__ = (const char*)(R_).V + (size_t)(k0) * P.kvs * 2; const size_t h__ = (size_t)32 * P.kvs * 2; \
                              S.st_v0 = LDG(vb__, kvoff); S.st_v1 = LDG(vb__ + h__, kvoff); S.st_k0 = LDG(kb__, kvoff); S.st_k1 = LDG(kb__ + h__, kvoff); \
                              if constexpr (PE) S.st_kp = LDG((const char*)(R_).Kpe + (size_t)(k0) * P.kpes * 2, kpoff); } while (0)
#define SWRITE_HK(bf) do { *(bf16x8*)(K_lds + (bf) * SHM_K + kws) = S.st_k0; *(bf16x8*)(K_lds + (bf) * SHM_K + kws + 32 * 256) = S.st_k1; \
                           if constexpr (PE) *(bf16x8*)(lds + OFF_KPE + (bf) * SHM_KPE + pws) = S.st_kp; } while (0)
#define SWRITE_HV(bf) do { *(bf16x8*)(V_lds + (bf) * SHM_V + vst0) = S.st_v0; *(bf16x8*)(V_lds + (bf) * SHM_V + vst1) = S.st_v1; } while (0)
#define SWRITE_H(bf) do { SWRITE_HV(bf); SWRITE_HK(bf); } while (0)
template <bool PE>
__device__ __forceinline__ void swa_prime(const BlockRef& cur, const Prm& P, char* lds, Seam<PE>& S) {
    int tid_ = threadIdx.x; asm volatile("" : "+v"(tid_));
    const int tid = tid_, wid = __builtin_amdgcn_readfirstlane(tid >> 6), lane = tid & 63, r32 = lane & 31, hi = lane >> 5;
    const int sr = tid >> 4, sc = (tid & 15) * 8, kws = KSWZ(sr, sc * 2); char* K_lds = lds + OFF_K;
    const int pr = tid >> 3, pc = (tid & 7) * 8, pws = pr * KPE_ROW + (tid & 7) * 16;
    const unsigned kvoff = (unsigned)(sr * P.kvs + sc) * 2u, kpoff = (unsigned)(pr * P.kpes + pc) * 2u, qoff = (unsigned)((wid * QBLK + r32) * P.qs + hi * 8) * 2u, qpoff = (unsigned)((wid * QBLK + r32) * P.qpes + hi * 8) * 2u;
    const int kb0 = swa_jlo(cur.P0, P.W) * KVBLK;
#pragma unroll
    for (int d0 = 0; d0 < 8; ++d0) S.qr[d0] = LDG(cur.Q, qoff + d0 * 32);
    if constexpr (PE) {
#pragma unroll
        for (int d0 = 0; d0 < 4; ++d0) *(bf16x8*)(lds + OFF_QPE + wid * 4096 + d0 * 1024 + lane * 16) = LDG(cur.Qpe, qpoff + d0 * 32);
    }
    SLOAD_H(cur, kb0); VMW(); SWRITE_HK(0);
    __syncthreads();
}
template <bool PE, bool SK, bool LSE, bool EARLY>
__device__ __forceinline__ void swa_block(const BlockRef& cur, const BlockRef& nxt, const Prm& P, char* lds, Seam<PE>& S) {
    int tid_ = threadIdx.x; asm volatile("" : "+v"(tid_));
    const int tid = tid_, wid = __builtin_amdgcn_readfirstlane(tid >> 6), lane = tid & 63, r32 = lane & 31, hi = lane >> 5;
    const int W = P.W;
    const int j_lo = swa_jlo(cur.P0, W);
    int j_hi = (cur.P0 + QB - 1) / KVBLK + 1; if (j_hi > P.skv / KVBLK) j_hi = P.skv / KVBLK;
    const int NT = j_hi - j_lo;
    const int kbn = swa_jlo(nxt.P0, W) * KVBLK;
    const int qlo = cur.P0 + wid * QBLK, qm = qlo + r32 - 4 * hi;
    char* V_lds = lds + OFF_V; char* K_lds = lds + OFF_K;
    float* ws = (float*)(lds + OFF_WS) + wid * 64; float* li_l = ws, * al_l = ws + 32;
    float m_reg = -1e30f, l_reg = 0; f32x16 o[4] = {};
    const int sr = tid >> 4, sc = (tid & 15) * 8, vst0 = v_st(sr, sc), vst1 = v_st(32 + sr, sc), kws = KSWZ(sr, sc * 2);
    const int pr = tid >> 3, pc = (tid & 7) * 8, pws = pr * KPE_ROW + (tid & 7) * 16;
    const unsigned kvoff = (unsigned)(sr * P.kvs + sc) * 2u, kpoff = (unsigned)(pr * P.kpes + pc) * 2u;
    const int vb0 = (int)(uintptr_t)lds + v_rd_base(lane);
#define RESC(a) do { if (__any((a) < 1.f)) { if (hi == 0) al_l[r32] = (a); asm volatile("s_waitcnt lgkmcnt(0)" ::: "memory");              \
                     for (int d_ = 0; d_ < 4; ++d_) for (int r = 0; r < 16; ++r) o[d_][r] *= al_l[crow(r, hi)]; } } while (0)
#define KBASE(t) ((j_lo + (t)) * KVBLK)
#define ACT(t) (KBASE(t) <= qlo + QBLK - 1 && KBASE(t) + KVBLK - 1 >= qlo - W + 1)
#define MASKT(P0_, P1_, t) do { const int kb_ = KBASE(t); if ((!SK || ACT(t)) && (kb_ + KVBLK - 1 > qlo || kb_ <= qlo + QBLK - 1 - W)) mask_tile(P0_, P1_, qm - kb_, (unsigned)W); } while (0)
    f32x16 pA0, pA1, pB0, pB1; float mnA, mnB, alA, alB; bf16x8 pa0, pa1, pa2, pa3;
    SWRITE_HV(0); SBAR();
    if (NT > 1) { SLOAD_H(cur, KBASE(1)); }
    SBAR(); qkt<0, SK, PE>(pA0, pA1, lds, r32, hi, wid, lane, S.qr, ACT(0));
    MASKT(pA0, pA1, 0); partialSM(pA0, pA1, m_reg, mnA, alA, P.scale);
    if (NT > 1) { VMW(); SWRITE_H(1); }
    __syncthreads();
#define HALF_STEP(PX0, PX1, mnX, alX, PY0, PY1, alY, t, KB, VB, SB) do {                                                      \
        SBAR(); if (EARLY && (t) + 1 < NT) { SLOAD_H(cur, KBASE((t) + 1)); SBAR(); }                                          \
        qkt<KB, SK, PE>(PX0, PX1, lds, r32, hi, wid, lane, S.qr, ACT(t));                                                     \
        finishSM(PY0, PY1, alY, l_reg, pa0, pa1, pa2, pa3); SBAR();                                                           \
        if (!EARLY && (t) + 1 < NT) { SLOAD_H(cur, KBASE((t) + 1)); SBAR(); }                                                 \
        pv_tile<VB, SK>(o, vb0, pa0, pa1, pa2, pa3, ACT((t) - 1)); MASKT(PX0, PX1, (t)); partialSM(PX0, PX1, m_reg, mnX, alX, P.scale); \
        __syncthreads();                                                                                                      \
        if ((t) + 1 < NT) { VMW(); SWRITE_H(SB); }                                                                            \
        RESC(alX); __syncthreads(); } while (0)
    for (int t = 1; t + 1 < NT; t += 2) {
        HALF_STEP(pB0, pB1, mnB, alB, pA0, pA1, alA, t, 1, 0, 0);
        HALF_STEP(pA0, pA1, mnA, alA, pB0, pB1, alB, t + 1, 0, 1, 1);
    }
    const bool even = (NT & 1) == 0;
    if (even) { SBAR(); qkt<1, SK, PE>(pB0, pB1, lds, r32, hi, wid, lane, S.qr, ACT(NT - 1)); SBAR(); }
    SLOAD_H(nxt, kbn); SBAR();
    { const unsigned qoff = (unsigned)((wid * QBLK + r32) * P.qs + hi * 8) * 2u;
#pragma unroll
      for (int d0 = 0; d0 < 8; ++d0) S.qr[d0] = LDG(nxt.Q, qoff + d0 * 32); }
    bf16x8 qpn[4];
    if constexpr (PE) { const unsigned qpoff = (unsigned)((wid * QBLK + r32) * P.qpes + hi * 8) * 2u;
#pragma unroll
        for (int d0 = 0; d0 < 4; ++d0) qpn[d0] = LDG(nxt.Qpe, qpoff + d0 * 32);
    }
    SBAR();
    finishSM(pA0, pA1, alA, l_reg, pa0, pa1, pa2, pa3); SBAR();
    pv_tile<0, SK>(o, vb0, pa0, pa1, pa2, pa3, ACT(even ? NT - 2 : NT - 1));
    if (even) { MASKT(pB0, pB1, NT - 1); partialSM(pB0, pB1, m_reg, mnB, alB, P.scale); __syncthreads(); RESC(alB);
        finishSM(pB0, pB1, alB, l_reg, pa0, pa1, pa2, pa3); SBAR(); pv_tile<1, SK>(o, vb0, pa0, pa1, pa2, pa3, ACT(NT - 1)); }
    SBAR();
    VMW(); SWRITE_HK(0);
    if constexpr (PE) {
#pragma unroll
        for (int d0 = 0; d0 < 4; ++d0) *(bf16x8*)(lds + OFF_QPE + wid * 4096 + d0 * 1024 + lane * 16) = qpn[d0];
    }
    SBAR();
    if (hi == 0) li_l[r32] = l_reg; asm volatile("s_waitcnt lgkmcnt(0)" ::: "memory");
    float rli[16];
#pragma unroll
    for (int r = 0; r < 16; ++r) rli[r] = __builtin_amdgcn_rcpf(li_l[crow(r, hi)]);
    const unsigned ooff = (unsigned)((wid * QBLK + 4 * hi) * P.os + r32) * 2u;
#pragma unroll
    for (int r = 0; r < 16; ++r) { char* ob = (char*)cur.O + (size_t)((r & 3) + 8 * (r >> 2)) * P.os * 2;
#pragma unroll
        for (int d0 = 0; d0 < 4; ++d0) { const float v = o[d0][r] * rli[r];
            const float vn = __uint_as_float((unsigned)__builtin_amdgcn_update_dpp(0, (int)__float_as_uint(v), 0xB1, 0xF, 0xF, true));
            if ((r32 & 1) == 0) *(unsigned*)(ob + ooff + d0 * 64) = cvtpk(v, vn); } }
    if constexpr (LSE) { if (hi == 0) *(float*)((char*)cur.Lse + (unsigned)((wid * QBLK + r32) * P.lses) * 4u) = m_reg * P.scale + __logf(l_reg); }
    __syncthreads();
#undef RESC
#undef KBASE
#undef ACT
#undef MASKT
#undef HALF_STEP
}
#undef LDG
#undef VMW
#undef SLOAD_H
#undef SWRITE_HK
#undef SWRITE_HV
#undef SWRITE_H
#undef KSWZ
#undef SBAR
}
constexpr int NWAVES = 8;
constexpr int BATCH = 4, SEQ = 4096, DM = 2048, M = BATCH * SEQ;
constexpr int NQKVA = 1280;
constexpr int NQB = 3072, NKVB = 4096, NDIL = 18432, FF = 5632, NUP = 2 * FF;
constexpr float EPS = 1e-6f;
constexpr size_t MiB = (size_t)1 << 20;
constexpr size_t WS_CTL = 0, CTL_ZERO_BYTES = 64 * 1024;
constexpr size_t WS_COSM = 1 * MiB, WS_SINM = 3 * MiB, WS_COSD = 5 * MiB, WS_SIND = 6 * MiB;
constexpr size_t WS_WMLA = 8 * MiB, WMLA_STRIDE = 20 * MiB, WMLA_QKVA = 0, WMLA_QB = 5 * MiB, WMLA_KVB = 8 * MiB, WMLA_WO = 12 * MiB;
constexpr size_t WS_WDIL = WS_WMLA + 2 * WMLA_STRIDE, WDIL_STRIDE = 80 * MiB, WDIL_IN = 0, WDIL_WO = 72 * MiB;
constexpr size_t WS_WFFN = WS_WDIL + 2 * WDIL_STRIDE, WFFN_STRIDE = 66 * MiB, WFFN_UP = 0, WFFN_DOWN = 44 * MiB;
constexpr size_t WS_H = WS_WFFN + 4 * WFFN_STRIDE;
constexpr size_t WS_S = WS_H + 64 * MiB;
constexpr size_t S_PQ = 0  , S_QN = 80 * MiB, S_CKVN = 96 * MiB, S_KPE = 112 * MiB, S_Q = 114 * MiB, S_KV = 210 * MiB, S_AO_MLA = 338 * MiB;
constexpr size_t S_QKV = 0, S_OG = 576 * MiB, S_LSE = 768 * MiB, S_AO_DIL = 771 * MiB;
constexpr size_t S_U = 0, S_ACT = 352 * MiB;
constexpr size_t WS_HALO = WS_S + 835 * MiB, WS_FIX = WS_HALO + 6 * MiB;
constexpr size_t WS_PS = WS_FIX + 6 * MiB, PS_STRIDE = 2 * MiB;
constexpr size_t WS_END = WS_PS + 8 * PS_STRIDE;
static_assert(WS_H == 472 * MiB && WS_END == 1399 * MiB, "d_ws map");
constexpr int CW_BAR = 4096;
constexpr int RING_OFF = 0, RING_BYTES = 131072, LDSCTL_OFF = RING_BYTES, MISC_OFF = LDSCTL_OFF + 320, XH_OFF = RING_BYTES + 1024  , CWL_OFF = XH_OFF + 6144  , RSL_OFF = CWL_OFF + 4096  , RSQ_OFF = RSL_OFF + 1024  , LDS_BYTES = 163840;
static_assert(CWL_OFF + 8192 <= LDS_BYTES, "LDS map");
static_assert(att::LDS_BYTES <= RING_BYTES && pg8::STAGE_BYTES <= RING_BYTES, "LDS map");

#define GAS __attribute__((address_space(1)))
#define LAS __attribute__((address_space(3)))
typedef unsigned short bf16;
typedef unsigned v4u __attribute__((ext_vector_type(4)));
typedef unsigned v2u __attribute__((ext_vector_type(2)));
typedef float f32x4 __attribute__((ext_vector_type(4)));
typedef GAS unsigned gu32;
#define RLX_AGENT __ATOMIC_RELAXED, __HIP_MEMORY_SCOPE_AGENT
#define LDS_WAIT() asm volatile("s_waitcnt lgkmcnt(0)" ::: "memory")
__device__ __forceinline__ unsigned pk2(float lo, float hi) { return pg8::cvt_pk_bf16(lo, hi); }
__device__ __forceinline__ float bf_lo(unsigned w) { return __uint_as_float(w << 16); }
__device__ __forceinline__ float bf_hi(unsigned w) { return __uint_as_float(w & 0xffff0000u); }

#define XB_TMO      128
#define XB_XCNT(j)  (256  + 64 * (j))
#define XB_XSUB(j)  (1280 + 64 * (j))
#define XB_XGEN(j)  (2304 + 64 * (j))
#define XB_TOP      3328
#define XB_TOPGEN   3392
#define XCD_BAR_WORDS 3456
#define XB_SPIN_CAP (1u << 18)

__device__ __forceinline__ unsigned xb_ld(unsigned* p)              { return __hip_atomic_load(p, __ATOMIC_RELAXED, __HIP_MEMORY_SCOPE_AGENT); }
__device__ __forceinline__ unsigned xb_add(unsigned* p, unsigned v) { return __hip_atomic_fetch_add(p, v, __ATOMIC_RELAXED, __HIP_MEMORY_SCOPE_AGENT); }
__device__ __forceinline__ unsigned xb_xcc_id() { return (unsigned)__builtin_amdgcn_s_getreg((3 << 11) | 20) & 0xFu; }
#define XB_SPIN(cond, bar) do { unsigned _sp = 0; while (cond) { __builtin_amdgcn_s_sleep(1); \
    if ((++_sp & 255u) == 0u) { if (xb_ld(&(bar)[XB_TMO])) break; if (_sp > XB_SPIN_CAP) { atomicAdd(&(bar)[XB_TMO], 1u); break; } } } } while (0)

struct XcdBarrier {
    unsigned* bar; unsigned x;
    volatile LAS unsigned* st;
};

__device__ __forceinline__ XcdBarrier xcd_barrier_post(unsigned* bar, volatile LAS unsigned* st) {
    XcdBarrier b; b.bar = bar; b.x = xb_xcc_id(); b.st = st;
    if (threadIdx.x == 0) (void)xb_add(&bar[XB_XCNT(b.x)], 1u);
    return b;
}
__device__ __forceinline__ void xcd_barrier_complete(unsigned* bar, unsigned x, unsigned& nloc, unsigned& nx) {
    const unsigned G = gridDim.x * gridDim.y * gridDim.z;
    unsigned sum, cnt, mine, sp = 0u;
    for (;;) {
        sum = 0u; cnt = 0u; mine = 0u;
#pragma unroll
        for (unsigned j = 0; j < 16; ++j) { const unsigned c = xb_ld(&bar[XB_XCNT(j)]); sum += c; cnt += (c > 0u) ? 1u : 0u; mine = (j == x) ? c : mine; }
        if (sum == G) break;
        __builtin_amdgcn_s_sleep(1);
        if ((++sp & 255u) == 0u) { if (xb_ld(&bar[XB_TMO])) break; if (sp > XB_SPIN_CAP) { atomicAdd(&bar[XB_TMO], 1u); break; } }
    }
    nloc = mine > 0u ? mine : 1u; nx = cnt > 0u ? cnt : 1u;
}

__device__ __forceinline__ void xcd_barrier(const XcdBarrier& b) {
    asm volatile("s_waitcnt vmcnt(0)" ::: "memory");
    __syncthreads();
    if (threadIdx.x == 0) {
        __attribute__((address_space(1))) unsigned* barg_ = (__attribute__((address_space(1))) unsigned*)b.bar; unsigned bx_ = b.x;
        asm volatile("" : "+s"(barg_), "+s"(bx_)); unsigned* bar = (unsigned*)barg_;
        __builtin_amdgcn_s_waitcnt(0);
        unsigned nloc = b.st[0], nx = b.st[1];
        if (nloc == 0u) { xcd_barrier_complete(bar, bx_, nloc, nx); b.st[0] = nloc; b.st[1] = nx; }
        const unsigned old = xb_add(&bar[XB_XSUB(bx_)], 1u);
        const unsigned gen = old / nloc;
        if (old + 1u == (gen + 1u) * nloc) {
            __builtin_amdgcn_fence(__ATOMIC_RELEASE, "agent");
            asm volatile("s_waitcnt vmcnt(0)" ::: "memory");
            const unsigned og = xb_add(&bar[XB_TOP], 1u);
            const unsigned tg = og / nx;
            if (og + 1u == (tg + 1u) * nx) xb_add(&bar[XB_TOPGEN], 1u);
            else XB_SPIN(xb_ld(&bar[XB_TOPGEN]) == tg, bar);
            __builtin_amdgcn_fence(__ATOMIC_ACQUIRE, "agent");
            xb_add(&bar[XB_XGEN(bx_)], 1u);
            asm volatile("s_waitcnt vmcnt(0)" ::: "memory");
        } else {
            XB_SPIN(xb_ld(&bar[XB_XGEN(bx_)]) == gen, bar);
            __builtin_amdgcn_fence(__ATOMIC_ACQUIRE, "agent");
            asm volatile("s_waitcnt vmcnt(0)" ::: "memory");
        }
    }
    __syncthreads();
}


__device__ __forceinline__ const void* karg(int k) {
    const __attribute__((address_space(4))) char* kp = (const __attribute__((address_space(4))) char*)__builtin_amdgcn_kernarg_segment_ptr();
    asm volatile("" : "+s"(kp));
    return *(const void* const __attribute__((address_space(4)))*)(kp + 8 * k);
}
#define LANE_IDS() int tid_ = threadIdx.x; asm volatile("" : "+v"(tid_)); const int tid = tid_, lane = tid & 63, wave = __builtin_amdgcn_readfirstlane(tid >> 6); (void)tid; (void)lane; (void)wave
struct Frame {
    LAS unsigned char* lds;
    volatile LAS unsigned* MISC;
    gu32* ctl;
    int vcu, G;
    float* out; unsigned char* wsb;
};
#define SWZ_XOR(v, m) __uint_as_float((unsigned)__builtin_amdgcn_ds_swizzle((int)__float_as_uint(v), (((m) << 10) | 0x1f)))
__device__ __forceinline__ float xor32(float v) { auto rr = __builtin_amdgcn_permlane32_swap(__float_as_uint(v), __float_as_uint(v), false, false); return __uint_as_float((threadIdx.x & 32) ? rr[0] : rr[1]); }
__device__ __forceinline__ float xor1(float v) { return __uint_as_float((unsigned)__builtin_amdgcn_update_dpp(0, (int)__float_as_uint(v), 0xB1, 0xF, 0xF, true)); }
__device__ __forceinline__ float wave_sum(float v) {
    v += SWZ_XOR(v, 1); v += SWZ_XOR(v, 2); v += SWZ_XOR(v, 4); v += SWZ_XOR(v, 8); v += SWZ_XOR(v, 16);
    auto rr = __builtin_amdgcn_permlane32_swap(__float_as_uint(v), __float_as_uint(v), false, false);
    return __uint_as_float(rr[0]) + __uint_as_float(rr[1]);
}
__device__ __forceinline__ float dot4(const f32x4 a) { return (a.x * a.x + a.y * a.y) + (a.z * a.z + a.w * a.w); }

template <int KIND> __device__ __forceinline__ int dest_row(int n) {
    if constexpr (KIND == 0) return n;
    else if constexpr (KIND == 3) return n < 544 ? n : n + 96;
    else if constexpr (KIND == 4) { const int v = n >= FF, c = v ? n - FF : n; return 256 * (c >> 7) + 128 * v + (c & 127); }
    else if constexpr (KIND == 1) {
        const int h = n / 192, d = n - h * 192;
        if (d < 128) return h * 128 + d;
        const int i = d - 128, t = h >> 2, hh = h & 3;
        return 2048 + 256 * t + 32 * hh + (i < 32 ? i : 128 + (i - 32));
    } else {
        const int g = n / 6144, r = n - g * 6144, t = r >> 11, r2 = r & 2047, h = r2 >> 7, d = r2 & 127;
        if (t == 2) return n;
        const int T = h >> 1, hh = h & 1;
        const int tc = d < 16 ? 16 * hh + d : (d < 32 ? 128 + 16 * hh + (d - 16) : hh * 128 + d);
        return g * 6144 + t * 2048 + T * 256 + tc;
    }
}
template <int KIND, bool GAIN> __device__ __forceinline__ void p0_transpose_item(const float* W, const float* gain, int K, int N, bf16* WT, int row_off, LAS float* scr, int item, int lane) {
    const int nblk = N / 32, kb = item / nblk, nb = item - kb * nblk, k0 = 64 * kb, n0 = 32 * nb;
#pragma unroll 8
    for (int i = 0; i < 32; ++i) { const int kk = 2 * i + (lane >> 5); scr[kk * 33 + (lane & 31)] = W[(size_t)(k0 + kk) * N + n0 + (lane & 31)]; }
    LDS_WAIT(); asm volatile("" ::: "memory");
    const int c = lane & 7;
    f32x4 g0 = {1.f, 1.f, 1.f, 1.f}, g1 = g0;
    if constexpr (GAIN) { g0 = *(const f32x4*)(gain + k0 + 8 * c); g1 = *(const f32x4*)(gain + k0 + 8 * c + 4); }
#pragma unroll
    for (int j = 0; j < 4; ++j) { const int n = (lane >> 3) + 8 * j; const LAS float* s = scr + (8 * c) * 33 + n;
        v4u o; o.x = pk2(s[0 * 33] * g0.x, s[1 * 33] * g0.y); o.y = pk2(s[2 * 33] * g0.z, s[3 * 33] * g0.w); o.z = pk2(s[4 * 33] * g1.x, s[5 * 33] * g1.y); o.w = pk2(s[6 * 33] * g1.z, s[7 * 33] * g1.w);
        *(GAS v4u*)(WT + (size_t)(row_off + dest_row<KIND>(n0 + n)) * K + k0 + 8 * c) = o; }
    LDS_WAIT(); asm volatile("" ::: "memory");
}
__device__ const double kRopeRev[32] = {
    0.15915494309189535, 0.10561541722123227, 0.0700865215877985, 0.046509502471476706, 0.03086376340470123, 0.020481231595318977, 0.013591370636193905, 0.009019250376164549,
    0.005985185712713705, 0.00397177664679776, 0.002635675898667414, 0.001749037788521446, 0.001160663641240061, 0.0007702178288757531, 0.0005111175045375439, 0.00033917820861925017,
    0.00022507907903927653, 0.00014936275542995963, 9.911730936901935e-05, 6.577436917438735e-05, 4.364795279280289e-05, 2.8964835496204437e-05, 1.9221100684944863e-05, 1.2755146204410543e-05,
    8.464330808241401e-06, 5.616940400618127e-06, 3.727408601915352e-06, 2.473512961630074e-06, 1.6414262627950345e-06, 1.0892524995776498e-06, 7.228293068832865e-07, 4.796704226907546e-07};

__device__ __forceinline__ void norm_rows_bf16(Frame& F, const float* src, const float* gain, bf16* dst) {
    LANE_IDS();
    const int gw = F.vcu * NWAVES + wave, NGW = F.G * NWAVES;
    f32x4 g[8];
#pragma unroll
    for (int j = 0; j < 8; ++j) g[j] = *(const f32x4*)(gain + 4 * lane + 256 * j);
    for (int m = gw; m < M; m += NGW) {
        const GAS f32x4* xr = (const GAS f32x4*)(src + (size_t)m * DM) + lane;
        f32x4 v[8]; float s = 0.f;
#pragma unroll
        for (int j = 0; j < 8; ++j) { v[j] = xr[64 * j]; s += dot4(v[j]); }
        const float r = 1.0f / sqrtf(wave_sum(s) * (1.0f / DM) + EPS);
        GAS v2u* o8 = (GAS v2u*)(dst + (size_t)m * DM) + lane;
#pragma unroll
        for (int j = 0; j < 8; ++j) { const f32x4 y = (v[j] * r) * g[j]; v2u w; w.x = pk2(y.x, y.y); w.y = pk2(y.z, y.w); o8[64 * j] = w; }
    }
}
__device__ __forceinline__ void norm_rows_f32_inplace(Frame& F, float* x, const float* gain) {
    LANE_IDS();
    const int gw = F.vcu * NWAVES + wave, NGW = F.G * NWAVES;
    f32x4 g[8];
#pragma unroll
    for (int j = 0; j < 8; ++j) g[j] = *(const f32x4*)(gain + 4 * lane + 256 * j);
    for (int m = gw; m < M; m += NGW) {
        GAS f32x4* xr = (GAS f32x4*)(x + (size_t)m * DM) + lane;
        f32x4 v[8]; float s = 0.f;
#pragma unroll
        for (int j = 0; j < 8; ++j) { v[j] = xr[64 * j]; s += dot4(v[j]); }
        const float r = 1.0f / sqrtf(wave_sum(s) * (1.0f / DM) + EPS);
#pragma unroll
        for (int j = 0; j < 8; ++j) xr[64 * j] = (v[j] * r) * g[j];
    }
}

__device__ __forceinline__ void p0_prologue(Frame& F) {
    LANE_IDS();
    LAS float* scr = (LAS float*)(F.lds + RING_OFF + wave * 16384);
    const int gw = F.vcu * NWAVES + wave, NGW = F.G * NWAVES;
    unsigned char* ws = F.wsb;
    constexpr int I0 = 32 * 16, I1 = 32 * 18, I2 = 8 * 96, I3 = 8 * 128, I4 = 32 * 64, I5 = 32 * 576, I6 = 32 * 64, I7 = 32 * 352, I8 = 88 * 64;
    constexpr int NITEMS = 2 * (I0 + I1 + I2 + I3 + I4 + I5 + I6) + 4 * (I7 + I8);
    for (int it = gw; it < NITEMS; it += NGW) {
        int r = it;
        if (r < 2 * I5) { const int l = r / I5; p0_transpose_item<2, true>((const float*)karg(12) + (size_t)l * DM * NDIL, (const float*)karg(2) + (2 * l + 1) * DM, DM, NDIL, (bf16*)(ws + WS_WDIL + l * WDIL_STRIDE + WDIL_IN), 0, scr, r - l * I5, lane); continue; } r -= 2 * I5;
        if (r < 4 * I7) { const int l = r / I7; p0_transpose_item<4, true>((const float*)karg(14) + (size_t)l * DM * NUP, (const float*)karg(3) + l * DM, DM, NUP, (bf16*)(ws + WS_WFFN + l * WFFN_STRIDE + WFFN_UP), 0, scr, r - l * I7, lane); continue; } r -= 4 * I7;
        if (r < 4 * I8) { const int l = r / I8; p0_transpose_item<0, false>((const float*)karg(17) + (size_t)l * FF * DM, nullptr, FF, DM, (bf16*)(ws + WS_WFFN + l * WFFN_STRIDE + WFFN_DOWN), 0, scr, r - l * I8, lane); continue; } r -= 4 * I8;
        if (r < 2 * I6) { const int l = r / I6; p0_transpose_item<0, false>((const float*)karg(13) + (size_t)l * DM * DM, nullptr, DM, DM, (bf16*)(ws + WS_WDIL + l * WDIL_STRIDE + WDIL_WO), 0, scr, r - l * I6, lane); continue; } r -= 2 * I6;
        if (r < 2 * I4) { const int l = r / I4; p0_transpose_item<0, false>((const float*)karg(11) + (size_t)l * DM * DM, nullptr, DM, DM, (bf16*)(ws + WS_WMLA + l * WMLA_STRIDE + WMLA_WO), 0, scr, r - l * I4, lane); continue; } r -= 2 * I4;
        if (r < 2 * I3) { const int l = r / I3; p0_transpose_item<0, true>((const float*)karg(10) + (size_t)l * 512 * NKVB, (const float*)karg(9) + l * 512, 512, NKVB, (bf16*)(ws + WS_WMLA + l * WMLA_STRIDE + WMLA_KVB), 0, scr, r - l * I3, lane); continue; } r -= 2 * I3;
        if (r < 2 * I2) { const int l = r / I2; p0_transpose_item<1, true>((const float*)karg(7) + (size_t)l * 512 * NQB, (const float*)karg(6) + l * 512, 512, NQB, (bf16*)(ws + WS_WMLA + l * WMLA_STRIDE + WMLA_QB), 0, scr, r - l * I2, lane); continue; } r -= 2 * I2;
        if (r < 2 * I1) { const int l = r / I1; p0_transpose_item<3, true>((const float*)karg(8) + (size_t)l * DM * 576, (const float*)karg(2) + (2 * l) * DM, DM, 576, (bf16*)(ws + WS_WMLA + l * WMLA_STRIDE + WMLA_QKVA), 512, scr, r - l * I1, lane); continue; } r -= 2 * I1;
        { const int l = r / I0; p0_transpose_item<0, true>((const float*)karg(5) + (size_t)l * DM * 512, (const float*)karg(2) + (2 * l) * DM, DM, 512, (bf16*)(ws + WS_WMLA + l * WMLA_STRIDE + WMLA_QKVA), 0, scr, r - l * I0, lane); }
    }
    const int gt = F.vcu * (NWAVES * 64) + tid, NGT = F.G * NWAVES * 64;
    for (int i = gt; i < 2 * 192 * DM / 8; i += NGT) { const int l = i / (192 * DM / 8), e = i - l * (192 * DM / 8), rr = e / (DM / 8), cc = e - rr * (DM / 8), row = rr < 96 ? 1056 + rr : 1184 + (rr - 96);
        *((GAS v4u*)(ws + WS_WMLA + l * WMLA_STRIDE + WMLA_QKVA + (size_t)row * DM * 2) + cc) = (v4u){0u, 0u, 0u, 0u}; }
    const int* pos = (const int*)karg(1);
    for (int i = gt; i < M * 32; i += NGT) { const int row = i >> 5, k = i & 31;
        const double rev = (double)pos[row] * kRopeRev[k]; const float fr = (float)(rev - __builtin_rint(rev));
        const float c = __builtin_amdgcn_cosf(fr), s = __builtin_amdgcn_sinf(fr);
        ((float*)(ws + WS_COSM))[i] = c; ((float*)(ws + WS_SINM))[i] = s;
        if ((k & 1) == 0) { ((float*)(ws + WS_COSD))[row * 16 + (k >> 1)] = c; ((float*)(ws + WS_SIND))[row * 16 + (k >> 1)] = s; } }
    { const int gwv = F.vcu * NWAVES + wave, NGWv = F.G * NWAVES; const float* x = (const float*)karg(0); bf16* XB = (bf16*)(ws + WS_H); float* ps0 = (float*)(ws + WS_PS);
      for (int m = gwv; m < M; m += NGWv) {
        const GAS f32x4* xr = (const GAS f32x4*)(x + (size_t)m * DM) + lane; f32x4 v[8]; float s = 0.f;
#pragma unroll
        for (int j = 0; j < 8; ++j) { v[j] = xr[64 * j]; s += dot4(v[j]); }
        s = wave_sum(s);
        GAS v2u* o8 = (GAS v2u*)(XB + (size_t)m * DM) + lane;
#pragma unroll
        for (int j = 0; j < 8; ++j) { v2u w; w.x = pk2(v[j].x, v[j].y); w.y = pk2(v[j].z, v[j].w); o8[64 * j] = w; }
        if (lane < 32) ps0[(size_t)m * 32 + lane] = lane == 0 ? s : 0.f; } }
}

__device__ __forceinline__ void dil_merge(Frame& F) {
    LANE_IDS();
    const int gw = F.vcu * NWAVES + wave, NGW = F.G * NWAVES;
    unsigned char* ws = F.wsb;
    const bf16* OG = (const bf16*)(ws + WS_S + S_OG); const float* LSE = (const float*)(ws + WS_S + S_LSE); bf16* AO = (bf16*)(ws + WS_S + S_AO_DIL);
    for (int m = gw; m < M; m += NGW) {
        const int b = m >> 12, s = m & (SEQ - 1);
        const size_t sp0 = s, sp1 = (size_t)(s & 3) * (SEQ / 4) + (s >> 2), sp2 = (size_t)(s & 15) * (SEQ / 16) + (s >> 4);
#pragma unroll
        for (int j = 0; j < 4; ++j) { const int col = 8 * lane + 512 * j, head = col >> 7, dim = col & 127;
            const size_t r0 = ((size_t)(0 * 16 + head) * BATCH + b) * SEQ + sp0, r1 = ((size_t)(1 * 16 + head) * BATCH + b) * SEQ + sp1, r2 = ((size_t)(2 * 16 + head) * BATCH + b) * SEQ + sp2;
            const float l0 = LSE[r0], l1 = LSE[r1], l2 = LSE[r2];
            const float mx = fmaxf(l0, fmaxf(l1, l2)); float e0 = __expf(l0 - mx), e1 = __expf(l1 - mx), e2 = __expf(l2 - mx);
            const float inv = 1.0f / (e0 + e1 + e2); e0 *= inv; e1 *= inv; e2 *= inv;
            const v4u a = *(const GAS v4u*)(OG + r0 * 128 + dim), bb = *(const GAS v4u*)(OG + r1 * 128 + dim), c = *(const GAS v4u*)(OG + r2 * 128 + dim);
            v4u w;
#pragma unroll
            for (int q = 0; q < 4; ++q) w[q] = pk2(e0 * bf_lo(a[q]) + e1 * bf_lo(bb[q]) + e2 * bf_lo(c[q]), e0 * bf_hi(a[q]) + e1 * bf_hi(bb[q]) + e2 * bf_hi(c[q]));
            *(GAS v4u*)(AO + (size_t)m * DM + col) = w; }
    }
}

__device__ __forceinline__ void ffn_fixup(Frame& F, int layer, int pm) {
    LANE_IDS();
    if ((pm & 15) == 0) return;
    unsigned char* ws = F.wsb;
    const float* HALO = (const float*)(ws + WS_HALO); const float* FIX = (const float*)(ws + WS_FIX); bf16* ACT = (bf16*)(ws + WS_S + S_ACT);
    const float* cw = (const float*)karg(15) + (size_t)layer * 3 * NUP;
    for (int idx = tid; idx < 2 * (FF / 8); idx += NWAVES * 64) { const int rs = idx / (FF / 8), ch = (idx - rs * (FF / 8)) * 8;
        float o[8];
#pragma unroll
        for (int e = 0; e < 8; e += 4) {
            f32x4 cg = *(const GAS f32x4*)(FIX + ((size_t)pm * 2 + rs) * NUP + ch + e), cv = *(const GAS f32x4*)(FIX + ((size_t)pm * 2 + rs) * NUP + FF + ch + e);
            const f32x4 u1g = *(const GAS f32x4*)(HALO + ((size_t)(pm - 1) * 2 + 1) * NUP + ch + e), u1v = *(const GAS f32x4*)(HALO + ((size_t)(pm - 1) * 2 + 1) * NUP + FF + ch + e);
            const f32x4 u2g = *(const GAS f32x4*)(HALO + ((size_t)(pm - 1) * 2 + 0) * NUP + ch + e), u2v = *(const GAS f32x4*)(HALO + ((size_t)(pm - 1) * 2 + 0) * NUP + FF + ch + e);
            const f32x4 w0g = *(const f32x4*)(cw + ch + e), w0v = *(const f32x4*)(cw + FF + ch + e), w1g = *(const f32x4*)(cw + NUP + ch + e), w1v = *(const f32x4*)(cw + NUP + FF + ch + e);
            if (rs == 0) { cg = cg + w1g * u1g + w0g * u2g; cv = cv + w1v * u1v + w0v * u2v; } else { cg = cg + w0g * u1g; cv = cv + w0v * u1v; }
#pragma unroll
            for (int k = 0; k < 4; ++k) o[e + k] = cg[k] * __builtin_amdgcn_rcpf(1.0f + __builtin_amdgcn_exp2f(-1.4426950408889634f * cg[k])) * cv[k]; }
        v4u w; w.x = pk2(o[0], o[1]); w.y = pk2(o[2], o[3]); w.z = pk2(o[4], o[5]); w.w = pk2(o[6], o[7]);
        *(GAS v4u*)(ACT + ((size_t)pm * 256 + rs) * FF + ch) = w; }
}

__device__ __forceinline__ void row_scale_table(Frame& F, const float* ps, int pm) {
    LANE_IDS();
    LAS float* rsl = (LAS float*)(F.lds + RSL_OFF);
    if (tid < 256) { const GAS f32x4* p = (const GAS f32x4*)(ps + ((size_t)pm * 256 + tid) * 32); float s = 0.f;
#pragma unroll
        for (int i = 0; i < 8; ++i) { const f32x4 a = p[i]; s += (a.x + a.y) + (a.z + a.w); }
        rsl[tid] = __builtin_amdgcn_rsqf(s * (1.0f / DM) + EPS); }
    __syncthreads();
}

__device__ __forceinline__ void row_scale_table2(Frame& F, const float* pq, int pm) {
    LANE_IDS();
    LAS float* rsq = (LAS float*)(F.lds + RSQ_OFF);
    if (tid < 256) { const GAS f32x4* p = (const GAS f32x4*)(pq + ((size_t)pm * 256 + tid) * 16);
        const f32x4 a = p[0], b = p[1], c = p[2], d = p[3];
        rsq[tid] = __builtin_amdgcn_rsqf((((a.x + a.y) + (a.z + a.w)) + ((b.x + b.y) + (b.z + b.w))) * (1.0f / 512) + EPS);
        rsq[256 + tid] = __builtin_amdgcn_rsqf((((c.x + c.y) + (c.z + c.w)) + ((d.x + d.y) + (d.z + d.w))) * (1.0f / 512) + EPS); }
    __syncthreads();
}

struct MlaRef {
    const bf16* Q; const bf16* KV; const bf16* KPE; bf16* AO; int vcu;
    __device__ __forceinline__ att::BlockRef operator()(int i) const {
        const int I = vcu + 256 * (i >> 1), bh = I >> 3, x = I & 7, qb = (i & 1) ? 15 - x : x, b = bh >> 4, h = bh & 15;
        const size_t row0 = (size_t)b * SEQ + (size_t)qb * 256;
        att::BlockRef r; r.Q = Q + row0 * NQB + h * 128; r.Qpe = Q + row0 * NQB + 2048 + h * 64;
        r.K = KV + (size_t)bh * SEQ * 128; r.V = r.K + (size_t)M * DM; r.Kpe = KPE + (size_t)b * SEQ * 64;
        r.O = AO + row0 * DM + h * 128; r.Lse = nullptr; r.P0 = qb * 256; return r;
    }
};
struct DilRef {
    const bf16* QKV; bf16* OG; float* LSE; int vcu, g;
    __device__ __forceinline__ att::BlockRef operator()(int i) const {
        const int I = vcu + 256 * i, sh = 2 * g, d = 1 << sh, nqbs = 4 - sh;
        const int seq = I >> nqbs, qb = (I + ((i << nqbs) >> 2)) & ((1 << nqbs) - 1), h = seq & 15, br = seq >> 4, rr = br & (d - 1), b = br >> sh;
        const size_t sp0 = (size_t)rr * (SEQ >> sh), spq = sp0 + (size_t)qb * 256;
        const size_t hb = ((size_t)(g * 3) * 16 + h) * BATCH + b, tstep = (size_t)16 * BATCH * SEQ * 128;
        att::BlockRef r; r.Q = QKV + (hb * SEQ + spq) * 128; r.Qpe = nullptr; r.Kpe = nullptr;
        r.K = QKV + tstep + (hb * SEQ + sp0) * 128; r.V = r.K + tstep;
        const size_t ob = ((size_t)g * 16 + h) * BATCH + b;
        r.O = OG + (ob * SEQ + spq) * 128; r.Lse = LSE + ob * SEQ + spq; r.P0 = qb * 256; return r;
    }
};
template <bool PE, bool SK, bool LSE, bool EARLY, class RefFn>
__device__ __forceinline__ void attn_run(char* lds, const att::Prm& P, int n, const RefFn& ref) {
    att::BlockRef cur = ref(0); att::Seam<PE> S;
    att::swa_prime<PE>(cur, P, lds, S);
    for (int i = 0;; ++i) {
        const bool last = i + 1 >= n;
        const att::BlockRef nxt = last ? cur : ref(i + 1);
        att::swa_block<PE, SK, LSE, EARLY>(cur, nxt, P, lds, S);
        if (last) break;
        cur = nxt;
    }
}

struct Args { const void* in[18]; float* out; unsigned char* ws; };
__global__ void __launch_bounds__(NWAVES * 64, 2) fwd_kernel(Args args) {
    extern __shared__ __attribute__((aligned(16))) unsigned char lds[];
    Frame F;
    F.lds = (LAS unsigned char*)lds;
    F.MISC = (volatile LAS unsigned*)(F.lds + MISC_OFF);
    F.G = gridDim.x; { const int bx = blockIdx.x; F.vcu = (F.G % 8 == 0) ? (bx % 8) * (F.G / 8) + bx / 8 : bx; }
        F.out = args.out; F.wsb = args.ws;
    F.ctl = (gu32*)(args.ws + WS_CTL);
#define ws F.wsb
#define RELAUNDER() asm volatile("" : "+s"(F.vcu), "+s"(F.wsb), "+s"(F.out))
    for (int u = threadIdx.x; u < (LDS_BYTES - LDSCTL_OFF) / 4; u += NWAVES * 64) ((LAS unsigned*)(F.lds + LDSCTL_OFF))[u] = 0u;
    __syncthreads();
    XcdBarrier bar = xcd_barrier_post((unsigned*)(F.ctl + CW_BAR), F.MISC + 8);
#define GRID_BAR() xcd_barrier(bar)
    typedef pg8::StaticOrder SO;
#define GEMMR(EpiT, Aptr, Bptr, N_, K_, Eobj, REP_) do { pg8::Gemm g_{(const bf16*)(Aptr), (const bf16*)(Bptr), M, (N_), (K_)}; SO S_; S_.init(M, (N_), F.G, (int)blockIdx.x); \
        pg8::gemm_phase<EpiT, SO, true, true, REP_>(F.lds + RING_OFF, g_, S_, (Eobj)); } while (0)
#define GEMM(EpiT, Aptr, Bptr, N_, K_, Eobj) GEMMR(EpiT, Aptr, Bptr, N_, K_, Eobj, 1)

    bf16* H = (bf16*)(ws + WS_H);
    const float* cosM = (const float*)(ws + WS_COSM); const float* sinM = (const float*)(ws + WS_SINM);
    const float* cosD = (const float*)(ws + WS_COSD); const float* sinD = (const float*)(ws + WS_SIND);

    p0_prologue(F);
    GRID_BAR();

#define PSP(i) ((float*)(ws + WS_PS + (size_t)(i) * PS_STRIDE))
    const PG8_LAS float* rsl = (const PG8_LAS float*)(F.lds + RSL_OFF);
    const int my_pm = 8 * ((int)blockIdx.x & 7) + (((int)blockIdx.x >> 3) & 7);
    for (int j = 0; j < 2; ++j) {
        {
            RELAUNDER();
            const unsigned char* wl = ws + WS_WMLA + j * WMLA_STRIDE;
            float* PQ = (float*)(ws + WS_S + S_PQ); bf16* QN = (bf16*)(ws + WS_S + S_QN); bf16* CK = (bf16*)(ws + WS_S + S_CKVN); bf16* KPE = (bf16*)(ws + WS_S + S_KPE);
            bf16* Q = (bf16*)(ws + WS_S + S_Q); bf16* KV = (bf16*)(ws + WS_S + S_KV); bf16* AO = (bf16*)(ws + WS_S + S_AO_MLA);
            row_scale_table(F, PSP(4 * j), my_pm);
            { pg8::EpiQaCkv E{QN, CK, PQ, rsl}; GEMM(pg8::EpiQaCkv, H, wl + WMLA_QKVA, 1024, DM, E); }
            GRID_BAR();
            row_scale_table2(F, PQ, my_pm);
            { const int slot = (int)blockIdx.x >> 6; const PG8_LAS float* rsq = (const PG8_LAS float*)(F.lds + RSQ_OFF);
              if (slot == 0) { pg8::Gemm g_{(const bf16*)H, (const bf16*)(wl + WMLA_QKVA), M, NQKVA, DM}; pg8::OneUnit S_{my_pm, 4}; pg8::EpiKpe E{KPE, cosM, sinM, rsl};
                  pg8::gemm_phase<pg8::EpiKpe, pg8::OneUnit, true, true>(F.lds + RING_OFF, g_, S_, E); }
              if (slot < 2) { pg8::Gemm g_{(const bf16*)QN, (const bf16*)(wl + WMLA_QB), M, NQB, 512}; pg8::PanelUnits S_{my_pm, slot ? 4 : 0, slot ? 8 : 4}; pg8::EpiQMla E{Q, cosM, sinM, rsq};
                  pg8::gemm_phase<pg8::EpiQMla, pg8::PanelUnits, true, true>(F.lds + RING_OFF, g_, S_, E); }
              else { pg8::Gemm g_{(const bf16*)CK, (const bf16*)(wl + WMLA_KVB), M, NKVB, 512}; pg8::PanelUnits S_{my_pm, 8 * (slot - 2), 8}; pg8::EpiKvMla E{KV, KV + (size_t)M * DM, rsq + 256};
                  pg8::gemm_phase<pg8::EpiKvMla, pg8::PanelUnits, true, true>(F.lds + RING_OFF, g_, S_, E); }
            }
            GRID_BAR();
            RELAUNDER();
            { att::Prm P{NQB, 128, DM, NQB, 64, 0, SEQ, SEQ, 0.07216878364870322f};
              MlaRef R{Q, KV, KPE, AO, F.vcu};
              attn_run<true, false, false, false>((char*)lds + RING_OFF, P, 4, R);
            }
            GRID_BAR();
            if (j == 0) { pg8::EpiResB<true> E{(const float*)karg(0), H, PSP(1), DM}; GEMM(pg8::EpiResB<true>, AO, wl + WMLA_WO, DM, DM, E); }
            else { pg8::EpiResB<false> E{nullptr, H, PSP(5), DM}; GEMM(pg8::EpiResB<false>, AO, wl + WMLA_WO, DM, DM, E); }
            GRID_BAR();
        }
        {
            RELAUNDER();
            const int layer = 2 * j; const unsigned char* wl = ws + WS_WFFN + layer * WFFN_STRIDE;
            bf16* ACT = (bf16*)(ws + WS_S + S_ACT);
            row_scale_table(F, PSP(1 + 4 * j), my_pm);
            { pg8::EpiUpConv E{ACT, (float*)(ws + WS_HALO), (float*)(ws + WS_FIX), (const float*)karg(15) + (size_t)layer * 3 * NUP, (const float*)karg(16) + (size_t)layer * NUP,
                               (PG8_LAS float*)(F.lds + XH_OFF), (PG8_LAS float*)(F.lds + CWL_OFF), rsl};
              GEMM(pg8::EpiUpConv, H, wl + WFFN_UP, NUP, DM, E); }
            GRID_BAR();
            { SO S_; S_.init(M, DM, F.G, (int)blockIdx.x); pg8::Unit u_; for (int i = 0; S_.next(i, u_); ++i) ffn_fixup(F, layer, u_.pm);
              asm volatile("s_waitcnt vmcnt(0)" ::: "memory"); __syncthreads(); }
            { pg8::EpiResB<false> E{nullptr, H, PSP(2 + 4 * j), DM}; GEMM(pg8::EpiResB<false>, ACT, wl + WFFN_DOWN, DM, FF, E); }
            GRID_BAR();
        }
        {
            RELAUNDER();
            const unsigned char* wl = ws + WS_WDIL + j * WDIL_STRIDE;
            bf16* QKV = (bf16*)(ws + WS_S + S_QKV); bf16* OG = (bf16*)(ws + WS_S + S_OG); float* LSE = (float*)(ws + WS_S + S_LSE); bf16* AO = (bf16*)(ws + WS_S + S_AO_DIL);
            row_scale_table(F, PSP(2 + 4 * j), my_pm);
            { pg8::EpiQkvDil E{QKV, cosD, sinD, rsl}; GEMM(pg8::EpiQkvDil, H, wl + WDIL_IN, NDIL, DM, E); }
            GRID_BAR();
#pragma unroll 1
            for (int g = 0; g < 3; ++g) { const int d = 1 << (2 * g);
              att::Prm P{128, 128, 128, 0, 0, 1, SEQ / d, 129, 0.08838834764831845f};
              DilRef R{QKV, OG, LSE, F.vcu, g};
              attn_run<false, true, true, true>((char*)lds + RING_OFF, P, 4, R);
            }
            GRID_BAR();
            dil_merge(F);
            GRID_BAR();
            { pg8::EpiResB<false> E{nullptr, H, PSP(3 + 4 * j), DM}; GEMM(pg8::EpiResB<false>, AO, wl + WDIL_WO, DM, DM, E); }
            GRID_BAR();
        }
        {
            RELAUNDER();
            const int layer = 2 * j + 1; const unsigned char* wl = ws + WS_WFFN + layer * WFFN_STRIDE;
            bf16* ACT = (bf16*)(ws + WS_S + S_ACT);
            row_scale_table(F, PSP(3 + 4 * j), my_pm);
            { pg8::EpiUpConv E{ACT, (float*)(ws + WS_HALO), (float*)(ws + WS_FIX), (const float*)karg(15) + (size_t)layer * 3 * NUP, (const float*)karg(16) + (size_t)layer * NUP,
                               (PG8_LAS float*)(F.lds + XH_OFF), (PG8_LAS float*)(F.lds + CWL_OFF), rsl};
              GEMM(pg8::EpiUpConv, H, wl + WFFN_UP, NUP, DM, E); }
            GRID_BAR();
            { SO S_; S_.init(M, DM, F.G, (int)blockIdx.x); pg8::Unit u_; for (int i = 0; S_.next(i, u_); ++i) ffn_fixup(F, layer, u_.pm);
              asm volatile("s_waitcnt vmcnt(0)" ::: "memory"); __syncthreads(); }
            if (j == 0) { pg8::EpiResB<false> E{nullptr, H, PSP(4), DM}; GEMM(pg8::EpiResB<false>, ACT, wl + WFFN_DOWN, DM, FF, E); }
            else { pg8::EpiResLast E{H, F.out, DM}; GEMM(pg8::EpiResLast, ACT, wl + WFFN_DOWN, DM, FF, E); }
            GRID_BAR();
        }
    }
    RELAUNDER();
    norm_rows_f32_inplace(F, F.out, (const float*)karg(4));
#undef PSP
#undef ws
#undef RELAUNDER
#undef GEMM
#undef GEMMR
#undef GRID_BAR
}

extern "C" void kernel_launch(void* const* d_in, const int* in_sizes, int n_in, void* d_out, int out_size, void* d_ws, size_t ws_size, hipStream_t stream) {
    static int grid = 0;
    if (grid == 0) {
        if (n_in != 18 || in_sizes[0] != M * DM || out_size != M * DM || ws_size < WS_END) {
            fprintf(stderr, "kernel_launch: shape / workspace mismatch (n_in %d, in0 %d, out %d, ws %zu, need %zu); nothing launched\n", n_in, n_in > 0 ? in_sizes[0] : -1, out_size, ws_size, (size_t)WS_END); grid = -1; return; }
        int dev = 0, cus = 0, per_cu = 0;
        if (hipGetDevice(&dev) != hipSuccess || hipDeviceGetAttribute(&cus, hipDeviceAttributeMultiprocessorCount, dev) != hipSuccess) { grid = -1; return; }
        if (hipFuncSetAttribute((const void*)fwd_kernel, hipFuncAttributeMaxDynamicSharedMemorySize, LDS_BYTES) != hipSuccess) { fprintf(stderr, "kernel_launch: hipFuncSetAttribute failed\n"); grid = -1; return; }
        if (hipOccupancyMaxActiveBlocksPerMultiprocessor(&per_cu, (const void*)fwd_kernel, NWAVES * 64, LDS_BYTES) != hipSuccess || per_cu < 1) fprintf(stderr, "kernel_launch: occupancy query reports %d\n", per_cu);
        (void)hipGetLastError();
        if (cus < 256) { fprintf(stderr, "kernel_launch: built for a 256-CU device, found %d CUs; nothing launched\n", cus); grid = -1; return; }
        grid = 256;
    }
    if (grid < 0) return;
    if (hipMemsetAsync((char*)d_ws + WS_CTL, 0, CTL_ZERO_BYTES, stream) != hipSuccess) return;
    Args a{};
    for (int i = 0; i < 18; ++i) a.in[i] = d_in[i];
    a.out = (float*)d_out; a.ws = (unsigned char*)d_ws;
    hipLaunchKernelGGL(fwd_kernel, dim3(grid), dim3(NWAVES * 64), LDS_BYTES, stream, a);
}
```

```cpp
#include <hip/hip_runtime.h>
#include <cstdio>
#include <cstdint>
namespace pg8 {
#define PG8_LAS __attribute__((address_space(3)))
typedef unsigned short bf16_t;
typedef short bf16x8 __attribute__((ext_vector_type(8)));
typedef float f32x4 __attribute__((ext_vector_type(4)));
typedef unsigned u32x4 __attribute__((ext_vector_type(4)));
constexpr int BM = 256, BK = 64, HALF = 128, HTB = HALF * BK * 2  , STAGE_BYTES = 8 * HTB, NXCD = 8, WGM = 8;

__host__ __device__ __forceinline__ int lds_byte(int r, int c) { const int st = (r >> 4) * 2 + (c >> 5), rr = r & 15, cc = c & 31, ob = rr * 64 + cc * 2; return st * 1024 + (ob ^ (((ob >> 9) & 1) << 5)); }
__host__ __device__ __forceinline__ void stage_rc(int b, int& R, int& C) { const int st = b / 1024, sb = b % 1024, swz = sb ^ (((sb >> 9) & 1) << 5); R = (st >> 1) * 16 + swz / 64; C = (st & 1) * 32 + (swz % 64) / 2; }
__host__ __device__ __forceinline__ int perm32(int rho) { const int n = rho >> 4, i = rho & 15; return 8 * (i >> 2) + 4 * n + (i & 3); }

struct Unit { int pm, pn; };
struct Gemm { const bf16_t* A; const bf16_t* Bt; int M, N, K; };

struct StaticOrder {
    int nM, nN, nwg, G, c;
    __host__ __device__ void init(int M, int N, int G_, int c_) { nM = M / BM; nN = N / BM; nwg = nM * nN; G = G_; c = c_; }
    __host__ __device__ __forceinline__ bool next(int i, Unit& u) const {
        const long L = (long)i * G + c; if (L >= nwg) return false;
        int wgid = (int)L; { const int q = nwg / NXCD, r = nwg % NXCD, xcd = wgid % NXCD, off = wgid / NXCD; wgid = (xcd < r ? xcd * (q + 1) : r * (q + 1) + (xcd - r) * q) + off; }
        const int nig = WGM * nN, gid = wgid / nig, fm = gid * WGM, gsz = (nM - fm) < WGM ? (nM - fm) : WGM;
        u.pm = fm + ((wgid % nig) % gsz); u.pn = (wgid % nig) / gsz; return true;
    }
    __device__ __forceinline__ void a_ready(const Unit&) const {}
    __device__ __forceinline__ void done(const Unit&) const {}
};

__device__ __forceinline__ unsigned cvt_pk_bf16(float lo, float hi) { unsigned r; asm volatile("v_cvt_pk_bf16_f32 %0, %1, %2" : "=v"(r) : "v"(lo), "v"(hi)); return r; }
typedef float f32x2 __attribute__((ext_vector_type(2)));
typedef unsigned u32x2 __attribute__((ext_vector_type(2)));
__device__ __forceinline__ u32x4 pack8bf(const f32x4 a, const f32x4 b) { u32x4 w; w.x = cvt_pk_bf16(a[0], a[1]); w.y = cvt_pk_bf16(a[2], a[3]); w.z = cvt_pk_bf16(b[0], b[1]); w.w = cvt_pk_bf16(b[2], b[3]); return w; }
#define PG8_NOPRE struct Pre {}; __device__ __forceinline__ void pre_issue(Pre&, const Unit&, int, int) const {} __device__ __forceinline__ void pre_finish(Pre&, int, int) const {}
struct EpiF32Store {
    PG8_NOPRE
    static constexpr bool PERM = false, AFTER_DRAIN = false;
    float* C; int ldc;
    __device__ __forceinline__ void operator()(const f32x4 (&acc)[2][2][4][2], const Unit& u, int wr, int wc, int fr, int fq, int ui) const {
        const int row0 = u.pm * BM + wr * 64 + fr, col0 = u.pn * BM + wc * 32 + 4 * fq;
#pragma unroll
        for (int ai = 0; ai < 2; ++ai)
#pragma unroll
            for (int m = 0; m < 4; ++m) { float* rowp = C + (size_t)(row0 + ai * HALF + m * 16) * ldc + col0;
#pragma unroll
                for (int bj = 0; bj < 2; ++bj)
#pragma unroll
                    for (int n = 0; n < 2; ++n) *(f32x4*)(rowp + bj * HALF + n * 16) = acc[ai][bj][m][n]; }
    }
};

__device__ __forceinline__ float sum_fq(float v) {
    v += __uint_as_float((unsigned)__builtin_amdgcn_ds_swizzle((int)__float_as_uint(v), ((0x10 << 10) | 0x1f)));
    auto rr = __builtin_amdgcn_permlane32_swap(__float_as_uint(v), __float_as_uint(v), false, false);
    return __uint_as_float(rr[0]) + __uint_as_float(rr[1]);
}
__device__ __forceinline__ float sq4(const f32x4 a) { return (a[0] * a[0] + a[1] * a[1]) + (a[2] * a[2] + a[3] * a[3]); }
__device__ __forceinline__ void load_rs(float (&r)[2][4], const PG8_LAS float* rsl, int wr, int fr) {
#pragma unroll
    for (int ai = 0; ai < 2; ++ai)
#pragma unroll
        for (int m = 0; m < 4; ++m) r[ai][m] = rsl[ai * HALF + wr * 64 + m * 16 + fr]; }
__device__ __forceinline__ void unpack8bf(const u32x4 w, f32x4& a, f32x4& b) {
    a = (f32x4){__uint_as_float(w.x << 16), __uint_as_float(w.x & 0xffff0000u), __uint_as_float(w.y << 16), __uint_as_float(w.y & 0xffff0000u)};
    b = (f32x4){__uint_as_float(w.z << 16), __uint_as_float(w.z & 0xffff0000u), __uint_as_float(w.w << 16), __uint_as_float(w.w & 0xffff0000u)}; }
template <bool BASE_F32> struct EpiResB {
    PG8_NOPRE
    static constexpr bool PERM = true, AFTER_DRAIN = false;
    const float* basef; bf16_t* X; float* ps; int ldc;
    __device__ __forceinline__ void operator()(const f32x4 (&acc)[2][2][4][2], const Unit& u, int wr, int wc, int fr, int fq, int ui) const {
        const int row0 = u.pm * BM + wr * 64 + fr, col0 = u.pn * BM + wc * 32 + 8 * fq;
#pragma unroll
        for (int ai = 0; ai < 2; ++ai) {
            f32x4 bs[4][2][2]; u32x4 bx[4][2];
#pragma unroll
            for (int m = 0; m < 4; ++m) { const size_t off = (size_t)(row0 + ai * HALF + m * 16) * ldc + col0;
#pragma unroll
                for (int bj = 0; bj < 2; ++bj) {
                    if constexpr (BASE_F32) { bs[m][bj][0] = *(const f32x4*)(basef + off + bj * HALF); bs[m][bj][1] = *(const f32x4*)(basef + off + bj * HALF + 4); }
                    else bx[m][bj] = *(const u32x4*)(X + off + bj * HALF); } }
#pragma unroll
            for (int m = 0; m < 4; ++m) { const int row = row0 + ai * HALF + m * 16; const size_t off = (size_t)row * ldc + col0; float q = 0.f;
#pragma unroll
                for (int bj = 0; bj < 2; ++bj) { f32x4 x0, x1;
                    if constexpr (BASE_F32) { x0 = bs[m][bj][0]; x1 = bs[m][bj][1]; } else unpack8bf(bx[m][bj], x0, x1);
                    const f32x4 o0 = x0 + acc[ai][bj][m][0], o1 = x1 + acc[ai][bj][m][1]; q += sq4(o0) + sq4(o1);
                    *(u32x4*)(X + off + bj * HALF) = pack8bf(o0, o1); }
                q = sum_fq(q);
                if (fq == 0) ps[(size_t)row * 32 + u.pn * 4 + wc] = q; }
            asm volatile("" ::: "memory"); }
    }
};
struct EpiResLast {
    PG8_NOPRE
    static constexpr bool PERM = true, AFTER_DRAIN = false;
    const bf16_t* X; float* out; int ldc;
    __device__ __forceinline__ void operator()(const f32x4 (&acc)[2][2][4][2], const Unit& u, int wr, int wc, int fr, int fq, int ui) const {
        const int row0 = u.pm * BM + wr * 64 + fr, col0 = u.pn * BM + wc * 32 + 8 * fq;
#pragma unroll
        for (int ai = 0; ai < 2; ++ai) {
            u32x4 bx[4][2];
#pragma unroll
            for (int m = 0; m < 4; ++m) { const size_t off = (size_t)(row0 + ai * HALF + m * 16) * ldc + col0;
#pragma unroll
                for (int bj = 0; bj < 2; ++bj) bx[m][bj] = *(const u32x4*)(X + off + bj * HALF); }
#pragma unroll
            for (int m = 0; m < 4; ++m) { const size_t off = (size_t)(row0 + ai * HALF + m * 16) * ldc + col0;
#pragma unroll
                for (int bj = 0; bj < 2; ++bj) { f32x4 x0, x1; unpack8bf(bx[m][bj], x0, x1);
                    *(f32x4*)(out + off + bj * HALF) = x0 + acc[ai][bj][m][0]; *(f32x4*)(out + off + bj * HALF + 4) = x1 + acc[ai][bj][m][1]; } }
            asm volatile("" ::: "memory"); }
    }
};
struct EpiF32Scaled {
    PG8_NOPRE
    static constexpr bool PERM = false, AFTER_DRAIN = false;
    float* C; int ldc; const PG8_LAS float* rsl;
    __device__ __forceinline__ void operator()(const f32x4 (&acc)[2][2][4][2], const Unit& u, int wr, int wc, int fr, int fq, int ui) const {
        const int row0 = u.pm * BM + wr * 64 + fr, col0 = u.pn * BM + wc * 32 + 4 * fq;
        float r[2][4]; load_rs(r, rsl, wr, fr);
#pragma unroll
        for (int ai = 0; ai < 2; ++ai)
#pragma unroll
            for (int m = 0; m < 4; ++m) { float* rowp = C + (size_t)(row0 + ai * HALF + m * 16) * ldc + col0;
#pragma unroll
                for (int bj = 0; bj < 2; ++bj)
#pragma unroll
                    for (int n = 0; n < 2; ++n) *(f32x4*)(rowp + bj * HALF + n * 16) = acc[ai][bj][m][n] * r[ai][m]; }
    }
};

struct EpiQaCkv {
    PG8_NOPRE
    static constexpr bool PERM = true, AFTER_DRAIN = false;
    bf16_t* QA; bf16_t* CK; float* pq; const PG8_LAS float* rsl;
    __device__ __forceinline__ void operator()(const f32x4 (&acc)[2][2][4][2], const Unit& u, int wr, int wc, int fr_, int fq_, int ui) const {
        int fr = fr_, fq = fq_; asm volatile("" : "+v"(fr), "+v"(fq));
        const int row0 = u.pm * BM + wr * 64 + fr, col0 = (u.pn & 1) * BM + wc * 32 + 8 * fq;
        bf16_t* D = u.pn < 2 ? QA : CK;
        float r[2][4]; load_rs(r, rsl, wr, fr);
#pragma unroll
        for (int ai = 0; ai < 2; ++ai)
#pragma unroll
            for (int m = 0; m < 4; ++m) { const int row = row0 + ai * HALF + m * 16; float q = 0.f;
#pragma unroll
                for (int bj = 0; bj < 2; ++bj) { const f32x4 o0 = acc[ai][bj][m][0] * r[ai][m], o1 = acc[ai][bj][m][1] * r[ai][m]; q += sq4(o0) + sq4(o1);
                    *(u32x4*)(D + (size_t)row * 512 + col0 + bj * HALF) = pack8bf(o0, o1); }
                q = sum_fq(q);
                if (fq == 0) pq[(size_t)row * 16 + u.pn * 4 + wc] = q; }
    }
};

#define PG8_DPP(old_, src_, ctrl_) __uint_as_float((unsigned)__builtin_amdgcn_update_dpp((int)__float_as_uint(old_), (int)__float_as_uint(src_), (ctrl_), 0xF, 0xF, false))
struct EpiUpConv {
    static constexpr bool PERM = true, AFTER_DRAIN = false;
    bf16_t* ACT; float* HALO; float* FIX; const float* cw; const float* cb;
    PG8_LAS float* xh; PG8_LAS float* cwl; const PG8_LAS float* rsl;
    PG8_NOPRE
    __device__ __forceinline__ void operator()(const f32x4 (&acc_)[2][2][4][2], const Unit& u, int wr, int wc, int fr_, int fq_, int ui) const {
        int fr = fr_, fq = fq_; asm volatile("" : "+v"(fr), "+v"(fq));
        f32x4 (&acc)[2][2][4][2] = const_cast<f32x4 (&)[2][2][4][2]>(acc_);
        { float r[2][4]; load_rs(r, rsl, wr, fr);
#pragma unroll
          for (int ai = 0; ai < 2; ++ai)
#pragma unroll
            for (int bj = 0; bj < 2; ++bj)
#pragma unroll
                for (int m = 0; m < 4; ++m)
#pragma unroll
                    for (int n = 0; n < 2; ++n) acc[ai][bj][m][n] = acc[ai][bj][m][n] * r[ai][m]; }
        const int ch0 = 128 * u.pn + 32 * wc + 8 * fq;
        f32x4 wv = {0.f, 0.f, 0.f, 0.f};
        if (wr == 0) { const int lane = fq * 16 + fr; wv = *(const f32x4*)((wc < 3 ? cw + (size_t)wc * 11264 : cb) + (lane < 32 ? 128 * u.pn + lane * 4 : 5632 + 128 * u.pn + (lane - 32) * 4)); }
        if (fr >= 14) {
#pragma unroll
            for (int ai = 0; ai < 2; ++ai) if (ai == 0 || wr == 0) { PG8_LAS float* b = xh + ((((ai == 0 ? wr : 2) * 4 + wc) * 2 + (fr - 14)) * 4 + fq) * 16;
#pragma unroll
                for (int bj = 0; bj < 2; ++bj)
#pragma unroll
                    for (int n = 0; n < 2; ++n) *(PG8_LAS f32x4*)(b + (bj * 2 + n) * 4) = acc[ai][bj][3][n]; }
            if (wr == 1) { float* hp = HALO + ((size_t)u.pm * 2 + (fr - 14)) * 11264 + ch0;
#pragma unroll
                for (int bj = 0; bj < 2; ++bj)
#pragma unroll
                    for (int n = 0; n < 2; ++n) *(f32x4*)(hp + bj * 5632 + n * 4) = acc[1][bj][3][n]; }
        }
        if (wr == 0) *(PG8_LAS f32x4*)(cwl + wc * 256 + (fq * 16 + fr) * 4) = wv;
        asm volatile("s_waitcnt lgkmcnt(0)" ::: "memory"); __builtin_amdgcn_s_barrier(); asm volatile("" ::: "memory");
        const bool fixtile = (u.pm & 15) != 0;
#pragma unroll
        for (int n = 0; n < 2; ++n) {
            const PG8_LAS float* cwb = cwl + wc * 32 + fq * 8 + n * 4;
            f32x4 Wq[2][4];
#pragma unroll
            for (int bj = 0; bj < 2; ++bj)
#pragma unroll
                for (int t = 0; t < 4; ++t) Wq[bj][t] = *(const PG8_LAS f32x4*)(cwb + t * 256 + bj * 128);
#pragma unroll
            for (int ai = 0; ai < 2; ++ai)
#pragma unroll
                for (int m = 0; m < 4; ++m) {
                    f32x4 c[2];
#pragma unroll
                    for (int bj = 0; bj < 2; ++bj) {
                        const f32x4 (&W)[4] = Wq[bj];
                        f32x4 h1 = {0.f, 0.f, 0.f, 0.f}, h2 = {0.f, 0.f, 0.f, 0.f};
                        if (m == 0 && !(ai == 0 && wr == 0)) { const int slot = ai == 0 ? 0 : (wr == 0 ? 1 : 2); const PG8_LAS float* b = xh + (((slot * 4 + wc) * 2) * 4 + fq) * 16 + n * 4 + bj * 8;
                            h2 = *(const PG8_LAS f32x4*)b; h1 = *(const PG8_LAS f32x4*)(b + 64); }
#pragma unroll
                        for (int k = 0; k < 4; ++k) { const float cur = acc[ai][bj][m][n][k]; float x1, z;
                            if (m == 0) { x1 = h1[k]; z = fr == 0 ? h2[k] : h1[k]; }
                            else { const float p = acc[ai][bj][m > 0 ? m - 1 : 0][n][k]; x1 = PG8_DPP(0.f, p, 0x121); z = PG8_DPP(0.f, p, 0x122); }
                            const float t1 = PG8_DPP(x1, cur, 0x111), t2 = PG8_DPP(z, cur, 0x112);
                            c[bj][k] = W[3][k] + W[0][k] * t2 + W[1][k] * t1 + W[2][k] * cur; }
                        __builtin_amdgcn_sched_barrier(0);
                    }
                    const int row = u.pm * BM + ai * HALF + wr * 64 + m * 16 + fr;
                    if (ai == 0 && m == 0 && wr == 0 && fixtile && fr < 2) {
                        float* fp = FIX + ((size_t)u.pm * 2 + fr) * 11264 + ch0 + n * 4;
                        *(f32x4*)fp = c[0]; *(f32x4*)(fp + 5632) = c[1];
                    } else {
                        f32x4 a;
#pragma unroll
                        for (int k = 0; k < 4; ++k) { const float g = c[0][k]; a[k] = g * __builtin_amdgcn_rcpf(1.0f + __builtin_amdgcn_exp2f(-1.4426950408889634f * g)) * c[1][k]; }
                        u32x2 w; w.x = cvt_pk_bf16(a[0], a[1]); w.y = cvt_pk_bf16(a[2], a[3]);
                        *(u32x2*)(ACT + (size_t)row * 5632 + ch0 + n * 4) = w;
                    }
                    asm volatile("" ::: "memory"); __builtin_amdgcn_sched_barrier(0);
                }
        }
    }
};
struct EpiKpe {
    PG8_NOPRE
    static constexpr bool PERM = true, AFTER_DRAIN = false;
    bf16_t* KPE; const float* cosT; const float* sinT; const PG8_LAS float* rsl;
    __device__ __forceinline__ void operator()(const f32x4 (&acc)[2][2][4][2], const Unit& u, int wr, int wc, int fr_, int fq_, int ui) const {
        int fr = fr_, fq = fq_; asm volatile("" : "+v"(fr), "+v"(fq));
        if (wc != 0) return;
        const int row0 = u.pm * BM + wr * 64 + fr, i0 = 8 * fq;
        float r[2][4]; load_rs(r, rsl, wr, fr);
#pragma unroll
        for (int ai = 0; ai < 2; ++ai)
#pragma unroll
            for (int m = 0; m < 4; ++m) { const int row = row0 + ai * HALF + m * 16;
                const f32x4 c0 = *(const f32x4*)(cosT + (size_t)row * 32 + i0), c1 = *(const f32x4*)(cosT + (size_t)row * 32 + i0 + 4);
                const f32x4 s0 = *(const f32x4*)(sinT + (size_t)row * 32 + i0), s1 = *(const f32x4*)(sinT + (size_t)row * 32 + i0 + 4);
                const f32x4 x1a = acc[ai][0][m][0] * r[ai][m], x1b = acc[ai][0][m][1] * r[ai][m], x2a = acc[ai][1][m][0] * r[ai][m], x2b = acc[ai][1][m][1] * r[ai][m];
                const f32x4 y1a = x1a * c0 - x2a * s0, y1b = x1b * c1 - x2b * s1, y2a = x2a * c0 + x1a * s0, y2b = x2b * c1 + x1b * s1;
                bf16_t* dst = KPE + (size_t)row * 64 + i0;
                *(u32x4*)dst = pack8bf(y1a, y1b); *(u32x4*)(dst + 32) = pack8bf(y2a, y2b); }
    }
};
struct PanelUnits { int pm, pn0, n;
    __device__ __forceinline__ bool next(int i, Unit& u) const { if (i >= n) return false; u.pm = pm; u.pn = pn0 + i; return true; }
    __device__ __forceinline__ void a_ready(const Unit&) const {}
    __device__ __forceinline__ void done(const Unit&) const {}
};
struct OneUnit { int pm, pn;
    __device__ __forceinline__ bool next(int i, Unit& u) const { if (i) return false; u.pm = pm; u.pn = pn; return true; }
    __device__ __forceinline__ void a_ready(const Unit&) const {}
    __device__ __forceinline__ void done(const Unit&) const {}
};
struct EpiKvMla {
    PG8_NOPRE
    static constexpr bool PERM = true, AFTER_DRAIN = false;
    bf16_t* KH; bf16_t* VH; const PG8_LAS float* rsl;
    __device__ __forceinline__ void operator()(const f32x4 (&acc)[2][2][4][2], const Unit& u, int wr, int wc, int fr_, int fq_, int ui) const {
        int fr = fr_, fq = fq_; asm volatile("" : "+v"(fr), "+v"(fq));
        const int row0 = u.pm * BM + wr * 64 + fr, dim0 = wc * 32 + 8 * fq;
        float r[2][4]; load_rs(r, rsl, wr, fr);
#pragma unroll
        for (int ai = 0; ai < 2; ++ai)
#pragma unroll
            for (int m = 0; m < 4; ++m) { const int row = row0 + ai * HALF + m * 16, b = row >> 12, s = row & 4095;
                const size_t o = (((size_t)b * 16 + u.pn) * 4096 + s) * 128 + dim0;
                *(u32x4*)(KH + o) = pack8bf(acc[ai][0][m][0] * r[ai][m], acc[ai][0][m][1] * r[ai][m]); *(u32x4*)(VH + o) = pack8bf(acc[ai][1][m][0] * r[ai][m], acc[ai][1][m][1] * r[ai][m]); }
    }
};
struct EpiQMla {
    PG8_NOPRE
    static constexpr bool PERM = true, AFTER_DRAIN = false;
    bf16_t* Q; const float* cosT; const float* sinT; const PG8_LAS float* rsl;
    __device__ __forceinline__ void operator()(const f32x4 (&acc)[2][2][4][2], const Unit& u, int wr, int wc, int fr_, int fq_, int ui) const {
        int fr = fr_, fq = fq_; asm volatile("" : "+v"(fr), "+v"(fq));
        const int row0 = u.pm * BM + wr * 64 + fr;
        float r[2][4]; load_rs(r, rsl, wr, fr);
        if (u.pn < 8) {
            const int col0 = u.pn * BM + wc * 32 + 8 * fq;
#pragma unroll
            for (int ai = 0; ai < 2; ++ai)
#pragma unroll
                for (int m = 0; m < 4; ++m) { bf16_t* rowp = Q + (size_t)(row0 + ai * HALF + m * 16) * 3072 + col0;
#pragma unroll
                    for (int bj = 0; bj < 2; ++bj) *(u32x4*)(rowp + bj * HALF) = pack8bf(acc[ai][bj][m][0] * r[ai][m], acc[ai][bj][m][1] * r[ai][m]); }
        } else {
            const int head = 4 * (u.pn - 8) + wc, i0 = 8 * fq;
#pragma unroll
            for (int ai = 0; ai < 2; ++ai)
#pragma unroll
                for (int m = 0; m < 4; ++m) { const int row = row0 + ai * HALF + m * 16;
                    const f32x4 c0 = *(const f32x4*)(cosT + (size_t)row * 32 + i0), c1 = *(const f32x4*)(cosT + (size_t)row * 32 + i0 + 4);
                    const f32x4 s0 = *(const f32x4*)(sinT + (size_t)row * 32 + i0), s1 = *(const f32x4*)(sinT + (size_t)row * 32 + i0 + 4);
                    const f32x4 x1a = acc[ai][0][m][0] * r[ai][m], x1b = acc[ai][0][m][1] * r[ai][m], x2a = acc[ai][1][m][0] * r[ai][m], x2b = acc[ai][1][m][1] * r[ai][m];
                    const f32x4 y1a = x1a * c0 - x2a * s0, y1b = x1b * c1 - x2b * s1, y2a = x2a * c0 + x1a * s0, y2b = x2b * c1 + x1b * s1;
                    bf16_t* dst = Q + (size_t)row * 3072 + 2048 + head * 64 + i0;
                    *(u32x4*)dst = pack8bf(y1a, y1b); *(u32x4*)(dst + 32) = pack8bf(y2a, y2b); }
        }
    }
};
struct EpiQkvDil {
    PG8_NOPRE
    static constexpr bool PERM = true, AFTER_DRAIN = false;
    bf16_t* O; const float* cosT; const float* sinT; const PG8_LAS float* rsl;
    __device__ __forceinline__ void operator()(const f32x4 (&acc)[2][2][4][2], const Unit& u, int wr, int wc, int fr, int fq, int ui) const {
        const int row0 = u.pm * BM + wr * 64 + fr;
        const int g = u.pn / 24, rem = u.pn - g * 24, t = rem >> 3, T = rem & 7, sh = 2 * g;
        float r[2][4]; load_rs(r, rsl, wr, fr);
        const size_t plane = ((size_t)(g * 3 + t) * 16 + 2 * T) * 4;
        if (t == 2 || wc != 0) {
            const int dim0 = wc * 32 + 8 * fq;
#pragma unroll
            for (int ai = 0; ai < 2; ++ai)
#pragma unroll
                for (int m = 0; m < 4; ++m) { const int row = row0 + ai * HALF + m * 16, b = row >> 12, s = row & 4095, sp = ((s & ((1 << sh) - 1)) << (12 - sh)) + (s >> sh);
#pragma unroll
                    for (int bj = 0; bj < 2; ++bj) *(u32x4*)(O + ((plane + bj * 4 + b) * 4096 + sp) * 128 + dim0) = pack8bf(acc[ai][bj][m][0] * r[ai][m], acc[ai][bj][m][1] * r[ai][m]); }
        } else {
            const int hh = fq >> 1, i0 = 8 * (fq & 1);
#pragma unroll
            for (int ai = 0; ai < 2; ++ai)
#pragma unroll
                for (int m = 0; m < 4; ++m) { const int row = row0 + ai * HALF + m * 16, b = row >> 12, s = row & 4095, sp = ((s & ((1 << sh) - 1)) << (12 - sh)) + (s >> sh);
                    const f32x4 c0 = *(const f32x4*)(cosT + (size_t)row * 16 + i0), c1 = *(const f32x4*)(cosT + (size_t)row * 16 + i0 + 4);
                    const f32x4 s0 = *(const f32x4*)(sinT + (size_t)row * 16 + i0), s1 = *(const f32x4*)(sinT + (size_t)row * 16 + i0 + 4);
                    const f32x4 x1a = acc[ai][0][m][0] * r[ai][m], x1b = acc[ai][0][m][1] * r[ai][m], x2a = acc[ai][1][m][0] * r[ai][m], x2b = acc[ai][1][m][1] * r[ai][m];
                    const f32x4 y1a = x1a * c0 - x2a * s0, y1b = x1b * c1 - x2b * s1, y2a = x2a * c0 + x1a * s0, y2b = x2b * c1 + x1b * s1;
                    bf16_t* dst = O + ((plane + hh * 4 + b) * 4096 + sp) * 128 + i0;
                    *(u32x4*)dst = pack8bf(y1a, y1b); *(u32x4*)(dst + 16) = pack8bf(y2a, y2b); }
        }
    }
};

template <class Epi, class Sched, bool ALIGN_EPI = false, bool SP2 = false, int EPI_REP = 1>
__device__ __forceinline__ void gemm_phase(PG8_LAS unsigned char* lds, const Gemm g, const Sched& S, const Epi& E) {
    int tid_ = threadIdx.x; asm volatile("" : "+v"(tid_));
    const int tid = tid_, wid = __builtin_amdgcn_readfirstlane(tid >> 6), lane = tid & 63, wr = wid >> 2, wc = wid & 3, fr = lane & 15, fq = lane >> 4;
    const int K = g.K, nt = K / BK;
    unsigned voffA[2], voffB[2];
#pragma unroll
    for (int i = 0; i < 2; ++i) { int R, C; stage_rc(tid * 16 + i * 8192, R, C); const int Rb = Epi::PERM ? ((R & ~31) + perm32(R & 31)) : R;
        voffA[i] = (unsigned)(R * K + C) * 2u; voffB[i] = (unsigned)(Rb * K + C) * 2u; }
    const size_t kstep = (size_t)(BK * 2);
    const size_t hstep = (size_t)HALF * K * 2;
    const size_t tstep = 2 * hstep;
    const unsigned ldsw = (unsigned)wid * 1024u;
    const int aoff = lds_byte(wr * 64 + fr, fq * 8), boff = lds_byte(wc * 32 + fr, fq * 8);
#define PG8_SA(b, h) (((b) * 2 + (h)) * HTB)
#define PG8_SB(b, h) ((4 + (b) * 2 + (h)) * HTB)
#define PG8_STAGE(bufoff, gbase, voff) do { _Pragma("unroll") for (int _i = 0; _i < 2; ++_i) \
        __builtin_amdgcn_global_load_lds((const unsigned*)((const char*)(gbase) + (voff)[_i]), (PG8_LAS unsigned*)(lds + (bufoff) + ldsw + _i * 8192), 16, 0, 0); } while (0)
#define PG8_LDA(dst, b, h) do { _Pragma("unroll") for (int m = 0; m < 4; ++m) _Pragma("unroll") for (int k = 0; k < 2; ++k) dst[m][k] = *(const PG8_LAS bf16x8*)(lds + PG8_SA(b, h) + aoff + m * 2048 + k * 1024); } while (0)
#define PG8_LDB(dst, b, h) do { _Pragma("unroll") for (int n = 0; n < 2; ++n) _Pragma("unroll") for (int k = 0; k < 2; ++k) dst[n][k] = *(const PG8_LAS bf16x8*)(lds + PG8_SB(b, h) + boff + n * 2048 + k * 1024); } while (0)
#define PG8_MMA(ai, bj, At, Bt) do { __builtin_amdgcn_s_setprio(1); _Pragma("unroll") for (int m = 0; m < 4; ++m) _Pragma("unroll") for (int n = 0; n < 2; ++n) _Pragma("unroll") for (int k = 0; k < 2; ++k) \
        acc[ai][bj][m][n] = __builtin_amdgcn_mfma_f32_16x16x32_bf16(Bt[n][k], At[m][k], acc[ai][bj][m][n], 0, 0, 0); __builtin_amdgcn_s_setprio(0); } while (0)
#define PG8_WAIT_V(n) asm volatile("s_waitcnt vmcnt(" #n ")" ::: "memory")
#define PG8_WAIT_L(n) asm volatile("s_waitcnt lgkmcnt(" #n ")" ::: "memory")
#define PG8_BAR __builtin_amdgcn_s_barrier()
#define PG8_SCHED __builtin_amdgcn_sched_barrier(0)
    Unit cur, nxt; int ui = 0;
    typename Epi::Pre pre;
    if (!S.next(0, cur)) return;
    f32x4 acc[2][2][4][2];
#pragma unroll
    for (int a = 0; a < 2; ++a)
#pragma unroll
        for (int b = 0; b < 2; ++b)
#pragma unroll
            for (int m = 0; m < 4; ++m)
#pragma unroll
                for (int n = 0; n < 2; ++n) acc[a][b][m][n] = (f32x4){0.f, 0.f, 0.f, 0.f};
    bf16x8 At[4][2], B0[2][2], B1[2][2];
    const char* cA = (const char*)g.A + (size_t)cur.pm * tstep; const char* cB = (const char*)g.Bt + (size_t)cur.pn * tstep;
    S.a_ready(cur);
    if constexpr (SP2) {
        PG8_STAGE(PG8_SB(0, 0), cB, voffB); PG8_STAGE(PG8_SB(0, 1), cB + hstep, voffB); PG8_STAGE(PG8_SA(0, 0), cA, voffA); PG8_STAGE(PG8_SA(0, 1), cA + hstep, voffA);
        if (wr == 1) PG8_BAR;
        PG8_WAIT_V(2); PG8_BAR;
        PG8_STAGE(PG8_SB(1, 0), cB + kstep, voffB); PG8_STAGE(PG8_SA(1, 0), cA + kstep, voffA); PG8_STAGE(PG8_SB(1, 1), cB + hstep + kstep, voffB);
        PG8_WAIT_V(6); PG8_BAR;
    } else {
        PG8_STAGE(PG8_SB(0, 0), cB, voffB); PG8_STAGE(PG8_SA(0, 0), cA, voffA); PG8_STAGE(PG8_SB(0, 1), cB + hstep, voffB); PG8_STAGE(PG8_SA(0, 1), cA + hstep, voffA);
        if (wr == 1) PG8_BAR;
        PG8_WAIT_V(4); PG8_BAR;
        PG8_STAGE(PG8_SB(1, 0), cB + kstep, voffB); PG8_STAGE(PG8_SA(1, 0), cA + kstep, voffA); PG8_STAGE(PG8_SB(1, 1), cB + hstep + kstep, voffB);
        PG8_WAIT_V(6); PG8_BAR;
    }
    for (;;) {
        const bool has_next = S.next(ui + 1, nxt);
        const char* nA = has_next ? (const char*)g.A + (size_t)nxt.pm * tstep : cA; const char* nB = has_next ? (const char*)g.Bt + (size_t)nxt.pn * tstep : cB;
        for (int t = 0; t < nt; t += 2) {
            const bool last = (t == nt - 2);
            const char* a1 = cA + (size_t)(t + 1) * kstep;
            const char* a2 = last ? nA : cA + (size_t)(t + 2) * kstep; const char* b2 = last ? nB : cB + (size_t)(t + 2) * kstep;
            const char* a3 = a2 + kstep; const char* b3 = b2 + kstep;
            if (last && has_next) S.a_ready(nxt);
            if (t == 0) E.pre_issue(pre, cur, tid, ui); else if (t == 2) E.pre_finish(pre, tid, ui);
            if constexpr (SP2) {
            PG8_LDB(B0, 0, 0); PG8_LDB(B1, 0, 1); PG8_SCHED; PG8_LDA(At, 0, 0); PG8_STAGE(PG8_SA(1, 1), a1 + hstep, voffA);
            PG8_WAIT_V(8); PG8_WAIT_L(0); PG8_BAR; PG8_MMA(0, 0, At, B0); PG8_MMA(0, 1, At, B1); PG8_BAR; PG8_SCHED;
            PG8_LDA(At, 0, 1); PG8_STAGE(PG8_SB(0, 0), b2, voffB); PG8_STAGE(PG8_SB(0, 1), b2 + hstep, voffB); PG8_STAGE(PG8_SA(0, 0), a2, voffA);
            PG8_WAIT_V(8); PG8_WAIT_L(0); PG8_BAR; PG8_MMA(1, 0, At, B0); PG8_MMA(1, 1, At, B1); PG8_BAR; PG8_SCHED;
            PG8_LDB(B0, 1, 0); PG8_LDB(B1, 1, 1); PG8_SCHED; PG8_LDA(At, 1, 0); PG8_STAGE(PG8_SA(0, 1), a2 + hstep, voffA);
            PG8_WAIT_V(8); PG8_WAIT_L(0); PG8_BAR; PG8_MMA(0, 0, At, B0); PG8_MMA(0, 1, At, B1); PG8_BAR; PG8_SCHED;
            PG8_LDA(At, 1, 1); PG8_STAGE(PG8_SB(1, 0), b3, voffB); PG8_STAGE(PG8_SB(1, 1), b3 + hstep, voffB); PG8_STAGE(PG8_SA(1, 0), a3, voffA);
            PG8_WAIT_V(8); PG8_WAIT_L(0); PG8_BAR; PG8_MMA(1, 0, At, B0); PG8_MMA(1, 1, At, B1); PG8_BAR; PG8_SCHED;
            } else {
            PG8_LDB(B0, 0, 0); PG8_SCHED; PG8_LDA(At, 0, 0); PG8_STAGE(PG8_SA(1, 1), a1 + hstep, voffA);
            PG8_WAIT_L(8); PG8_BAR; PG8_WAIT_L(0); PG8_MMA(0, 0, At, B0); PG8_BAR; PG8_SCHED;
            PG8_LDB(B1, 0, 1); PG8_STAGE(PG8_SB(0, 0), b2, voffB);
            PG8_BAR; PG8_WAIT_L(0); PG8_MMA(0, 1, At, B1); PG8_BAR;
            PG8_LDA(At, 0, 1); PG8_STAGE(PG8_SA(0, 0), a2, voffA);
            PG8_BAR; PG8_WAIT_L(0); PG8_MMA(1, 0, At, B0); PG8_BAR; PG8_SCHED;
            PG8_STAGE(PG8_SB(0, 1), b2 + hstep, voffB);
            PG8_WAIT_V(6); PG8_BAR; PG8_MMA(1, 1, At, B1); PG8_BAR;
            PG8_LDB(B0, 1, 0); PG8_SCHED; PG8_LDA(At, 1, 0); PG8_STAGE(PG8_SA(0, 1), a2 + hstep, voffA);
            PG8_WAIT_L(8); PG8_BAR; PG8_WAIT_L(0); PG8_MMA(0, 0, At, B0); PG8_BAR; PG8_SCHED;
            PG8_LDB(B1, 1, 1); PG8_STAGE(PG8_SB(1, 0), b3, voffB);
            PG8_BAR; PG8_WAIT_L(0); PG8_MMA(0, 1, At, B1); PG8_BAR;
            PG8_LDA(At, 1, 1); PG8_STAGE(PG8_SA(1, 0), a3, voffA);
            PG8_BAR; PG8_WAIT_L(0); PG8_MMA(1, 0, At, B0); PG8_BAR; PG8_SCHED;
            PG8_STAGE(PG8_SB(1, 1), b3 + hstep, voffB);
            PG8_WAIT_V(6); PG8_BAR; PG8_MMA(1, 1, At, B1); PG8_BAR;
            }
        }
        if constexpr (ALIGN_EPI) { if (wr == 0) PG8_BAR; }
        if constexpr (!Epi::AFTER_DRAIN) { _Pragma("unroll") for (int rep_ = 0; rep_ < EPI_REP; ++rep_) E(acc, cur, wr, wc, fr, fq, ui); S.done(cur); }
        if (!has_next) break;
#pragma unroll
        for (int a = 0; a < 2; ++a)
#pragma unroll
            for (int b = 0; b < 2; ++b)
#pragma unroll
                for (int m = 0; m < 4; ++m)
#pragma unroll
                    for (int n = 0; n < 2; ++n) acc[a][b][m][n] = (f32x4){0.f, 0.f, 0.f, 0.f};
        cur = nxt; cA = nA; cB = nB; ++ui;
        if constexpr (ALIGN_EPI) { if (wr == 1) PG8_BAR; }
    }
    PG8_WAIT_V(0);
    if constexpr (!ALIGN_EPI) { if (wr == 0) PG8_BAR; }
    PG8_BAR;
    if constexpr (Epi::AFTER_DRAIN) { E.fused(acc, cur, wr, wc, fr, fq, lds, wid, lane); S.done(cur); }
#undef PG8_SA
#undef PG8_SB
#undef PG8_STAGE
#undef PG8_LDA
#undef PG8_LDB
#undef PG8_MMA
#undef PG8_WAIT_V
#undef PG8_WAIT_L
#undef PG8_BAR
#undef PG8_SCHED
}
}
namespace att {
typedef unsigned short bf16;
typedef short bf16x8 __attribute__((ext_vector_type(8)));
typedef short s16x4 __attribute__((ext_vector_type(4)));
typedef float f32x16 __attribute__((ext_vector_type(16)));
typedef float f32x4 __attribute__((ext_vector_type(4)));
typedef unsigned u32x4 __attribute__((ext_vector_type(4)));
constexpr int NW = 8, QBLK = 32, KVBLK = 64, QB = NW * QBLK;
constexpr int SHM_V = KVBLK * 128 * 2, SHM_K = KVBLK * 128 * 2, KPE_ROW = 144, SHM_KPE = KVBLK * KPE_ROW;
constexpr int OFF_V = 0, OFF_K = 2 * SHM_V, OFF_WS = OFF_K + 2 * SHM_K, OFF_KPE = OFF_WS + NW * 64 * 4, OFF_QPE = OFF_KPE + 2 * SHM_KPE, LDS_BYTES = OFF_QPE + NW * 4096;
constexpr float THR = 8.f;

#define KSWZ(row, colB) ((row) * 256 + ((colB) ^ (((row) & 7) << 4)))
#define SBAR() __builtin_amdgcn_sched_barrier(0)
__device__ __forceinline__ int v_st(int k, int c) { const int kk = (k & ~0xC) | ((k & 4) << 1) | ((k & 8) >> 1); return ((kk >> 3) * 4 + (c >> 5)) * 512 + ((kk & 7) * 32 + (c & 31)) * 2; }
__device__ __forceinline__ int v_rd_base(int lane) { return ((lane & 3) << 3) | (((lane >> 2) & 3) << 6) | (((lane >> 4) & 1) << 5) | (((lane >> 5) & 1) << 8); }
constexpr int v_rd_off(int d0, int ks, int half) { return d0 * 512 + ks * 4096 + half * 2048; }
__device__ __forceinline__ int crow(int r, int hi) { return (r & 3) + 8 * (r >> 2) + 4 * hi; }
__device__ __forceinline__ unsigned cvtpk(float lo, float hi) { unsigned r; asm volatile("v_cvt_pk_bf16_f32 %0, %1, %2" : "=v"(r) : "v"(lo), "v"(hi)); return r; }
__device__ __forceinline__ bf16x8 ld8(const bf16* p) { return *reinterpret_cast<const bf16x8*>(p); }
__device__ __forceinline__ void mask_tile(f32x16& p0, f32x16& p1, int dq, unsigned W) {
    const float NEG = -__builtin_inff();
#pragma unroll
    for (int r = 0; r < 16; ++r) {
        const int c = (r & 3) + 8 * (r >> 2);
        if ((unsigned)(dq - c) >= W) p0[r] = NEG;
        if ((unsigned)(dq - c - 32) >= W) p1[r] = NEG;
    }
}
__device__ __forceinline__ void partialSM(f32x16& p0, f32x16& p1, float& m_reg, float& mn, float& alpha, const float scale) {
    float pmax = p0[0]; for (int r = 1; r < 16; ++r) pmax = fmaxf(pmax, p0[r]); for (int r = 0; r < 16; ++r) pmax = fmaxf(pmax, p1[r]);
    { auto rr = __builtin_amdgcn_permlane32_swap(__float_as_uint(pmax), __float_as_uint(pmax), false, false);
      pmax = fmaxf(__uint_as_float(rr[0]), __uint_as_float(rr[1])); }
    const float C2 = 1.4426950408889634f * scale;
    if (__builtin_expect(__all((pmax - m_reg) * scale <= THR), 1)) { mn = m_reg; alpha = 1.f; }
    else { mn = fmaxf(m_reg, pmax); alpha = __builtin_amdgcn_exp2f((m_reg - mn) * C2); m_reg = mn; }
    const float mnL = -mn * C2;
    for (int r = 0; r < 16; ++r) p0[r] = fmaf(p0[r], C2, mnL); for (int r = 0; r < 16; ++r) p1[r] = fmaf(p1[r], C2, mnL);
    for (int r = 0; r < 16; ++r) p0[r] = __builtin_amdgcn_exp2f(p0[r]);
}
__device__ __forceinline__ void finishSM(f32x16& p0, f32x16& p1, float alpha, float& l_reg, bf16x8& pa0, bf16x8& pa1, bf16x8& pa2, bf16x8& pa3) {
    for (int r = 0; r < 16; ++r) p1[r] = __builtin_amdgcn_exp2f(p1[r]);
    float ps = 0; for (int r = 0; r < 16; ++r) ps += p0[r]; for (int r = 0; r < 16; ++r) ps += p1[r];
    { auto rr = __builtin_amdgcn_permlane32_swap(__float_as_uint(ps), __float_as_uint(ps), false, false);
      ps = __uint_as_float(rr[0]) + __uint_as_float(rr[1]); }
    l_reg = l_reg * alpha + ps;
#define PK4(P, B_, OUT) do { unsigned a0 = cvtpk(P[B_+0], P[B_+1]), a1 = cvtpk(P[B_+2], P[B_+3]);                          \
        unsigned b0 = cvtpk(P[B_+4], P[B_+5]), b1 = cvtpk(P[B_+6], P[B_+7]);                                             \
        auto r0 = __builtin_amdgcn_permlane32_swap(a0, b0, false, false); auto r1 = __builtin_amdgcn_permlane32_swap(a1, b1, false, false); \
        u32x4 w = {r0[0], r1[0], r0[1], r1[1]}; OUT = *reinterpret_cast<bf16x8*>(&w); } while (0)
    PK4(p0, 0, pa0); PK4(p0, 8, pa1); PK4(p1, 0, pa2); PK4(p1, 8, pa3);
#undef PK4
}
template <int KB, bool SK, bool PE>
__device__ __forceinline__ void qkt(f32x16& p0, f32x16& p1, const char* lds, int r32, int hi, int wid, int lane, const bf16x8* qr, bool act) {
    if (SK && !act) { const float NEG = -__builtin_inff();
#pragma unroll
        for (int r = 0; r < 16; ++r) { p0[r] = NEG; p1[r] = NEG; } return; }
    p0 = f32x16{}; p1 = f32x16{};
    const char* kb[4];
#pragma unroll
    for (int dd = 0; dd < 4; ++dd) kb[dd] = lds + OFF_K + KB * SHM_K + KSWZ(r32, (dd * 16 + hi * 8) * 2);
#pragma unroll
    for (int d0 = 0; d0 < 8; ++d0) { const char* a = kb[d0 & 3] + (d0 >> 2) * 128;
        bf16x8 b0 = *reinterpret_cast<const bf16x8*>(a);
        bf16x8 b1 = *reinterpret_cast<const bf16x8*>(a + 32 * 256);
        p0 = __builtin_amdgcn_mfma_f32_32x32x16_bf16(b0, qr[d0], p0, 0, 0, 0);
        p1 = __builtin_amdgcn_mfma_f32_32x32x16_bf16(b1, qr[d0], p1, 0, 0, 0); }
    if constexpr (PE) {
        const char* kp = lds + OFF_KPE + KB * SHM_KPE + r32 * KPE_ROW + hi * 16;
        const char* qp = lds + OFF_QPE + wid * 4096 + lane * 16;
#pragma unroll
        for (int d0 = 0; d0 < 4; ++d0) {
            bf16x8 b0 = *reinterpret_cast<const bf16x8*>(kp + d0 * 32);
            bf16x8 b1 = *reinterpret_cast<const bf16x8*>(kp + d0 * 32 + 32 * KPE_ROW);
            bf16x8 qf = *reinterpret_cast<const bf16x8*>(qp + d0 * 1024);
            p0 = __builtin_amdgcn_mfma_f32_32x32x16_bf16(b0, qf, p0, 0, 0, 0);
            p1 = __builtin_amdgcn_mfma_f32_32x32x16_bf16(b1, qf, p1, 0, 0, 0); }
    }
}
template <int VB, bool SK>
__device__ __forceinline__ void pv_tile(f32x16* o, int vb0, bf16x8 pa0, bf16x8 pa1, bf16x8 pa2, bf16x8 pa3, bool act) {
    if (SK && !act) return;
#define TRRD(dst, off) asm volatile("ds_read_b64_tr_b16 %0, %1 offset:%2" : "=&v"(dst) : "v"(vb0), "i"(off) : "memory")
#define PV_D0(d0) do { s16x4 l0, l1, l2, l3, h0, h1, h2, h3; constexpr int b_ = OFF_V + VB * SHM_V + v_rd_off(d0, 0, 0); \
        TRRD(l0, b_); TRRD(h0, b_ + 2048); TRRD(l1, b_ + 4096); TRRD(h1, b_ + 6144); TRRD(l2, b_ + 8192); TRRD(h2, b_ + 10240); TRRD(l3, b_ + 12288); TRRD(h3, b_ + 14336); \
        asm volatile("s_waitcnt lgkmcnt(0)" ::: "memory"); SBAR();   \
        o[d0] = __builtin_amdgcn_mfma_f32_32x32x16_bf16(pa0, (bf16x8){l0[0], l0[1], l0[2], l0[3], h0[0], h0[1], h0[2], h0[3]}, o[d0], 0, 0, 0);   \
        o[d0] = __builtin_amdgcn_mfma_f32_32x32x16_bf16(pa1, (bf16x8){l1[0], l1[1], l1[2], l1[3], h1[0], h1[1], h1[2], h1[3]}, o[d0], 0, 0, 0);   \
        o[d0] = __builtin_amdgcn_mfma_f32_32x32x16_bf16(pa2, (bf16x8){l2[0], l2[1], l2[2], l2[3], h2[0], h2[1], h2[2], h2[3]}, o[d0], 0, 0, 0);   \
        o[d0] = __builtin_amdgcn_mfma_f32_32x32x16_bf16(pa3, (bf16x8){l3[0], l3[1], l3[2], l3[3], h3[0], h3[1], h3[2], h3[3]}, o[d0], 0, 0, 0); } while (0)
    PV_D0(0); PV_D0(1); PV_D0(2); PV_D0(3);
#undef PV_D0
#undef TRRD
}

struct Prm { int qs, kvs, os, qpes, kpes, lses, skv, W; float scale; };
struct BlockRef { const bf16* Q; const bf16* K; const bf16* V; bf16* O; const bf16* Qpe; const bf16* Kpe; float* Lse; int P0; };
template <bool PE> struct Seam { bf16x8 qr[8]; bf16x8 st_v0, st_v1, st_k0, st_k1, st_kp; };
__device__ __forceinline__ int swa_jlo(int P0, int W) { const int lowk = P0 - W + 1; return lowk > 0 ? lowk / KVBLK : 0; }
#define VMW() asm volatile("s_waitcnt vmcnt(0)" ::: "memory")
#define LDG(base, off) (*(const bf16x8*)((const char*)(base) + (off)))
#define SLOAD_H(R_, k0) do { const char* kb__ = (const char*)(R_).K + (size_t)(k0) * P.kvs * 2; const char* vb__ = (const char*)(R_).V + (size_t)(k0) * P.kvs * 2; const size_t h__ = (size_t)32 * P.kvs * 2; \
                              S.st_v0 = LDG(vb__, kvoff); S.st_v1 = LDG(vb__ + h__, kvoff); S.st_k0 = LDG(kb__, kvoff); S.st_k1 = LDG(kb__ + h__, kvoff); \
                              if constexpr (PE) S.st_kp = LDG((const char*)(R_).Kpe + (size_t)(k0) * P.kpes * 2, kpoff); } while (0)
#define SWRITE_HK(bf) do { *(bf16x8*)(K_lds + (bf) * SHM_K + kws) = S.st_k0; *(bf16x8*)(K_lds + (bf) * SHM_K + kws + 32 * 256) = S.st_k1; \
                           if constexpr (PE) *(bf16x8*)(lds + OFF_KPE + (bf) * SHM_KPE + pws) = S.st_kp; } while (0)
#define SWRITE_HV(bf) do { *(bf16x8*)(V_lds + (bf) * SHM_V + vst0) = S.st_v0; *(bf16x8*)(V_lds + (bf) * SHM_V + vst1) = S.st_v1; } while (0)
#define SWRITE_H(bf) do { SWRITE_HV(bf); SWRITE_HK(bf); } while (0)
template <bool PE>
__device__ __forceinline__ void swa_prime(const BlockRef& cur, const Prm& P, char* lds, Seam<PE>& S) {
    int tid_ = threadIdx.x; asm volatile("" : "+v"(tid_));
    const int tid = tid_, wid = __builtin_amdgcn_readfirstlane(tid >> 6), lane = tid & 63, r32 = lane & 31, hi = lane >> 5;
    const int sr = tid >> 4, sc = (tid & 15) * 8, kws = KSWZ(sr, sc * 2); char* K_lds = lds + OFF_K;
    const int pr = tid >> 3, pc = (tid & 7) * 8, pws = pr * KPE_ROW + (tid & 7) * 16;
    const unsigned kvoff = (unsigned)(sr * P.kvs + sc) * 2u, kpoff = (unsigned)(pr * P.kpes + pc) * 2u, qoff = (unsigned)((wid * QBLK + r32) * P.qs + hi * 8) * 2u, qpoff = (unsigned)((wid * QBLK + r32) * P.qpes + hi * 8) * 2u;
    const int kb0 = swa_jlo(cur.P0, P.W) * KVBLK;
#pragma unroll
    for (int d0 = 0; d0 < 8; ++d0) S.qr[d0] = LDG(cur.Q, qoff + d0 * 32);
    if constexpr (PE) {
#pragma unroll
        for (int d0 = 0; d0 < 4; ++d0) *(bf16x8*)(lds + OFF_QPE + wid * 4096 + d0 * 1024 + lane * 16) = LDG(cur.Qpe, qpoff + d0 * 32);
    }
    SLOAD_H(cur, kb0); VMW(); SWRITE_HK(0);
    __syncthreads();
}
template <bool PE, bool SK, bool LSE, bool EARLY>
__device__ __forceinline__ void swa_block(const BlockRef& cur, const BlockRef& nxt, const Prm& P, char* lds, Seam<PE>& S) {
    int tid_ = threadIdx.x; asm volatile("" : "+v"(tid_));
    const int tid = tid_, wid = __builtin_amdgcn_readfirstlane(tid >> 6), lane = tid & 63, r32 = lane & 31, hi = lane >> 5;
    const int W = P.W;
    const int j_lo = swa_jlo(cur.P0, W);
    int j_hi = (cur.P0 + QB - 1) / KVBLK + 1; if (j_hi > P.skv / KVBLK) j_hi = P.skv / KVBLK;
    const int NT = j_hi - j_lo;
    const int kbn = swa_jlo(nxt.P0, W) * KVBLK;
    const int qlo = cur.P0 + wid * QBLK, qm = qlo + r32 - 4 * hi;
    char* V_lds = lds + OFF_V; char* K_lds = lds + OFF_K;
    float* ws = (float*)(lds + OFF_WS) + wid * 64; float* li_l = ws, * al_l = ws + 32;
    float m_reg = -1e30f, l_reg = 0; f32x16 o[4] = {};
    const int sr = tid >> 4, sc = (tid & 15) * 8, vst0 = v_st(sr, sc), vst1 = v_st(32 + sr, sc), kws = KSWZ(sr, sc * 2);
    const int pr = tid >> 3, pc = (tid & 7) * 8, pws = pr * KPE_ROW + (tid & 7) * 16;
    const unsigned kvoff = (unsigned)(sr * P.kvs + sc) * 2u, kpoff = (unsigned)(pr * P.kpes + pc) * 2u;
    const int vb0 = (int)(uintptr_t)lds + v_rd_base(lane);
#define RESC(a) do { if (__any((a) < 1.f)) { if (hi == 0) al_l[r32] = (a); asm volatile("s_waitcnt lgkmcnt(0)" ::: "memory");              \
                     for (int d_ = 0; d_ < 4; ++d_) for (int r = 0; r < 16; ++r) o[d_][r] *= al_l[crow(r, hi)]; } } while (0)
#define KBASE(t) ((j_lo + (t)) * KVBLK)
#define ACT(t) (KBASE(t) <= qlo + QBLK - 1 && KBASE(t) + KVBLK - 1 >= qlo - W + 1)
#define MASKT(P0_, P1_, t) do { const int kb_ = KBASE(t); if ((!SK || ACT(t)) && (kb_ + KVBLK - 1 > qlo || kb_ <= qlo + QBLK - 1 - W)) mask_tile(P0_, P1_, qm - kb_, (unsigned)W); } while (0)
    f32x16 pA0, pA1, pB0, pB1; float mnA, mnB, alA, alB; bf16x8 pa0, pa1, pa2, pa3;
    SWRITE_HV(0); SBAR();
    if (NT > 1) { SLOAD_H(cur, KBASE(1)); }
    SBAR(); qkt<0, SK, PE>(pA0, pA1, lds, r32, hi, wid, lane, S.qr, ACT(0));
    MASKT(pA0, pA1, 0); partialSM(pA0, pA1, m_reg, mnA, alA, P.scale);
    if (NT > 1) { VMW(); SWRITE_H(1); }
    __syncthreads();
#define HALF_STEP(PX0, PX1, mnX, alX, PY0, PY1, alY, t, KB, VB, SB) do {                                                      \
        SBAR(); if (EARLY && (t) + 1 < NT) { SLOAD_H(cur, KBASE((t) + 1)); SBAR(); }                                          \
        qkt<KB, SK, PE>(PX0, PX1, lds, r32, hi, wid, lane, S.qr, ACT(t));                                                     \
        finishSM(PY0, PY1, alY, l_reg, pa0, pa1, pa2, pa3); SBAR();                                                           \
        if (!EARLY && (t) + 1 < NT) { SLOAD_H(cur, KBASE((t) + 1)); SBAR(); }                                                 \
        pv_tile<VB, SK>(o, vb0, pa0, pa1, pa2, pa3, ACT((t) - 1)); MASKT(PX0, PX1, (t)); partialSM(PX0, PX1, m_reg, mnX, alX, P.scale); \
        __syncthreads();                                                                                                      \
        if ((t) + 1 < NT) { VMW(); SWRITE_H(SB); }                                                                            \
        RESC(alX); __syncthreads(); } while (0)
    for (int t = 1; t + 1 < NT; t += 2) {
        HALF_STEP(pB0, pB1, mnB, alB, pA0, pA1, alA, t, 1, 0, 0);
        HALF_STEP(pA0, pA1, mnA, alA, pB0, pB1, alB, t + 1, 0, 1, 1);
    }
    const bool even = (NT & 1) == 0;
    if (even) { SBAR(); qkt<1, SK, PE>(pB0, pB1, lds, r32, hi, wid, lane, S.qr, ACT(NT - 1)); SBAR(); }
    SLOAD_H(nxt, kbn); SBAR();
    { const unsigned qoff = (unsigned)((wid * QBLK + r32) * P.qs + hi * 8) * 2u;
#pragma unroll
      for (int d0 = 0; d0 < 8; ++d0) S.qr[d0] = LDG(nxt.Q, qoff + d0 * 32); }
    bf16x8 qpn[4];
    if constexpr (PE) { const unsigned qpoff = (unsigned)((wid * QBLK + r32) * P.qpes + hi * 8) * 2u;
#pragma unroll
        for (int d0 = 0; d0 < 4; ++d0) qpn[d0] = LDG(nxt.Qpe, qpoff + d0 * 32);
    }
    SBAR();
    finishSM(pA0, pA1, alA, l_reg, pa0, pa1, pa2, pa3); SBAR();
    pv_tile<0, SK>(o, vb0, pa0, pa1, pa2, pa3, ACT(even ? NT - 2 : NT - 1));
    if (even) { MASKT(pB0, pB1, NT - 1); partialSM(pB0, pB1, m_reg, mnB, alB, P.scale); __syncthreads(); RESC(alB);
        finishSM(pB0, pB1, alB, l_reg, pa0, pa1, pa2, pa3); SBAR(); pv_tile<1, SK>(o, vb0, pa0, pa1, pa2, pa3, ACT(NT - 1)); }
    SBAR();
    VMW(); SWRITE_HK(0);
    if constexpr (PE) {
#pragma unroll
        for (int d0 = 0; d0 < 4; ++d0) *(bf16x8*)(lds + OFF_QPE + wid * 4096 + d0 * 1024 + lane * 16) = qpn[d0];
    }
    SBAR();
    if (hi == 0) li_l[r32] = l_reg; asm volatile("s_waitcnt lgkmcnt(0)" ::: "memory");
    float rli[16];
#pragma unroll
    for (int r = 0; r < 16; ++r) rli[r] = __builtin_amdgcn_rcpf(li_l[crow(r, hi)]);
    const unsigned ooff = (unsigned)((wid * QBLK + 4 * hi) * P.os + r32) * 2u;
#pragma unroll
    for (int r = 0; r < 16; ++r) { char* ob = (char*)cur.O + (size_t)((r & 3) + 8 * (r >> 2)) * P.os * 2;
#pragma unroll
        for (int d0 = 0; d0 < 4; ++d0) { const float v = o[d0][r] * rli[r];
            const float vn = __uint_as_float((unsigned)__builtin_amdgcn_update_dpp(0, (int)__float_as_uint(v), 0xB1, 0xF, 0xF, true));
            if ((r32 & 1) == 0) *(unsigned*)(ob + ooff + d0 * 64) = cvtpk(v, vn); } }
    if constexpr (LSE) { if (hi == 0) *(float*)((char*)cur.Lse + (unsigned)((wid * QBLK + r32) * P.lses) * 4u) = m_reg * P.scale + __logf(l_reg); }
    __syncthreads();
#undef RESC
#undef KBASE
#undef ACT
#undef MASKT
#undef HALF_STEP
}
#undef LDG
#undef VMW
#undef SLOAD_H
#undef SWRITE_HK
#undef SWRITE_HV
#undef SWRITE_H
#undef KSWZ
#undef SBAR
}
constexpr int NWAVES = 8;
constexpr int BATCH = 4, SEQ = 4096, DM = 2048, M = BATCH * SEQ;
constexpr int NQKVA = 1280;
constexpr int NQB = 3072, NKVB = 4096, NDIL = 18432, FF = 5632, NUP = 2 * FF;
constexpr float EPS = 1e-6f;
constexpr size_t MiB = (size_t)1 << 20;
constexpr size_t WS_CTL = 0, CTL_ZERO_BYTES = 64 * 1024;
constexpr size_t WS_COSM = 1 * MiB, WS_SINM = 3 * MiB, WS_COSD = 5 * MiB, WS_SIND = 6 * MiB;
constexpr size_t WS_WMLA = 8 * MiB, WMLA_STRIDE = 20 * MiB, WMLA_QKVA = 0, WMLA_QB = 5 * MiB, WMLA_KVB = 8 * MiB, WMLA_WO = 12 * MiB;
constexpr size_t WS_WDIL = WS_WMLA + 2 * WMLA_STRIDE, WDIL_STRIDE = 80 * MiB, WDIL_IN = 0, WDIL_WO = 72 * MiB;
constexpr size_t WS_WFFN = WS_WDIL + 2 * WDIL_STRIDE, WFFN_STRIDE = 66 * MiB, WFFN_UP = 0, WFFN_DOWN = 44 * MiB;
constexpr size_t WS_H = WS_WFFN + 4 * WFFN_STRIDE;
constexpr size_t WS_S = WS_H + 64 * MiB;
constexpr size_t S_PQ = 0  , S_QN = 80 * MiB, S_CKVN = 96 * MiB, S_KPE = 112 * MiB, S_Q = 114 * MiB, S_KV = 210 * MiB, S_AO_MLA = 338 * MiB;
constexpr size_t S_QKV = 0, S_OG = 576 * MiB, S_LSE = 768 * MiB, S_AO_DIL = 771 * MiB;
constexpr size_t S_U = 0, S_ACT = 352 * MiB;
constexpr size_t WS_HALO = WS_S + 835 * MiB, WS_FIX = WS_HALO + 6 * MiB;
constexpr size_t WS_PS = WS_FIX + 6 * MiB, PS_STRIDE = 2 * MiB;
constexpr size_t WS_END = WS_PS + 8 * PS_STRIDE;
static_assert(WS_H == 472 * MiB && WS_END == 1399 * MiB, "d_ws map");
constexpr int CW_BAR = 4096;
constexpr int RING_OFF = 0, RING_BYTES = 131072, LDSCTL_OFF = RING_BYTES, MISC_OFF = LDSCTL_OFF + 320, XH_OFF = RING_BYTES + 1024  , CWL_OFF = XH_OFF + 6144  , RSL_OFF = CWL_OFF + 4096  , RSQ_OFF = RSL_OFF + 1024  , LDS_BYTES = 163840;
static_assert(CWL_OFF + 8192 <= LDS_BYTES, "LDS map");
static_assert(att::LDS_BYTES <= RING_BYTES && pg8::STAGE_BYTES <= RING_BYTES, "LDS map");

#define GAS __attribute__((address_space(1)))
#define LAS __attribute__((address_space(3)))
typedef unsigned short bf16;
typedef unsigned v4u __attribute__((ext_vector_type(4)));
typedef unsigned v2u __attribute__((ext_vector_type(2)));
typedef float f32x4 __attribute__((ext_vector_type(4)));
typedef GAS unsigned gu32;
#define RLX_AGENT __ATOMIC_RELAXED, __HIP_MEMORY_SCOPE_AGENT
#define LDS_WAIT() asm volatile("s_waitcnt lgkmcnt(0)" ::: "memory")
__device__ __forceinline__ unsigned pk2(float lo, float hi) { return pg8::cvt_pk_bf16(lo, hi); }
__device__ __forceinline__ float bf_lo(unsigned w) { return __uint_as_float(w << 16); }
__device__ __forceinline__ float bf_hi(unsigned w) { return __uint_as_float(w & 0xffff0000u); }

#define XB_TMO      128
#define XB_XCNT(j)  (256  + 64 * (j))
#define XB_XSUB(j)  (1280 + 64 * (j))
#define XB_XGEN(j)  (2304 + 64 * (j))
#define XB_TOP      3328
#define XB_TOPGEN   3392
#define XCD_BAR_WORDS 3456
#define XB_SPIN_CAP (1u << 18)

__device__ __forceinline__ unsigned xb_ld(unsigned* p)              { return __hip_atomic_load(p, __ATOMIC_RELAXED, __HIP_MEMORY_SCOPE_AGENT); }
__device__ __forceinline__ unsigned xb_add(unsigned* p, unsigned v) { return __hip_atomic_fetch_add(p, v, __ATOMIC_RELAXED, __HIP_MEMORY_SCOPE_AGENT); }
__device__ __forceinline__ unsigned xb_xcc_id() { return (unsigned)__builtin_amdgcn_s_getreg((3 << 11) | 20) & 0xFu; }
#define XB_SPIN(cond, bar) do { unsigned _sp = 0; while (cond) { __builtin_amdgcn_s_sleep(1); \
    if ((++_sp & 255u) == 0u) { if (xb_ld(&(bar)[XB_TMO])) break; if (_sp > XB_SPIN_CAP) { atomicAdd(&(bar)[XB_TMO], 1u); break; } } } } while (0)

struct XcdBarrier {
    unsigned* bar; unsigned x;
    volatile LAS unsigned* st;
};

__device__ __forceinline__ XcdBarrier xcd_barrier_post(unsigned* bar, volatile LAS unsigned* st) {
    XcdBarrier b; b.bar = bar; b.x = xb_xcc_id(); b.st = st;
    if (threadIdx.x == 0) (void)xb_add(&bar[XB_XCNT(b.x)], 1u);
    return b;
}
__device__ __forceinline__ void xcd_barrier_complete(unsigned* bar, unsigned x, unsigned& nloc, unsigned& nx) {
    const unsigned G = gridDim.x * gridDim.y * gridDim.z;
    unsigned sum, cnt, mine, sp = 0u;
    for (;;) {
        sum = 0u; cnt = 0u; mine = 0u;
#pragma unroll
        for (unsigned j = 0; j < 16; ++j) { const unsigned c = xb_ld(&bar[XB_XCNT(j)]); sum += c; cnt += (c > 0u) ? 1u : 0u; mine = (j == x) ? c : mine; }
        if (sum == G) break;
        __builtin_amdgcn_s_sleep(1);
        if ((++sp & 255u) == 0u) { if (xb_ld(&bar[XB_TMO])) break; if (sp > XB_SPIN_CAP) { atomicAdd(&bar[XB_TMO], 1u); break; } }
    }
    nloc = mine > 0u ? mine : 1u; nx = cnt > 0u ? cnt : 1u;
}

__device__ __forceinline__ void xcd_barrier(const XcdBarrier& b) {
    asm volatile("s_waitcnt vmcnt(0)" ::: "memory");
    __syncthreads();
    if (threadIdx.x == 0) {
        __attribute__((address_space(1))) unsigned* barg_ = (__attribute__((address_space(1))) unsigned*)b.bar; unsigned bx_ = b.x;
        asm volatile("" : "+s"(barg_), "+s"(bx_)); unsigned* bar = (unsigned*)barg_;
        __builtin_amdgcn_s_waitcnt(0);
        unsigned nloc = b.st[0], nx = b.st[1];
        if (nloc == 0u) { xcd_barrier_complete(bar, bx_, nloc, nx); b.st[0] = nloc; b.st[1] = nx; }
        const unsigned old = xb_add(&bar[XB_XSUB(bx_)], 1u);
        const unsigned gen = old / nloc;
        if (old + 1u == (gen + 1u) * nloc) {
            __builtin_amdgcn_fence(__ATOMIC_RELEASE, "agent");
            asm volatile("s_waitcnt vmcnt(0)" ::: "memory");
            const unsigned og = xb_add(&bar[XB_TOP], 1u);
            const unsigned tg = og / nx;
            if (og + 1u == (tg + 1u) * nx) xb_add(&bar[XB_TOPGEN], 1u);
            else XB_SPIN(xb_ld(&bar[XB_TOPGEN]) == tg, bar);
            __builtin_amdgcn_fence(__ATOMIC_ACQUIRE, "agent");
            xb_add(&bar[XB_XGEN(bx_)], 1u);
            asm volatile("s_waitcnt vmcnt(0)" ::: "memory");
        } else {
            XB_SPIN(xb_ld(&bar[XB_XGEN(bx_)]) == gen, bar);
            __builtin_amdgcn_fence(__ATOMIC_ACQUIRE, "agent");
            asm volatile("s_waitcnt vmcnt(0)" ::: "memory");
        }
    }
    __syncthreads();
}


__device__ __forceinline__ const void* karg(int k) {
    const __attribute__((address_space(4))) char* kp = (const __attribute__((address_space(4))) char*)__builtin_amdgcn_kernarg_segment_ptr();
    asm volatile("" : "+s"(kp));
    return *(const void* const __attribute__((address_space(4)))*)(kp + 8 * k);
}
#define LANE_IDS() int tid_ = threadIdx.x; asm volatile("" : "+v"(tid_)); const int tid = tid_, lane = tid & 63, wave = __builtin_amdgcn_readfirstlane(tid >> 6); (void)tid; (void)lane; (void)wave
struct Frame {
    LAS unsigned char* lds;
    volatile LAS unsigned* MISC;
    gu32* ctl;
    int vcu, G;
    float* out; unsigned char* wsb;
};
#define SWZ_XOR(v, m) __uint_as_float((unsigned)__builtin_amdgcn_ds_swizzle((int)__float_as_uint(v), (((m) << 10) | 0x1f)))
__device__ __forceinline__ float xor32(float v) { auto rr = __builtin_amdgcn_permlane32_swap(__float_as_uint(v), __float_as_uint(v), false, false); return __uint_as_float((threadIdx.x & 32) ? rr[0] : rr[1]); }
__device__ __forceinline__ float xor1(float v) { return __uint_as_float((unsigned)__builtin_amdgcn_update_dpp(0, (int)__float_as_uint(v), 0xB1, 0xF, 0xF, true)); }
__device__ __forceinline__ float wave_sum(float v) {
    v += SWZ_XOR(v, 1); v += SWZ_XOR(v, 2); v += SWZ_XOR(v, 4); v += SWZ_XOR(v, 8); v += SWZ_XOR(v, 16);
    auto rr = __builtin_amdgcn_permlane32_swap(__float_as_uint(v), __float_as_uint(v), false, false);
    return __uint_as_float(rr[0]) + __uint_as_float(rr[1]);
}
__device__ __forceinline__ float dot4(const f32x4 a) { return (a.x * a.x + a.y * a.y) + (a.z * a.z + a.w * a.w); }

template <int KIND> __device__ __forceinline__ int dest_row(int n) {
    if constexpr (KIND == 0) return n;
    else if constexpr (KIND == 3) return n < 544 ? n : n + 96;
    else if constexpr (KIND == 4) { const int v = n >= FF, c = v ? n - FF : n; return 256 * (c >> 7) + 128 * v + (c & 127); }
    else if constexpr (KIND == 1) {
        const int h = n / 192, d = n - h * 192;
        if (d < 128) return h * 128 + d;
        const int i = d - 128, t = h >> 2, hh = h & 3;
        return 2048 + 256 * t + 32 * hh + (i < 32 ? i : 128 + (i - 32));
    } else {
        const int g = n / 6144, r = n - g * 6144, t = r >> 11, r2 = r & 2047, h = r2 >> 7, d = r2 & 127;
        if (t == 2) return n;
        const int T = h >> 1, hh = h & 1;
        const int tc = d < 16 ? 16 * hh + d : (d < 32 ? 128 + 16 * hh + (d - 16) : hh * 128 + d);
        return g * 6144 + t * 2048 + T * 256 + tc;
    }
}
template <int KIND, bool GAIN> __device__ __forceinline__ void p0_transpose_item(const float* W, const float* gain, int K, int N, bf16* WT, int row_off, LAS float* scr, int item, int lane) {
    const int nblk = N / 32, kb = item / nblk, nb = item - kb * nblk, k0 = 64 * kb, n0 = 32 * nb;
#pragma unroll 8
    for (int i = 0; i < 32; ++i) { const int kk = 2 * i + (lane >> 5); scr[kk * 33 + (lane & 31)] = W[(size_t)(k0 + kk) * N + n0 + (lane & 31)]; }
    LDS_WAIT(); asm volatile("" ::: "memory");
    const int c = lane & 7;
    f32x4 g0 = {1.f, 1.f, 1.f, 1.f}, g1 = g0;
    if constexpr (GAIN) { g0 = *(const f32x4*)(gain + k0 + 8 * c); g1 = *(const f32x4*)(gain + k0 + 8 * c + 4); }
#pragma unroll
    for (int j = 0; j < 4; ++j) { const int n = (lane >> 3) + 8 * j; const LAS float* s = scr + (8 * c) * 33 + n;
        v4u o; o.x = pk2(s[0 * 33] * g0.x, s[1 * 33] * g0.y); o.y = pk2(s[2 * 33] * g0.z, s[3 * 33] * g0.w); o.z = pk2(s[4 * 33] * g1.x, s[5 * 33] * g1.y); o.w = pk2(s[6 * 33] * g1.z, s[7 * 33] * g1.w);
        *(GAS v4u*)(WT + (size_t)(row_off + dest_row<KIND>(n0 + n)) * K + k0 + 8 * c) = o; }
    LDS_WAIT(); asm volatile("" ::: "memory");
}
__device__ const double kRopeRev[32] = {
    0.15915494309189535, 0.10561541722123227, 0.0700865215877985, 0.046509502471476706, 0.03086376340470123, 0.020481231595318977, 0.013591370636193905, 0.009019250376164549,
    0.005985185712713705, 0.00397177664679776, 0.002635675898667414, 0.001749037788521446, 0.001160663641240061, 0.0007702178288757531, 0.0005111175045375439, 0.00033917820861925017,
    0.00022507907903927653, 0.00014936275542995963, 9.911730936901935e-05, 6.577436917438735e-05, 4.364795279280289e-05, 2.8964835496204437e-05, 1.9221100684944863e-05, 1.2755146204410543e-05,
    8.464330808241401e-06, 5.616940400618127e-06, 3.727408601915352e-06, 2.473512961630074e-06, 1.6414262627950345e-06, 1.0892524995776498e-06, 7.228293068832865e-07, 4.796704226907546e-07};

__device__ __forceinline__ void norm_rows_bf16(Frame& F, const float* src, const float* gain, bf16* dst) {
    LANE_IDS();
    const int gw = F.vcu * NWAVES + wave, NGW = F.G * NWAVES;
    f32x4 g[8];
#pragma unroll
    for (int j = 0; j < 8; ++j) g[j] = *(const f32x4*)(gain + 4 * lane + 256 * j);
    for (int m = gw; m < M; m += NGW) {
        const GAS f32x4* xr = (const GAS f32x4*)(src + (size_t)m * DM) + lane;
        f32x4 v[8]; float s = 0.f;
#pragma unroll
        for (int j = 0; j < 8; ++j) { v[j] = xr[64 * j]; s += dot4(v[j]); }
        const float r = 1.0f / sqrtf(wave_sum(s) * (1.0f / DM) + EPS);
        GAS v2u* o8 = (GAS v2u*)(dst + (size_t)m * DM) + lane;
#pragma unroll
        for (int j = 0; j < 8; ++j) { const f32x4 y = (v[j] * r) * g[j]; v2u w; w.x = pk2(y.x, y.y); w.y = pk2(y.z, y.w); o8[64 * j] = w; }
    }
}
__device__ __forceinline__ void norm_rows_f32_inplace(Frame& F, float* x, const float* gain) {
    LANE_IDS();
    const int gw = F.vcu * NWAVES + wave, NGW = F.G * NWAVES;
    f32x4 g[8];
#pragma unroll
    for (int j = 0; j < 8; ++j) g[j] = *(const f32x4*)(gain + 4 * lane + 256 * j);
    for (int m = gw; m < M; m += NGW) {
        GAS f32x4* xr = (GAS f32x4*)(x + (size_t)m * DM) + lane;
        f32x4 v[8]; float s = 0.f;
#pragma unroll
        for (int j = 0; j < 8; ++j) { v[j] = xr[64 * j]; s += dot4(v[j]); }
        const float r = 1.0f / sqrtf(wave_sum(s) * (1.0f / DM) + EPS);
#pragma unroll
        for (int j = 0; j < 8; ++j) xr[64 * j] = (v[j] * r) * g[j];
    }
}

__device__ __forceinline__ void p0_prologue(Frame& F) {
    LANE_IDS();
    LAS float* scr = (LAS float*)(F.lds + RING_OFF + wave * 16384);
    const int gw = F.vcu * NWAVES + wave, NGW = F.G * NWAVES;
    unsigned char* ws = F.wsb;
    constexpr int I0 = 32 * 16, I1 = 32 * 18, I2 = 8 * 96, I3 = 8 * 128, I4 = 32 * 64, I5 = 32 * 576, I6 = 32 * 64, I7 = 32 * 352, I8 = 88 * 64;
    constexpr int NITEMS = 2 * (I0 + I1 + I2 + I3 + I4 + I5 + I6) + 4 * (I7 + I8);
    for (int it = gw; it < NITEMS; it += NGW) {
        int r = it;
        if (r < 2 * I5) { const int l = r / I5; p0_transpose_item<2, true>((const float*)karg(12) + (size_t)l * DM * NDIL, (const float*)karg(2) + (2 * l + 1) * DM, DM, NDIL, (bf16*)(ws + WS_WDIL + l * WDIL_STRIDE + WDIL_IN), 0, scr, r - l * I5, lane); continue; } r -= 2 * I5;
        if (r < 4 * I7) { const int l = r / I7; p0_transpose_item<4, true>((const float*)karg(14) + (size_t)l * DM * NUP, (const float*)karg(3) + l * DM, DM, NUP, (bf16*)(ws + WS_WFFN + l * WFFN_STRIDE + WFFN_UP), 0, scr, r - l * I7, lane); continue; } r -= 4 * I7;
        if (r < 4 * I8) { const int l = r / I8; p0_transpose_item<0, false>((const float*)karg(17) + (size_t)l * FF * DM, nullptr, FF, DM, (bf16*)(ws + WS_WFFN + l * WFFN_STRIDE + WFFN_DOWN), 0, scr, r - l * I8, lane); continue; } r -= 4 * I8;
        if (r < 2 * I6) { const int l = r / I6; p0_transpose_item<0, false>((const float*)karg(13) + (size_t)l * DM * DM, nullptr, DM, DM, (bf16*)(ws + WS_WDIL + l * WDIL_STRIDE + WDIL_WO), 0, scr, r - l * I6, lane); continue; } r -= 2 * I6;
        if (r < 2 * I4) { const int l = r / I4; p0_transpose_item<0, false>((const float*)karg(11) + (size_t)l * DM * DM, nullptr, DM, DM, (bf16*)(ws + WS_WMLA + l * WMLA_STRIDE + WMLA_WO), 0, scr, r - l * I4, lane); continue; } r -= 2 * I4;
        if (r < 2 * I3) { const int l = r / I3; p0_transpose_item<0, true>((const float*)karg(10) + (size_t)l * 512 * NKVB, (const float*)karg(9) + l * 512, 512, NKVB, (bf16*)(ws + WS_WMLA + l * WMLA_STRIDE + WMLA_KVB), 0, scr, r - l * I3, lane); continue; } r -= 2 * I3;
        if (r < 2 * I2) { const int l = r / I2; p0_transpose_item<1, true>((const float*)karg(7) + (size_t)l * 512 * NQB, (const float*)karg(6) + l * 512, 512, NQB, (bf16*)(ws + WS_WMLA + l * WMLA_STRIDE + WMLA_QB), 0, scr, r - l * I2, lane); continue; } r -= 2 * I2;
        if (r < 2 * I1) { const int l = r / I1; p0_transpose_item<3, true>((const float*)karg(8) + (size_t)l * DM * 576, (const float*)karg(2) + (2 * l) * DM, DM, 576, (bf16*)(ws + WS_WMLA + l * WMLA_STRIDE + WMLA_QKVA), 512, scr, r - l * I1, lane); continue; } r -= 2 * I1;
        { const int l = r / I0; p0_transpose_item<0, true>((const float*)karg(5) + (size_t)l * DM * 512, (const float*)karg(2) + (2 * l) * DM, DM, 512, (bf16*)(ws + WS_WMLA + l * WMLA_STRIDE + WMLA_QKVA), 0, scr, r - l * I0, lane); }
    }
    const int gt = F.vcu * (NWAVES * 64) + tid, NGT = F.G * NWAVES * 64;
    for (int i = gt; i < 2 * 192 * DM / 8; i += NGT) { const int l = i / (192 * DM / 8), e = i - l * (192 * DM / 8), rr = e / (DM / 8), cc = e - rr * (DM / 8), row = rr < 96 ? 1056 + rr : 1184 + (rr - 96);
        *((GAS v4u*)(ws + WS_WMLA + l * WMLA_STRIDE + WMLA_QKVA + (size_t)row * DM * 2) + cc) = (v4u){0u, 0u, 0u, 0u}; }
    const int* pos = (const int*)karg(1);
    for (int i = gt; i < M * 32; i += NGT) { const int row = i >> 5, k = i & 31;
        const double rev = (double)pos[row] * kRopeRev[k]; const float fr = (float)(rev - __builtin_rint(rev));
        const float c = __builtin_amdgcn_cosf(fr), s = __builtin_amdgcn_sinf(fr);
        ((float*)(ws + WS_COSM))[i] = c; ((float*)(ws + WS_SINM))[i] = s;
        if ((k & 1) == 0) { ((float*)(ws + WS_COSD))[row * 16 + (k >> 1)] = c; ((float*)(ws + WS_SIND))[row * 16 + (k >> 1)] = s; } }
    { const int gwv = F.vcu * NWAVES + wave, NGWv = F.G * NWAVES; const float* x = (const float*)karg(0); bf16* XB = (bf16*)(ws + WS_H); float* ps0 = (float*)(ws + WS_PS);
      for (int m = gwv; m < M; m += NGWv) {
        const GAS f32x4* xr = (const GAS f32x4*)(x + (size_t)m * DM) + lane; f32x4 v[8]; float s = 0.f;
#pragma unroll
        for (int j = 0; j < 8; ++j) { v[j] = xr[64 * j]; s += dot4(v[j]); }
        s = wave_sum(s);
        GAS v2u* o8 = (GAS v2u*)(XB + (size_t)m * DM) + lane;
#pragma unroll
        for (int j = 0; j < 8; ++j) { v2u w; w.x = pk2(v[j].x, v[j].y); w.y = pk2(v[j].z, v[j].w); o8[64 * j] = w; }
        if (lane < 32) ps0[(size_t)m * 32 + lane] = lane == 0 ? s : 0.f; } }
}

__device__ __forceinline__ void dil_merge(Frame& F) {
    LANE_IDS();
    const int gw = F.vcu * NWAVES + wave, NGW = F.G * NWAVES;
    unsigned char* ws = F.wsb;
    const bf16* OG = (const bf16*)(ws + WS_S + S_OG); const float* LSE = (const float*)(ws + WS_S + S_LSE); bf16* AO = (bf16*)(ws + WS_S + S_AO_DIL);
    for (int m = gw; m < M; m += NGW) {
        const int b = m >> 12, s = m & (SEQ - 1);
        const size_t sp0 = s, sp1 = (size_t)(s & 3) * (SEQ / 4) + (s >> 2), sp2 = (size_t)(s & 15) * (SEQ / 16) + (s >> 4);
#pragma unroll
        for (int j = 0; j < 4; ++j) { const int col = 8 * lane + 512 * j, head = col >> 7, dim = col & 127;
            const size_t r0 = ((size_t)(0 * 16 + head) * BATCH + b) * SEQ + sp0, r1 = ((size_t)(1 * 16 + head) * BATCH + b) * SEQ + sp1, r2 = ((size_t)(2 * 16 + head) * BATCH + b) * SEQ + sp2;
            const float l0 = LSE[r0], l1 = LSE[r1], l2 = LSE[r2];
            const float mx = fmaxf(l0, fmaxf(l1, l2)); float e0 = __expf(l0 - mx), e1 = __expf(l1 - mx), e2 = __expf(l2 - mx);
            const float inv = 1.0f / (e0 + e1 + e2); e0 *= inv; e1 *= inv; e2 *= inv;
            const v4u a = *(const GAS v4u*)(OG + r0 * 128 + dim), bb = *(const GAS v4u*)(OG + r1 * 128 + dim), c = *(const GAS v4u*)(OG + r2 * 128 + dim);
            v4u w;
#pragma unroll
            for (int q = 0; q < 4; ++q) w[q] = pk2(e0 * bf_lo(a[q]) + e1 * bf_lo(bb[q]) + e2 * bf_lo(c[q]), e0 * bf_hi(a[q]) + e1 * bf_hi(bb[q]) + e2 * bf_hi(c[q]));
            *(GAS v4u*)(AO + (size_t)m * DM + col) = w; }
    }
}

__device__ __forceinline__ void ffn_fixup(Frame& F, int layer, int pm) {
    LANE_IDS();
    if ((pm & 15) == 0) return;
    unsigned char* ws = F.wsb;
    const float* HALO = (const float*)(ws + WS_HALO); const float* FIX = (const float*)(ws + WS_FIX); bf16* ACT = (bf16*)(ws + WS_S + S_ACT);
    const float* cw = (const float*)karg(15) + (size_t)layer * 3 * NUP;
    for (int idx = tid; idx < 2 * (FF / 8); idx += NWAVES * 64) { const int rs = idx / (FF / 8), ch = (idx - rs * (FF / 8)) * 8;
        float o[8];
#pragma unroll
        for (int e = 0; e < 8; e += 4) {
            f32x4 cg = *(const GAS f32x4*)(FIX + ((size_t)pm * 2 + rs) * NUP + ch + e), cv = *(const GAS f32x4*)(FIX + ((size_t)pm * 2 + rs) * NUP + FF + ch + e);
            const f32x4 u1g = *(const GAS f32x4*)(HALO + ((size_t)(pm - 1) * 2 + 1) * NUP + ch + e), u1v = *(const GAS f32x4*)(HALO + ((size_t)(pm - 1) * 2 + 1) * NUP + FF + ch + e);
            const f32x4 u2g = *(const GAS f32x4*)(HALO + ((size_t)(pm - 1) * 2 + 0) * NUP + ch + e), u2v = *(const GAS f32x4*)(HALO + ((size_t)(pm - 1) * 2 + 0) * NUP + FF + ch + e);
            const f32x4 w0g = *(const f32x4*)(cw + ch + e), w0v = *(const f32x4*)(cw + FF + ch + e), w1g = *(const f32x4*)(cw + NUP + ch + e), w1v = *(const f32x4*)(cw + NUP + FF + ch + e);
            if (rs == 0) { cg = cg + w1g * u1g + w0g * u2g; cv = cv + w1v * u1v + w0v * u2v; } else { cg = cg + w0g * u1g; cv = cv + w0v * u1v; }
#pragma unroll
            for (int k = 0; k < 4; ++k) o[e + k] = cg[k] * __builtin_amdgcn_rcpf(1.0f + __builtin_amdgcn_exp2f(-1.4426950408889634f * cg[k])) * cv[k]; }
        v4u w; w.x = pk2(o[0], o[1]); w.y = pk2(o[2], o[3]); w.z = pk2(o[4], o[5]); w.w = pk2(o[6], o[7]);
        *(GAS v4u*)(ACT + ((size_t)pm * 256 + rs) * FF + ch) = w; }
}

__device__ __forceinline__ void row_scale_table(Frame& F, const float* ps, int pm) {
    LANE_IDS();
    LAS float* rsl = (LAS float*)(F.lds + RSL_OFF);
    if (tid < 256) { const GAS f32x4* p = (const GAS f32x4*)(ps + ((size_t)pm * 256 + tid) * 32); float s = 0.f;
#pragma unroll
        for (int i = 0; i < 8; ++i) { const f32x4 a = p[i]; s += (a.x + a.y) + (a.z + a.w); }
        rsl[tid] = __builtin_amdgcn_rsqf(s * (1.0f / DM) + EPS); }
    __syncthreads();
}

__device__ __forceinline__ void row_scale_table2(Frame& F, const float* pq, int pm) {
    LANE_IDS();
    LAS float* rsq = (LAS float*)(F.lds + RSQ_OFF);
    if (tid < 256) { const GAS f32x4* p = (const GAS f32x4*)(pq + ((size_t)pm * 256 + tid) * 16);
        const f32x4 a = p[0], b = p[1], c = p[2], d = p[3];
        rsq[tid] = __builtin_amdgcn_rsqf((((a.x + a.y) + (a.z + a.w)) + ((b.x + b.y) + (b.z + b.w))) * (1.0f / 512) + EPS);
        rsq[256 + tid] = __builtin_amdgcn_rsqf((((c.x + c.y) + (c.z + c.w)) + ((d.x + d.y) + (d.z + d.w))) * (1.0f / 512) + EPS); }
    __syncthreads();
}

struct MlaRef {
    const bf16* Q; const bf16* KV; const bf16* KPE; bf16* AO; int vcu;
    __device__ __forceinline__ att::BlockRef operator()(int i) const {
        const int I = vcu + 256 * (i >> 1), bh = I >> 3, x = I & 7, qb = (i & 1) ? 15 - x : x, b = bh >> 4, h = bh & 15;
        const size_t row0 = (size_t)b * SEQ + (size_t)qb * 256;
        att::BlockRef r; r.Q = Q + row0 * NQB + h * 128; r.Qpe = Q + row0 * NQB + 2048 + h * 64;
        r.K = KV + (size_t)bh * SEQ * 128; r.V = r.K + (size_t)M * DM; r.Kpe = KPE + (size_t)b * SEQ * 64;
        r.O = AO + row0 * DM + h * 128; r.Lse = nullptr; r.P0 = qb * 256; return r;
    }
};
struct DilRef {
    const bf16* QKV; bf16* OG; float* LSE; int vcu, g;
    __device__ __forceinline__ att::BlockRef operator()(int i) const {
        const int I = vcu + 256 * i, sh = 2 * g, d = 1 << sh, nqbs = 4 - sh;
        const int seq = I >> nqbs, qb = (I + ((i << nqbs) >> 2)) & ((1 << nqbs) - 1), h = seq & 15, br = seq >> 4, rr = br & (d - 1), b = br >> sh;
        const size_t sp0 = (size_t)rr * (SEQ >> sh), spq = sp0 + (size_t)qb * 256;
        const size_t hb = ((size_t)(g * 3) * 16 + h) * BATCH + b, tstep = (size_t)16 * BATCH * SEQ * 128;
        att::BlockRef r; r.Q = QKV + (hb * SEQ + spq) * 128; r.Qpe = nullptr; r.Kpe = nullptr;
        r.K = QKV + tstep + (hb * SEQ + sp0) * 128; r.V = r.K + tstep;
        const size_t ob = ((size_t)g * 16 + h) * BATCH + b;
        r.O = OG + (ob * SEQ + spq) * 128; r.Lse = LSE + ob * SEQ + spq; r.P0 = qb * 256; return r;
    }
};
template <bool PE, bool SK, bool LSE, bool EARLY, class RefFn>
__device__ __forceinline__ void attn_run(char* lds, const att::Prm& P, int n, const RefFn& ref) {
    att::BlockRef cur = ref(0); att::Seam<PE> S;
    att::swa_prime<PE>(cur, P, lds, S);
    for (int i = 0;; ++i) {
        const bool last = i + 1 >= n;
        const att::BlockRef nxt = last ? cur : ref(i + 1);
        att::swa_block<PE, SK, LSE, EARLY>(cur, nxt, P, lds, S);
        if (last) break;
        cur = nxt;
    }
}

struct Args { const void* in[18]; float* out; unsigned char* ws; };
__global__ void __launch_bounds__(NWAVES * 64, 2) fwd_kernel(Args args) {
    extern __shared__ __attribute__((aligned(16))) unsigned char lds[];
    Frame F;
    F.lds = (LAS unsigned char*)lds;
    F.MISC = (volatile LAS unsigned*)(F.lds + MISC_OFF);
    F.G = gridDim.x; { const int bx = blockIdx.x; F.vcu = (F.G % 8 == 0) ? (bx % 8) * (F.G / 8) + bx / 8 : bx; }
        F.out = args.out; F.wsb = args.ws;
    F.ctl = (gu32*)(args.ws + WS_CTL);
#define ws F.wsb
#define RELAUNDER() asm volatile("" : "+s"(F.vcu), "+s"(F.wsb), "+s"(F.out))
    for (int u = threadIdx.x; u < (LDS_BYTES - LDSCTL_OFF) / 4; u += NWAVES * 64) ((LAS unsigned*)(F.lds + LDSCTL_OFF))[u] = 0u;
    __syncthreads();
    XcdBarrier bar = xcd_barrier_post((unsigned*)(F.ctl + CW_BAR), F.MISC + 8);
#define GRID_BAR() xcd_barrier(bar)
    typedef pg8::StaticOrder SO;
#define GEMMR(EpiT, Aptr, Bptr, N_, K_, Eobj, REP_) do { pg8::Gemm g_{(const bf16*)(Aptr), (const bf16*)(Bptr), M, (N_), (K_)}; SO S_; S_.init(M, (N_), F.G, (int)blockIdx.x); \
        pg8::gemm_phase<EpiT, SO, true, true, REP_>(F.lds + RING_OFF, g_, S_, (Eobj)); } while (0)
#define GEMM(EpiT, Aptr, Bptr, N_, K_, Eobj) GEMMR(EpiT, Aptr, Bptr, N_, K_, Eobj, 1)

    bf16* H = (bf16*)(ws + WS_H);
    const float* cosM = (const float*)(ws + WS_COSM); const float* sinM = (const float*)(ws + WS_SINM);
    const float* cosD = (const float*)(ws + WS_COSD); const float* sinD = (const float*)(ws + WS_SIND);

    p0_prologue(F);
    GRID_BAR();

#define PSP(i) ((float*)(ws + WS_PS + (size_t)(i) * PS_STRIDE))
    const PG8_LAS float* rsl = (const PG8_LAS float*)(F.lds + RSL_OFF);
    const int my_pm = 8 * ((int)blockIdx.x & 7) + (((int)blockIdx.x >> 3) & 7);
    for (int j = 0; j < 2; ++j) {
        {
            RELAUNDER();
            const unsigned char* wl = ws + WS_WMLA + j * WMLA_STRIDE;
            float* PQ = (float*)(ws + WS_S + S_PQ); bf16* QN = (bf16*)(ws + WS_S + S_QN); bf16* CK = (bf16*)(ws + WS_S + S_CKVN); bf16* KPE = (bf16*)(ws + WS_S + S_KPE);
            bf16* Q = (bf16*)(ws + WS_S + S_Q); bf16* KV = (bf16*)(ws + WS_S + S_KV); bf16* AO = (bf16*)(ws + WS_S + S_AO_MLA);
            row_scale_table(F, PSP(4 * j), my_pm);
            { pg8::EpiQaCkv E{QN, CK, PQ, rsl}; GEMM(pg8::EpiQaCkv, H, wl + WMLA_QKVA, 1024, DM, E); }
            GRID_BAR();
            row_scale_table2(F, PQ, my_pm);
            { const int slot = (int)blockIdx.x >> 6; const PG8_LAS float* rsq = (const PG8_LAS float*)(F.lds + RSQ_OFF);
              if (slot == 0) { pg8::Gemm g_{(const bf16*)H, (const bf16*)(wl + WMLA_QKVA), M, NQKVA, DM}; pg8::OneUnit S_{my_pm, 4}; pg8::EpiKpe E{KPE, cosM, sinM, rsl};
                  pg8::gemm_phase<pg8::EpiKpe, pg8::OneUnit, true, true>(F.lds + RING_OFF, g_, S_, E); }
              if (slot < 2) { pg8::Gemm g_{(const bf16*)QN, (const bf16*)(wl + WMLA_QB), M, NQB, 512}; pg8::PanelUnits S_{my_pm, slot ? 4 : 0, slot ? 8 : 4}; pg8::EpiQMla E{Q, cosM, sinM, rsq};
                  pg8::gemm_phase<pg8::EpiQMla, pg8::PanelUnits, true, true>(F.lds + RING_OFF, g_, S_, E); }
              else { pg8::Gemm g_{(const bf16*)CK, (const bf16*)(wl + WMLA_KVB), M, NKVB, 512}; pg8::PanelUnits S_{my_pm, 8 * (slot - 2), 8}; pg8::EpiKvMla E{KV, KV + (size_t)M * DM, rsq + 256};
                  pg8::gemm_phase<pg8::EpiKvMla, pg8::PanelUnits, true, true>(F.lds + RING_OFF, g_, S_, E); }
            }
            GRID_BAR();
            RELAUNDER();
            { att::Prm P{NQB, 128, DM, NQB, 64, 0, SEQ, SEQ, 0.07216878364870322f};
              MlaRef R{Q, KV, KPE, AO, F.vcu};
              attn_run<true, false, false, false>((char*)lds + RING_OFF, P, 4, R);
            }
            GRID_BAR();
            if (j == 0) { pg8::EpiResB<true> E{(const float*)karg(0), H, PSP(1), DM}; GEMM(pg8::EpiResB<true>, AO, wl + WMLA_WO, DM, DM, E); }
            else { pg8::EpiResB<false> E{nullptr, H, PSP(5), DM}; GEMM(pg8::EpiResB<false>, AO, wl + WMLA_WO, DM, DM, E); }
            GRID_BAR();
        }
        {
            RELAUNDER();
            const int layer = 2 * j; const unsigned char* wl = ws + WS_WFFN + layer * WFFN_STRIDE;
            bf16* ACT = (bf16*)(ws + WS_S + S_ACT);
            row_scale_table(F, PSP(1 + 4 * j), my_pm);
            { pg8::EpiUpConv E{ACT, (float*)(ws + WS_HALO), (float*)(ws + WS_FIX), (const float*)karg(15) + (size_t)layer * 3 * NUP, (const float*)karg(16) + (size_t)layer * NUP,
                               (PG8_LAS float*)(F.lds + XH_OFF), (PG8_LAS float*)(F.lds + CWL_OFF), rsl};
              GEMM(pg8::EpiUpConv, H, wl + WFFN_UP, NUP, DM, E); }
            GRID_BAR();
            { SO S_; S_.init(M, DM, F.G, (int)blockIdx.x); pg8::Unit u_; for (int i = 0; S_.next(i, u_); ++i) ffn_fixup(F, layer, u_.pm);
              asm volatile("s_waitcnt vmcnt(0)" ::: "memory"); __syncthreads(); }
            { pg8::EpiResB<false> E{nullptr, H, PSP(2 + 4 * j), DM}; GEMM(pg8::EpiResB<false>, ACT, wl + WFFN_DOWN, DM, FF, E); }
            GRID_BAR();
        }
        {
            RELAUNDER();
            const unsigned char* wl = ws + WS_WDIL + j * WDIL_STRIDE;
            bf16* QKV = (bf16*)(ws + WS_S + S_QKV); bf16* OG = (bf16*)(ws + WS_S + S_OG); float* LSE = (float*)(ws + WS_S + S_LSE); bf16* AO = (bf16*)(ws + WS_S + S_AO_DIL);
            row_scale_table(F, PSP(2 + 4 * j), my_pm);
            { pg8::EpiQkvDil E{QKV, cosD, sinD, rsl}; GEMM(pg8::EpiQkvDil, H, wl + WDIL_IN, NDIL, DM, E); }
            GRID_BAR();
#pragma unroll 1
            for (int g = 0; g < 3; ++g) { const int d = 1 << (2 * g);
              att::Prm P{128, 128, 128, 0, 0, 1, SEQ / d, 129, 0.08838834764831845f};
              DilRef R{QKV, OG, LSE, F.vcu, g};
              attn_run<false, true, true, true>((char*)lds + RING_OFF, P, 4, R);
            }
            GRID_BAR();
            dil_merge(F);
            GRID_BAR();
            { pg8::EpiResB<false> E{nullptr, H, PSP(3 + 4 * j), DM}; GEMM(pg8::EpiResB<false>, AO, wl + WDIL_WO, DM, DM, E); }
            GRID_BAR();
        }
        {
            RELAUNDER();
            const int layer = 2 * j + 1; const unsigned char* wl = ws + WS_WFFN + layer * WFFN_STRIDE;
            bf16* ACT = (bf16*)(ws + WS_S + S_ACT);
            row_scale_table(F, PSP(3 + 4 * j), my_pm);
            { pg8::EpiUpConv E{ACT, (float*)(ws + WS_HALO), (float*)(ws + WS_FIX), (const float*)karg(15) + (size_t)layer * 3 * NUP, (const float*)karg(16) + (size_t)layer * NUP,
                               (PG8_LAS float*)(F.lds + XH_OFF), (PG8_LAS float*)(F.lds + CWL_OFF), rsl};
              GEMM(pg8::EpiUpConv, H, wl + WFFN_UP, NUP, DM, E); }
            GRID_BAR();
            { SO S_; S_.init(M, DM, F.G, (int)blockIdx.x); pg8::Unit u_; for (int i = 0; S_.next(i, u_); ++i) ffn_fixup(F, layer, u_.pm);
              asm volatile("s_waitcnt vmcnt(0)" ::: "memory"); __syncthreads(); }
            if (j == 0) { pg8::EpiResB<false> E{nullptr, H, PSP(4), DM}; GEMM(pg8::EpiResB<false>, ACT, wl + WFFN_DOWN, DM, FF, E); }
            else { pg8::EpiResLast E{H, F.out, DM}; GEMM(pg8::EpiResLast, ACT, wl + WFFN_DOWN, DM, FF, E); }
            GRID_BAR();
        }
    }
    RELAUNDER();
    norm_rows_f32_inplace(F, F.out, (const float*)karg(4));
#undef PSP
#undef ws
#undef RELAUNDER
#undef GEMM
#undef GEMMR
#undef GRID_BAR
}

extern "C" void kernel_launch(void* const* d_in, const int* in_sizes, int n_in, void* d_out, int out_size, void* d_ws, size_t ws_size, hipStream_t stream) {
    static int grid = 0;
    if (grid == 0) {
        if (n_in != 18 || in_sizes[0] != M * DM || out_size != M * DM || ws_size < WS_END) {
            fprintf(stderr, "kernel_launch: shape / workspace mismatch (n_in %d, in0 %d, out %d, ws %zu, need %zu); nothing launched\n", n_in, n_in > 0 ? in_sizes[0] : -1, out_size, ws_size, (size_t)WS_END); grid = -1; return; }
        int dev = 0, cus = 0, per_cu = 0;
        if (hipGetDevice(&dev) != hipSuccess || hipDeviceGetAttribute(&cus, hipDeviceAttributeMultiprocessorCount, dev) != hipSuccess) { grid = -1; return; }
        if (hipFuncSetAttribute((const void*)fwd_kernel, hipFuncAttributeMaxDynamicSharedMemorySize, LDS_BYTES) != hipSuccess) { fprintf(stderr, "kernel_launch: hipFuncSetAttribute failed\n"); grid = -1; return; }
        if (hipOccupancyMaxActiveBlocksPerMultiprocessor(&per_cu, (const void*)fwd_kernel, NWAVES * 64, LDS_BYTES) != hipSuccess || per_cu < 1) fprintf(stderr, "kernel_launch: occupancy query reports %d\n", per_cu);
        (void)hipGetLastError();
        if (cus < 256) { fprintf(stderr, "kernel_launch: built for a 256-CU device, found %d CUs; nothing launched\n", cus); grid = -1; return; }
        grid = 256;
    }
    if (grid < 0) return;
    if (hipMemsetAsync((char*)d_ws + WS_CTL, 0, CTL_ZERO_BYTES, stream) != hipSuccess) return;
    Args a{};
    for (int i = 0; i < 18; ++i) a.in[i] = d_in[i];
    a.out = (float*)d_out; a.ws = (unsigned char*)d_ws;
    hipLaunchKernelGGL(fwd_kernel, dim3(grid), dim3(NWAVES * 64), LDS_BYTES, stream, a);
}
```

```cpp
#include <hip/hip_runtime.h>
#include <cstdio>
#include <cstdint>
namespace pg8 {
#define PG8_LAS __attribute__((address_space(3)))
typedef unsigned short bf16_t;
typedef short bf16x8 __attribute__((ext_vector_type(8)));
typedef float f32x4 __attribute__((ext_vector_type(4)));
typedef unsigned u32x4 __attribute__((ext_vector_type(4)));
constexpr int BM = 256, BK = 64, HALF = 128, HTB = HALF * BK * 2  , STAGE_BYTES = 8 * HTB, NXCD = 8, WGM = 8;

__host__ __device__ __forceinline__ int lds_byte(int r, int c) { const int st = (r >> 4) * 2 + (c >> 5), rr = r & 15, cc = c & 31, ob = rr * 64 + cc * 2; return st * 1024 + (ob ^ (((ob >> 9) & 1) << 5)); }
__host__ __device__ __forceinline__ void stage_rc(int b, int& R, int& C) { const int st = b / 1024, sb = b % 1024, swz = sb ^ (((sb >> 9) & 1) << 5); R = (st >> 1) * 16 + swz / 64; C = (st & 1) * 32 + (swz % 64) / 2; }
__host__ __device__ __forceinline__ int perm32(int rho) { const int n = rho >> 4, i = rho & 15; return 8 * (i >> 2) + 4 * n + (i & 3); }

struct Unit { int pm, pn; };
struct Gemm { const bf16_t* A; const bf16_t* Bt; int M, N, K; };

struct StaticOrder {
    int nM, nN, nwg, G, c;
    __host__ __device__ void init(int M, int N, int G_, int c_) { nM = M / BM; nN = N / BM; nwg = nM * nN; G = G_; c = c_; }
    __host__ __device__ __forceinline__ bool next(int i, Unit& u) const {
        const long L = (long)i * G + c; if (L >= nwg) return false;
        int wgid = (int)L; { const int q = nwg / NXCD, r = nwg % NXCD, xcd = wgid % NXCD, off = wgid / NXCD; wgid = (xcd < r ? xcd * (q + 1) : r * (q + 1) + (xcd - r) * q) + off; }
        const int nig = WGM * nN, gid = wgid / nig, fm = gid * WGM, gsz = (nM - fm) < WGM ? (nM - fm) : WGM;
        u.pm = fm + ((wgid % nig) % gsz); u.pn = (wgid % nig) / gsz; return true;
    }
    __device__ __forceinline__ void a_ready(const Unit&) const {}
    __device__ __forceinline__ void done(const Unit&) const {}
};

__device__ __forceinline__ unsigned cvt_pk_bf16(float lo, float hi) { unsigned r; asm volatile("v_cvt_pk_bf16_f32 %0, %1, %2" : "=v"(r) : "v"(lo), "v"(hi)); return r; }
typedef float f32x2 __attribute__((ext_vector_type(2)));
#define PG8_G __attribute__((address_space(1)))
typedef unsigned u32x2 __attribute__((ext_vector_type(2)));
__device__ __forceinline__ u32x4 pack8bf(const f32x4 a, const f32x4 b) { u32x4 w; w.x = cvt_pk_bf16(a[0], a[1]); w.y = cvt_pk_bf16(a[2], a[3]); w.z = cvt_pk_bf16(b[0], b[1]); w.w = cvt_pk_bf16(b[2], b[3]); return w; }
#define PG8_NOPRE struct Pre {}; __device__ __forceinline__ void pre_issue(Pre&, const Unit&, int, int) const {} __device__ __forceinline__ void pre_finish(Pre&, int, int) const {}
struct EpiF32Store {
    PG8_NOPRE
    static constexpr bool PERM = false, AFTER_DRAIN = false;
    float* C; int ldc;
    __device__ __forceinline__ void operator()(const f32x4 (&acc)[2][2][4][2], const Unit& u, int wr, int wc, int fr, int fq, int ui) const {
        const int row0 = u.pm * BM + wr * 64 + fr, col0 = u.pn * BM + wc * 32 + 4 * fq;
#pragma unroll
        for (int ai = 0; ai < 2; ++ai)
#pragma unroll
            for (int m = 0; m < 4; ++m) { float* rowp = C + (size_t)(row0 + ai * HALF + m * 16) * ldc + col0;
#pragma unroll
                for (int bj = 0; bj < 2; ++bj)
#pragma unroll
                    for (int n = 0; n < 2; ++n) *(PG8_G f32x4*)(rowp + bj * HALF + n * 16) = acc[ai][bj][m][n]; }
    }
};

__device__ __forceinline__ float sum_fq(float v) {
    v += __uint_as_float((unsigned)__builtin_amdgcn_ds_swizzle((int)__float_as_uint(v), ((0x10 << 10) | 0x1f)));
    auto rr = __builtin_amdgcn_permlane32_swap(__float_as_uint(v), __float_as_uint(v), false, false);
    return __uint_as_float(rr[0]) + __uint_as_float(rr[1]);
}
__device__ __forceinline__ float sq4(const f32x4 a) { return (a[0] * a[0] + a[1] * a[1]) + (a[2] * a[2] + a[3] * a[3]); }
__device__ __forceinline__ void load_rs(float (&r)[2][4], const PG8_LAS float* rsl, int wr, int fr) {
#pragma unroll
    for (int ai = 0; ai < 2; ++ai)
#pragma unroll
        for (int m = 0; m < 4; ++m) r[ai][m] = rsl[ai * HALF + wr * 64 + m * 16 + fr]; }
__device__ __forceinline__ void unpack8bf(const u32x4 w, f32x4& a, f32x4& b) {
    a = (f32x4){__uint_as_float(w.x << 16), __uint_as_float(w.x & 0xffff0000u), __uint_as_float(w.y << 16), __uint_as_float(w.y & 0xffff0000u)};
    b = (f32x4){__uint_as_float(w.z << 16), __uint_as_float(w.z & 0xffff0000u), __uint_as_float(w.w << 16), __uint_as_float(w.w & 0xffff0000u)}; }
template <bool BASE_F32> struct EpiResB {
    PG8_NOPRE
    static constexpr bool PERM = true, AFTER_DRAIN = false;
    const float* basef; bf16_t* X; float* ps; int ldc;
    __device__ __forceinline__ void operator()(const f32x4 (&acc)[2][2][4][2], const Unit& u, int wr, int wc, int fr_, int fq_, int ui) const {
        int fr = fr_, fq = fq_; asm volatile("" : "+v"(fr), "+v"(fq));
        const int row0 = u.pm * BM + wr * 64 + fr, col0 = u.pn * BM + wc * 32 + 8 * fq;
        u32x4 bx[2][4][2];
#pragma unroll
        for (int ai = 0; ai < 2; ++ai)
#pragma unroll
            for (int m = 0; m < 4; ++m) { const size_t off = (size_t)(row0 + ai * HALF + m * 16) * ldc + col0;
#pragma unroll
                for (int bj = 0; bj < 2; ++bj) bx[ai][m][bj] = *(const PG8_G u32x4*)(X + off + bj * HALF); }
#pragma unroll
        for (int ai = 0; ai < 2; ++ai)
#pragma unroll
            for (int m = 0; m < 4; ++m) { const int row = row0 + ai * HALF + m * 16; const size_t off = (size_t)row * ldc + col0; float q = 0.f;
#pragma unroll
                for (int bj = 0; bj < 2; ++bj) { f32x4 x0, x1; unpack8bf(bx[ai][m][bj], x0, x1);
                    const f32x4 o0 = x0 + acc[ai][bj][m][0], o1 = x1 + acc[ai][bj][m][1]; q += sq4(o0) + sq4(o1);
                    *(PG8_G u32x4*)(X + off + bj * HALF) = pack8bf(o0, o1); }
                q = sum_fq(q);
                if (fq == 0) ((PG8_G float*)ps)[(size_t)row * 32 + u.pn * 4 + wc] = q; }
    }
};
struct EpiResLast {
    PG8_NOPRE
    static constexpr bool PERM = true, AFTER_DRAIN = false;
    const bf16_t* X; float* out; int ldc;
    __device__ __forceinline__ void operator()(const f32x4 (&acc)[2][2][4][2], const Unit& u, int wr, int wc, int fr, int fq, int ui) const {
        const int row0 = u.pm * BM + wr * 64 + fr, col0 = u.pn * BM + wc * 32 + 8 * fq;
#pragma unroll
        for (int ai = 0; ai < 2; ++ai) {
            u32x4 bx[4][2];
#pragma unroll
            for (int m = 0; m < 4; ++m) { const size_t off = (size_t)(row0 + ai * HALF + m * 16) * ldc + col0;
#pragma unroll
                for (int bj = 0; bj < 2; ++bj) bx[m][bj] = *(const PG8_G u32x4*)(X + off + bj * HALF); }
#pragma unroll
            for (int m = 0; m < 4; ++m) { const size_t off = (size_t)(row0 + ai * HALF + m * 16) * ldc + col0;
#pragma unroll
                for (int bj = 0; bj < 2; ++bj) { f32x4 x0, x1; unpack8bf(bx[m][bj], x0, x1);
                    *(PG8_G f32x4*)(out + off + bj * HALF) = x0 + acc[ai][bj][m][0]; *(PG8_G f32x4*)(out + off + bj * HALF + 4) = x1 + acc[ai][bj][m][1]; } }
            asm volatile("" ::: "memory"); }
    }
};
struct EpiF32Scaled {
    PG8_NOPRE
    static constexpr bool PERM = false, AFTER_DRAIN = false;
    float* C; int ldc; const PG8_LAS float* rsl;
    __device__ __forceinline__ void operator()(const f32x4 (&acc)[2][2][4][2], const Unit& u, int wr, int wc, int fr, int fq, int ui) const {
        const int row0 = u.pm * BM + wr * 64 + fr, col0 = u.pn * BM + wc * 32 + 4 * fq;
        float r[2][4]; load_rs(r, rsl, wr, fr);
#pragma unroll
        for (int ai = 0; ai < 2; ++ai)
#pragma unroll
            for (int m = 0; m < 4; ++m) { float* rowp = C + (size_t)(row0 + ai * HALF + m * 16) * ldc + col0;
#pragma unroll
                for (int bj = 0; bj < 2; ++bj)
#pragma unroll
                    for (int n = 0; n < 2; ++n) *(PG8_G f32x4*)(rowp + bj * HALF + n * 16) = acc[ai][bj][m][n] * r[ai][m]; }
    }
};

struct EpiQaCkv {
    PG8_NOPRE
    static constexpr bool PERM = true, AFTER_DRAIN = false;
    bf16_t* QA; bf16_t* CK; float* pq; const PG8_LAS float* rsl;
    __device__ __forceinline__ void operator()(const f32x4 (&acc)[2][2][4][2], const Unit& u, int wr, int wc, int fr_, int fq_, int ui) const {
        int fr = fr_, fq = fq_; asm volatile("" : "+v"(fr), "+v"(fq));
        const int row0 = u.pm * BM + wr * 64 + fr, col0 = (u.pn & 1) * BM + wc * 32 + 8 * fq;
        bf16_t* D = u.pn < 2 ? QA : CK;
        float r[2][4]; load_rs(r, rsl, wr, fr);
#pragma unroll
        for (int ai = 0; ai < 2; ++ai)
#pragma unroll
            for (int m = 0; m < 4; ++m) { const int row = row0 + ai * HALF + m * 16; float q = 0.f;
#pragma unroll
                for (int bj = 0; bj < 2; ++bj) { const f32x4 o0 = acc[ai][bj][m][0] * r[ai][m], o1 = acc[ai][bj][m][1] * r[ai][m]; q += sq4(o0) + sq4(o1);
                    *(PG8_G u32x4*)(D + (size_t)row * 512 + col0 + bj * HALF) = pack8bf(o0, o1); }
                q = sum_fq(q);
                if (fq == 0) ((PG8_G float*)pq)[(size_t)row * 16 + u.pn * 4 + wc] = q; }
    }
};

#define PG8_DPP(old_, src_, ctrl_) __uint_as_float((unsigned)__builtin_amdgcn_update_dpp((int)__float_as_uint(old_), (int)__float_as_uint(src_), (ctrl_), 0xF, 0xF, false))
struct EpiUpConv {
    static constexpr bool PERM = true, AFTER_DRAIN = false;
    bf16_t* ACT; float* HALO; float* FIX; const float* cws;
    PG8_LAS float* xh; PG8_LAS float* cwl; const PG8_LAS float* rsl;
    __device__ __forceinline__ static void w_dma(const float* cws, int pn, PG8_LAS float* buf, int tap, int lane) {
        const float* src = cws + (size_t)tap * 11264 + (lane < 32 ? 128 * pn + lane * 4 : 5632 + 128 * pn + (lane - 32) * 4);
        __builtin_amdgcn_global_load_lds((const unsigned*)src, (PG8_LAS unsigned*)(buf + tap * 256), 16, 0, 0); }
    PG8_NOPRE
    __device__ __forceinline__ void operator()(const f32x4 (&acc_)[2][2][4][2], const Unit& u, int wr, int wc, int fr_, int fq_, int ui) const {
        int fr = fr_, fq = fq_; asm volatile("" : "+v"(fr), "+v"(fq));
        f32x4 (&acc)[2][2][4][2] = const_cast<f32x4 (&)[2][2][4][2]>(acc_);
        { float r[2][4]; load_rs(r, rsl, wr, fr);
#pragma unroll
          for (int ai = 0; ai < 2; ++ai)
#pragma unroll
            for (int bj = 0; bj < 2; ++bj)
#pragma unroll
                for (int m = 0; m < 4; ++m)
#pragma unroll
                    for (int n = 0; n < 2; ++n) acc[ai][bj][m][n] = acc[ai][bj][m][n] * r[ai][m]; }
        const int ch0 = 128 * u.pn + 32 * wc + 8 * fq;
        PG8_LAS float* cwc = cwl + (ui & 1) * 1024;
        if (wr == 0 && u.pn + 4 < 44) w_dma(cws, u.pn + 4, cwl + ((ui + 1) & 1) * 1024, wc, fq * 16 + fr);
        if (fr >= 14) {
#pragma unroll
            for (int ai = 0; ai < 2; ++ai) if (ai == 0 || wr == 0) { PG8_LAS float* b = xh + ((((ai == 0 ? wr : 2) * 4 + wc) * 2 + (fr - 14)) * 4 + fq) * 16;
#pragma unroll
                for (int bj = 0; bj < 2; ++bj)
#pragma unroll
                    for (int n = 0; n < 2; ++n) *(PG8_LAS f32x4*)(b + (bj * 2 + n) * 4) = acc[ai][bj][3][n]; }
            if (wr == 1) { float* hp = HALO + ((size_t)u.pm * 2 + (fr - 14)) * 11264 + ch0;
#pragma unroll
                for (int bj = 0; bj < 2; ++bj)
#pragma unroll
                    for (int n = 0; n < 2; ++n) *(PG8_G f32x4*)(hp + bj * 5632 + n * 4) = acc[1][bj][3][n]; }
        }
        asm volatile("s_waitcnt lgkmcnt(0)" ::: "memory"); __builtin_amdgcn_s_barrier(); asm volatile("" ::: "memory");
        const bool fixtile = (u.pm & 15) != 0;
#define PG8_FMAC_DPP(c_, x_, w_, ctrl_) asm("v_fmac_f32_dpp %0, %1, %2 " ctrl_ : "+v"(c_) : "v"(x_), "v"(w_))
        u32x2 wkeep[2][4];
#pragma unroll
        for (int n = 0; n < 2; ++n) {
            const PG8_LAS float* cwb = cwc + wc * 32 + fq * 8 + n * 4;
            f32x4 Wq[2][4], W1m[2], W0m[2];
#pragma unroll
            for (int bj = 0; bj < 2; ++bj) {
#pragma unroll
                for (int t = 0; t < 4; ++t) Wq[bj][t] = *(const PG8_LAS f32x4*)(cwb + t * 256 + bj * 128);
#pragma unroll
                for (int k = 0; k < 4; ++k) { W1m[bj][k] = fr == 0 ? Wq[bj][1][k] : 0.f; W0m[bj][k] = fr < 2 ? Wq[bj][0][k] : 0.f; } }
#pragma unroll
            for (int ai = 0; ai < 2; ++ai)
#pragma unroll
                for (int m = 0; m < 4; ++m) {
                    f32x4 c[2];
#pragma unroll
                    for (int bj = 0; bj < 2; ++bj) {
                        f32x4 h1 = {0.f, 0.f, 0.f, 0.f}, h2 = {0.f, 0.f, 0.f, 0.f};
                        if (m == 0 && !(ai == 0 && wr == 0)) { const int slot = ai == 0 ? 0 : (wr == 0 ? 1 : 2); const PG8_LAS float* b = xh + (((slot * 4 + wc) * 2) * 4 + fq) * 16 + n * 4 + bj * 8;
                            h2 = *(const PG8_LAS f32x4*)b; h1 = *(const PG8_LAS f32x4*)(b + 64); }
#pragma unroll
                        for (int k = 0; k < 4; ++k) { const float cur = acc[ai][bj][m][n][k];
                            float cc = fmaf(Wq[bj][2][k], cur, Wq[bj][3][k]);
                            PG8_FMAC_DPP(cc, cur, Wq[bj][1][k], "row_shr:1 row_mask:0xf bank_mask:0xf bound_ctrl:1");
                            PG8_FMAC_DPP(cc, cur, Wq[bj][0][k], "row_shr:2 row_mask:0xf bank_mask:0xf bound_ctrl:1");
                            if (m == 0) { const float z = fr == 0 ? h2[k] : h1[k]; cc = fmaf(W1m[bj][k], h1[k], cc); cc = fmaf(W0m[bj][k], z, cc); }
                            else { const float p = acc[ai][bj][m > 0 ? m - 1 : 0][n][k]; PG8_FMAC_DPP(cc, p, W1m[bj][k], "row_ror:1 row_mask:0xf bank_mask:0xf"); PG8_FMAC_DPP(cc, p, W0m[bj][k], "row_ror:2 row_mask:0xf bank_mask:0xf"); }
                            c[bj][k] = cc; }
                        __builtin_amdgcn_sched_barrier(0);
                    }
                    const int row = u.pm * BM + ai * HALF + wr * 64 + m * 16 + fr;
                    if (ai == 0 && m == 0 && wr == 0 && fixtile && fr < 2) {
                        float* fp = FIX + ((size_t)u.pm * 2 + fr) * 11264 + ch0 + n * 4;
                        *(PG8_G f32x4*)fp = c[0] * 0.6931471805599453f; *(PG8_G f32x4*)(fp + 5632) = c[1] * 1.4426950408889634f;
                    } else {
                        f32x4 ex;
#pragma unroll
                        for (int k = 0; k < 4; ++k) ex[k] = __builtin_amdgcn_exp2f(-c[0][k]);
                        const f32x4 den = ex + 1.0f, gv = c[0] * c[1]; f32x4 rc;
#pragma unroll
                        for (int k = 0; k < 4; ++k) rc[k] = __builtin_amdgcn_rcpf(den[k]);
                        const f32x4 a = gv * rc;
                        u32x2 w; w.x = cvt_pk_bf16(a[0], a[1]); w.y = cvt_pk_bf16(a[2], a[3]);
                        if (n == 0) wkeep[ai][m] = w;
                        else { const u32x4 w4 = {wkeep[ai][m].x, wkeep[ai][m].y, w.x, w.y}; *(PG8_G u32x4*)(ACT + (size_t)row * 5632 + ch0) = w4; }
                    }
                    asm volatile("" ::: "memory"); __builtin_amdgcn_sched_barrier(0);
                }
        }
    }
};
struct EpiKpe {
    PG8_NOPRE
    static constexpr bool PERM = true, AFTER_DRAIN = false;
    bf16_t* KPE; const float* cosT; const float* sinT; const PG8_LAS float* rsl;
    __device__ __forceinline__ void operator()(const f32x4 (&acc)[2][2][4][2], const Unit& u, int wr, int wc, int fr_, int fq_, int ui) const {
        int fr = fr_, fq = fq_; asm volatile("" : "+v"(fr), "+v"(fq));
        if (wc != 0) return;
        const int row0 = u.pm * BM + wr * 64 + fr, i0 = 8 * fq;
        float r[2][4]; load_rs(r, rsl, wr, fr);
#pragma unroll
        for (int ai = 0; ai < 2; ++ai)
#pragma unroll
            for (int m = 0; m < 4; ++m) { const int row = row0 + ai * HALF + m * 16;
                const f32x4 c0 = *(const PG8_G f32x4*)(cosT + (size_t)row * 32 + i0), c1 = *(const PG8_G f32x4*)(cosT + (size_t)row * 32 + i0 + 4);
                const f32x4 s0 = *(const PG8_G f32x4*)(sinT + (size_t)row * 32 + i0), s1 = *(const PG8_G f32x4*)(sinT + (size_t)row * 32 + i0 + 4);
                const f32x4 x1a = acc[ai][0][m][0] * r[ai][m], x1b = acc[ai][0][m][1] * r[ai][m], x2a = acc[ai][1][m][0] * r[ai][m], x2b = acc[ai][1][m][1] * r[ai][m];
                const f32x4 y1a = x1a * c0 - x2a * s0, y1b = x1b * c1 - x2b * s1, y2a = x2a * c0 + x1a * s0, y2b = x2b * c1 + x1b * s1;
                bf16_t* dst = KPE + (size_t)row * 64 + i0;
                *(PG8_G u32x4*)dst = pack8bf(y1a, y1b); *(PG8_G u32x4*)(dst + 32) = pack8bf(y2a, y2b); }
    }
};
struct PanelUnits { int pm, pn0, n;
    __device__ __forceinline__ bool next(int i, Unit& u) const { if (i >= n) return false; u.pm = pm; u.pn = pn0 + i; return true; }
    __device__ __forceinline__ void a_ready(const Unit&) const {}
    __device__ __forceinline__ void done(const Unit&) const {}
};
struct OneUnit { int pm, pn;
    __device__ __forceinline__ bool next(int i, Unit& u) const { if (i) return false; u.pm = pm; u.pn = pn; return true; }
    __device__ __forceinline__ void a_ready(const Unit&) const {}
    __device__ __forceinline__ void done(const Unit&) const {}
};
struct EpiKvMla {
    PG8_NOPRE
    static constexpr bool PERM = true, AFTER_DRAIN = false;
    bf16_t* KH; bf16_t* VH; const PG8_LAS float* rsl;
    __device__ __forceinline__ void operator()(const f32x4 (&acc)[2][2][4][2], const Unit& u, int wr, int wc, int fr_, int fq_, int ui) const {
        int fr = fr_, fq = fq_; asm volatile("" : "+v"(fr), "+v"(fq));
        const int row0 = u.pm * BM + wr * 64 + fr, dim0 = wc * 32 + 8 * fq;
        float r[2][4]; load_rs(r, rsl, wr, fr);
#pragma unroll
        for (int ai = 0; ai < 2; ++ai)
#pragma unroll
            for (int m = 0; m < 4; ++m) { const int row = row0 + ai * HALF + m * 16, b = row >> 12, s = row & 4095;
                const size_t o = (((size_t)b * 16 + u.pn) * 4096 + s) * 128 + dim0;
                *(PG8_G u32x4*)(KH + o) = pack8bf(acc[ai][0][m][0] * r[ai][m], acc[ai][0][m][1] * r[ai][m]); *(PG8_G u32x4*)(VH + o) = pack8bf(acc[ai][1][m][0] * r[ai][m], acc[ai][1][m][1] * r[ai][m]); }
    }
};
struct EpiQMla {
    PG8_NOPRE
    static constexpr bool PERM = true, AFTER_DRAIN = false;
    bf16_t* Q; const float* cosT; const float* sinT; const PG8_LAS float* rsl;
    __device__ __forceinline__ void operator()(const f32x4 (&acc)[2][2][4][2], const Unit& u, int wr, int wc, int fr_, int fq_, int ui) const {
        int fr = fr_, fq = fq_; asm volatile("" : "+v"(fr), "+v"(fq));
        const int row0 = u.pm * BM + wr * 64 + fr;
        float r[2][4]; load_rs(r, rsl, wr, fr);
        if (u.pn < 8) {
            const int col0 = u.pn * BM + wc * 32 + 8 * fq;
#pragma unroll
            for (int ai = 0; ai < 2; ++ai)
#pragma unroll
                for (int m = 0; m < 4; ++m) { bf16_t* rowp = Q + (size_t)(row0 + ai * HALF + m * 16) * 3072 + col0;
#pragma unroll
                    for (int bj = 0; bj < 2; ++bj) *(PG8_G u32x4*)(rowp + bj * HALF) = pack8bf(acc[ai][bj][m][0] * r[ai][m], acc[ai][bj][m][1] * r[ai][m]); }
        } else {
            const int head = 4 * (u.pn - 8) + wc, i0 = 8 * fq;
#pragma unroll
            for (int ai = 0; ai < 2; ++ai)
#pragma unroll
                for (int m = 0; m < 4; ++m) { const int row = row0 + ai * HALF + m * 16;
                    const f32x4 c0 = *(const PG8_G f32x4*)(cosT + (size_t)row * 32 + i0), c1 = *(const PG8_G f32x4*)(cosT + (size_t)row * 32 + i0 + 4);
                    const f32x4 s0 = *(const PG8_G f32x4*)(sinT + (size_t)row * 32 + i0), s1 = *(const PG8_G f32x4*)(sinT + (size_t)row * 32 + i0 + 4);
                    const f32x4 x1a = acc[ai][0][m][0] * r[ai][m], x1b = acc[ai][0][m][1] * r[ai][m], x2a = acc[ai][1][m][0] * r[ai][m], x2b = acc[ai][1][m][1] * r[ai][m];
                    const f32x4 y1a = x1a * c0 - x2a * s0, y1b = x1b * c1 - x2b * s1, y2a = x2a * c0 + x1a * s0, y2b = x2b * c1 + x1b * s1;
                    bf16_t* dst = Q + (size_t)row * 3072 + 2048 + head * 64 + i0;
                    *(PG8_G u32x4*)dst = pack8bf(y1a, y1b); *(PG8_G u32x4*)(dst + 32) = pack8bf(y2a, y2b); }
        }
    }
};
struct EpiQkvDil {
    PG8_NOPRE
    static constexpr bool PERM = true, AFTER_DRAIN = false;
    bf16_t* O; const float* cosT; const float* sinT; const PG8_LAS float* rsl;
    __device__ __forceinline__ void operator()(const f32x4 (&acc)[2][2][4][2], const Unit& u, int wr, int wc, int fr, int fq, int ui) const {
        const int row0 = u.pm * BM + wr * 64 + fr;
        const int g = u.pn / 24, rem = u.pn - g * 24, t = rem >> 3, T = rem & 7, sh = 2 * g;
        float r[2][4]; load_rs(r, rsl, wr, fr);
        const size_t plane = ((size_t)(g * 3 + t) * 16 + 2 * T) * 4;
        if (t == 2 || wc != 0) {
            const int dim0 = wc * 32 + 8 * fq;
#pragma unroll
            for (int ai = 0; ai < 2; ++ai)
#pragma unroll
                for (int m = 0; m < 4; ++m) { const int row = row0 + ai * HALF + m * 16, b = row >> 12, s = row & 4095, sp = ((s & ((1 << sh) - 1)) << (12 - sh)) + (s >> sh);
#pragma unroll
                    for (int bj = 0; bj < 2; ++bj) *(PG8_G u32x4*)(O + ((plane + bj * 4 + b) * 4096 + sp) * 128 + dim0) = pack8bf(acc[ai][bj][m][0] * r[ai][m], acc[ai][bj][m][1] * r[ai][m]); }
        } else {
            const int hh = fq >> 1, i0 = 8 * (fq & 1);
#pragma unroll
            for (int ai = 0; ai < 2; ++ai)
#pragma unroll
                for (int m = 0; m < 4; ++m) { const int row = row0 + ai * HALF + m * 16, b = row >> 12, s = row & 4095, sp = ((s & ((1 << sh) - 1)) << (12 - sh)) + (s >> sh);
                    const f32x4 c0 = *(const PG8_G f32x4*)(cosT + (size_t)row * 16 + i0), c1 = *(const PG8_G f32x4*)(cosT + (size_t)row * 16 + i0 + 4);
                    const f32x4 s0 = *(const PG8_G f32x4*)(sinT + (size_t)row * 16 + i0), s1 = *(const PG8_G f32x4*)(sinT + (size_t)row * 16 + i0 + 4);
                    const f32x4 x1a = acc[ai][0][m][0] * r[ai][m], x1b = acc[ai][0][m][1] * r[ai][m], x2a = acc[ai][1][m][0] * r[ai][m], x2b = acc[ai][1][m][1] * r[ai][m];
                    const f32x4 y1a = x1a * c0 - x2a * s0, y1b = x1b * c1 - x2b * s1, y2a = x2a * c0 + x1a * s0, y2b = x2b * c1 + x1b * s1;
                    bf16_t* dst = O + ((plane + hh * 4 + b) * 4096 + sp) * 128 + i0;
                    *(PG8_G u32x4*)dst = pack8bf(y1a, y1b); *(PG8_G u32x4*)(dst + 16) = pack8bf(y2a, y2b); }
        }
    }
};

template <class Epi, class Sched, bool ALIGN_EPI = false, bool SP2 = false, int EPI_REP = 1>
__device__ __forceinline__ void gemm_phase(PG8_LAS unsigned char* lds, const Gemm g, const Sched& S, const Epi& E) {
    int tid_ = threadIdx.x; asm volatile("" : "+v"(tid_));
    const int tid = tid_, wid = __builtin_amdgcn_readfirstlane(tid >> 6), lane = tid & 63, wr = wid >> 2, wc = wid & 3, fr = lane & 15, fq = lane >> 4;
    const int K = g.K, nt = K / BK;
    unsigned voffA[2], voffB[2];
#pragma unroll
    for (int i = 0; i < 2; ++i) { int R, C; stage_rc(tid * 16 + i * 8192, R, C); const int Rb = Epi::PERM ? ((R & ~31) + perm32(R & 31)) : R;
        voffA[i] = (unsigned)(R * K + C) * 2u; voffB[i] = (unsigned)(Rb * K + C) * 2u; }
    const size_t kstep = (size_t)(BK * 2);
    const size_t hstep = (size_t)HALF * K * 2;
    const size_t tstep = 2 * hstep;
    const unsigned ldsw = (unsigned)wid * 1024u;
    const int aoff = lds_byte(wr * 64 + fr, fq * 8), boff = lds_byte(wc * 32 + fr, fq * 8);
#define PG8_SA(b, h) (((b) * 2 + (h)) * HTB)
#define PG8_SB(b, h) ((4 + (b) * 2 + (h)) * HTB)
#define PG8_STAGE(bufoff, gbase, voff) do { _Pragma("unroll") for (int _i = 0; _i < 2; ++_i) \
        __builtin_amdgcn_global_load_lds((const unsigned*)((const char*)(gbase) + (voff)[_i]), (PG8_LAS unsigned*)(lds + (bufoff) + ldsw + _i * 8192), 16, 0, 0); } while (0)
#define PG8_LDA(dst, b, h) do { _Pragma("unroll") for (int m = 0; m < 4; ++m) _Pragma("unroll") for (int k = 0; k < 2; ++k) dst[m][k] = *(const PG8_LAS bf16x8*)(lds + PG8_SA(b, h) + aoff + m * 2048 + k * 1024); } while (0)
#define PG8_LDB(dst, b, h) do { _Pragma("unroll") for (int n = 0; n < 2; ++n) _Pragma("unroll") for (int k = 0; k < 2; ++k) dst[n][k] = *(const PG8_LAS bf16x8*)(lds + PG8_SB(b, h) + boff + n * 2048 + k * 1024); } while (0)
#define PG8_MMA(ai, bj, At, Bt) do { __builtin_amdgcn_s_setprio(1); _Pragma("unroll") for (int m = 0; m < 4; ++m) _Pragma("unroll") for (int n = 0; n < 2; ++n) _Pragma("unroll") for (int k = 0; k < 2; ++k) \
        acc[ai][bj][m][n] = __builtin_amdgcn_mfma_f32_16x16x32_bf16(Bt[n][k], At[m][k], acc[ai][bj][m][n], 0, 0, 0); __builtin_amdgcn_s_setprio(0); } while (0)
#define PG8_WAIT_V(n) asm volatile("s_waitcnt vmcnt(" #n ")" ::: "memory")
#define PG8_WAIT_L(n) asm volatile("s_waitcnt lgkmcnt(" #n ")" ::: "memory")
#define PG8_BAR __builtin_amdgcn_s_barrier()
#define PG8_SCHED __builtin_amdgcn_sched_barrier(0)
    Unit cur, nxt; int ui = 0;
    typename Epi::Pre pre;
    if (!S.next(0, cur)) return;
    f32x4 acc[2][2][4][2];
#pragma unroll
    for (int a = 0; a < 2; ++a)
#pragma unroll
        for (int b = 0; b < 2; ++b)
#pragma unroll
            for (int m = 0; m < 4; ++m)
#pragma unroll
                for (int n = 0; n < 2; ++n) acc[a][b][m][n] = (f32x4){0.f, 0.f, 0.f, 0.f};
    bf16x8 At[4][2], B0[2][2], B1[2][2];
    const char* cA = (const char*)g.A + (size_t)cur.pm * tstep; const char* cB = (const char*)g.Bt + (size_t)cur.pn * tstep;
    S.a_ready(cur);
    if constexpr (SP2) {
        PG8_STAGE(PG8_SB(0, 0), cB, voffB); PG8_STAGE(PG8_SB(0, 1), cB + hstep, voffB); PG8_STAGE(PG8_SA(0, 0), cA, voffA); PG8_STAGE(PG8_SA(0, 1), cA + hstep, voffA);
        if (wr == 1) PG8_BAR;
        PG8_WAIT_V(2); PG8_BAR;
        PG8_STAGE(PG8_SB(1, 0), cB + kstep, voffB); PG8_STAGE(PG8_SA(1, 0), cA + kstep, voffA); PG8_STAGE(PG8_SB(1, 1), cB + hstep + kstep, voffB);
        PG8_WAIT_V(6); PG8_BAR;
    } else {
        PG8_STAGE(PG8_SB(0, 0), cB, voffB); PG8_STAGE(PG8_SA(0, 0), cA, voffA); PG8_STAGE(PG8_SB(0, 1), cB + hstep, voffB); PG8_STAGE(PG8_SA(0, 1), cA + hstep, voffA);
        if (wr == 1) PG8_BAR;
        PG8_WAIT_V(4); PG8_BAR;
        PG8_STAGE(PG8_SB(1, 0), cB + kstep, voffB); PG8_STAGE(PG8_SA(1, 0), cA + kstep, voffA); PG8_STAGE(PG8_SB(1, 1), cB + hstep + kstep, voffB);
        PG8_WAIT_V(6); PG8_BAR;
    }
    for (;;) {
        const bool has_next = S.next(ui + 1, nxt);
        const char* nA = has_next ? (const char*)g.A + (size_t)nxt.pm * tstep : cA; const char* nB = has_next ? (const char*)g.Bt + (size_t)nxt.pn * tstep : cB;
        for (int t = 0; t < nt; t += 2) {
            const bool last = (t == nt - 2);
            const char* a1 = cA + (size_t)(t + 1) * kstep;
            const char* a2 = last ? nA : cA + (size_t)(t + 2) * kstep; const char* b2 = last ? nB : cB + (size_t)(t + 2) * kstep;
            const char* a3 = a2 + kstep; const char* b3 = b2 + kstep;
            if (last && has_next) S.a_ready(nxt);
            if (t == 0) E.pre_issue(pre, cur, tid, ui); else if (t == 2) E.pre_finish(pre, tid, ui);
            if constexpr (SP2) {
            PG8_LDB(B0, 0, 0); PG8_LDB(B1, 0, 1); PG8_SCHED; PG8_LDA(At, 0, 0); PG8_STAGE(PG8_SA(1, 1), a1 + hstep, voffA);
            PG8_WAIT_V(8); PG8_WAIT_L(0); PG8_BAR; PG8_MMA(0, 0, At, B0); PG8_MMA(0, 1, At, B1); PG8_BAR; PG8_SCHED;
            PG8_LDA(At, 0, 1); PG8_STAGE(PG8_SB(0, 0), b2, voffB); PG8_STAGE(PG8_SB(0, 1), b2 + hstep, voffB); PG8_STAGE(PG8_SA(0, 0), a2, voffA);
            PG8_WAIT_V(8); PG8_WAIT_L(0); PG8_BAR; PG8_MMA(1, 0, At, B0); PG8_MMA(1, 1, At, B1); PG8_BAR; PG8_SCHED;
            PG8_LDB(B0, 1, 0); PG8_LDB(B1, 1, 1); PG8_SCHED; PG8_LDA(At, 1, 0); PG8_STAGE(PG8_SA(0, 1), a2 + hstep, voffA);
            PG8_WAIT_V(8); PG8_WAIT_L(0); PG8_BAR; PG8_MMA(0, 0, At, B0); PG8_MMA(0, 1, At, B1); PG8_BAR; PG8_SCHED;
            PG8_LDA(At, 1, 1); PG8_STAGE(PG8_SB(1, 0), b3, voffB); PG8_STAGE(PG8_SB(1, 1), b3 + hstep, voffB); PG8_STAGE(PG8_SA(1, 0), a3, voffA);
            PG8_WAIT_V(8); PG8_WAIT_L(0); PG8_BAR; PG8_MMA(1, 0, At, B0); PG8_MMA(1, 1, At, B1); PG8_BAR; PG8_SCHED;
            } else {
            PG8_LDB(B0, 0, 0); PG8_SCHED; PG8_LDA(At, 0, 0); PG8_STAGE(PG8_SA(1, 1), a1 + hstep, voffA);
            PG8_WAIT_L(8); PG8_BAR; PG8_WAIT_L(0); PG8_MMA(0, 0, At, B0); PG8_BAR; PG8_SCHED;
            PG8_LDB(B1, 0, 1); PG8_STAGE(PG8_SB(0, 0), b2, voffB);
            PG8_BAR; PG8_WAIT_L(0); PG8_MMA(0, 1, At, B1); PG8_BAR;
            PG8_LDA(At, 0, 1); PG8_STAGE(PG8_SA(0, 0), a2, voffA);
            PG8_BAR; PG8_WAIT_L(0); PG8_MMA(1, 0, At, B0); PG8_BAR; PG8_SCHED;
            PG8_STAGE(PG8_SB(0, 1), b2 + hstep, voffB);
            PG8_WAIT_V(6); PG8_BAR; PG8_MMA(1, 1, At, B1); PG8_BAR;
            PG8_LDB(B0, 1, 0); PG8_SCHED; PG8_LDA(At, 1, 0); PG8_STAGE(PG8_SA(0, 1), a2 + hstep, voffA);
            PG8_WAIT_L(8); PG8_BAR; PG8_WAIT_L(0); PG8_MMA(0, 0, At, B0); PG8_BAR; PG8_SCHED;
            PG8_LDB(B1, 1, 1); PG8_STAGE(PG8_SB(1, 0), b3, voffB);
            PG8_BAR; PG8_WAIT_L(0); PG8_MMA(0, 1, At, B1); PG8_BAR;
            PG8_LDA(At, 1, 1); PG8_STAGE(PG8_SA(1, 0), a3, voffA);
            PG8_BAR; PG8_WAIT_L(0); PG8_MMA(1, 0, At, B0); PG8_BAR; PG8_SCHED;
            PG8_STAGE(PG8_SB(1, 1), b3 + hstep, voffB);
            PG8_WAIT_V(6); PG8_BAR; PG8_MMA(1, 1, At, B1); PG8_BAR;
            }
        }
        if constexpr (ALIGN_EPI) { if (wr == 0) PG8_BAR; }
        if constexpr (!Epi::AFTER_DRAIN) { _Pragma("unroll") for (int rep_ = 0; rep_ < EPI_REP; ++rep_) E(acc, cur, wr, wc, fr, fq, ui); S.done(cur); }
        if (!has_next) break;
#pragma unroll
        for (int a = 0; a < 2; ++a)
#pragma unroll
            for (int b = 0; b < 2; ++b)
#pragma unroll
                for (int m = 0; m < 4; ++m)
#pragma unroll
                    for (int n = 0; n < 2; ++n) acc[a][b][m][n] = (f32x4){0.f, 0.f, 0.f, 0.f};
        cur = nxt; cA = nA; cB = nB; ++ui;
        if constexpr (ALIGN_EPI) { if (wr == 1) PG8_BAR; }
    }
    PG8_WAIT_V(0);
    if constexpr (!ALIGN_EPI) { if (wr == 0) PG8_BAR; }
    PG8_BAR;
    if constexpr (Epi::AFTER_DRAIN) { E.fused(acc, cur, wr, wc, fr, fq, lds, wid, lane); S.done(cur); }
#undef PG8_SA
#undef PG8_SB
#undef PG8_STAGE
#undef PG8_LDA
#undef PG8_LDB
#undef PG8_MMA
#undef PG8_WAIT_V
#undef PG8_WAIT_L
#undef PG8_BAR
#undef PG8_SCHED
}
}
namespace att {
typedef unsigned short bf16;
typedef short bf16x8 __attribute__((ext_vector_type(8)));
typedef short s16x4 __attribute__((ext_vector_type(4)));
typedef float f32x16 __attribute__((ext_vector_type(16)));
typedef float f32x4 __attribute__((ext_vector_type(4)));
typedef unsigned u32x4 __attribute__((ext_vector_type(4)));
constexpr int NW = 8, QBLK = 32, KVBLK = 64, QB = NW * QBLK;
constexpr int SHM_V = KVBLK * 128 * 2, SHM_K = KVBLK * 128 * 2, KPE_ROW = 144, SHM_KPE = KVBLK * KPE_ROW;
constexpr int OFF_V = 0, OFF_K = 2 * SHM_V, OFF_WS = OFF_K + 2 * SHM_K, OFF_KPE = OFF_WS + NW * 64 * 4, OFF_QPE = OFF_KPE + 2 * SHM_KPE, LDS_BYTES = OFF_QPE + NW * 4096;
constexpr float THR = 8.f;

#define KSWZ(row, colB) ((row) * 256 + ((colB) ^ (((row) & 7) << 4)))
#define SBAR() __builtin_amdgcn_sched_barrier(0)
__device__ __forceinline__ int v_st(int k, int c) { const int kk = (k & ~0xC) | ((k & 4) << 1) | ((k & 8) >> 1); return ((kk >> 3) * 4 + (c >> 5)) * 512 + ((kk & 7) * 32 + (c & 31)) * 2; }
__device__ __forceinline__ int v_rd_base(int lane) { return ((lane & 3) << 3) | (((lane >> 2) & 3) << 6) | (((lane >> 4) & 1) << 5) | (((lane >> 5) & 1) << 11); }
constexpr int v_rd_off(int d0, int ks, int half) { return d0 * 512 + ks * 4096 + half * 256; }
__device__ __forceinline__ int crow(int r, int hi) { return (r & 3) + 8 * (r >> 2) + 4 * hi; }
__device__ __forceinline__ unsigned cvtpk(float lo, float hi) { unsigned r; asm volatile("v_cvt_pk_bf16_f32 %0, %1, %2" : "=v"(r) : "v"(lo), "v"(hi)); return r; }
__device__ __forceinline__ bf16x8 ld8(const bf16* p) { return *reinterpret_cast<const bf16x8*>(p); }
__device__ __forceinline__ void mask_tile(f32x16& p0, f32x16& p1, int dq, unsigned W) {
    const float NEG = -__builtin_inff();
#pragma unroll
    for (int r = 0; r < 16; ++r) {
        const int c = (r & 3) + 8 * (r >> 2);
        if ((unsigned)(dq - c) >= W) p0[r] = NEG;
        if ((unsigned)(dq - c - 32) >= W) p1[r] = NEG;
    }
}
__device__ __forceinline__ void partialSM(f32x16& p0, f32x16& p1, float& m_reg, float& mn, float& alpha, const float scale) {
    float pmax = p0[0]; for (int r = 1; r < 16; ++r) pmax = fmaxf(pmax, p0[r]); for (int r = 0; r < 16; ++r) pmax = fmaxf(pmax, p1[r]);
    { auto rr = __builtin_amdgcn_permlane32_swap(__float_as_uint(pmax), __float_as_uint(pmax), false, false);
      pmax = fmaxf(__uint_as_float(rr[0]), __uint_as_float(rr[1])); }
    const float C2 = 1.4426950408889634f * scale;
    if (__builtin_expect(__all((pmax - m_reg) * scale <= THR), 1)) { mn = m_reg; alpha = 1.f; }
    else { mn = fmaxf(m_reg, pmax); alpha = __builtin_amdgcn_exp2f((m_reg - mn) * C2); m_reg = mn; }
    const float mnL = -mn * C2;
    for (int r = 0; r < 16; ++r) p0[r] = fmaf(p0[r], C2, mnL); for (int r = 0; r < 16; ++r) p1[r] = fmaf(p1[r], C2, mnL);
    for (int r = 0; r < 16; ++r) p0[r] = __builtin_amdgcn_exp2f(p0[r]);
}
__device__ __forceinline__ void finishSM(f32x16& p0, f32x16& p1, float alpha, float& l_reg, bf16x8& pa0, bf16x8& pa1, bf16x8& pa2, bf16x8& pa3) {
    for (int r = 0; r < 16; ++r) p1[r] = __builtin_amdgcn_exp2f(p1[r]);
    float ps = 0; for (int r = 0; r < 16; ++r) ps += p0[r]; for (int r = 0; r < 16; ++r) ps += p1[r];
    { auto rr = __builtin_amdgcn_permlane32_swap(__float_as_uint(ps), __float_as_uint(ps), false, false);
      ps = __uint_as_float(rr[0]) + __uint_as_float(rr[1]); }
    l_reg = l_reg * alpha + ps;
#define PK4(P, B_, OUT) do { const u32x4 w = {cvtpk(P[B_+0], P[B_+1]), cvtpk(P[B_+2], P[B_+3]), cvtpk(P[B_+4], P[B_+5]), cvtpk(P[B_+6], P[B_+7])};     \
        OUT = *reinterpret_cast<const bf16x8*>(&w); } while (0)
    PK4(p0, 0, pa0); PK4(p0, 8, pa1); PK4(p1, 0, pa2); PK4(p1, 8, pa3);
#undef PK4
}
template <int KB, bool SK, bool PE>
__device__ __forceinline__ void qkt(f32x16& p0, f32x16& p1, const char* lds, int r32, int hi, int wid, int lane, const bf16x8* qr, bool act) {
    if (SK && !act) { const float NEG = -__builtin_inff();
#pragma unroll
        for (int r = 0; r < 16; ++r) { p0[r] = NEG; p1[r] = NEG; } return; }
    p0 = f32x16{}; p1 = f32x16{};
    const char* kb[4];
#pragma unroll
    for (int dd = 0; dd < 4; ++dd) kb[dd] = lds + OFF_K + KB * SHM_K + KSWZ(r32, (dd * 16 + hi * 8) * 2);
#pragma unroll
    for (int d0 = 0; d0 < 8; ++d0) { const char* a = kb[d0 & 3] + (d0 >> 2) * 128;
        bf16x8 b0 = *reinterpret_cast<const bf16x8*>(a);
        bf16x8 b1 = *reinterpret_cast<const bf16x8*>(a + 32 * 256);
        p0 = __builtin_amdgcn_mfma_f32_32x32x16_bf16(b0, qr[d0], p0, 0, 0, 0);
        p1 = __builtin_amdgcn_mfma_f32_32x32x16_bf16(b1, qr[d0], p1, 0, 0, 0); }
    if constexpr (PE) {
        const char* kp = lds + OFF_KPE + KB * SHM_KPE + r32 * KPE_ROW + hi * 16;
        const char* qp = lds + OFF_QPE + wid * 4096 + lane * 16;
#pragma unroll
        for (int d0 = 0; d0 < 4; ++d0) {
            bf16x8 b0 = *reinterpret_cast<const bf16x8*>(kp + d0 * 32);
            bf16x8 b1 = *reinterpret_cast<const bf16x8*>(kp + d0 * 32 + 32 * KPE_ROW);
            bf16x8 qf = *reinterpret_cast<const bf16x8*>(qp + d0 * 1024);
            p0 = __builtin_amdgcn_mfma_f32_32x32x16_bf16(b0, qf, p0, 0, 0, 0);
            p1 = __builtin_amdgcn_mfma_f32_32x32x16_bf16(b1, qf, p1, 0, 0, 0); }
    }
}
template <int VB, bool SK>
__device__ __forceinline__ void pv_tile(f32x16* o, int vb0, bf16x8 pa0, bf16x8 pa1, bf16x8 pa2, bf16x8 pa3, bool act) {
    if (SK && !act) return;
#define TRRD(dst, off) asm volatile("ds_read_b64_tr_b16 %0, %1 offset:%2" : "=&v"(dst) : "v"(vb0), "i"(off) : "memory")
#define PV_D0(d0) do { s16x4 l0, l1, l2, l3, h0, h1, h2, h3; constexpr int b_ = OFF_V + VB * SHM_V + v_rd_off(d0, 0, 0); \
        TRRD(l0, b_); TRRD(h0, b_ + 256); TRRD(l1, b_ + 4096); TRRD(h1, b_ + 4352); TRRD(l2, b_ + 8192); TRRD(h2, b_ + 8448); TRRD(l3, b_ + 12288); TRRD(h3, b_ + 12544); \
        asm volatile("s_waitcnt lgkmcnt(0)" ::: "memory"); SBAR();   \
        o[d0] = __builtin_amdgcn_mfma_f32_32x32x16_bf16((bf16x8){l0[0], l0[1], l0[2], l0[3], h0[0], h0[1], h0[2], h0[3]}, pa0, o[d0], 0, 0, 0);   \
        o[d0] = __builtin_amdgcn_mfma_f32_32x32x16_bf16((bf16x8){l1[0], l1[1], l1[2], l1[3], h1[0], h1[1], h1[2], h1[3]}, pa1, o[d0], 0, 0, 0);   \
        o[d0] = __builtin_amdgcn_mfma_f32_32x32x16_bf16((bf16x8){l2[0], l2[1], l2[2], l2[3], h2[0], h2[1], h2[2], h2[3]}, pa2, o[d0], 0, 0, 0);   \
        o[d0] = __builtin_amdgcn_mfma_f32_32x32x16_bf16((bf16x8){l3[0], l3[1], l3[2], l3[3], h3[0], h3[1], h3[2], h3[3]}, pa3, o[d0], 0, 0, 0); } while (0)
    PV_D0(0); PV_D0(1); PV_D0(2); PV_D0(3);
#undef PV_D0
#undef TRRD
}

struct Prm { int qs, kvs, os, qpes, kpes, lses, skv, W; float scale; };
struct BlockRef { const bf16* Q; const bf16* K; const bf16* V; bf16* O; const bf16* Qpe; const bf16* Kpe; float* Lse; int P0; };
template <bool PE> struct Seam { bf16x8 qr[8]; bf16x8 st_v0, st_v1, st_k0, st_k1, st_kp; };
__device__ __forceinline__ int swa_jlo(int P0, int W) { const int lowk = P0 - W + 1; return lowk > 0 ? lowk / KVBLK : 0; }
#define VMW() asm volatile("s_waitcnt vmcnt(0)" ::: "memory")
#define ATT_G __attribute__((address_space(1)))
#define LDG(base, off) (*(const ATT_G bf16x8*)((const ATT_G char*)(base) + (off)))
#define SLOAD_H(R_, k0) do { const char* kb__ = (const char*)(R_).K + (size_t)(k0) * P.kvs * 2; const char* vb__ = (const char*)(R_).V + (size_t)(k0) * P.kvs * 2; const size_t h__ = (size_t)32 * P.kvs * 2; \
                              S.st_v0 = LDG(vb__, kvoff); S.st_v1 = LDG(vb__ + h__, kvoff); S.st_k0 = LDG(kb__, kvoff); S.st_k1 = LDG(kb__ + h__, kvoff); \
                              if constexpr (PE) S.st_kp = LDG((const char*)(R_).Kpe + (size_t)(k0) * P.kpes * 2, kpoff); } while (0)
#define SWRITE_HK(bf) do { *(bf16x8*)(K_lds + (bf) * SHM_K + kws) = S.st_k0; *(bf16x8*)(K_lds + (bf) * SHM_K + kws + 32 * 256) = S.st_k1; \
                           if constexpr (PE) *(bf16x8*)(lds + OFF_KPE + (bf) * SHM_KPE + pws) = S.st_kp; } while (0)
#define SWRITE_HV(bf) do { *(bf16x8*)(V_lds + (bf) * SHM_V + vst0) = S.st_v0; *(bf16x8*)(V_lds + (bf) * SHM_V + vst1) = S.st_v1; } while (0)
#define SWRITE_H(bf) do { SWRITE_HV(bf); SWRITE_HK(bf); } while (0)
template <bool PE>
__device__ __forceinline__ void swa_prime(const BlockRef& cur, const Prm& P, char* lds, Seam<PE>& S) {
    int tid_ = threadIdx.x; asm volatile("" : "+v"(tid_));
    const int tid = tid_, wid = __builtin_amdgcn_readfirstlane(tid >> 6), lane = tid & 63, r32 = lane & 31, hi = lane >> 5;
    const int sr = tid >> 4, sc = (tid & 15) * 8, kws = KSWZ(sr, sc * 2); char* K_lds = lds + OFF_K;
    const int pr = tid >> 3, pc = (tid & 7) * 8, pws = pr * KPE_ROW + (tid & 7) * 16;
    const unsigned kvoff = (unsigned)(sr * P.kvs + sc) * 2u, kpoff = (unsigned)(pr * P.kpes + pc) * 2u, qoff = (unsigned)((wid * QBLK + r32) * P.qs + hi * 8) * 2u, qpoff = (unsigned)((wid * QBLK + r32) * P.qpes + hi * 8) * 2u;
    const int kb0 = swa_jlo(cur.P0, P.W) * KVBLK;
#pragma unroll
    for (int d0 = 0; d0 < 8; ++d0) S.qr[d0] = LDG(cur.Q, qoff + d0 * 32);
    if constexpr (PE) {
#pragma unroll
        for (int d0 = 0; d0 < 4; ++d0) *(bf16x8*)(lds + OFF_QPE + wid * 4096 + d0 * 1024 + lane * 16) = LDG(cur.Qpe, qpoff + d0 * 32);
    }
    SLOAD_H(cur, kb0); VMW(); SWRITE_HK(0);
    __syncthreads();
}
template <bool PE, bool SK, bool LSE, bool EARLY>
__device__ __forceinline__ void swa_block(const BlockRef& cur, const BlockRef& nxt, const Prm& P, char* lds, Seam<PE>& S) {
    int tid_ = threadIdx.x; asm volatile("" : "+v"(tid_));
    const int tid = tid_, wid = __builtin_amdgcn_readfirstlane(tid >> 6), lane = tid & 63, r32 = lane & 31, hi = lane >> 5;
    const int W = P.W;
    const int j_lo = swa_jlo(cur.P0, W);
    int j_hi = (cur.P0 + QB - 1) / KVBLK + 1; if (j_hi > P.skv / KVBLK) j_hi = P.skv / KVBLK;
    const int NT = j_hi - j_lo;
    const int kbn = swa_jlo(nxt.P0, W) * KVBLK;
    const int qlo = cur.P0 + wid * QBLK, qm = qlo + r32 - 4 * hi;
    char* V_lds = lds + OFF_V; char* K_lds = lds + OFF_K;
    float* ws = (float*)(lds + OFF_WS) + wid * 64; float* li_l = ws, * al_l = ws + 32;
    float m_reg = -1e30f, l_reg = 0; f32x16 o[4] = {};
    const int sr = tid >> 4, sc = (tid & 15) * 8, vst0 = v_st(sr, sc), vst1 = v_st(32 + sr, sc), kws = KSWZ(sr, sc * 2);
    const int pr = tid >> 3, pc = (tid & 7) * 8, pws = pr * KPE_ROW + (tid & 7) * 16;
    const unsigned kvoff = (unsigned)(sr * P.kvs + sc) * 2u, kpoff = (unsigned)(pr * P.kpes + pc) * 2u;
    const int vb0 = (int)(uintptr_t)lds + v_rd_base(lane);
#define RESC(a) do { if (__any((a) < 1.f && l_reg != 0.f)) {        \
                     for (int d_ = 0; d_ < 4; ++d_) for (int r = 0; r < 16; ++r) o[d_][r] *= (a); } } while (0)
#define KBASE(t) ((j_lo + (t)) * KVBLK)
#define ACT(t) (KBASE(t) <= qlo + QBLK - 1 && KBASE(t) + KVBLK - 1 >= qlo - W + 1)
#define MASKT(P0_, P1_, t) do { const int kb_ = KBASE(t); if ((!SK || ACT(t)) && (kb_ + KVBLK - 1 > qlo || kb_ <= qlo + QBLK - 1 - W)) mask_tile(P0_, P1_, qm - kb_, (unsigned)W); } while (0)
    f32x16 pA0, pA1, pB0, pB1; float mnA, mnB, alA, alB; bf16x8 pa0, pa1, pa2, pa3;
    SWRITE_HV(0); SBAR();
    if (NT > 1) { SLOAD_H(cur, KBASE(1)); }
    SBAR(); qkt<0, SK, PE>(pA0, pA1, lds, r32, hi, wid, lane, S.qr, ACT(0));
    MASKT(pA0, pA1, 0); partialSM(pA0, pA1, m_reg, mnA, alA, P.scale);
    if (NT > 1) { VMW(); SWRITE_H(1); }
    __syncthreads();
#define HALF_STEP(PX0, PX1, mnX, alX, PY0, PY1, alY, t, KB, VB, SB) do {                                                      \
        SBAR(); if (EARLY && (t) + 1 < NT) { SLOAD_H(cur, KBASE((t) + 1)); SBAR(); }                                          \
        qkt<KB, SK, PE>(PX0, PX1, lds, r32, hi, wid, lane, S.qr, ACT(t));                                                     \
        finishSM(PY0, PY1, alY, l_reg, pa0, pa1, pa2, pa3); SBAR();                                                           \
        if (!EARLY && (t) + 1 < NT) { SLOAD_H(cur, KBASE((t) + 1)); SBAR(); }                                                 \
        pv_tile<VB, SK>(o, vb0, pa0, pa1, pa2, pa3, ACT((t) - 1)); MASKT(PX0, PX1, (t)); partialSM(PX0, PX1, m_reg, mnX, alX, P.scale); \
        __syncthreads();                                                                                                      \
        if ((t) + 1 < NT) { VMW(); SWRITE_H(SB); }                                                                            \
        RESC(alX); __syncthreads(); } while (0)
    for (int t = 1; t + 1 < NT; t += 2) {
        HALF_STEP(pB0, pB1, mnB, alB, pA0, pA1, alA, t, 1, 0, 0);
        HALF_STEP(pA0, pA1, mnA, alA, pB0, pB1, alB, t + 1, 0, 1, 1);
    }
    const bool even = (NT & 1) == 0;
    if (even) { SBAR(); qkt<1, SK, PE>(pB0, pB1, lds, r32, hi, wid, lane, S.qr, ACT(NT - 1)); SBAR(); }
    SLOAD_H(nxt, kbn); SBAR();
    { const unsigned qoff = (unsigned)((wid * QBLK + r32) * P.qs + hi * 8) * 2u;
#pragma unroll
      for (int d0 = 0; d0 < 8; ++d0) S.qr[d0] = LDG(nxt.Q, qoff + d0 * 32); }
    bf16x8 qpn[4];
    if constexpr (PE) { const unsigned qpoff = (unsigned)((wid * QBLK + r32) * P.qpes + hi * 8) * 2u;
#pragma unroll
        for (int d0 = 0; d0 < 4; ++d0) qpn[d0] = LDG(nxt.Qpe, qpoff + d0 * 32);
    }
    SBAR();
    finishSM(pA0, pA1, alA, l_reg, pa0, pa1, pa2, pa3); SBAR();
    pv_tile<0, SK>(o, vb0, pa0, pa1, pa2, pa3, ACT(even ? NT - 2 : NT - 1));
    if (even) { MASKT(pB0, pB1, NT - 1); partialSM(pB0, pB1, m_reg, mnB, alB, P.scale); __syncthreads(); RESC(alB);
        finishSM(pB0, pB1, alB, l_reg, pa0, pa1, pa2, pa3); SBAR(); pv_tile<1, SK>(o, vb0, pa0, pa1, pa2, pa3, ACT(NT - 1)); }
    SBAR();
    VMW(); SWRITE_HK(0);
    if constexpr (PE) {
#pragma unroll
        for (int d0 = 0; d0 < 4; ++d0) *(bf16x8*)(lds + OFF_QPE + wid * 4096 + d0 * 1024 + lane * 16) = qpn[d0];
    }
    SBAR();
    { const float rl = __builtin_amdgcn_rcpf(l_reg);
      ATT_G char* ob = (ATT_G char*)cur.O + (unsigned)(((wid * QBLK + r32) * P.os + 8 * hi) * 2);
#pragma unroll
      for (int d0 = 0; d0 < 4; ++d0)
#pragma unroll
        for (int j = 0; j < 2; ++j) {
            const unsigned ax = cvtpk(o[d0][8 * j + 0] * rl, o[d0][8 * j + 1] * rl), ay = cvtpk(o[d0][8 * j + 2] * rl, o[d0][8 * j + 3] * rl);
            const unsigned bx = cvtpk(o[d0][8 * j + 4] * rl, o[d0][8 * j + 5] * rl), by = cvtpk(o[d0][8 * j + 6] * rl, o[d0][8 * j + 7] * rl);
            auto rx = __builtin_amdgcn_permlane32_swap(ax, bx, false, false); auto ry = __builtin_amdgcn_permlane32_swap(ay, by, false, false);
            const u32x4 w = {rx[0], ry[0], rx[1], ry[1]};
            *(ATT_G u32x4*)(ob + d0 * 64 + j * 32) = w; } }
    if constexpr (LSE) { if (hi == 0) *(ATT_G float*)((ATT_G char*)cur.Lse + (unsigned)((wid * QBLK + r32) * P.lses) * 4u) = m_reg * P.scale + __logf(l_reg); }
    __syncthreads();
#undef RESC
#undef KBASE
#undef ACT
#undef MASKT
#undef HALF_STEP
}
#undef LDG
#undef ATT_G
#undef VMW
#undef SLOAD_H
#undef SWRITE_HK
#undef SWRITE_HV
#undef SWRITE_H
#undef KSWZ
#undef SBAR
}
constexpr int NWAVES = 8;
constexpr int BATCH = 4, SEQ = 4096, DM = 2048, M = BATCH * SEQ;
constexpr int NQKVA = 1280;
constexpr int NQB = 3072, NKVB = 4096, NDIL = 18432, FF = 5632, NUP = 2 * FF;
constexpr float EPS = 1e-6f;
constexpr size_t MiB = (size_t)1 << 20;
constexpr size_t WS_CTL = 0, CTL_ZERO_BYTES = 64 * 1024;
constexpr size_t WS_COSM = 1 * MiB, WS_SINM = 3 * MiB, WS_COSD = 5 * MiB, WS_SIND = 6 * MiB;
constexpr size_t WS_CWS = 7 * MiB;
constexpr size_t WS_WMLA = 8 * MiB, WMLA_STRIDE = 20 * MiB, WMLA_QKVA = 0, WMLA_QB = 5 * MiB, WMLA_KVB = 8 * MiB, WMLA_WO = 12 * MiB;
constexpr size_t WS_WDIL = WS_WMLA + 2 * WMLA_STRIDE, WDIL_STRIDE = 80 * MiB, WDIL_IN = 0, WDIL_WO = 72 * MiB;
constexpr size_t WS_WFFN = WS_WDIL + 2 * WDIL_STRIDE, WFFN_STRIDE = 66 * MiB, WFFN_UP = 0, WFFN_DOWN = 44 * MiB;
constexpr size_t WS_H = WS_WFFN + 4 * WFFN_STRIDE;
constexpr size_t WS_S = WS_H + 64 * MiB;
constexpr size_t S_PQ = 0  , S_QN = 80 * MiB, S_CKVN = 96 * MiB, S_KPE = 112 * MiB, S_Q = 114 * MiB, S_KV = 210 * MiB, S_AO_MLA = 338 * MiB;
constexpr size_t S_QKV = 0, S_OG = 576 * MiB, S_LSE = 768 * MiB, S_AO_DIL = 771 * MiB;
constexpr size_t S_U = 0, S_ACT = 352 * MiB;
constexpr size_t WS_HALO = WS_S + 835 * MiB, WS_FIX = WS_HALO + 6 * MiB;
constexpr size_t WS_PS = WS_FIX + 6 * MiB, PS_STRIDE = 2 * MiB;
constexpr size_t WS_END = WS_PS + 8 * PS_STRIDE;
static_assert(WS_H == 472 * MiB && WS_END == 1399 * MiB, "d_ws map");
constexpr int CW_PX = 1280;
constexpr int CW_PB = 1024;
constexpr int CW_BAR = 4096;
constexpr int RING_OFF = 0, RING_BYTES = 131072, LDSCTL_OFF = RING_BYTES, MISC_OFF = LDSCTL_OFF + 320, XH_OFF = RING_BYTES + 1024  , CWL_OFF = XH_OFF + 6144  , RSL_OFF = CWL_OFF + 8192  , RSQ_OFF = RSL_OFF + 1024  , LDS_BYTES = 163840;
static_assert(RSQ_OFF + 2048 <= LDS_BYTES, "LDS map");
static_assert(att::LDS_BYTES <= RING_BYTES && pg8::STAGE_BYTES <= RING_BYTES, "LDS map");

#define GAS __attribute__((address_space(1)))
#define LAS __attribute__((address_space(3)))
typedef unsigned short bf16;
typedef unsigned v4u __attribute__((ext_vector_type(4)));
typedef unsigned v2u __attribute__((ext_vector_type(2)));
typedef float f32x4 __attribute__((ext_vector_type(4)));
typedef GAS unsigned gu32;
#define RLX_AGENT __ATOMIC_RELAXED, __HIP_MEMORY_SCOPE_AGENT
#define LDS_WAIT() asm volatile("s_waitcnt lgkmcnt(0)" ::: "memory")
__device__ __forceinline__ unsigned pk2(float lo, float hi) { return pg8::cvt_pk_bf16(lo, hi); }
__device__ __forceinline__ float bf_lo(unsigned w) { return __uint_as_float(w << 16); }
__device__ __forceinline__ float bf_hi(unsigned w) { return __uint_as_float(w & 0xffff0000u); }

#define XB_TMO      128
#define XB_XCNT(j)  (256  + 64 * (j))
#define XB_XSUB(j)  (1280 + 64 * (j))
#define XB_XGEN(j)  (2304 + 64 * (j))
#define XB_TOP      3328
#define XB_TOPGEN   3392
#define XCD_BAR_WORDS 3456
#define XB_SPIN_CAP (1u << 18)

__device__ __forceinline__ unsigned xb_ld(unsigned* p)              { return __hip_atomic_load(p, __ATOMIC_RELAXED, __HIP_MEMORY_SCOPE_AGENT); }
__device__ __forceinline__ unsigned xb_add(unsigned* p, unsigned v) { return __hip_atomic_fetch_add(p, v, __ATOMIC_RELAXED, __HIP_MEMORY_SCOPE_AGENT); }
__device__ __forceinline__ unsigned xb_xcc_id() { return (unsigned)__builtin_amdgcn_s_getreg((3 << 11) | 20) & 0xFu; }
#define XB_SPIN(cond, bar) do { unsigned _sp = 0; while (cond) { __builtin_amdgcn_s_sleep(1); \
    if ((++_sp & 255u) == 0u) { if (xb_ld(&(bar)[XB_TMO])) break; if (_sp > XB_SPIN_CAP) { atomicAdd(&(bar)[XB_TMO], 1u); break; } } } } while (0)

struct XcdBarrier {
    unsigned* bar; unsigned x;
    volatile LAS unsigned* st;
};

__device__ __forceinline__ XcdBarrier xcd_barrier_post(unsigned* bar, volatile LAS unsigned* st) {
    XcdBarrier b; b.bar = bar; b.x = xb_xcc_id(); b.st = st;
    if (threadIdx.x == 0) (void)xb_add(&bar[XB_XCNT(b.x)], 1u);
    return b;
}
__device__ __forceinline__ void xcd_barrier_complete(unsigned* bar, unsigned x, unsigned& nloc, unsigned& nx) {
    const unsigned G = gridDim.x * gridDim.y * gridDim.z;
    unsigned sum, cnt, mine, sp = 0u;
    for (;;) {
        sum = 0u; cnt = 0u; mine = 0u;
#pragma unroll
        for (unsigned j = 0; j < 16; ++j) { const unsigned c = xb_ld(&bar[XB_XCNT(j)]); sum += c; cnt += (c > 0u) ? 1u : 0u; mine = (j == x) ? c : mine; }
        if (sum == G) break;
        __builtin_amdgcn_s_sleep(1);
        if ((++sp & 255u) == 0u) { if (xb_ld(&bar[XB_TMO])) break; if (sp > XB_SPIN_CAP) { atomicAdd(&bar[XB_TMO], 1u); break; } }
    }
    nloc = mine > 0u ? mine : 1u; nx = cnt > 0u ? cnt : 1u;
}

__device__ __forceinline__ void xcd_barrier(const XcdBarrier& b) {
    asm volatile("s_waitcnt vmcnt(0)" ::: "memory");
    __syncthreads();
    if (threadIdx.x == 0) {
        __attribute__((address_space(1))) unsigned* barg_ = (__attribute__((address_space(1))) unsigned*)b.bar; unsigned bx_ = b.x;
        asm volatile("" : "+s"(barg_), "+s"(bx_)); unsigned* bar = (unsigned*)barg_;
        __builtin_amdgcn_s_waitcnt(0);
        unsigned nloc = b.st[0], nx = b.st[1];
        if (nloc == 0u) { xcd_barrier_complete(bar, bx_, nloc, nx); b.st[0] = nloc; b.st[1] = nx; }
        const unsigned old = xb_add(&bar[XB_XSUB(bx_)], 1u);
        const unsigned gen = old / nloc;
        if (old + 1u == (gen + 1u) * nloc) {
            __builtin_amdgcn_fence(__ATOMIC_RELEASE, "agent");
            asm volatile("s_waitcnt vmcnt(0)" ::: "memory");
            const unsigned og = xb_add(&bar[XB_TOP], 1u);
            const unsigned tg = og / nx;
            if (og + 1u == (tg + 1u) * nx) xb_add(&bar[XB_TOPGEN], 1u);
            else XB_SPIN(xb_ld(&bar[XB_TOPGEN]) == tg, bar);
            __builtin_amdgcn_fence(__ATOMIC_ACQUIRE, "agent");
            xb_add(&bar[XB_XGEN(bx_)], 1u);
            asm volatile("s_waitcnt vmcnt(0)" ::: "memory");
        } else {
            XB_SPIN(xb_ld(&bar[XB_XGEN(bx_)]) == gen, bar);
            __builtin_amdgcn_fence(__ATOMIC_ACQUIRE, "agent");
            asm volatile("s_waitcnt vmcnt(0)" ::: "memory");
        }
    }
    __syncthreads();
}


__device__ __forceinline__ const void* karg(int k) {
    const __attribute__((address_space(4))) char* kp = (const __attribute__((address_space(4))) char*)__builtin_amdgcn_kernarg_segment_ptr();
    asm volatile("" : "+s"(kp));
    return *(const void* const __attribute__((address_space(4)))*)(kp + 8 * k);
}
#define LANE_IDS() int tid_ = threadIdx.x; asm volatile("" : "+v"(tid_)); const int tid = tid_, lane = tid & 63, wave = __builtin_amdgcn_readfirstlane(tid >> 6); (void)tid; (void)lane; (void)wave
struct Frame {
    LAS unsigned char* lds;
    volatile LAS unsigned* MISC;
    gu32* ctl;
    int vcu, G;
    float* out; unsigned char* wsb;
};
#define SWZ_XOR(v, m) __uint_as_float((unsigned)__builtin_amdgcn_ds_swizzle((int)__float_as_uint(v), (((m) << 10) | 0x1f)))
__device__ __forceinline__ float xor32(float v) { auto rr = __builtin_amdgcn_permlane32_swap(__float_as_uint(v), __float_as_uint(v), false, false); return __uint_as_float((threadIdx.x & 32) ? rr[0] : rr[1]); }
__device__ __forceinline__ float xor1(float v) { return __uint_as_float((unsigned)__builtin_amdgcn_update_dpp(0, (int)__float_as_uint(v), 0xB1, 0xF, 0xF, true)); }
__device__ __forceinline__ float wave_sum(float v) {
    v += SWZ_XOR(v, 1); v += SWZ_XOR(v, 2); v += SWZ_XOR(v, 4); v += SWZ_XOR(v, 8); v += SWZ_XOR(v, 16);
    auto rr = __builtin_amdgcn_permlane32_swap(__float_as_uint(v), __float_as_uint(v), false, false);
    return __uint_as_float(rr[0]) + __uint_as_float(rr[1]);
}
__device__ __forceinline__ float dot4(const f32x4 a) { return (a.x * a.x + a.y * a.y) + (a.z * a.z + a.w * a.w); }

template <int KIND> __device__ __forceinline__ int dest_row(int n) {
    if constexpr (KIND == 0) return n;
    else if constexpr (KIND == 3) return n < 544 ? n : n + 96;
    else if constexpr (KIND == 4) { const int v = n >= FF, c = v ? n - FF : n; return 256 * (c >> 7) + 128 * v + (c & 127); }
    else if constexpr (KIND == 1) {
        const int h = n / 192, d = n - h * 192;
        if (d < 128) return h * 128 + d;
        const int i = d - 128, t = h >> 2, hh = h & 3;
        return 2048 + 256 * t + 32 * hh + (i < 32 ? i : 128 + (i - 32));
    } else {
        const int g = n / 6144, r = n - g * 6144, t = r >> 11, r2 = r & 2047, h = r2 >> 7, d = r2 & 127;
        if (t == 2) return n;
        const int T = h >> 1, hh = h & 1;
        const int tc = d < 16 ? 16 * hh + d : (d < 32 ? 128 + 16 * hh + (d - 16) : hh * 128 + d);
        return g * 6144 + t * 2048 + T * 256 + tc;
    }
}
template <int KIND, bool GAIN> __device__ __forceinline__ void p0_transpose_item(const float* W, const float* gain, int K, int N, bf16* WT, int row_off, LAS float* scr, int item, int lane) {
    const int nblk = N / 32, kb = item / nblk, nb = item - kb * nblk, k0 = 64 * kb, n0 = 32 * nb;
#pragma unroll 8
    for (int i = 0; i < 32; ++i) { const int kk = 2 * i + (lane >> 5); scr[kk * 33 + (lane & 31)] = __builtin_nontemporal_load((const GAS float*)(W + (size_t)(k0 + kk) * N + n0 + (lane & 31))); }
    LDS_WAIT(); asm volatile("" ::: "memory");
    const int c = lane & 7;
    f32x4 g0 = {1.f, 1.f, 1.f, 1.f}, g1 = g0;
    if constexpr (GAIN) { g0 = *(const f32x4*)(gain + k0 + 8 * c); g1 = *(const f32x4*)(gain + k0 + 8 * c + 4); }
#pragma unroll
    for (int j = 0; j < 4; ++j) { const int n = (lane >> 3) + 8 * j; const LAS float* s = scr + (8 * c) * 33 + n;
        v4u o; o.x = pk2(s[0 * 33] * g0.x, s[1 * 33] * g0.y); o.y = pk2(s[2 * 33] * g0.z, s[3 * 33] * g0.w); o.z = pk2(s[4 * 33] * g1.x, s[5 * 33] * g1.y); o.w = pk2(s[6 * 33] * g1.z, s[7 * 33] * g1.w);
        *(GAS v4u*)(WT + (size_t)(row_off + dest_row<KIND>(n0 + n)) * K + k0 + 8 * c) = o; }
    LDS_WAIT(); asm volatile("" ::: "memory");
}
__device__ const double kRopeRev[32] = {
    0.15915494309189535, 0.10561541722123227, 0.0700865215877985, 0.046509502471476706, 0.03086376340470123, 0.020481231595318977, 0.013591370636193905, 0.009019250376164549,
    0.005985185712713705, 0.00397177664679776, 0.002635675898667414, 0.001749037788521446, 0.001160663641240061, 0.0007702178288757531, 0.0005111175045375439, 0.00033917820861925017,
    0.00022507907903927653, 0.00014936275542995963, 9.911730936901935e-05, 6.577436917438735e-05, 4.364795279280289e-05, 2.8964835496204437e-05, 1.9221100684944863e-05, 1.2755146204410543e-05,
    8.464330808241401e-06, 5.616940400618127e-06, 3.727408601915352e-06, 2.473512961630074e-06, 1.6414262627950345e-06, 1.0892524995776498e-06, 7.228293068832865e-07, 4.796704226907546e-07};

__device__ __forceinline__ void norm_rows_bf16(Frame& F, const float* src, const float* gain, bf16* dst) {
    LANE_IDS();
    const int gw = F.vcu * NWAVES + wave, NGW = F.G * NWAVES;
    f32x4 g[8];
#pragma unroll
    for (int j = 0; j < 8; ++j) g[j] = *(const f32x4*)(gain + 4 * lane + 256 * j);
    for (int m = gw; m < M; m += NGW) {
        const GAS f32x4* xr = (const GAS f32x4*)(src + (size_t)m * DM) + lane;
        f32x4 v[8]; float s = 0.f;
#pragma unroll
        for (int j = 0; j < 8; ++j) { v[j] = xr[64 * j]; s += dot4(v[j]); }
        const float r = 1.0f / sqrtf(wave_sum(s) * (1.0f / DM) + EPS);
        GAS v2u* o8 = (GAS v2u*)(dst + (size_t)m * DM) + lane;
#pragma unroll
        for (int j = 0; j < 8; ++j) { const f32x4 y = (v[j] * r) * g[j]; v2u w; w.x = pk2(y.x, y.y); w.y = pk2(y.z, y.w); o8[64 * j] = w; }
    }
}
__device__ __forceinline__ void norm_rows_bf16_to_f32(Frame& F, const bf16* X, const float* gain, float* out) {
    LANE_IDS();
    const int gw = F.vcu * NWAVES + wave, NGW = F.G * NWAVES;
    f32x4 g[8];
#pragma unroll
    for (int j = 0; j < 4; ++j) { g[2 * j] = *(const GAS f32x4*)(gain + 8 * lane + 512 * j); g[2 * j + 1] = *(const GAS f32x4*)(gain + 8 * lane + 512 * j + 4); }
    for (int m = gw; m < M; m += NGW) {
        const GAS v4u* xr = (const GAS v4u*)(X + (size_t)m * DM + 8 * lane);
        f32x4 v[8]; float s = 0.f;
#pragma unroll
        for (int j = 0; j < 4; ++j) { const v4u w = xr[64 * j];
            v[2 * j] = (f32x4){bf_lo(w.x), bf_hi(w.x), bf_lo(w.y), bf_hi(w.y)}; v[2 * j + 1] = (f32x4){bf_lo(w.z), bf_hi(w.z), bf_lo(w.w), bf_hi(w.w)};
            s += dot4(v[2 * j]) + dot4(v[2 * j + 1]); }
        const float r = 1.0f / sqrtf(wave_sum(s) * (1.0f / DM) + EPS);
        GAS f32x4* o = (GAS f32x4*)(out + (size_t)m * DM + 8 * lane);
#pragma unroll
        for (int j = 0; j < 4; ++j) { o[128 * j] = (v[2 * j] * r) * g[2 * j]; o[128 * j + 1] = (v[2 * j + 1] * r) * g[2 * j + 1]; }
    }
}
__device__ __forceinline__ void norm_rows_f32_inplace(Frame& F, float* x, const float* gain) {
    LANE_IDS();
    const int gw = F.vcu * NWAVES + wave, NGW = F.G * NWAVES;
    f32x4 g[8];
#pragma unroll
    for (int j = 0; j < 8; ++j) g[j] = *(const f32x4*)(gain + 4 * lane + 256 * j);
    for (int m = gw; m < M; m += NGW) {
        GAS f32x4* xr = (GAS f32x4*)(x + (size_t)m * DM) + lane;
        f32x4 v[8]; float s = 0.f;
#pragma unroll
        for (int j = 0; j < 8; ++j) { v[j] = xr[64 * j]; s += dot4(v[j]); }
        const float r = 1.0f / sqrtf(wave_sum(s) * (1.0f / DM) + EPS);
#pragma unroll
        for (int j = 0; j < 8; ++j) xr[64 * j] = (v[j] * r) * g[j];
    }
}

__device__ __forceinline__ void p0_prologue(Frame& F) {
    LANE_IDS();
    LAS float* scr = (LAS float*)(F.lds + RING_OFF + wave * 16384);
    const int gw = F.vcu * NWAVES + wave, NGW = F.G * NWAVES;
    unsigned char* ws = F.wsb;
    constexpr int I0 = 32 * 16, I1 = 32 * 18, I2 = 8 * 96, I3 = 8 * 128, I4 = 32 * 64, I5 = 32 * 576, I6 = 32 * 64, I7 = 32 * 352, I8 = 88 * 64;
    constexpr int NITEMS = 2 * (I0 + I1 + I2 + I3 + I4 + I5 + I6) + 4 * (I7 + I8);
    for (int it = gw; it < NITEMS; it += NGW) {
        int r = it;
        if (r < 2 * I5) { const int l = r / I5; p0_transpose_item<2, true>((const float*)karg(12) + (size_t)l * DM * NDIL, (const float*)karg(2) + (2 * l + 1) * DM, DM, NDIL, (bf16*)(ws + WS_WDIL + l * WDIL_STRIDE + WDIL_IN), 0, scr, r - l * I5, lane); continue; } r -= 2 * I5;
        if (r < 4 * I7) { const int l = r / I7; p0_transpose_item<4, true>((const float*)karg(14) + (size_t)l * DM * NUP, (const float*)karg(3) + l * DM, DM, NUP, (bf16*)(ws + WS_WFFN + l * WFFN_STRIDE + WFFN_UP), 0, scr, r - l * I7, lane); continue; } r -= 4 * I7;
        if (r < 4 * I8) { const int l = r / I8; p0_transpose_item<0, false>((const float*)karg(17) + (size_t)l * FF * DM, nullptr, FF, DM, (bf16*)(ws + WS_WFFN + l * WFFN_STRIDE + WFFN_DOWN), 0, scr, r - l * I8, lane); continue; } r -= 4 * I8;
        if (r < 2 * I6) { const int l = r / I6; p0_transpose_item<0, false>((const float*)karg(13) + (size_t)l * DM * DM, nullptr, DM, DM, (bf16*)(ws + WS_WDIL + l * WDIL_STRIDE + WDIL_WO), 0, scr, r - l * I6, lane); continue; } r -= 2 * I6;
        if (r < 2 * I4) { const int l = r / I4; p0_transpose_item<0, false>((const float*)karg(11) + (size_t)l * DM * DM, nullptr, DM, DM, (bf16*)(ws + WS_WMLA + l * WMLA_STRIDE + WMLA_WO), 0, scr, r - l * I4, lane); continue; } r -= 2 * I4;
        if (r < 2 * I3) { const int l = r / I3; p0_transpose_item<0, true>((const float*)karg(10) + (size_t)l * 512 * NKVB, (const float*)karg(9) + l * 512, 512, NKVB, (bf16*)(ws + WS_WMLA + l * WMLA_STRIDE + WMLA_KVB), 0, scr, r - l * I3, lane); continue; } r -= 2 * I3;
        if (r < 2 * I2) { const int l = r / I2; p0_transpose_item<1, true>((const float*)karg(7) + (size_t)l * 512 * NQB, (const float*)karg(6) + l * 512, 512, NQB, (bf16*)(ws + WS_WMLA + l * WMLA_STRIDE + WMLA_QB), 0, scr, r - l * I2, lane); continue; } r -= 2 * I2;
        if (r < 2 * I1) { const int l = r / I1; p0_transpose_item<3, true>((const float*)karg(8) + (size_t)l * DM * 576, (const float*)karg(2) + (2 * l) * DM, DM, 576, (bf16*)(ws + WS_WMLA + l * WMLA_STRIDE + WMLA_QKVA), 512, scr, r - l * I1, lane); continue; } r -= 2 * I1;
        { const int l = r / I0; p0_transpose_item<0, true>((const float*)karg(5) + (size_t)l * DM * 512, (const float*)karg(2) + (2 * l) * DM, DM, 512, (bf16*)(ws + WS_WMLA + l * WMLA_STRIDE + WMLA_QKVA), 0, scr, r - l * I0, lane); }
    }
    const int gt = F.vcu * (NWAVES * 64) + tid, NGT = F.G * NWAVES * 64;
    for (int i = gt; i < 2 * 192 * DM / 8; i += NGT) { const int l = i / (192 * DM / 8), e = i - l * (192 * DM / 8), rr = e / (DM / 8), cc = e - rr * (DM / 8), row = rr < 96 ? 1056 + rr : 1184 + (rr - 96);
        *((GAS v4u*)(ws + WS_WMLA + l * WMLA_STRIDE + WMLA_QKVA + (size_t)row * DM * 2) + cc) = (v4u){0u, 0u, 0u, 0u}; }
    { const float* cw = (const float*)karg(15); const float* cb = (const float*)karg(16); float* cws = (float*)(ws + WS_CWS);
      for (int i = gt; i < 4 * 4 * NUP; i += NGT) { const int l = i / (4 * NUP), r = i - l * 4 * NUP, t = r / NUP, ch = r - t * NUP;
          cws[i] = (t < 3 ? cw[((size_t)l * 3 + t) * NUP + ch] : cb[(size_t)l * NUP + ch]) * (ch < FF ? 1.4426950408889634f : 0.6931471805599453f); } }
    const int* pos = (const int*)karg(1);
    for (int i = gt; i < M * 32; i += NGT) { const int row = i >> 5, k = i & 31;
        const double rev = (double)pos[row] * kRopeRev[k]; const float fr = (float)(rev - __builtin_rint(rev));
        const float c = __builtin_amdgcn_cosf(fr), s = __builtin_amdgcn_sinf(fr);
        ((float*)(ws + WS_COSM))[i] = c; ((float*)(ws + WS_SINM))[i] = s;
        if ((k & 1) == 0) { ((float*)(ws + WS_COSD))[row * 16 + (k >> 1)] = c; ((float*)(ws + WS_SIND))[row * 16 + (k >> 1)] = s; } }
    { const int gwv = F.vcu * NWAVES + wave, NGWv = F.G * NWAVES; const float* x = (const float*)karg(0); bf16* XB = (bf16*)(ws + WS_H); float* ps0 = (float*)(ws + WS_PS);
      for (int m = gwv; m < M; m += NGWv) {
        const GAS f32x4* xr = (const GAS f32x4*)(x + (size_t)m * DM) + lane; f32x4 v[8]; float s = 0.f;
#pragma unroll
        for (int j = 0; j < 8; ++j) { v[j] = xr[64 * j]; s += dot4(v[j]); }
        s = wave_sum(s);
        GAS v2u* o8 = (GAS v2u*)(XB + (size_t)m * DM) + lane;
#pragma unroll
        for (int j = 0; j < 8; ++j) { v2u w; w.x = pk2(v[j].x, v[j].y); w.y = pk2(v[j].z, v[j].w); o8[64 * j] = w; }
        if (lane < 32) ps0[(size_t)m * 32 + lane] = lane == 0 ? s : 0.f; } }
}

__device__ __forceinline__ void dil_merge(Frame& F, int row_first) {
    LANE_IDS();
    unsigned char* ws = F.wsb;
    const bf16* OG = (const bf16*)(ws + WS_S + S_OG); const GAS float* LSE = (const GAS float*)(ws + WS_S + S_LSE); bf16* AO = (bf16*)(ws + WS_S + S_AO_DIL);
    for (int m = row_first + wave; m < row_first + 64; m += NWAVES) {
        const int b = m >> 12, s = m & (SEQ - 1);
        const size_t sp0 = s, sp1 = (size_t)(s & 3) * (SEQ / 4) + (s >> 2), sp2 = (size_t)(s & 15) * (SEQ / 16) + (s >> 4);
#pragma unroll
        for (int j = 0; j < 4; ++j) { const int col = 8 * lane + 512 * j, head = col >> 7, dim = col & 127;
            const size_t r0 = ((size_t)(0 * 16 + head) * BATCH + b) * SEQ + sp0, r1 = ((size_t)(1 * 16 + head) * BATCH + b) * SEQ + sp1, r2 = ((size_t)(2 * 16 + head) * BATCH + b) * SEQ + sp2;
            const float l0 = LSE[r0], l1 = LSE[r1], l2 = LSE[r2];
            const float mx = fmaxf(l0, fmaxf(l1, l2)); float e0 = __expf(l0 - mx), e1 = __expf(l1 - mx), e2 = __expf(l2 - mx);
            const float inv = 1.0f / (e0 + e1 + e2); e0 *= inv; e1 *= inv; e2 *= inv;
            const v4u a = *(const GAS v4u*)(OG + r0 * 128 + dim), bb = *(const GAS v4u*)(OG + r1 * 128 + dim), c = *(const GAS v4u*)(OG + r2 * 128 + dim);
            v4u w;
#pragma unroll
            for (int q = 0; q < 4; ++q) w[q] = pk2(e0 * bf_lo(a[q]) + e1 * bf_lo(bb[q]) + e2 * bf_lo(c[q]), e0 * bf_hi(a[q]) + e1 * bf_hi(bb[q]) + e2 * bf_hi(c[q]));
            *(GAS v4u*)(AO + (size_t)m * DM + col) = w; }
    }
}

__device__ __forceinline__ void panel_barrier(Frame& F, gu32* word, bool same_xcd) {
    asm volatile("s_waitcnt vmcnt(0)" ::: "memory");
    __syncthreads();
    if (threadIdx.x == 0) {
        if (!same_xcd) { __builtin_amdgcn_fence(__ATOMIC_RELEASE, "agent"); asm volatile("s_waitcnt vmcnt(0)" ::: "memory"); }
        (void)__hip_atomic_fetch_add((unsigned*)word, 1u, __ATOMIC_RELAXED, __HIP_MEMORY_SCOPE_AGENT);
        unsigned sp = 0u;
        while (__hip_atomic_load((unsigned*)word, __ATOMIC_RELAXED, __HIP_MEMORY_SCOPE_AGENT) < 4u) { __builtin_amdgcn_s_sleep(1); if (++sp > (1u << 22)) break; }
        __builtin_amdgcn_fence(__ATOMIC_ACQUIRE, "agent");
        asm volatile("s_waitcnt vmcnt(0)" ::: "memory");
    }
    __syncthreads();
}

__device__ __forceinline__ void ffn_fixup(Frame& F, int layer, int pm) {
    LANE_IDS();
    if ((pm & 15) == 0) return;
    unsigned char* ws = F.wsb;
    const float* HALO = (const float*)(ws + WS_HALO); const float* FIX = (const float*)(ws + WS_FIX); bf16* ACT = (bf16*)(ws + WS_S + S_ACT);
    const float* cw = (const float*)karg(15) + (size_t)layer * 3 * NUP;
    for (int idx = tid; idx < 2 * (FF / 8); idx += NWAVES * 64) { const int rs = idx / (FF / 8), ch = (idx - rs * (FF / 8)) * 8;
        float o[8];
#pragma unroll
        for (int e = 0; e < 8; e += 4) {
            f32x4 cg = *(const GAS f32x4*)(FIX + ((size_t)pm * 2 + rs) * NUP + ch + e), cv = *(const GAS f32x4*)(FIX + ((size_t)pm * 2 + rs) * NUP + FF + ch + e);
            const f32x4 u1g = *(const GAS f32x4*)(HALO + ((size_t)(pm - 1) * 2 + 1) * NUP + ch + e), u1v = *(const GAS f32x4*)(HALO + ((size_t)(pm - 1) * 2 + 1) * NUP + FF + ch + e);
            const f32x4 u2g = *(const GAS f32x4*)(HALO + ((size_t)(pm - 1) * 2 + 0) * NUP + ch + e), u2v = *(const GAS f32x4*)(HALO + ((size_t)(pm - 1) * 2 + 0) * NUP + FF + ch + e);
            const f32x4 w0g = *(const f32x4*)(cw + ch + e), w0v = *(const f32x4*)(cw + FF + ch + e), w1g = *(const f32x4*)(cw + NUP + ch + e), w1v = *(const f32x4*)(cw + NUP + FF + ch + e);
            if (rs == 0) { cg = cg + w1g * u1g + w0g * u2g; cv = cv + w1v * u1v + w0v * u2v; } else { cg = cg + w0g * u1g; cv = cv + w0v * u1v; }
#pragma unroll
            for (int k = 0; k < 4; ++k) o[e + k] = cg[k] * __builtin_amdgcn_rcpf(1.0f + __builtin_amdgcn_exp2f(-1.4426950408889634f * cg[k])) * cv[k]; }
        v4u w; w.x = pk2(o[0], o[1]); w.y = pk2(o[2], o[3]); w.z = pk2(o[4], o[5]); w.w = pk2(o[6], o[7]);
        *(GAS v4u*)(ACT + ((size_t)pm * 256 + rs) * FF + ch) = w; }
}

__device__ __forceinline__ void row_scale_table(Frame& F, const float* ps, int pm) {
    LANE_IDS();
    LAS float* rsl = (LAS float*)(F.lds + RSL_OFF);
    if (tid < 256) { const GAS f32x4* p = (const GAS f32x4*)(ps + ((size_t)pm * 256 + tid) * 32); float s = 0.f;
#pragma unroll
        for (int i = 0; i < 8; ++i) { const f32x4 a = p[i]; s += (a.x + a.y) + (a.z + a.w); }
        rsl[tid] = __builtin_amdgcn_rsqf(s * (1.0f / DM) + EPS); }
    __syncthreads();
}

__device__ __forceinline__ void row_scale_table2(Frame& F, const float* pq, int pm) {
    LANE_IDS();
    LAS float* rsq = (LAS float*)(F.lds + RSQ_OFF);
    if (tid < 256) { const GAS f32x4* p = (const GAS f32x4*)(pq + ((size_t)pm * 256 + tid) * 16);
        const f32x4 a = p[0], b = p[1], c = p[2], d = p[3];
        rsq[tid] = __builtin_amdgcn_rsqf((((a.x + a.y) + (a.z + a.w)) + ((b.x + b.y) + (b.z + b.w))) * (1.0f / 512) + EPS);
        rsq[256 + tid] = __builtin_amdgcn_rsqf((((c.x + c.y) + (c.z + c.w)) + ((d.x + d.y) + (d.z + d.w))) * (1.0f / 512) + EPS); }
    __syncthreads();
}

struct MlaRef {
    const bf16* Q; const bf16* KV; const bf16* KPE; bf16* AO; int vcu;
    __device__ __forceinline__ att::BlockRef operator()(int i) const {
        const int I = vcu + 256 * (i >> 1), bh = I >> 3, x = I & 7, qb = (i & 1) ? 15 - x : x, b = bh >> 4, h = bh & 15;
        const size_t row0 = (size_t)b * SEQ + (size_t)qb * 256;
        att::BlockRef r; r.Q = Q + row0 * NQB + h * 128; r.Qpe = Q + row0 * NQB + 2048 + h * 64;
        r.K = KV + (size_t)bh * SEQ * 128; r.V = r.K + (size_t)M * DM; r.Kpe = KPE + (size_t)b * SEQ * 64;
        r.O = AO + row0 * DM + h * 128; r.Lse = nullptr; r.P0 = qb * 256; return r;
    }
};
struct DilRef {
    const bf16* QKV; bf16* OG; float* LSE; int vcu, g;
    __device__ __forceinline__ att::BlockRef operator()(int i) const {
        const int I = vcu + 256 * i, sh = 2 * g, d = 1 << sh, nqbs = 4 - sh;
        const int seq = I >> nqbs, qb = (I + ((i << nqbs) >> 2)) & ((1 << nqbs) - 1), h = seq & 15, br = seq >> 4, rr = br & (d - 1), b = br >> sh;
        const size_t sp0 = (size_t)rr * (SEQ >> sh), spq = sp0 + (size_t)qb * 256;
        const size_t hb = ((size_t)(g * 3) * 16 + h) * BATCH + b, tstep = (size_t)16 * BATCH * SEQ * 128;
        att::BlockRef r; r.Q = QKV + (hb * SEQ + spq) * 128; r.Qpe = nullptr; r.Kpe = nullptr;
        r.K = QKV + tstep + (hb * SEQ + sp0) * 128; r.V = r.K + tstep;
        const size_t ob = ((size_t)g * 16 + h) * BATCH + b;
        r.O = OG + (ob * SEQ + spq) * 128; r.Lse = LSE + ob * SEQ + spq; r.P0 = qb * 256; return r;
    }
};
template <bool PE, bool SK, bool LSE, bool EARLY, class RefFn>
__device__ __forceinline__ void attn_run(char* lds, const att::Prm& P, int n, const RefFn& ref) {
    att::BlockRef cur = ref(0); att::Seam<PE> S;
    att::swa_prime<PE>(cur, P, lds, S);
    for (int i = 0;; ++i) {
        const bool last = i + 1 >= n;
        const att::BlockRef nxt = last ? cur : ref(i + 1);
        att::swa_block<PE, SK, LSE, EARLY>(cur, nxt, P, lds, S);
        if (last) break;
        cur = nxt;
    }
}

struct Args { const void* in[18]; float* out; unsigned char* ws; };
__global__ void __launch_bounds__(NWAVES * 64, 2) fwd_kernel(Args args) {
    extern __shared__ __attribute__((aligned(16))) unsigned char lds[];
    Frame F;
    F.lds = (LAS unsigned char*)lds;
    F.MISC = (volatile LAS unsigned*)(F.lds + MISC_OFF);
    F.G = gridDim.x; { const int bx = blockIdx.x; F.vcu = (F.G % 8 == 0) ? (bx % 8) * (F.G / 8) + bx / 8 : bx; }
        F.out = args.out; F.wsb = args.ws;
    F.ctl = (gu32*)(args.ws + WS_CTL);
#define ws F.wsb
#define RELAUNDER() asm volatile("" : "+s"(F.vcu), "+s"(F.wsb), "+s"(F.out))
    for (int u = threadIdx.x; u < (LDS_BYTES - LDSCTL_OFF) / 4; u += NWAVES * 64) ((LAS unsigned*)(F.lds + LDSCTL_OFF))[u] = 0u;
    __syncthreads();
    XcdBarrier bar = xcd_barrier_post((unsigned*)(F.ctl + CW_BAR), F.MISC + 8);
#define GRID_BAR() xcd_barrier(bar)
    typedef pg8::StaticOrder SO;
#define GEMMR(EpiT, Aptr, Bptr, N_, K_, Eobj, REP_) do { pg8::Gemm g_{(const bf16*)(Aptr), (const bf16*)(Bptr), M, (N_), (K_)}; SO S_; S_.init(M, (N_), F.G, (int)blockIdx.x); \
        pg8::gemm_phase<EpiT, SO, true, true, REP_>(F.lds + RING_OFF, g_, S_, (Eobj)); } while (0)
#define GEMM(EpiT, Aptr, Bptr, N_, K_, Eobj) GEMMR(EpiT, Aptr, Bptr, N_, K_, Eobj, 1)

    bf16* H = (bf16*)(ws + WS_H);
    const float* cosM = (const float*)(ws + WS_COSM); const float* sinM = (const float*)(ws + WS_SINM);
    const float* cosD = (const float*)(ws + WS_COSD); const float* sinD = (const float*)(ws + WS_SIND);

    if (threadIdx.x == 0) (void)__hip_atomic_fetch_or((unsigned*)(F.ctl + CW_PX + (8 * ((int)blockIdx.x & 7) + (((int)blockIdx.x >> 3) & 7))), 1u << bar.x, __ATOMIC_RELAXED, __HIP_MEMORY_SCOPE_AGENT);
    p0_prologue(F);
    GRID_BAR();
    const bool panel_same_xcd = __builtin_popcount(__hip_atomic_load((unsigned*)(F.ctl + CW_PX + (8 * ((int)blockIdx.x & 7) + (((int)blockIdx.x >> 3) & 7))), __ATOMIC_RELAXED, __HIP_MEMORY_SCOPE_AGENT)) == 1;

#define PSP(i) ((float*)(ws + WS_PS + (size_t)(i) * PS_STRIDE))
    const PG8_LAS float* rsl = (const PG8_LAS float*)(F.lds + RSL_OFF);
    const int my_pm = 8 * ((int)blockIdx.x & 7) + (((int)blockIdx.x >> 3) & 7);
    for (int j = 0; j < 2; ++j) {
        {
            RELAUNDER();
            const unsigned char* wl = ws + WS_WMLA + j * WMLA_STRIDE;
            float* PQ = (float*)(ws + WS_S + S_PQ); bf16* QN = (bf16*)(ws + WS_S + S_QN); bf16* CK = (bf16*)(ws + WS_S + S_CKVN); bf16* KPE = (bf16*)(ws + WS_S + S_KPE);
            bf16* Q = (bf16*)(ws + WS_S + S_Q); bf16* KV = (bf16*)(ws + WS_S + S_KV); bf16* AO = (bf16*)(ws + WS_S + S_AO_MLA);
            row_scale_table(F, PSP(4 * j), my_pm);
            { pg8::EpiQaCkv E{QN, CK, PQ, rsl}; GEMM(pg8::EpiQaCkv, H, wl + WMLA_QKVA, 1024, DM, E); }
            GRID_BAR();
            row_scale_table2(F, PQ, my_pm);
            { const int slot = (int)blockIdx.x >> 6; const PG8_LAS float* rsq = (const PG8_LAS float*)(F.lds + RSQ_OFF);
              if (slot == 0) { pg8::Gemm g_{(const bf16*)H, (const bf16*)(wl + WMLA_QKVA), M, NQKVA, DM}; pg8::OneUnit S_{my_pm, 4}; pg8::EpiKpe E{KPE, cosM, sinM, rsl};
                  pg8::gemm_phase<pg8::EpiKpe, pg8::OneUnit, true, true>(F.lds + RING_OFF, g_, S_, E); }
              if (slot < 2) { pg8::Gemm g_{(const bf16*)QN, (const bf16*)(wl + WMLA_QB), M, NQB, 512}; pg8::PanelUnits S_{my_pm, slot ? 4 : 0, slot ? 8 : 4}; pg8::EpiQMla E{Q, cosM, sinM, rsq};
                  pg8::gemm_phase<pg8::EpiQMla, pg8::PanelUnits, false, true>(F.lds + RING_OFF, g_, S_, E); }
              else { pg8::Gemm g_{(const bf16*)CK, (const bf16*)(wl + WMLA_KVB), M, NKVB, 512}; pg8::PanelUnits S_{my_pm, 8 * (slot - 2), 8}; pg8::EpiKvMla E{KV, KV + (size_t)M * DM, rsq + 256};
                  pg8::gemm_phase<pg8::EpiKvMla, pg8::PanelUnits, false, true>(F.lds + RING_OFF, g_, S_, E); }
            }
            GRID_BAR();
            RELAUNDER();
            { att::Prm P{NQB, 128, DM, NQB, 64, 0, SEQ, SEQ, 0.07216878364870322f};
              MlaRef R{Q, KV, KPE, AO, F.vcu};
              attn_run<true, false, false, false>((char*)lds + RING_OFF, P, 4, R);
            }
            GRID_BAR();
            { pg8::EpiResB<false> E{nullptr, H, PSP(1 + 4 * j), DM}; GEMM(pg8::EpiResB<false>, AO, wl + WMLA_WO, DM, DM, E); }
            GRID_BAR();
        }
        {
            RELAUNDER();
            const int layer = 2 * j; const unsigned char* wl = ws + WS_WFFN + layer * WFFN_STRIDE;
            bf16* ACT = (bf16*)(ws + WS_S + S_ACT);
            row_scale_table(F, PSP(1 + 4 * j), my_pm);
            { pg8::EpiUpConv E{ACT, (float*)(ws + WS_HALO), (float*)(ws + WS_FIX), (const float*)(ws + WS_CWS) + (size_t)layer * 4 * NUP,
                               (PG8_LAS float*)(F.lds + XH_OFF), (PG8_LAS float*)(F.lds + CWL_OFF), rsl};
              { LANE_IDS(); if (wave < 4) pg8::EpiUpConv::w_dma(E.cws, (int)blockIdx.x >> 6, E.cwl, wave, lane); }
              GEMM(pg8::EpiUpConv, H, wl + WFFN_UP, NUP, DM, E);
            }
            GRID_BAR();
            { SO S_; S_.init(M, DM, F.G, (int)blockIdx.x); pg8::Unit u_; for (int i = 0; S_.next(i, u_); ++i) ffn_fixup(F, layer, u_.pm);
              asm volatile("s_waitcnt vmcnt(0)" ::: "memory"); __syncthreads(); }
            { pg8::EpiResB<false> E{nullptr, H, PSP(2 + 4 * j), DM}; GEMM(pg8::EpiResB<false>, ACT, wl + WFFN_DOWN, DM, FF, E); }
            GRID_BAR();
        }
        {
            RELAUNDER();
            const unsigned char* wl = ws + WS_WDIL + j * WDIL_STRIDE;
            bf16* QKV = (bf16*)(ws + WS_S + S_QKV); bf16* OG = (bf16*)(ws + WS_S + S_OG); float* LSE = (float*)(ws + WS_S + S_LSE); bf16* AO = (bf16*)(ws + WS_S + S_AO_DIL);
            row_scale_table(F, PSP(2 + 4 * j), my_pm);
            { pg8::EpiQkvDil E{QKV, cosD, sinD, rsl}; GEMM(pg8::EpiQkvDil, H, wl + WDIL_IN, NDIL, DM, E); }
            GRID_BAR();
#pragma unroll 1
            for (int g = 0; g < 3; ++g) { const int d = 1 << (2 * g);
              att::Prm P{128, 128, 128, 0, 0, 1, SEQ / d, 129, 0.08838834764831845f};
              DilRef R{QKV, OG, LSE, F.vcu, g};
              attn_run<false, true, true, true>((char*)lds + RING_OFF, P, 4, R);
            }
            GRID_BAR();
            dil_merge(F, my_pm * 256 + ((int)blockIdx.x >> 6) * 64);
            panel_barrier(F, F.ctl + CW_PB + j * 64 + my_pm, panel_same_xcd);
            { pg8::EpiResB<false> E{nullptr, H, PSP(3 + 4 * j), DM}; GEMM(pg8::EpiResB<false>, AO, wl + WDIL_WO, DM, DM, E); }
            GRID_BAR();
        }
        {
            RELAUNDER();
            const int layer = 2 * j + 1; const unsigned char* wl = ws + WS_WFFN + layer * WFFN_STRIDE;
            bf16* ACT = (bf16*)(ws + WS_S + S_ACT);
            row_scale_table(F, PSP(3 + 4 * j), my_pm);
            { pg8::EpiUpConv E{ACT, (float*)(ws + WS_HALO), (float*)(ws + WS_FIX), (const float*)(ws + WS_CWS) + (size_t)layer * 4 * NUP,
                               (PG8_LAS float*)(F.lds + XH_OFF), (PG8_LAS float*)(F.lds + CWL_OFF), rsl};
              { LANE_IDS(); if (wave < 4) pg8::EpiUpConv::w_dma(E.cws, (int)blockIdx.x >> 6, E.cwl, wave, lane); }
              GEMM(pg8::EpiUpConv, H, wl + WFFN_UP, NUP, DM, E);
            }
            GRID_BAR();
            { SO S_; S_.init(M, DM, F.G, (int)blockIdx.x); pg8::Unit u_; for (int i = 0; S_.next(i, u_); ++i) ffn_fixup(F, layer, u_.pm);
              asm volatile("s_waitcnt vmcnt(0)" ::: "memory"); __syncthreads(); }
            if (j == 0) { pg8::EpiResB<false> E{nullptr, H, PSP(4), DM}; GEMM(pg8::EpiResB<false>, ACT, wl + WFFN_DOWN, DM, FF, E); }
            else { pg8::EpiResB<false> E{nullptr, H, PSP(0), DM}; GEMM(pg8::EpiResB<false>, ACT, wl + WFFN_DOWN, DM, FF, E); }
            GRID_BAR();
        }
    }
    RELAUNDER();
    norm_rows_bf16_to_f32(F, H, (const float*)karg(4), F.out);
#undef PSP
#undef ws
#undef RELAUNDER
#undef GEMM
#undef GEMMR
#undef GRID_BAR
}

extern "C" void kernel_launch(void* const* d_in, const int* in_sizes, int n_in, void* d_out, int out_size, void* d_ws, size_t ws_size, hipStream_t stream) {
    static int grid = 0;
    if (grid == 0) {
        if (n_in != 18 || in_sizes[0] != M * DM || out_size != M * DM || ws_size < WS_END) {
            fprintf(stderr, "kernel_launch: shape / workspace mismatch (n_in %d, in0 %d, out %d, ws %zu, need %zu); nothing launched\n", n_in, n_in > 0 ? in_sizes[0] : -1, out_size, ws_size, (size_t)WS_END); grid = -1; return; }
        int dev = 0, cus = 0, per_cu = 0;
        if (hipGetDevice(&dev) != hipSuccess || hipDeviceGetAttribute(&cus, hipDeviceAttributeMultiprocessorCount, dev) != hipSuccess) { grid = -1; return; }
        if (hipFuncSetAttribute((const void*)fwd_kernel, hipFuncAttributeMaxDynamicSharedMemorySize, LDS_BYTES) != hipSuccess) { fprintf(stderr, "kernel_launch: hipFuncSetAttribute failed\n"); grid = -1; return; }
        if (hipOccupancyMaxActiveBlocksPerMultiprocessor(&per_cu, (const void*)fwd_kernel, NWAVES * 64, LDS_BYTES) != hipSuccess || per_cu < 1) fprintf(stderr, "kernel_launch: occupancy query reports %d\n", per_cu);
        (void)hipGetLastError();
        if (cus < 256) { fprintf(stderr, "kernel_launch: built for a 256-CU device, found %d CUs; nothing launched\n", cus); grid = -1; return; }
        grid = 256;
    }
    if (grid < 0) return;
    if (hipMemsetAsync((char*)d_ws + WS_CTL, 0, CTL_ZERO_BYTES, stream) != hipSuccess) return;
    Args a{};
    for (int i = 0; i < 18; ++i) a.in[i] = d_in[i];
    a.out = (float*)d_out; a.ws = (unsigned char*)d_ws;
    hipLaunchKernelGGL(fwd_kernel, dim3(grid), dim3(NWAVES * 64), LDS_BYTES, stream, a);
}
```

```cpp
#include <hip/hip_runtime.h>
#include <cstdio>
#include <cstdint>
namespace pg8 {
#define PG8_LAS __attribute__((address_space(3)))
typedef unsigned short bf16_t;
typedef short bf16x8 __attribute__((ext_vector_type(8)));
typedef float f32x4 __attribute__((ext_vector_type(4)));
typedef unsigned u32x4 __attribute__((ext_vector_type(4)));
constexpr int BM = 256, BK = 64, HALF = 128, HTB = HALF * BK * 2  , STAGE_BYTES = 8 * HTB, NXCD = 8, WGM = 8;

__host__ __device__ __forceinline__ int lds_byte(int r, int c) { const int st = (r >> 4) * 2 + (c >> 5), rr = r & 15, cc = c & 31, ob = rr * 64 + cc * 2; return st * 1024 + (ob ^ (((ob >> 9) & 1) << 5)); }
__host__ __device__ __forceinline__ void stage_rc(int b, int& R, int& C) { const int st = b / 1024, sb = b % 1024, swz = sb ^ (((sb >> 9) & 1) << 5); R = (st >> 1) * 16 + swz / 64; C = (st & 1) * 32 + (swz % 64) / 2; }
__host__ __device__ __forceinline__ int perm32(int rho) { const int n = rho >> 4, i = rho & 15; return 8 * (i >> 2) + 4 * n + (i & 3); }

struct Unit { int pm, pn; };
struct Gemm { const bf16_t* A; const bf16_t* Bt; int M, N, K; };

struct StaticOrder {
    int nM, nN, nwg, G, c;
    __host__ __device__ void init(int M, int N, int G_, int c_) { nM = M / BM; nN = N / BM; nwg = nM * nN; G = G_; c = c_; }
    __host__ __device__ __forceinline__ bool next(int i, Unit& u) const {
        const long L = (long)i * G + c; if (L >= nwg) return false;
        int wgid = (int)L; { const int q = nwg / NXCD, r = nwg % NXCD, xcd = wgid % NXCD, off = wgid / NXCD; wgid = (xcd < r ? xcd * (q + 1) : r * (q + 1) + (xcd - r) * q) + off; }
        const int nig = WGM * nN, gid = wgid / nig, fm = gid * WGM, gsz = (nM - fm) < WGM ? (nM - fm) : WGM;
        u.pm = fm + ((wgid % nig) % gsz); u.pn = (wgid % nig) / gsz; return true;
    }
    __device__ __forceinline__ void a_ready(const Unit&) const {}
    __device__ __forceinline__ void done(const Unit&) const {}
};

__device__ __forceinline__ unsigned cvt_pk_bf16(float lo, float hi) { unsigned r; asm volatile("v_cvt_pk_bf16_f32 %0, %1, %2" : "=v"(r) : "v"(lo), "v"(hi)); return r; }
typedef float f32x2 __attribute__((ext_vector_type(2)));
#define PG8_G __attribute__((address_space(1)))
typedef unsigned u32x2 __attribute__((ext_vector_type(2)));
__device__ __forceinline__ u32x4 pack8bf(const f32x4 a, const f32x4 b) { u32x4 w; w.x = cvt_pk_bf16(a[0], a[1]); w.y = cvt_pk_bf16(a[2], a[3]); w.z = cvt_pk_bf16(b[0], b[1]); w.w = cvt_pk_bf16(b[2], b[3]); return w; }
#define PG8_NOPRE struct Pre {}; __device__ __forceinline__ void pre_issue(Pre&, const Unit&, int, int) const {} __device__ __forceinline__ void pre_finish(Pre&, int, int) const {}
struct EpiF32Store {
    PG8_NOPRE
    static constexpr bool PERM = false, AFTER_DRAIN = false;
    float* C; int ldc;
    __device__ __forceinline__ void operator()(const f32x4 (&acc)[2][2][4][2], const Unit& u, int wr, int wc, int fr, int fq, int ui) const {
        const int row0 = u.pm * BM + wr * 64 + fr, col0 = u.pn * BM + wc * 32 + 4 * fq;
#pragma unroll
        for (int ai = 0; ai < 2; ++ai)
#pragma unroll
            for (int m = 0; m < 4; ++m) { float* rowp = C + (size_t)(row0 + ai * HALF + m * 16) * ldc + col0;
#pragma unroll
                for (int bj = 0; bj < 2; ++bj)
#pragma unroll
                    for (int n = 0; n < 2; ++n) *(PG8_G f32x4*)(rowp + bj * HALF + n * 16) = acc[ai][bj][m][n]; }
    }
};

__device__ __forceinline__ float sum_fq(float v) {
    v += __uint_as_float((unsigned)__builtin_amdgcn_ds_swizzle((int)__float_as_uint(v), ((0x10 << 10) | 0x1f)));
    auto rr = __builtin_amdgcn_permlane32_swap(__float_as_uint(v), __float_as_uint(v), false, false);
    return __uint_as_float(rr[0]) + __uint_as_float(rr[1]);
}
__device__ __forceinline__ float sq4(const f32x4 a) { return (a[0] * a[0] + a[1] * a[1]) + (a[2] * a[2] + a[3] * a[3]); }
__device__ __forceinline__ void load_rs(float (&r)[2][4], const PG8_LAS float* rsl, int wr, int fr) {
#pragma unroll
    for (int ai = 0; ai < 2; ++ai)
#pragma unroll
        for (int m = 0; m < 4; ++m) r[ai][m] = rsl[ai * HALF + wr * 64 + m * 16 + fr]; }
__device__ __forceinline__ void unpack8bf(const u32x4 w, f32x4& a, f32x4& b) {
    a = (f32x4){__uint_as_float(w.x << 16), __uint_as_float(w.x & 0xffff0000u), __uint_as_float(w.y << 16), __uint_as_float(w.y & 0xffff0000u)};
    b = (f32x4){__uint_as_float(w.z << 16), __uint_as_float(w.z & 0xffff0000u), __uint_as_float(w.w << 16), __uint_as_float(w.w & 0xffff0000u)}; }
template <bool BASE_F32> struct EpiResB {
    PG8_NOPRE
    static constexpr bool PERM = true, AFTER_DRAIN = false;
    const float* basef; bf16_t* X; float* ps; int ldc;
    __device__ __forceinline__ void operator()(const f32x4 (&acc)[2][2][4][2], const Unit& u, int wr, int wc, int fr_, int fq_, int ui) const {
        int fr = fr_, fq = fq_; asm volatile("" : "+v"(fr), "+v"(fq));
        const int row0 = u.pm * BM + wr * 64 + fr, col0 = u.pn * BM + wc * 32 + 8 * fq;
        u32x4 bx[2][4][2];
#pragma unroll
        for (int ai = 0; ai < 2; ++ai)
#pragma unroll
            for (int m = 0; m < 4; ++m) { const size_t off = (size_t)(row0 + ai * HALF + m * 16) * ldc + col0;
#pragma unroll
                for (int bj = 0; bj < 2; ++bj) bx[ai][m][bj] = *(const PG8_G u32x4*)(X + off + bj * HALF); }
#pragma unroll
        for (int ai = 0; ai < 2; ++ai)
#pragma unroll
            for (int m = 0; m < 4; ++m) { const int row = row0 + ai * HALF + m * 16; const size_t off = (size_t)row * ldc + col0; float q = 0.f;
#pragma unroll
                for (int bj = 0; bj < 2; ++bj) { f32x4 x0, x1; unpack8bf(bx[ai][m][bj], x0, x1);
                    const f32x4 o0 = x0 + acc[ai][bj][m][0], o1 = x1 + acc[ai][bj][m][1]; q += sq4(o0) + sq4(o1);
                    *(PG8_G u32x4*)(X + off + bj * HALF) = pack8bf(o0, o1); }
                q = sum_fq(q);
                if (fq == 0) ((PG8_G float*)ps)[(size_t)row * 32 + u.pn * 4 + wc] = q; }
    }
};
struct EpiResLast {
    PG8_NOPRE
    static constexpr bool PERM = true, AFTER_DRAIN = false;
    const bf16_t* X; float* out; int ldc;
    __device__ __forceinline__ void operator()(const f32x4 (&acc)[2][2][4][2], const Unit& u, int wr, int wc, int fr, int fq, int ui) const {
        const int row0 = u.pm * BM + wr * 64 + fr, col0 = u.pn * BM + wc * 32 + 8 * fq;
#pragma unroll
        for (int ai = 0; ai < 2; ++ai) {
            u32x4 bx[4][2];
#pragma unroll
            for (int m = 0; m < 4; ++m) { const size_t off = (size_t)(row0 + ai * HALF + m * 16) * ldc + col0;
#pragma unroll
                for (int bj = 0; bj < 2; ++bj) bx[m][bj] = *(const PG8_G u32x4*)(X + off + bj * HALF); }
#pragma unroll
            for (int m = 0; m < 4; ++m) { const size_t off = (size_t)(row0 + ai * HALF + m * 16) * ldc + col0;
#pragma unroll
                for (int bj = 0; bj < 2; ++bj) { f32x4 x0, x1; unpack8bf(bx[m][bj], x0, x1);
                    *(PG8_G f32x4*)(out + off + bj * HALF) = x0 + acc[ai][bj][m][0]; *(PG8_G f32x4*)(out + off + bj * HALF + 4) = x1 + acc[ai][bj][m][1]; } }
            asm volatile("" ::: "memory"); }
    }
};
struct EpiF32Scaled {
    PG8_NOPRE
    static constexpr bool PERM = false, AFTER_DRAIN = false;
    float* C; int ldc; const PG8_LAS float* rsl;
    __device__ __forceinline__ void operator()(const f32x4 (&acc)[2][2][4][2], const Unit& u, int wr, int wc, int fr, int fq, int ui) const {
        const int row0 = u.pm * BM + wr * 64 + fr, col0 = u.pn * BM + wc * 32 + 4 * fq;
        float r[2][4]; load_rs(r, rsl, wr, fr);
#pragma unroll
        for (int ai = 0; ai < 2; ++ai)
#pragma unroll
            for (int m = 0; m < 4; ++m) { float* rowp = C + (size_t)(row0 + ai * HALF + m * 16) * ldc + col0;
#pragma unroll
                for (int bj = 0; bj < 2; ++bj)
#pragma unroll
                    for (int n = 0; n < 2; ++n) *(PG8_G f32x4*)(rowp + bj * HALF + n * 16) = acc[ai][bj][m][n] * r[ai][m]; }
    }
};

struct EpiQaCkv {
    PG8_NOPRE
    static constexpr bool PERM = true, AFTER_DRAIN = false;
    bf16_t* QA; bf16_t* CK; float* pq; const PG8_LAS float* rsl;
    __device__ __forceinline__ void operator()(const f32x4 (&acc)[2][2][4][2], const Unit& u, int wr, int wc, int fr_, int fq_, int ui) const {
        int fr = fr_, fq = fq_; asm volatile("" : "+v"(fr), "+v"(fq));
        const int row0 = u.pm * BM + wr * 64 + fr, col0 = (u.pn & 1) * BM + wc * 32 + 8 * fq;
        bf16_t* D = u.pn < 2 ? QA : CK;
        float r[2][4]; load_rs(r, rsl, wr, fr);
#pragma unroll
        for (int ai = 0; ai < 2; ++ai)
#pragma unroll
            for (int m = 0; m < 4; ++m) { const int row = row0 + ai * HALF + m * 16; float q = 0.f;
#pragma unroll
                for (int bj = 0; bj < 2; ++bj) { const f32x4 o0 = acc[ai][bj][m][0] * r[ai][m], o1 = acc[ai][bj][m][1] * r[ai][m]; q += sq4(o0) + sq4(o1);
                    *(PG8_G u32x4*)(D + (size_t)row * 512 + col0 + bj * HALF) = pack8bf(o0, o1); }
                q = sum_fq(q);
                if (fq == 0) ((PG8_G float*)pq)[(size_t)row * 16 + u.pn * 4 + wc] = q; }
    }
};

#define PG8_DPP(old_, src_, ctrl_) __uint_as_float((unsigned)__builtin_amdgcn_update_dpp((int)__float_as_uint(old_), (int)__float_as_uint(src_), (ctrl_), 0xF, 0xF, false))
struct EpiUpConv {
    static constexpr bool PERM = true, AFTER_DRAIN = false;
    bf16_t* ACT; float* HALO; float* FIX; const float* cws;
    PG8_LAS float* xh; PG8_LAS float* cwl; const PG8_LAS float* rsl;
    __device__ __forceinline__ static void w_dma(const float* cws, int pn, PG8_LAS float* buf, int tap, int lane) {
        const float* src = cws + (size_t)tap * 11264 + (lane < 32 ? 128 * pn + lane * 4 : 5632 + 128 * pn + (lane - 32) * 4);
        __builtin_amdgcn_global_load_lds((const unsigned*)src, (PG8_LAS unsigned*)(buf + tap * 256), 16, 0, 0); }
    PG8_NOPRE
    __device__ __forceinline__ void operator()(const f32x4 (&acc_)[2][2][4][2], const Unit& u, int wr, int wc, int fr_, int fq_, int ui) const {
        int fr = fr_, fq = fq_; asm volatile("" : "+v"(fr), "+v"(fq));
        f32x4 (&acc)[2][2][4][2] = const_cast<f32x4 (&)[2][2][4][2]>(acc_);
        { float r[2][4]; load_rs(r, rsl, wr, fr);
#pragma unroll
          for (int ai = 0; ai < 2; ++ai)
#pragma unroll
            for (int bj = 0; bj < 2; ++bj)
#pragma unroll
                for (int m = 0; m < 4; ++m)
#pragma unroll
                    for (int n = 0; n < 2; ++n) acc[ai][bj][m][n] = acc[ai][bj][m][n] * r[ai][m]; }
        const int ch0 = 128 * u.pn + 32 * wc + 8 * fq;
        PG8_LAS float* cwc = cwl + (ui & 1) * 1024;
        if (wr == 0 && u.pn + 4 < 44) w_dma(cws, u.pn + 4, cwl + ((ui + 1) & 1) * 1024, wc, fq * 16 + fr);
        if (fr >= 14) {
#pragma unroll
            for (int ai = 0; ai < 2; ++ai) if (ai == 0 || wr == 0) { PG8_LAS float* b = xh + ((((ai == 0 ? wr : 2) * 4 + wc) * 2 + (fr - 14)) * 4 + fq) * 16;
#pragma unroll
                for (int bj = 0; bj < 2; ++bj)
#pragma unroll
                    for (int n = 0; n < 2; ++n) *(PG8_LAS f32x4*)(b + (bj * 2 + n) * 4) = acc[ai][bj][3][n]; }
            if (wr == 1) { float* hp = HALO + ((size_t)u.pm * 2 + (fr - 14)) * 11264 + ch0;
#pragma unroll
                for (int bj = 0; bj < 2; ++bj)
#pragma unroll
                    for (int n = 0; n < 2; ++n) *(PG8_G f32x4*)(hp + bj * 5632 + n * 4) = acc[1][bj][3][n]; }
        }
        asm volatile("s_waitcnt lgkmcnt(0)" ::: "memory"); __builtin_amdgcn_s_barrier(); asm volatile("" ::: "memory");
        const bool fixtile = (u.pm & 15) != 0;
#define PG8_FMAC_DPP(c_, x_, w_, ctrl_) asm("v_fmac_f32_dpp %0, %1, %2 " ctrl_ : "+v"(c_) : "v"(x_), "v"(w_))
        u32x2 wkeep[2][4];
#pragma unroll
        for (int n = 0; n < 2; ++n) {
            const PG8_LAS float* cwb = cwc + wc * 32 + fq * 8 + n * 4;
            f32x4 Wq[2][4], W1m[2], W0m[2];
#pragma unroll
            for (int bj = 0; bj < 2; ++bj) {
#pragma unroll
                for (int t = 0; t < 4; ++t) Wq[bj][t] = *(const PG8_LAS f32x4*)(cwb + t * 256 + bj * 128);
#pragma unroll
                for (int k = 0; k < 4; ++k) { W1m[bj][k] = fr == 0 ? Wq[bj][1][k] : 0.f; W0m[bj][k] = fr < 2 ? Wq[bj][0][k] : 0.f; } }
#pragma unroll
            for (int ai = 0; ai < 2; ++ai)
#pragma unroll
                for (int m = 0; m < 4; ++m) {
                    f32x4 c[2];
#pragma unroll
                    for (int bj = 0; bj < 2; ++bj) {
                        f32x4 h1 = {0.f, 0.f, 0.f, 0.f}, h2 = {0.f, 0.f, 0.f, 0.f};
                        if (m == 0 && !(ai == 0 && wr == 0)) { const int slot = ai == 0 ? 0 : (wr == 0 ? 1 : 2); const PG8_LAS float* b = xh + (((slot * 4 + wc) * 2) * 4 + fq) * 16 + n * 4 + bj * 8;
                            h2 = *(const PG8_LAS f32x4*)b; h1 = *(const PG8_LAS f32x4*)(b + 64); }
#pragma unroll
                        for (int k = 0; k < 4; ++k) { const float cur = acc[ai][bj][m][n][k];
                            float cc = fmaf(Wq[bj][2][k], cur, Wq[bj][3][k]);
                            PG8_FMAC_DPP(cc, cur, Wq[bj][1][k], "row_shr:1 row_mask:0xf bank_mask:0xf bound_ctrl:1");
                            PG8_FMAC_DPP(cc, cur, Wq[bj][0][k], "row_shr:2 row_mask:0xf bank_mask:0xf bound_ctrl:1");
                            if (m == 0) { const float z = fr == 0 ? h2[k] : h1[k]; cc = fmaf(W1m[bj][k], h1[k], cc); cc = fmaf(W0m[bj][k], z, cc); }
                            else { const float p = acc[ai][bj][m > 0 ? m - 1 : 0][n][k]; PG8_FMAC_DPP(cc, p, W1m[bj][k], "row_ror:1 row_mask:0xf bank_mask:0xf"); PG8_FMAC_DPP(cc, p, W0m[bj][k], "row_ror:2 row_mask:0xf bank_mask:0xf"); }
                            c[bj][k] = cc; }
                        __builtin_amdgcn_sched_barrier(0);
                    }
                    const int row = u.pm * BM + ai * HALF + wr * 64 + m * 16 + fr;
                    if (ai == 0 && m == 0 && wr == 0 && fixtile && fr < 2) {
                        float* fp = FIX + ((size_t)u.pm * 2 + fr) * 11264 + ch0 + n * 4;
                        *(PG8_G f32x4*)fp = c[0] * 0.6931471805599453f; *(PG8_G f32x4*)(fp + 5632) = c[1] * 1.4426950408889634f;
                    } else {
                        f32x4 ex;
#pragma unroll
                        for (int k = 0; k < 4; ++k) ex[k] = __builtin_amdgcn_exp2f(-c[0][k]);
                        const f32x4 den = ex + 1.0f, gv = c[0] * c[1]; f32x4 rc;
#pragma unroll
                        for (int k = 0; k < 4; ++k) rc[k] = __builtin_amdgcn_rcpf(den[k]);
                        const f32x4 a = gv * rc;
                        u32x2 w; w.x = cvt_pk_bf16(a[0], a[1]); w.y = cvt_pk_bf16(a[2], a[3]);
                        if (n == 0) wkeep[ai][m] = w;
                        else { const u32x4 w4 = {wkeep[ai][m].x, wkeep[ai][m].y, w.x, w.y}; *(PG8_G u32x4*)(ACT + (size_t)row * 5632 + ch0) = w4; }
                    }
                    asm volatile("" ::: "memory"); __builtin_amdgcn_sched_barrier(0);
                }
        }
    }
};
struct EpiKpe {
    PG8_NOPRE
    static constexpr bool PERM = true, AFTER_DRAIN = false;
    bf16_t* KPE; const float* cosT; const float* sinT; const PG8_LAS float* rsl;
    __device__ __forceinline__ void operator()(const f32x4 (&acc)[2][2][4][2], const Unit& u, int wr, int wc, int fr_, int fq_, int ui) const {
        int fr = fr_, fq = fq_; asm volatile("" : "+v"(fr), "+v"(fq));
        if (wc != 0) return;
        const int row0 = u.pm * BM + wr * 64 + fr, i0 = 8 * fq;
        float r[2][4]; load_rs(r, rsl, wr, fr);
#pragma unroll
        for (int ai = 0; ai < 2; ++ai)
#pragma unroll
            for (int m = 0; m < 4; ++m) { const int row = row0 + ai * HALF + m * 16;
                const f32x4 c0 = *(const PG8_G f32x4*)(cosT + (size_t)row * 32 + i0), c1 = *(const PG8_G f32x4*)(cosT + (size_t)row * 32 + i0 + 4);
                const f32x4 s0 = *(const PG8_G f32x4*)(sinT + (size_t)row * 32 + i0), s1 = *(const PG8_G f32x4*)(sinT + (size_t)row * 32 + i0 + 4);
                const f32x4 x1a = acc[ai][0][m][0] * r[ai][m], x1b = acc[ai][0][m][1] * r[ai][m], x2a = acc[ai][1][m][0] * r[ai][m], x2b = acc[ai][1][m][1] * r[ai][m];
                const f32x4 y1a = x1a * c0 - x2a * s0, y1b = x1b * c1 - x2b * s1, y2a = x2a * c0 + x1a * s0, y2b = x2b * c1 + x1b * s1;
                bf16_t* dst = KPE + (size_t)row * 64 + i0;
                *(PG8_G u32x4*)dst = pack8bf(y1a, y1b); *(PG8_G u32x4*)(dst + 32) = pack8bf(y2a, y2b); }
    }
};
struct PanelUnits { int pm, pn0, n;
    __device__ __forceinline__ bool next(int i, Unit& u) const { if (i >= n) return false; u.pm = pm; u.pn = pn0 + i; return true; }
    __device__ __forceinline__ void a_ready(const Unit&) const {}
    __device__ __forceinline__ void done(const Unit&) const {}
};
struct OneUnit { int pm, pn;
    __device__ __forceinline__ bool next(int i, Unit& u) const { if (i) return false; u.pm = pm; u.pn = pn; return true; }
    __device__ __forceinline__ void a_ready(const Unit&) const {}
    __device__ __forceinline__ void done(const Unit&) const {}
};
struct EpiKvMla {
    PG8_NOPRE
    static constexpr bool PERM = true, AFTER_DRAIN = false;
    bf16_t* KH; bf16_t* VH; const PG8_LAS float* rsl;
    __device__ __forceinline__ void operator()(const f32x4 (&acc)[2][2][4][2], const Unit& u, int wr, int wc, int fr_, int fq_, int ui) const {
        int fr = fr_, fq = fq_; asm volatile("" : "+v"(fr), "+v"(fq));
        const int row0 = u.pm * BM + wr * 64 + fr, dim0 = wc * 32 + 8 * fq;
        float r[2][4]; load_rs(r, rsl, wr, fr);
#pragma unroll
        for (int ai = 0; ai < 2; ++ai)
#pragma unroll
            for (int m = 0; m < 4; ++m) { const int row = row0 + ai * HALF + m * 16, b = row >> 12, s = row & 4095;
                const size_t o = (((size_t)b * 16 + u.pn) * 4096 + s) * 128 + dim0;
                *(PG8_G u32x4*)(KH + o) = pack8bf(acc[ai][0][m][0] * r[ai][m], acc[ai][0][m][1] * r[ai][m]); *(PG8_G u32x4*)(VH + o) = pack8bf(acc[ai][1][m][0] * r[ai][m], acc[ai][1][m][1] * r[ai][m]); }
    }
};
struct EpiQMla {
    PG8_NOPRE
    static constexpr bool PERM = true, AFTER_DRAIN = false;
    bf16_t* Q; const float* cosT; const float* sinT; const PG8_LAS float* rsl;
    __device__ __forceinline__ void operator()(const f32x4 (&acc)[2][2][4][2], const Unit& u, int wr, int wc, int fr_, int fq_, int ui) const {
        int fr = fr_, fq = fq_; asm volatile("" : "+v"(fr), "+v"(fq));
        const int row0 = u.pm * BM + wr * 64 + fr;
        float r[2][4]; load_rs(r, rsl, wr, fr);
        if (u.pn < 8) {
            const int col0 = u.pn * BM + wc * 32 + 8 * fq;
#pragma unroll
            for (int ai = 0; ai < 2; ++ai)
#pragma unroll
                for (int m = 0; m < 4; ++m) { bf16_t* rowp = Q + (size_t)(row0 + ai * HALF + m * 16) * 3072 + col0;
#pragma unroll
                    for (int bj = 0; bj < 2; ++bj) *(PG8_G u32x4*)(rowp + bj * HALF) = pack8bf(acc[ai][bj][m][0] * r[ai][m], acc[ai][bj][m][1] * r[ai][m]); }
        } else {
            const int head = 4 * (u.pn - 8) + wc, i0 = 8 * fq;
#pragma unroll
            for (int ai = 0; ai < 2; ++ai)
#pragma unroll
                for (int m = 0; m < 4; ++m) { const int row = row0 + ai * HALF + m * 16;
                    const f32x4 c0 = *(const PG8_G f32x4*)(cosT + (size_t)row * 32 + i0), c1 = *(const PG8_G f32x4*)(cosT + (size_t)row * 32 + i0 + 4);
                    const f32x4 s0 = *(const PG8_G f32x4*)(sinT + (size_t)row * 32 + i0), s1 = *(const PG8_G f32x4*)(sinT + (size_t)row * 32 + i0 + 4);
                    const f32x4 x1a = acc[ai][0][m][0] * r[ai][m], x1b = acc[ai][0][m][1] * r[ai][m], x2a = acc[ai][1][m][0] * r[ai][m], x2b = acc[ai][1][m][1] * r[ai][m];
                    const f32x4 y1a = x1a * c0 - x2a * s0, y1b = x1b * c1 - x2b * s1, y2a = x2a * c0 + x1a * s0, y2b = x2b * c1 + x1b * s1;
                    bf16_t* dst = Q + (size_t)row * 3072 + 2048 + head * 64 + i0;
                    *(PG8_G u32x4*)dst = pack8bf(y1a, y1b); *(PG8_G u32x4*)(dst + 32) = pack8bf(y2a, y2b); }
        }
    }
};
struct EpiQkvDil {
    PG8_NOPRE
    static constexpr bool PERM = true, AFTER_DRAIN = false;
    bf16_t* O; const float* cosT; const float* sinT; const PG8_LAS float* rsl;
    __device__ __forceinline__ void operator()(const f32x4 (&acc)[2][2][4][2], const Unit& u, int wr, int wc, int fr, int fq, int ui) const {
        const int row0 = u.pm * BM + wr * 64 + fr;
        const int g = u.pn / 24, rem = u.pn - g * 24, t = rem >> 3, T = rem & 7, sh = 2 * g;
        float r[2][4]; load_rs(r, rsl, wr, fr);
        const size_t plane = ((size_t)(g * 3 + t) * 16 + 2 * T) * 4;
        if (t == 2 || wc != 0) {
            const int dim0 = wc * 32 + 8 * fq;
#pragma unroll
            for (int ai = 0; ai < 2; ++ai)
#pragma unroll
                for (int m = 0; m < 4; ++m) { const int row = row0 + ai * HALF + m * 16, b = row >> 12, s = row & 4095, sp = ((s & ((1 << sh) - 1)) << (12 - sh)) + (s >> sh);
#pragma unroll
                    for (int bj = 0; bj < 2; ++bj) *(PG8_G u32x4*)(O + ((plane + bj * 4 + b) * 4096 + sp) * 128 + dim0) = pack8bf(acc[ai][bj][m][0] * r[ai][m], acc[ai][bj][m][1] * r[ai][m]); }
        } else {
            const int hh = fq >> 1, i0 = 8 * (fq & 1);
#pragma unroll
            for (int ai = 0; ai < 2; ++ai)
#pragma unroll
                for (int m = 0; m < 4; ++m) { const int row = row0 + ai * HALF + m * 16, b = row >> 12, s = row & 4095, sp = ((s & ((1 << sh) - 1)) << (12 - sh)) + (s >> sh);
                    const f32x4 c0 = *(const PG8_G f32x4*)(cosT + (size_t)row * 16 + i0), c1 = *(const PG8_G f32x4*)(cosT + (size_t)row * 16 + i0 + 4);
                    const f32x4 s0 = *(const PG8_G f32x4*)(sinT + (size_t)row * 16 + i0), s1 = *(const PG8_G f32x4*)(sinT + (size_t)row * 16 + i0 + 4);
                    const f32x4 x1a = acc[ai][0][m][0] * r[ai][m], x1b = acc[ai][0][m][1] * r[ai][m], x2a = acc[ai][1][m][0] * r[ai][m], x2b = acc[ai][1][m][1] * r[ai][m];
                    const f32x4 y1a = x1a * c0 - x2a * s0, y1b = x1b * c1 - x2b * s1, y2a = x2a * c0 + x1a * s0, y2b = x2b * c1 + x1b * s1;
                    bf16_t* dst = O + ((plane + hh * 4 + b) * 4096 + sp) * 128 + i0;
                    *(PG8_G u32x4*)dst = pack8bf(y1a, y1b); *(PG8_G u32x4*)(dst + 16) = pack8bf(y2a, y2b); }
        }
    }
};

template <class Epi, class Sched, bool ALIGN_EPI = false, bool SP2 = false, int EPI_REP = 1>
__device__ __forceinline__ void gemm_phase(PG8_LAS unsigned char* lds, const Gemm g, const Sched& S, const Epi& E) {
    int tid_ = threadIdx.x; asm volatile("" : "+v"(tid_));
    const int tid = tid_, wid = __builtin_amdgcn_readfirstlane(tid >> 6), lane = tid & 63, wr = wid >> 2, wc = wid & 3, fr = lane & 15, fq = lane >> 4;
    const int K = g.K, nt = K / BK;
    unsigned voffA[2], voffB[2];
#pragma unroll
    for (int i = 0; i < 2; ++i) { int R, C; stage_rc(tid * 16 + i * 8192, R, C); const int Rb = Epi::PERM ? ((R & ~31) + perm32(R & 31)) : R;
        voffA[i] = (unsigned)(R * K + C) * 2u; voffB[i] = (unsigned)(Rb * K + C) * 2u; }
    const size_t kstep = (size_t)(BK * 2);
    const size_t hstep = (size_t)HALF * K * 2;
    const size_t tstep = 2 * hstep;
    const unsigned ldsw = (unsigned)wid * 1024u;
    const int aoff = lds_byte(wr * 64 + fr, fq * 8), boff = lds_byte(wc * 32 + fr, fq * 8);
#define PG8_SA(b, h) (((b) * 2 + (h)) * HTB)
#define PG8_SB(b, h) ((4 + (b) * 2 + (h)) * HTB)
#define PG8_STAGE(bufoff, gbase, voff) do { _Pragma("unroll") for (int _i = 0; _i < 2; ++_i) \
        __builtin_amdgcn_global_load_lds((const unsigned*)((const char*)(gbase) + (voff)[_i]), (PG8_LAS unsigned*)(lds + (bufoff) + ldsw + _i * 8192), 16, 0, 0); } while (0)
#define PG8_LDA(dst, b, h) do { _Pragma("unroll") for (int m = 0; m < 4; ++m) _Pragma("unroll") for (int k = 0; k < 2; ++k) dst[m][k] = *(const PG8_LAS bf16x8*)(lds + PG8_SA(b, h) + aoff + m * 2048 + k * 1024); } while (0)
#define PG8_LDB(dst, b, h) do { _Pragma("unroll") for (int n = 0; n < 2; ++n) _Pragma("unroll") for (int k = 0; k < 2; ++k) dst[n][k] = *(const PG8_LAS bf16x8*)(lds + PG8_SB(b, h) + boff + n * 2048 + k * 1024); } while (0)
#define PG8_MMA(ai, bj, At, Bt) do { __builtin_amdgcn_s_setprio(1); _Pragma("unroll") for (int m = 0; m < 4; ++m) _Pragma("unroll") for (int n = 0; n < 2; ++n) _Pragma("unroll") for (int k = 0; k < 2; ++k) \
        acc[ai][bj][m][n] = __builtin_amdgcn_mfma_f32_16x16x32_bf16(Bt[n][k], At[m][k], acc[ai][bj][m][n], 0, 0, 0); __builtin_amdgcn_s_setprio(0); } while (0)
#define PG8_WAIT_V(n) asm volatile("s_waitcnt vmcnt(" #n ")" ::: "memory")
#define PG8_WAIT_L(n) asm volatile("s_waitcnt lgkmcnt(" #n ")" ::: "memory")
#define PG8_BAR __builtin_amdgcn_s_barrier()
#define PG8_SCHED __builtin_amdgcn_sched_barrier(0)
    Unit cur, nxt; int ui = 0;
    typename Epi::Pre pre;
    if (!S.next(0, cur)) return;
    f32x4 acc[2][2][4][2];
#pragma unroll
    for (int a = 0; a < 2; ++a)
#pragma unroll
        for (int b = 0; b < 2; ++b)
#pragma unroll
            for (int m = 0; m < 4; ++m)
#pragma unroll
                for (int n = 0; n < 2; ++n) acc[a][b][m][n] = (f32x4){0.f, 0.f, 0.f, 0.f};
    bf16x8 At[4][2], B0[2][2], B1[2][2];
    const char* cA = (const char*)g.A + (size_t)cur.pm * tstep; const char* cB = (const char*)g.Bt + (size_t)cur.pn * tstep;
    S.a_ready(cur);
    if constexpr (SP2) {
        PG8_STAGE(PG8_SB(0, 0), cB, voffB); PG8_STAGE(PG8_SB(0, 1), cB + hstep, voffB); PG8_STAGE(PG8_SA(0, 0), cA, voffA); PG8_STAGE(PG8_SA(0, 1), cA + hstep, voffA);
        if (wr == 1) PG8_BAR;
        PG8_WAIT_V(2); PG8_BAR;
        PG8_STAGE(PG8_SB(1, 0), cB + kstep, voffB); PG8_STAGE(PG8_SA(1, 0), cA + kstep, voffA); PG8_STAGE(PG8_SB(1, 1), cB + hstep + kstep, voffB);
        PG8_WAIT_V(6); PG8_BAR;
    } else {
        PG8_STAGE(PG8_SB(0, 0), cB, voffB); PG8_STAGE(PG8_SA(0, 0), cA, voffA); PG8_STAGE(PG8_SB(0, 1), cB + hstep, voffB); PG8_STAGE(PG8_SA(0, 1), cA + hstep, voffA);
        if (wr == 1) PG8_BAR;
        PG8_WAIT_V(4); PG8_BAR;
        PG8_STAGE(PG8_SB(1, 0), cB + kstep, voffB); PG8_STAGE(PG8_SA(1, 0), cA + kstep, voffA); PG8_STAGE(PG8_SB(1, 1), cB + hstep + kstep, voffB);
        PG8_WAIT_V(6); PG8_BAR;
    }
    for (;;) {
        const bool has_next = S.next(ui + 1, nxt);
        const char* nA = has_next ? (const char*)g.A + (size_t)nxt.pm * tstep : cA; const char* nB = has_next ? (const char*)g.Bt + (size_t)nxt.pn * tstep : cB;
        for (int t = 0; t < nt; t += 2) {
            const bool last = (t == nt - 2);
            const char* a1 = cA + (size_t)(t + 1) * kstep;
            const char* a2 = last ? nA : cA + (size_t)(t + 2) * kstep; const char* b2 = last ? nB : cB + (size_t)(t + 2) * kstep;
            const char* a3 = a2 + kstep; const char* b3 = b2 + kstep;
            if (last && has_next) S.a_ready(nxt);
            if (t == 0) E.pre_issue(pre, cur, tid, ui); else if (t == 2) E.pre_finish(pre, tid, ui);
            if constexpr (SP2) {
            PG8_LDB(B0, 0, 0); PG8_LDB(B1, 0, 1); PG8_SCHED; PG8_LDA(At, 0, 0); PG8_STAGE(PG8_SA(1, 1), a1 + hstep, voffA);
            PG8_WAIT_V(8); PG8_WAIT_L(0); PG8_BAR; PG8_MMA(0, 0, At, B0); PG8_MMA(0, 1, At, B1); PG8_BAR; PG8_SCHED;
            PG8_LDA(At, 0, 1); PG8_STAGE(PG8_SB(0, 0), b2, voffB); PG8_STAGE(PG8_SB(0, 1), b2 + hstep, voffB); PG8_STAGE(PG8_SA(0, 0), a2, voffA);
            PG8_WAIT_V(8); PG8_WAIT_L(0); PG8_BAR; PG8_MMA(1, 0, At, B0); PG8_MMA(1, 1, At, B1); PG8_BAR; PG8_SCHED;
            PG8_LDB(B0, 1, 0); PG8_LDB(B1, 1, 1); PG8_SCHED; PG8_LDA(At, 1, 0); PG8_STAGE(PG8_SA(0, 1), a2 + hstep, voffA);
            PG8_WAIT_V(8); PG8_WAIT_L(0); PG8_BAR; PG8_MMA(0, 0, At, B0); PG8_MMA(0, 1, At, B1); PG8_BAR; PG8_SCHED;
            PG8_LDA(At, 1, 1); PG8_STAGE(PG8_SB(1, 0), b3, voffB); PG8_STAGE(PG8_SB(1, 1), b3 + hstep, voffB); PG8_STAGE(PG8_SA(1, 0), a3, voffA);
            PG8_WAIT_V(8); PG8_WAIT_L(0); PG8_BAR; PG8_MMA(1, 0, At, B0); PG8_MMA(1, 1, At, B1); PG8_BAR; PG8_SCHED;
            } else {
            PG8_LDB(B0, 0, 0); PG8_SCHED; PG8_LDA(At, 0, 0); PG8_STAGE(PG8_SA(1, 1), a1 + hstep, voffA);
            PG8_WAIT_L(8); PG8_BAR; PG8_WAIT_L(0); PG8_MMA(0, 0, At, B0); PG8_BAR; PG8_SCHED;
            PG8_LDB(B1, 0, 1); PG8_STAGE(PG8_SB(0, 0), b2, voffB);
            PG8_BAR; PG8_WAIT_L(0); PG8_MMA(0, 1, At, B1); PG8_BAR;
            PG8_LDA(At, 0, 1); PG8_STAGE(PG8_SA(0, 0), a2, voffA);
            PG8_BAR; PG8_WAIT_L(0); PG8_MMA(1, 0, At, B0); PG8_BAR; PG8_SCHED;
            PG8_STAGE(PG8_SB(0, 1), b2 + hstep, voffB);
            PG8_WAIT_V(6); PG8_BAR; PG8_MMA(1, 1, At, B1); PG8_BAR;
            PG8_LDB(B0, 1, 0); PG8_SCHED; PG8_LDA(At, 1, 0); PG8_STAGE(PG8_SA(0, 1), a2 + hstep, voffA);
            PG8_WAIT_L(8); PG8_BAR; PG8_WAIT_L(0); PG8_MMA(0, 0, At, B0); PG8_BAR; PG8_SCHED;
            PG8_LDB(B1, 1, 1); PG8_STAGE(PG8_SB(1, 0), b3, voffB);
            PG8_BAR; PG8_WAIT_L(0); PG8_MMA(0, 1, At, B1); PG8_BAR;
            PG8_LDA(At, 1, 1); PG8_STAGE(PG8_SA(1, 0), a3, voffA);
            PG8_BAR; PG8_WAIT_L(0); PG8_MMA(1, 0, At, B0); PG8_BAR; PG8_SCHED;
            PG8_STAGE(PG8_SB(1, 1), b3 + hstep, voffB);
            PG8_WAIT_V(6); PG8_BAR; PG8_MMA(1, 1, At, B1); PG8_BAR;
            }
        }
        if constexpr (ALIGN_EPI) { if (wr == 0) PG8_BAR; }
        if constexpr (!Epi::AFTER_DRAIN) { _Pragma("unroll") for (int rep_ = 0; rep_ < EPI_REP; ++rep_) E(acc, cur, wr, wc, fr, fq, ui); S.done(cur); }
        if (!has_next) break;
#pragma unroll
        for (int a = 0; a < 2; ++a)
#pragma unroll
            for (int b = 0; b < 2; ++b)
#pragma unroll
                for (int m = 0; m < 4; ++m)
#pragma unroll
                    for (int n = 0; n < 2; ++n) acc[a][b][m][n] = (f32x4){0.f, 0.f, 0.f, 0.f};
        cur = nxt; cA = nA; cB = nB; ++ui;
        if constexpr (ALIGN_EPI) { if (wr == 1) PG8_BAR; }
    }
    PG8_WAIT_V(0);
    if constexpr (!ALIGN_EPI) { if (wr == 0) PG8_BAR; }
    PG8_BAR;
    if constexpr (Epi::AFTER_DRAIN) { E.fused(acc, cur, wr, wc, fr, fq, lds, wid, lane); S.done(cur); }
#undef PG8_SA
#undef PG8_SB
#undef PG8_STAGE
#undef PG8_LDA
#undef PG8_LDB
#undef PG8_MMA
#undef PG8_WAIT_V
#undef PG8_WAIT_L
#undef PG8_BAR
#undef PG8_SCHED
}
}
namespace att {
typedef unsigned short bf16;
typedef short bf16x8 __attribute__((ext_vector_type(8)));
typedef short s16x4 __attribute__((ext_vector_type(4)));
typedef float f32x16 __attribute__((ext_vector_type(16)));
typedef float f32x4 __attribute__((ext_vector_type(4)));
typedef unsigned u32x4 __attribute__((ext_vector_type(4)));
constexpr int NW = 8, QBLK = 32, KVBLK = 64, QB = NW * QBLK;
constexpr int SHM_V = KVBLK * 128 * 2, SHM_K = KVBLK * 128 * 2, KPE_ROW = 144, SHM_KPE = KVBLK * KPE_ROW;
constexpr int OFF_V = 0, OFF_K = 2 * SHM_V, OFF_WS = OFF_K + 2 * SHM_K, OFF_KPE = OFF_WS + NW * 64 * 4, OFF_QPE = OFF_KPE + 2 * SHM_KPE, LDS_BYTES = OFF_QPE + NW * 4096;
constexpr float THR = 8.f;

#define KSWZ(row, colB) ((row) * 256 + ((colB) ^ (((row) & 7) << 4)))
#define SBAR() __builtin_amdgcn_sched_barrier(0)
__device__ __forceinline__ int v_st(int k, int c) { const int kk = (k & ~0xC) | ((k & 4) << 1) | ((k & 8) >> 1); return ((kk >> 3) * 4 + (c >> 5)) * 512 + ((kk & 7) * 32 + (c & 31)) * 2; }
__device__ __forceinline__ int v_rd_base(int lane) { return ((lane & 3) << 3) | (((lane >> 2) & 3) << 6) | (((lane >> 4) & 1) << 5) | (((lane >> 5) & 1) << 11); }
constexpr int v_rd_off(int d0, int ks, int half) { return d0 * 512 + ks * 4096 + half * 256; }
__device__ __forceinline__ int crow(int r, int hi) { return (r & 3) + 8 * (r >> 2) + 4 * hi; }
__device__ __forceinline__ unsigned cvtpk(float lo, float hi) { unsigned r; asm volatile("v_cvt_pk_bf16_f32 %0, %1, %2" : "=v"(r) : "v"(lo), "v"(hi)); return r; }
__device__ __forceinline__ bf16x8 ld8(const bf16* p) { return *reinterpret_cast<const bf16x8*>(p); }
__device__ __forceinline__ void mask_tile(f32x16& p0, f32x16& p1, int dq, unsigned W) {
    const float NEG = -__builtin_inff();
#pragma unroll
    for (int r = 0; r < 16; ++r) {
        const int c = (r & 3) + 8 * (r >> 2);
        if ((unsigned)(dq - c) >= W) p0[r] = NEG;
        if ((unsigned)(dq - c - 32) >= W) p1[r] = NEG;
    }
}
__device__ __forceinline__ void partialSM(f32x16& p0, f32x16& p1, float& m_reg, float& mn, float& alpha, const float scale) {
    float pmax = p0[0]; for (int r = 1; r < 16; ++r) pmax = fmaxf(pmax, p0[r]); for (int r = 0; r < 16; ++r) pmax = fmaxf(pmax, p1[r]);
    { auto rr = __builtin_amdgcn_permlane32_swap(__float_as_uint(pmax), __float_as_uint(pmax), false, false);
      pmax = fmaxf(__uint_as_float(rr[0]), __uint_as_float(rr[1])); }
    const float C2 = 1.4426950408889634f * scale;
    if (__builtin_expect(__all((pmax - m_reg) * scale <= THR), 1)) { mn = m_reg; alpha = 1.f; }
    else { mn = fmaxf(m_reg, pmax); alpha = __builtin_amdgcn_exp2f((m_reg - mn) * C2); m_reg = mn; }
    const float mnL = -mn * C2;
    for (int r = 0; r < 16; ++r) p0[r] = fmaf(p0[r], C2, mnL); for (int r = 0; r < 16; ++r) p1[r] = fmaf(p1[r], C2, mnL);
    for (int r = 0; r < 16; ++r) p0[r] = __builtin_amdgcn_exp2f(p0[r]);
}
__device__ __forceinline__ void finishSM(f32x16& p0, f32x16& p1, float alpha, float& l_reg, bf16x8& pa0, bf16x8& pa1, bf16x8& pa2, bf16x8& pa3) {
    for (int r = 0; r < 16; ++r) p1[r] = __builtin_amdgcn_exp2f(p1[r]);
    float ps = 0; for (int r = 0; r < 16; ++r) ps += p0[r]; for (int r = 0; r < 16; ++r) ps += p1[r];
    { auto rr = __builtin_amdgcn_permlane32_swap(__float_as_uint(ps), __float_as_uint(ps), false, false);
      ps = __uint_as_float(rr[0]) + __uint_as_float(rr[1]); }
    l_reg = l_reg * alpha + ps;
#define PK4(P, B_, OUT) do { const u32x4 w = {cvtpk(P[B_+0], P[B_+1]), cvtpk(P[B_+2], P[B_+3]), cvtpk(P[B_+4], P[B_+5]), cvtpk(P[B_+6], P[B_+7])};     \
        OUT = *reinterpret_cast<const bf16x8*>(&w); } while (0)
    PK4(p0, 0, pa0); PK4(p0, 8, pa1); PK4(p1, 0, pa2); PK4(p1, 8, pa3);
#undef PK4
}
template <int KB, bool SK, bool PE>
__device__ __forceinline__ void qkt(f32x16& p0, f32x16& p1, const char* lds, int r32, int hi, int wid, int lane, const bf16x8* qr, bool act) {
    if (SK && !act) { const float NEG = -__builtin_inff();
#pragma unroll
        for (int r = 0; r < 16; ++r) { p0[r] = NEG; p1[r] = NEG; } return; }
    p0 = f32x16{}; p1 = f32x16{};
    const char* kb[4];
#pragma unroll
    for (int dd = 0; dd < 4; ++dd) kb[dd] = lds + OFF_K + KB * SHM_K + KSWZ(r32, (dd * 16 + hi * 8) * 2);
#pragma unroll
    for (int d0 = 0; d0 < 8; ++d0) { const char* a = kb[d0 & 3] + (d0 >> 2) * 128;
        bf16x8 b0 = *reinterpret_cast<const bf16x8*>(a);
        bf16x8 b1 = *reinterpret_cast<const bf16x8*>(a + 32 * 256);
        p0 = __builtin_amdgcn_mfma_f32_32x32x16_bf16(b0, qr[d0], p0, 0, 0, 0);
        p1 = __builtin_amdgcn_mfma_f32_32x32x16_bf16(b1, qr[d0], p1, 0, 0, 0); }
    if constexpr (PE) {
        const char* kp = lds + OFF_KPE + KB * SHM_KPE + r32 * KPE_ROW + hi * 16;
        const char* qp = lds + OFF_QPE + wid * 4096 + lane * 16;
#pragma unroll
        for (int d0 = 0; d0 < 4; ++d0) {
            bf16x8 b0 = *reinterpret_cast<const bf16x8*>(kp + d0 * 32);
            bf16x8 b1 = *reinterpret_cast<const bf16x8*>(kp + d0 * 32 + 32 * KPE_ROW);
            bf16x8 qf = *reinterpret_cast<const bf16x8*>(qp + d0 * 1024);
            p0 = __builtin_amdgcn_mfma_f32_32x32x16_bf16(b0, qf, p0, 0, 0, 0);
            p1 = __builtin_amdgcn_mfma_f32_32x32x16_bf16(b1, qf, p1, 0, 0, 0); }
    }
}
template <int VB, bool SK>
__device__ __forceinline__ void pv_tile(f32x16* o, int vb0, bf16x8 pa0, bf16x8 pa1, bf16x8 pa2, bf16x8 pa3, bool act) {
    if (SK && !act) return;
#define TRRD(dst, off) asm volatile("ds_read_b64_tr_b16 %0, %1 offset:%2" : "=&v"(dst) : "v"(vb0), "i"(off) : "memory")
#define PV_D0(d0) do { s16x4 l0, l1, l2, l3, h0, h1, h2, h3; constexpr int b_ = OFF_V + VB * SHM_V + v_rd_off(d0, 0, 0); \
        TRRD(l0, b_); TRRD(h0, b_ + 256); TRRD(l1, b_ + 4096); TRRD(h1, b_ + 4352); TRRD(l2, b_ + 8192); TRRD(h2, b_ + 8448); TRRD(l3, b_ + 12288); TRRD(h3, b_ + 12544); \
        asm volatile("s_waitcnt lgkmcnt(0)" ::: "memory"); SBAR();   \
        o[d0] = __builtin_amdgcn_mfma_f32_32x32x16_bf16((bf16x8){l0[0], l0[1], l0[2], l0[3], h0[0], h0[1], h0[2], h0[3]}, pa0, o[d0], 0, 0, 0);   \
        o[d0] = __builtin_amdgcn_mfma_f32_32x32x16_bf16((bf16x8){l1[0], l1[1], l1[2], l1[3], h1[0], h1[1], h1[2], h1[3]}, pa1, o[d0], 0, 0, 0);   \
        o[d0] = __builtin_amdgcn_mfma_f32_32x32x16_bf16((bf16x8){l2[0], l2[1], l2[2], l2[3], h2[0], h2[1], h2[2], h2[3]}, pa2, o[d0], 0, 0, 0);   \
        o[d0] = __builtin_amdgcn_mfma_f32_32x32x16_bf16((bf16x8){l3[0], l3[1], l3[2], l3[3], h3[0], h3[1], h3[2], h3[3]}, pa3, o[d0], 0, 0, 0); } while (0)
    PV_D0(0); PV_D0(1); PV_D0(2); PV_D0(3);
#undef PV_D0
#undef TRRD
}

struct Prm { int qs, kvs, os, qpes, kpes, lses, skv, W; float scale; };
struct BlockRef { const bf16* Q; const bf16* K; const bf16* V; bf16* O; const bf16* Qpe; const bf16* Kpe; float* Lse; int P0; };
template <bool PE> struct Seam { bf16x8 qr[8]; bf16x8 st_v0, st_v1, st_k0, st_k1, st_kp; };
__device__ __forceinline__ int swa_jlo(int P0, int W) { const int lowk = P0 - W + 1; return lowk > 0 ? lowk / KVBLK : 0; }
#define VMW() asm volatile("s_waitcnt vmcnt(0)" ::: "memory")
#define ATT_G __attribute__((address_space(1)))
#define LDG(base, off) (*(const ATT_G bf16x8*)((const ATT_G char*)(base) + (off)))
#define SLOAD_H(R_, k0) do { const char* kb__ = (const char*)(R_).K + (size_t)(k0) * P.kvs * 2; const char* vb__ = (const char*)(R_).V + (size_t)(k0) * P.kvs * 2; const size_t h__ = (size_t)32 * P.kvs * 2; \
                              S.st_v0 = LDG(vb__, kvoff); S.st_v1 = LDG(vb__ + h__, kvoff); S.st_k0 = LDG(kb__, kvoff); S.st_k1 = LDG(kb__ + h__, kvoff); \
                              if constexpr (PE) S.st_kp = LDG((const char*)(R_).Kpe + (size_t)(k0) * P.kpes * 2, kpoff); } while (0)
#define SWRITE_HK(bf) do { *(bf16x8*)(K_lds + (bf) * SHM_K + kws) = S.st_k0; *(bf16x8*)(K_lds + (bf) * SHM_K + kws + 32 * 256) = S.st_k1; \
                           if constexpr (PE) *(bf16x8*)(lds + OFF_KPE + (bf) * SHM_KPE + pws) = S.st_kp; } while (0)
#define SWRITE_HV(bf) do { *(bf16x8*)(V_lds + (bf) * SHM_V + vst0) = S.st_v0; *(bf16x8*)(V_lds + (bf) * SHM_V + vst1) = S.st_v1; } while (0)
#define SWRITE_H(bf) do { SWRITE_HV(bf); SWRITE_HK(bf); } while (0)
template <bool PE>
__device__ __forceinline__ void swa_prime(const BlockRef& cur, const Prm& P, char* lds, Seam<PE>& S) {
    int tid_ = threadIdx.x; asm volatile("" : "+v"(tid_));
    const int tid = tid_, wid = __builtin_amdgcn_readfirstlane(tid >> 6), lane = tid & 63, r32 = lane & 31, hi = lane >> 5;
    const int sr = tid >> 4, sc = (tid & 15) * 8, kws = KSWZ(sr, sc * 2); char* K_lds = lds + OFF_K;
    const int pr = tid >> 3, pc = (tid & 7) * 8, pws = pr * KPE_ROW + (tid & 7) * 16;
    const unsigned kvoff = (unsigned)(sr * P.kvs + sc) * 2u, kpoff = (unsigned)(pr * P.kpes + pc) * 2u, qoff = (unsigned)((wid * QBLK + r32) * P.qs + hi * 8) * 2u, qpoff = (unsigned)((wid * QBLK + r32) * P.qpes + hi * 8) * 2u;
    const int kb0 = swa_jlo(cur.P0, P.W) * KVBLK;
#pragma unroll
    for (int d0 = 0; d0 < 8; ++d0) S.qr[d0] = LDG(cur.Q, qoff + d0 * 32);
    if constexpr (PE) {
#pragma unroll
        for (int d0 = 0; d0 < 4; ++d0) *(bf16x8*)(lds + OFF_QPE + wid * 4096 + d0 * 1024 + lane * 16) = LDG(cur.Qpe, qpoff + d0 * 32);
    }
    SLOAD_H(cur, kb0); VMW(); SWRITE_HK(0);
    __syncthreads();
}
template <bool PE, bool SK, bool LSE, bool EARLY>
__device__ __forceinline__ void swa_block(const BlockRef& cur, const BlockRef& nxt, const Prm& P, char* lds, Seam<PE>& S) {
    int tid_ = threadIdx.x; asm volatile("" : "+v"(tid_));
    const int tid = tid_, wid = __builtin_amdgcn_readfirstlane(tid >> 6), lane = tid & 63, r32 = lane & 31, hi = lane >> 5;
    const int W = P.W;
    const int j_lo = swa_jlo(cur.P0, W);
    int j_hi = (cur.P0 + QB - 1) / KVBLK + 1; if (j_hi > P.skv / KVBLK) j_hi = P.skv / KVBLK;
    const int NT = j_hi - j_lo;
    const int kbn = swa_jlo(nxt.P0, W) * KVBLK;
    const int qlo = cur.P0 + wid * QBLK, qm = qlo + r32 - 4 * hi;
    char* V_lds = lds + OFF_V; char* K_lds = lds + OFF_K;
    float* ws = (float*)(lds + OFF_WS) + wid * 64; float* li_l = ws, * al_l = ws + 32;
    float m_reg = -1e30f, l_reg = 0; f32x16 o[4] = {};
    const int sr = tid >> 4, sc = (tid & 15) * 8, vst0 = v_st(sr, sc), vst1 = v_st(32 + sr, sc), kws = KSWZ(sr, sc * 2);
    const int pr = tid >> 3, pc = (tid & 7) * 8, pws = pr * KPE_ROW + (tid & 7) * 16;
    const unsigned kvoff = (unsigned)(sr * P.kvs + sc) * 2u, kpoff = (unsigned)(pr * P.kpes + pc) * 2u;
    const int vb0 = (int)(uintptr_t)lds + v_rd_base(lane);
#define RESC(a) do { if (__any((a) < 1.f && l_reg != 0.f)) {        \
                     for (int d_ = 0; d_ < 4; ++d_) for (int r = 0; r < 16; ++r) o[d_][r] *= (a); } } while (0)
#define KBASE(t) ((j_lo + (t)) * KVBLK)
#define ACT(t) (KBASE(t) <= qlo + QBLK - 1 && KBASE(t) + KVBLK - 1 >= qlo - W + 1)
#define MASKT(P0_, P1_, t) do { const int kb_ = KBASE(t); if ((!SK || ACT(t)) && (kb_ + KVBLK - 1 > qlo || kb_ <= qlo + QBLK - 1 - W)) mask_tile(P0_, P1_, qm - kb_, (unsigned)W); } while (0)
    f32x16 pA0, pA1, pB0, pB1; float mnA, mnB, alA, alB; bf16x8 pa0, pa1, pa2, pa3;
    SWRITE_HV(0); SBAR();
    if (NT > 1) { SLOAD_H(cur, KBASE(1)); }
    SBAR(); qkt<0, SK, PE>(pA0, pA1, lds, r32, hi, wid, lane, S.qr, ACT(0));
    MASKT(pA0, pA1, 0); partialSM(pA0, pA1, m_reg, mnA, alA, P.scale);
    if (NT > 1) { VMW(); SWRITE_H(1); }
    __syncthreads();
#define HALF_STEP(PX0, PX1, mnX, alX, PY0, PY1, alY, t, KB, VB, SB) do {                                                      \
        SBAR(); if (EARLY && (t) + 1 < NT) { SLOAD_H(cur, KBASE((t) + 1)); SBAR(); }                                          \
        qkt<KB, SK, PE>(PX0, PX1, lds, r32, hi, wid, lane, S.qr, ACT(t));                                                     \
        finishSM(PY0, PY1, alY, l_reg, pa0, pa1, pa2, pa3); SBAR();                                                           \
        if (!EARLY && (t) + 1 < NT) { SLOAD_H(cur, KBASE((t) + 1)); SBAR(); }                                                 \
        pv_tile<VB, SK>(o, vb0, pa0, pa1, pa2, pa3, ACT((t) - 1)); MASKT(PX0, PX1, (t)); partialSM(PX0, PX1, m_reg, mnX, alX, P.scale); \
        __syncthreads();                                                                                                      \
        if ((t) + 1 < NT) { VMW(); SWRITE_H(SB); }                                                                            \
        RESC(alX); __syncthreads(); } while (0)
    for (int t = 1; t + 1 < NT; t += 2) {
        HALF_STEP(pB0, pB1, mnB, alB, pA0, pA1, alA, t, 1, 0, 0);
        HALF_STEP(pA0, pA1, mnA, alA, pB0, pB1, alB, t + 1, 0, 1, 1);
    }
    const bool even = (NT & 1) == 0;
    if (even) { SBAR(); qkt<1, SK, PE>(pB0, pB1, lds, r32, hi, wid, lane, S.qr, ACT(NT - 1)); SBAR(); }
    SLOAD_H(nxt, kbn); SBAR();
    { const unsigned qoff = (unsigned)((wid * QBLK + r32) * P.qs + hi * 8) * 2u;
#pragma unroll
      for (int d0 = 0; d0 < 8; ++d0) S.qr[d0] = LDG(nxt.Q, qoff + d0 * 32); }
    bf16x8 qpn[4];
    if constexpr (PE) { const unsigned qpoff = (unsigned)((wid * QBLK + r32) * P.qpes + hi * 8) * 2u;
#pragma unroll
        for (int d0 = 0; d0 < 4; ++d0) qpn[d0] = LDG(nxt.Qpe, qpoff + d0 * 32);
    }
    SBAR();
    finishSM(pA0, pA1, alA, l_reg, pa0, pa1, pa2, pa3); SBAR();
    pv_tile<0, SK>(o, vb0, pa0, pa1, pa2, pa3, ACT(even ? NT - 2 : NT - 1));
    if (even) { MASKT(pB0, pB1, NT - 1); partialSM(pB0, pB1, m_reg, mnB, alB, P.scale); __syncthreads(); RESC(alB);
        finishSM(pB0, pB1, alB, l_reg, pa0, pa1, pa2, pa3); SBAR(); pv_tile<1, SK>(o, vb0, pa0, pa1, pa2, pa3, ACT(NT - 1)); }
    SBAR();
    VMW(); SWRITE_HK(0);
    if constexpr (PE) {
#pragma unroll
        for (int d0 = 0; d0 < 4; ++d0) *(bf16x8*)(lds + OFF_QPE + wid * 4096 + d0 * 1024 + lane * 16) = qpn[d0];
    }
    SBAR();
    { const float rl = __builtin_amdgcn_rcpf(l_reg);
      ATT_G char* ob = (ATT_G char*)cur.O + (unsigned)(((wid * QBLK + r32) * P.os + 8 * hi) * 2);
#pragma unroll
      for (int d0 = 0; d0 < 4; ++d0)
#pragma unroll
        for (int j = 0; j < 2; ++j) {
            const unsigned ax = cvtpk(o[d0][8 * j + 0] * rl, o[d0][8 * j + 1] * rl), ay = cvtpk(o[d0][8 * j + 2] * rl, o[d0][8 * j + 3] * rl);
            const unsigned bx = cvtpk(o[d0][8 * j + 4] * rl, o[d0][8 * j + 5] * rl), by = cvtpk(o[d0][8 * j + 6] * rl, o[d0][8 * j + 7] * rl);
            auto rx = __builtin_amdgcn_permlane32_swap(ax, bx, false, false); auto ry = __builtin_amdgcn_permlane32_swap(ay, by, false, false);
            const u32x4 w = {rx[0], ry[0], rx[1], ry[1]};
            *(ATT_G u32x4*)(ob + d0 * 64 + j * 32) = w; } }
    if constexpr (LSE) { if (hi == 0) *(ATT_G float*)((ATT_G char*)cur.Lse + (unsigned)((wid * QBLK + r32) * P.lses) * 4u) = m_reg * P.scale + __logf(l_reg); }
    __syncthreads();
#undef RESC
#undef KBASE
#undef ACT
#undef MASKT
#undef HALF_STEP
}
#undef LDG
#undef ATT_G
#undef VMW
#undef SLOAD_H
#undef SWRITE_HK
#undef SWRITE_HV
#undef SWRITE_H
#undef KSWZ
#undef SBAR
}
constexpr int NWAVES = 8;
constexpr int BATCH = 4, SEQ = 4096, DM = 2048, M = BATCH * SEQ;
constexpr int NQKVA = 1280;
constexpr int NQB = 3072, NKVB = 4096, NDIL = 18432, FF = 5632, NUP = 2 * FF;
constexpr float EPS = 1e-6f;
constexpr size_t MiB = (size_t)1 << 20;
constexpr size_t WS_CTL = 0, CTL_ZERO_BYTES = 64 * 1024;
constexpr size_t WS_COSM = 1 * MiB, WS_SINM = 3 * MiB, WS_COSD = 5 * MiB, WS_SIND = 6 * MiB;
constexpr size_t WS_CWS = 7 * MiB;
constexpr size_t WS_WMLA = 8 * MiB, WMLA_STRIDE = 20 * MiB, WMLA_QKVA = 0, WMLA_QB = 5 * MiB, WMLA_KVB = 8 * MiB, WMLA_WO = 12 * MiB;
constexpr size_t WS_WDIL = WS_WMLA + 2 * WMLA_STRIDE, WDIL_STRIDE = 80 * MiB, WDIL_IN = 0, WDIL_WO = 72 * MiB;
constexpr size_t WS_WFFN = WS_WDIL + 2 * WDIL_STRIDE, WFFN_STRIDE = 66 * MiB, WFFN_UP = 0, WFFN_DOWN = 44 * MiB;
constexpr size_t WS_H = WS_WFFN + 4 * WFFN_STRIDE;
constexpr size_t WS_S = WS_H + 64 * MiB;
constexpr size_t S_PQ = 0  , S_QN = 80 * MiB, S_CKVN = 96 * MiB, S_KPE = 112 * MiB, S_Q = 114 * MiB, S_KV = 210 * MiB, S_AO_MLA = 338 * MiB;
constexpr size_t S_QKV = 0, S_OG = 576 * MiB, S_LSE = 768 * MiB, S_AO_DIL = 771 * MiB;
constexpr size_t S_U = 0, S_ACT = 352 * MiB;
constexpr size_t WS_HALO = WS_S + 835 * MiB, WS_FIX = WS_HALO + 6 * MiB;
constexpr size_t WS_PS = WS_FIX + 6 * MiB, PS_STRIDE = 2 * MiB;
constexpr size_t WS_END = WS_PS + 8 * PS_STRIDE;
static_assert(WS_H == 472 * MiB && WS_END == 1399 * MiB, "d_ws map");
constexpr int CW_PX = 1280;
constexpr int CW_PB2 = 1536, CW_PB3 = 1664;
constexpr int CW_PB = 1024;
constexpr int CW_BAR = 4096;
constexpr int RING_OFF = 0, RING_BYTES = 131072, LDSCTL_OFF = RING_BYTES, MISC_OFF = LDSCTL_OFF + 320, XH_OFF = RING_BYTES + 1024  , CWL_OFF = XH_OFF + 6144  , RSL_OFF = CWL_OFF + 8192  , RSQ_OFF = RSL_OFF + 1024  , LDS_BYTES = 163840;
static_assert(RSQ_OFF + 2048 <= LDS_BYTES, "LDS map");
static_assert(att::LDS_BYTES <= RING_BYTES && pg8::STAGE_BYTES <= RING_BYTES, "LDS map");

#define GAS __attribute__((address_space(1)))
#define LAS __attribute__((address_space(3)))
typedef unsigned short bf16;
typedef unsigned v4u __attribute__((ext_vector_type(4)));
typedef unsigned v2u __attribute__((ext_vector_type(2)));
typedef float f32x4 __attribute__((ext_vector_type(4)));
typedef GAS unsigned gu32;
#define RLX_AGENT __ATOMIC_RELAXED, __HIP_MEMORY_SCOPE_AGENT
#define LDS_WAIT() asm volatile("s_waitcnt lgkmcnt(0)" ::: "memory")
__device__ __forceinline__ unsigned pk2(float lo, float hi) { return pg8::cvt_pk_bf16(lo, hi); }
__device__ __forceinline__ float bf_lo(unsigned w) { return __uint_as_float(w << 16); }
__device__ __forceinline__ float bf_hi(unsigned w) { return __uint_as_float(w & 0xffff0000u); }

#define XB_TMO      128
#define XB_XCNT(j)  (256  + 64 * (j))
#define XB_XSUB(j)  (1280 + 64 * (j))
#define XB_XGEN(j)  (2304 + 64 * (j))
#define XB_TOP      3328
#define XB_TOPGEN   3392
#define XCD_BAR_WORDS 3456
#define XB_SPIN_CAP (1u << 18)

__device__ __forceinline__ unsigned xb_ld(unsigned* p)              { return __hip_atomic_load(p, __ATOMIC_RELAXED, __HIP_MEMORY_SCOPE_AGENT); }
__device__ __forceinline__ unsigned xb_add(unsigned* p, unsigned v) { return __hip_atomic_fetch_add(p, v, __ATOMIC_RELAXED, __HIP_MEMORY_SCOPE_AGENT); }
__device__ __forceinline__ unsigned xb_xcc_id() { return (unsigned)__builtin_amdgcn_s_getreg((3 << 11) | 20) & 0xFu; }
#define XB_SPIN(cond, bar) do { unsigned _sp = 0; while (cond) { __builtin_amdgcn_s_sleep(1); \
    if ((++_sp & 255u) == 0u) { if (xb_ld(&(bar)[XB_TMO])) break; if (_sp > XB_SPIN_CAP) { atomicAdd(&(bar)[XB_TMO], 1u); break; } } } } while (0)

struct XcdBarrier {
    unsigned* bar; unsigned x;
    volatile LAS unsigned* st;
};

__device__ __forceinline__ XcdBarrier xcd_barrier_post(unsigned* bar, volatile LAS unsigned* st) {
    XcdBarrier b; b.bar = bar; b.x = xb_xcc_id(); b.st = st;
    if (threadIdx.x == 0) (void)xb_add(&bar[XB_XCNT(b.x)], 1u);
    return b;
}
__device__ __forceinline__ void xcd_barrier_complete(unsigned* bar, unsigned x, unsigned& nloc, unsigned& nx) {
    const unsigned G = gridDim.x * gridDim.y * gridDim.z;
    unsigned sum, cnt, mine, sp = 0u;
    for (;;) {
        sum = 0u; cnt = 0u; mine = 0u;
#pragma unroll
        for (unsigned j = 0; j < 16; ++j) { const unsigned c = xb_ld(&bar[XB_XCNT(j)]); sum += c; cnt += (c > 0u) ? 1u : 0u; mine = (j == x) ? c : mine; }
        if (sum == G) break;
        __builtin_amdgcn_s_sleep(1);
        if ((++sp & 255u) == 0u) { if (xb_ld(&bar[XB_TMO])) break; if (sp > XB_SPIN_CAP) { atomicAdd(&bar[XB_TMO], 1u); break; } }
    }
    nloc = mine > 0u ? mine : 1u; nx = cnt > 0u ? cnt : 1u;
}

__device__ __forceinline__ void xcd_barrier(const XcdBarrier& b) {
    asm volatile("s_waitcnt vmcnt(0)" ::: "memory");
    __syncthreads();
    if (threadIdx.x == 0) {
        __attribute__((address_space(1))) unsigned* barg_ = (__attribute__((address_space(1))) unsigned*)b.bar; unsigned bx_ = b.x;
        asm volatile("" : "+s"(barg_), "+s"(bx_)); unsigned* bar = (unsigned*)barg_;
        __builtin_amdgcn_s_waitcnt(0);
        unsigned nloc = b.st[0], nx = b.st[1];
        if (nloc == 0u) { xcd_barrier_complete(bar, bx_, nloc, nx); b.st[0] = nloc; b.st[1] = nx; }
        const unsigned old = xb_add(&bar[XB_XSUB(bx_)], 1u);
        const unsigned gen = old / nloc;
        if (old + 1u == (gen + 1u) * nloc) {
            __builtin_amdgcn_fence(__ATOMIC_RELEASE, "agent");
            asm volatile("s_waitcnt vmcnt(0)" ::: "memory");
            const unsigned og = xb_add(&bar[XB_TOP], 1u);
            const unsigned tg = og / nx;
            if (og + 1u == (tg + 1u) * nx) xb_add(&bar[XB_TOPGEN], 1u);
            else XB_SPIN(xb_ld(&bar[XB_TOPGEN]) == tg, bar);
            __builtin_amdgcn_fence(__ATOMIC_ACQUIRE, "agent");
            xb_add(&bar[XB_XGEN(bx_)], 1u);
            asm volatile("s_waitcnt vmcnt(0)" ::: "memory");
        } else {
            XB_SPIN(xb_ld(&bar[XB_XGEN(bx_)]) == gen, bar);
            __builtin_amdgcn_fence(__ATOMIC_ACQUIRE, "agent");
            asm volatile("s_waitcnt vmcnt(0)" ::: "memory");
        }
    }
    __syncthreads();
}


__device__ __forceinline__ const void* karg(int k) {
    const __attribute__((address_space(4))) char* kp = (const __attribute__((address_space(4))) char*)__builtin_amdgcn_kernarg_segment_ptr();
    asm volatile("" : "+s"(kp));
    return *(const void* const __attribute__((address_space(4)))*)(kp + 8 * k);
}
#define LANE_IDS() int tid_ = threadIdx.x; asm volatile("" : "+v"(tid_)); const int tid = tid_, lane = tid & 63, wave = __builtin_amdgcn_readfirstlane(tid >> 6); (void)tid; (void)lane; (void)wave
struct Frame {
    LAS unsigned char* lds;
    volatile LAS unsigned* MISC;
    gu32* ctl;
    int vcu, G;
    float* out; unsigned char* wsb;
};
#define SWZ_XOR(v, m) __uint_as_float((unsigned)__builtin_amdgcn_ds_swizzle((int)__float_as_uint(v), (((m) << 10) | 0x1f)))
__device__ __forceinline__ float xor32(float v) { auto rr = __builtin_amdgcn_permlane32_swap(__float_as_uint(v), __float_as_uint(v), false, false); return __uint_as_float((threadIdx.x & 32) ? rr[0] : rr[1]); }
__device__ __forceinline__ float xor1(float v) { return __uint_as_float((unsigned)__builtin_amdgcn_update_dpp(0, (int)__float_as_uint(v), 0xB1, 0xF, 0xF, true)); }
__device__ __forceinline__ float wave_sum(float v) {
    v += SWZ_XOR(v, 1); v += SWZ_XOR(v, 2); v += SWZ_XOR(v, 4); v += SWZ_XOR(v, 8); v += SWZ_XOR(v, 16);
    auto rr = __builtin_amdgcn_permlane32_swap(__float_as_uint(v), __float_as_uint(v), false, false);
    return __uint_as_float(rr[0]) + __uint_as_float(rr[1]);
}
__device__ __forceinline__ float dot4(const f32x4 a) { return (a.x * a.x + a.y * a.y) + (a.z * a.z + a.w * a.w); }

template <int KIND> __device__ __forceinline__ int dest_row(int n) {
    if constexpr (KIND == 0) return n;
    else if constexpr (KIND == 3) return n < 544 ? n : n + 96;
    else if constexpr (KIND == 4) { const int v = n >= FF, c = v ? n - FF : n; return 256 * (c >> 7) + 128 * v + (c & 127); }
    else if constexpr (KIND == 1) {
        const int h = n / 192, d = n - h * 192;
        if (d < 128) return h * 128 + d;
        const int i = d - 128, t = h >> 2, hh = h & 3;
        return 2048 + 256 * t + 32 * hh + (i < 32 ? i : 128 + (i - 32));
    } else {
        const int g = n / 6144, r = n - g * 6144, t = r >> 11, r2 = r & 2047, h = r2 >> 7, d = r2 & 127;
        if (t == 2) return n;
        const int T = h >> 1, hh = h & 1;
        const int tc = d < 16 ? 16 * hh + d : (d < 32 ? 128 + 16 * hh + (d - 16) : hh * 128 + d);
        return g * 6144 + t * 2048 + T * 256 + tc;
    }
}
template <int KIND, bool GAIN> __device__ __forceinline__ void p0_transpose_item(const float* W, const float* gain, int K, int N, bf16* WT, int row_off, LAS float* scr, int item, int lane) {
    const int nblk = N / 32, kb = item / nblk, nb = item - kb * nblk, k0 = 64 * kb, n0 = 32 * nb;
#pragma unroll 8
    for (int i = 0; i < 32; ++i) { const int kk = 2 * i + (lane >> 5); scr[kk * 33 + (lane & 31)] = __builtin_nontemporal_load((const GAS float*)(W + (size_t)(k0 + kk) * N + n0 + (lane & 31))); }
    LDS_WAIT(); asm volatile("" ::: "memory");
    const int c = lane & 7;
    f32x4 g0 = {1.f, 1.f, 1.f, 1.f}, g1 = g0;
    if constexpr (GAIN) { g0 = *(const f32x4*)(gain + k0 + 8 * c); g1 = *(const f32x4*)(gain + k0 + 8 * c + 4); }
#pragma unroll
    for (int j = 0; j < 4; ++j) { const int n = (lane >> 3) + 8 * j; const LAS float* s = scr + (8 * c) * 33 + n;
        v4u o; o.x = pk2(s[0 * 33] * g0.x, s[1 * 33] * g0.y); o.y = pk2(s[2 * 33] * g0.z, s[3 * 33] * g0.w); o.z = pk2(s[4 * 33] * g1.x, s[5 * 33] * g1.y); o.w = pk2(s[6 * 33] * g1.z, s[7 * 33] * g1.w);
        *(GAS v4u*)(WT + (size_t)(row_off + dest_row<KIND>(n0 + n)) * K + k0 + 8 * c) = o; }
    LDS_WAIT(); asm volatile("" ::: "memory");
}
__device__ const double kRopeRev[32] = {
    0.15915494309189535, 0.10561541722123227, 0.0700865215877985, 0.046509502471476706, 0.03086376340470123, 0.020481231595318977, 0.013591370636193905, 0.009019250376164549,
    0.005985185712713705, 0.00397177664679776, 0.002635675898667414, 0.001749037788521446, 0.001160663641240061, 0.0007702178288757531, 0.0005111175045375439, 0.00033917820861925017,
    0.00022507907903927653, 0.00014936275542995963, 9.911730936901935e-05, 6.577436917438735e-05, 4.364795279280289e-05, 2.8964835496204437e-05, 1.9221100684944863e-05, 1.2755146204410543e-05,
    8.464330808241401e-06, 5.616940400618127e-06, 3.727408601915352e-06, 2.473512961630074e-06, 1.6414262627950345e-06, 1.0892524995776498e-06, 7.228293068832865e-07, 4.796704226907546e-07};

__device__ __forceinline__ void norm_rows_bf16(Frame& F, const float* src, const float* gain, bf16* dst) {
    LANE_IDS();
    const int gw = F.vcu * NWAVES + wave, NGW = F.G * NWAVES;
    f32x4 g[8];
#pragma unroll
    for (int j = 0; j < 8; ++j) g[j] = *(const f32x4*)(gain + 4 * lane + 256 * j);
    for (int m = gw; m < M; m += NGW) {
        const GAS f32x4* xr = (const GAS f32x4*)(src + (size_t)m * DM) + lane;
        f32x4 v[8]; float s = 0.f;
#pragma unroll
        for (int j = 0; j < 8; ++j) { v[j] = xr[64 * j]; s += dot4(v[j]); }
        const float r = 1.0f / sqrtf(wave_sum(s) * (1.0f / DM) + EPS);
        GAS v2u* o8 = (GAS v2u*)(dst + (size_t)m * DM) + lane;
#pragma unroll
        for (int j = 0; j < 8; ++j) { const f32x4 y = (v[j] * r) * g[j]; v2u w; w.x = pk2(y.x, y.y); w.y = pk2(y.z, y.w); o8[64 * j] = w; }
    }
}
__device__ __forceinline__ void norm_rows_bf16_to_f32(Frame& F, const bf16* X, const float* gain, float* out) {
    LANE_IDS();
    const int gw = F.vcu * NWAVES + wave, NGW = F.G * NWAVES;
    f32x4 g[8];
#pragma unroll
    for (int j = 0; j < 4; ++j) { g[2 * j] = *(const GAS f32x4*)(gain + 8 * lane + 512 * j); g[2 * j + 1] = *(const GAS f32x4*)(gain + 8 * lane + 512 * j + 4); }
    for (int m = gw; m < M; m += NGW) {
        const GAS v4u* xr = (const GAS v4u*)(X + (size_t)m * DM + 8 * lane);
        f32x4 v[8]; float s = 0.f;
#pragma unroll
        for (int j = 0; j < 4; ++j) { const v4u w = xr[64 * j];
            v[2 * j] = (f32x4){bf_lo(w.x), bf_hi(w.x), bf_lo(w.y), bf_hi(w.y)}; v[2 * j + 1] = (f32x4){bf_lo(w.z), bf_hi(w.z), bf_lo(w.w), bf_hi(w.w)};
            s += dot4(v[2 * j]) + dot4(v[2 * j + 1]); }
        const float r = 1.0f / sqrtf(wave_sum(s) * (1.0f / DM) + EPS);
        GAS f32x4* o = (GAS f32x4*)(out + (size_t)m * DM + 8 * lane);
#pragma unroll
        for (int j = 0; j < 4; ++j) { o[128 * j] = (v[2 * j] * r) * g[2 * j]; o[128 * j + 1] = (v[2 * j + 1] * r) * g[2 * j + 1]; }
    }
}
__device__ __forceinline__ void norm_rows_f32_inplace(Frame& F, float* x, const float* gain) {
    LANE_IDS();
    const int gw = F.vcu * NWAVES + wave, NGW = F.G * NWAVES;
    f32x4 g[8];
#pragma unroll
    for (int j = 0; j < 8; ++j) g[j] = *(const f32x4*)(gain + 4 * lane + 256 * j);
    for (int m = gw; m < M; m += NGW) {
        GAS f32x4* xr = (GAS f32x4*)(x + (size_t)m * DM) + lane;
        f32x4 v[8]; float s = 0.f;
#pragma unroll
        for (int j = 0; j < 8; ++j) { v[j] = xr[64 * j]; s += dot4(v[j]); }
        const float r = 1.0f / sqrtf(wave_sum(s) * (1.0f / DM) + EPS);
#pragma unroll
        for (int j = 0; j < 8; ++j) xr[64 * j] = (v[j] * r) * g[j];
    }
}

__device__ __forceinline__ void p0_prologue(Frame& F) {
    LANE_IDS();
    LAS float* scr = (LAS float*)(F.lds + RING_OFF + wave * 16384);
    const int gw = F.vcu * NWAVES + wave, NGW = F.G * NWAVES;
    unsigned char* ws = F.wsb;
    constexpr int I0 = 32 * 16, I1 = 32 * 18, I2 = 8 * 96, I3 = 8 * 128, I4 = 32 * 64, I5 = 32 * 576, I6 = 32 * 64, I7 = 32 * 352, I8 = 88 * 64;
    constexpr int NITEMS = 2 * (I0 + I1 + I2 + I3 + I4 + I5 + I6) + 4 * (I7 + I8);
    for (int it = gw; it < NITEMS; it += NGW) {
        int r = it;
        if (r < 2 * I5) { const int l = r / I5; p0_transpose_item<2, true>((const float*)karg(12) + (size_t)l * DM * NDIL, (const float*)karg(2) + (2 * l + 1) * DM, DM, NDIL, (bf16*)(ws + WS_WDIL + l * WDIL_STRIDE + WDIL_IN), 0, scr, r - l * I5, lane); continue; } r -= 2 * I5;
        if (r < 4 * I7) { const int l = r / I7; p0_transpose_item<4, true>((const float*)karg(14) + (size_t)l * DM * NUP, (const float*)karg(3) + l * DM, DM, NUP, (bf16*)(ws + WS_WFFN + l * WFFN_STRIDE + WFFN_UP), 0, scr, r - l * I7, lane); continue; } r -= 4 * I7;
        if (r < 4 * I8) { const int l = r / I8; p0_transpose_item<0, false>((const float*)karg(17) + (size_t)l * FF * DM, nullptr, FF, DM, (bf16*)(ws + WS_WFFN + l * WFFN_STRIDE + WFFN_DOWN), 0, scr, r - l * I8, lane); continue; } r -= 4 * I8;
        if (r < 2 * I6) { const int l = r / I6; p0_transpose_item<0, false>((const float*)karg(13) + (size_t)l * DM * DM, nullptr, DM, DM, (bf16*)(ws + WS_WDIL + l * WDIL_STRIDE + WDIL_WO), 0, scr, r - l * I6, lane); continue; } r -= 2 * I6;
        if (r < 2 * I4) { const int l = r / I4; p0_transpose_item<0, false>((const float*)karg(11) + (size_t)l * DM * DM, nullptr, DM, DM, (bf16*)(ws + WS_WMLA + l * WMLA_STRIDE + WMLA_WO), 0, scr, r - l * I4, lane); continue; } r -= 2 * I4;
        if (r < 2 * I3) { const int l = r / I3; p0_transpose_item<0, true>((const float*)karg(10) + (size_t)l * 512 * NKVB, (const float*)karg(9) + l * 512, 512, NKVB, (bf16*)(ws + WS_WMLA + l * WMLA_STRIDE + WMLA_KVB), 0, scr, r - l * I3, lane); continue; } r -= 2 * I3;
        if (r < 2 * I2) { const int l = r / I2; p0_transpose_item<1, true>((const float*)karg(7) + (size_t)l * 512 * NQB, (const float*)karg(6) + l * 512, 512, NQB, (bf16*)(ws + WS_WMLA + l * WMLA_STRIDE + WMLA_QB), 0, scr, r - l * I2, lane); continue; } r -= 2 * I2;
        if (r < 2 * I1) { const int l = r / I1; p0_transpose_item<3, true>((const float*)karg(8) + (size_t)l * DM * 576, (const float*)karg(2) + (2 * l) * DM, DM, 576, (bf16*)(ws + WS_WMLA + l * WMLA_STRIDE + WMLA_QKVA), 512, scr, r - l * I1, lane); continue; } r -= 2 * I1;
        { const int l = r / I0; p0_transpose_item<0, true>((const float*)karg(5) + (size_t)l * DM * 512, (const float*)karg(2) + (2 * l) * DM, DM, 512, (bf16*)(ws + WS_WMLA + l * WMLA_STRIDE + WMLA_QKVA), 0, scr, r - l * I0, lane); }
    }
    const int gt = F.vcu * (NWAVES * 64) + tid, NGT = F.G * NWAVES * 64;
    for (int i = gt; i < 2 * 192 * DM / 8; i += NGT) { const int l = i / (192 * DM / 8), e = i - l * (192 * DM / 8), rr = e / (DM / 8), cc = e - rr * (DM / 8), row = rr < 96 ? 1056 + rr : 1184 + (rr - 96);
        *((GAS v4u*)(ws + WS_WMLA + l * WMLA_STRIDE + WMLA_QKVA + (size_t)row * DM * 2) + cc) = (v4u){0u, 0u, 0u, 0u}; }
    { const float* cw = (const float*)karg(15); const float* cb = (const float*)karg(16); float* cws = (float*)(ws + WS_CWS);
      for (int i = gt; i < 4 * 4 * NUP; i += NGT) { const int l = i / (4 * NUP), r = i - l * 4 * NUP, t = r / NUP, ch = r - t * NUP;
          cws[i] = (t < 3 ? cw[((size_t)l * 3 + t) * NUP + ch] : cb[(size_t)l * NUP + ch]) * (ch < FF ? 1.4426950408889634f : 0.6931471805599453f); } }
    const int* pos = (const int*)karg(1);
    for (int i = gt; i < M * 32; i += NGT) { const int row = i >> 5, k = i & 31;
        const double rev = (double)pos[row] * kRopeRev[k]; const float fr = (float)(rev - __builtin_rint(rev));
        const float c = __builtin_amdgcn_cosf(fr), s = __builtin_amdgcn_sinf(fr);
        ((float*)(ws + WS_COSM))[i] = c; ((float*)(ws + WS_SINM))[i] = s;
        if ((k & 1) == 0) { ((float*)(ws + WS_COSD))[row * 16 + (k >> 1)] = c; ((float*)(ws + WS_SIND))[row * 16 + (k >> 1)] = s; } }
    { const int gwv = F.vcu * NWAVES + wave, NGWv = F.G * NWAVES; const float* x = (const float*)karg(0); bf16* XB = (bf16*)(ws + WS_H); float* ps0 = (float*)(ws + WS_PS);
      for (int m = gwv; m < M; m += NGWv) {
        const GAS f32x4* xr = (const GAS f32x4*)(x + (size_t)m * DM) + lane; f32x4 v[8]; float s = 0.f;
#pragma unroll
        for (int j = 0; j < 8; ++j) { v[j] = xr[64 * j]; s += dot4(v[j]); }
        s = wave_sum(s);
        GAS v2u* o8 = (GAS v2u*)(XB + (size_t)m * DM) + lane;
#pragma unroll
        for (int j = 0; j < 8; ++j) { v2u w; w.x = pk2(v[j].x, v[j].y); w.y = pk2(v[j].z, v[j].w); o8[64 * j] = w; }
        if (lane < 32) ps0[(size_t)m * 32 + lane] = lane == 0 ? s : 0.f; } }
}

__device__ __forceinline__ void dil_merge(Frame& F, int row_first) {
    LANE_IDS();
    unsigned char* ws = F.wsb;
    const bf16* OG = (const bf16*)(ws + WS_S + S_OG); const GAS float* LSE = (const GAS float*)(ws + WS_S + S_LSE); bf16* AO = (bf16*)(ws + WS_S + S_AO_DIL);
    for (int m = row_first + wave; m < row_first + 64; m += NWAVES) {
        const int b = m >> 12, s = m & (SEQ - 1);
        const size_t sp0 = s, sp1 = (size_t)(s & 3) * (SEQ / 4) + (s >> 2), sp2 = (size_t)(s & 15) * (SEQ / 16) + (s >> 4);
#pragma unroll
        for (int j = 0; j < 4; ++j) { const int col = 8 * lane + 512 * j, head = col >> 7, dim = col & 127;
            const size_t r0 = ((size_t)(0 * 16 + head) * BATCH + b) * SEQ + sp0, r1 = ((size_t)(1 * 16 + head) * BATCH + b) * SEQ + sp1, r2 = ((size_t)(2 * 16 + head) * BATCH + b) * SEQ + sp2;
            const float l0 = LSE[r0], l1 = LSE[r1], l2 = LSE[r2];
            const float mx = fmaxf(l0, fmaxf(l1, l2)); float e0 = __expf(l0 - mx), e1 = __expf(l1 - mx), e2 = __expf(l2 - mx);
            const float inv = 1.0f / (e0 + e1 + e2); e0 *= inv; e1 *= inv; e2 *= inv;
            const v4u a = *(const GAS v4u*)(OG + r0 * 128 + dim), bb = *(const GAS v4u*)(OG + r1 * 128 + dim), c = *(const GAS v4u*)(OG + r2 * 128 + dim);
            v4u w;
#pragma unroll
            for (int q = 0; q < 4; ++q) w[q] = pk2(e0 * bf_lo(a[q]) + e1 * bf_lo(bb[q]) + e2 * bf_lo(c[q]), e0 * bf_hi(a[q]) + e1 * bf_hi(bb[q]) + e2 * bf_hi(c[q]));
            *(GAS v4u*)(AO + (size_t)m * DM + col) = w; }
    }
}

__device__ __forceinline__ void panel_barrier(Frame& F, gu32* word, bool same_xcd) {
    asm volatile("s_waitcnt vmcnt(0)" ::: "memory");
    __syncthreads();
    if (threadIdx.x == 0) {
        if (!same_xcd) { __builtin_amdgcn_fence(__ATOMIC_RELEASE, "agent"); asm volatile("s_waitcnt vmcnt(0)" ::: "memory"); }
        (void)__hip_atomic_fetch_add((unsigned*)word, 1u, __ATOMIC_RELAXED, __HIP_MEMORY_SCOPE_AGENT);
        unsigned sp = 0u;
        while (__hip_atomic_load((unsigned*)word, __ATOMIC_RELAXED, __HIP_MEMORY_SCOPE_AGENT) < 4u) { __builtin_amdgcn_s_sleep(1); if (++sp > (1u << 22)) break; }
        __builtin_amdgcn_fence(__ATOMIC_ACQUIRE, "agent");
        asm volatile("s_waitcnt vmcnt(0)" ::: "memory");
    }
    __syncthreads();
}

__device__ __forceinline__ void ffn_fixup(Frame& F, int layer, int pm) {
    LANE_IDS();
    if ((pm & 15) == 0) return;
    unsigned char* ws = F.wsb;
    const float* HALO = (const float*)(ws + WS_HALO); const float* FIX = (const float*)(ws + WS_FIX); bf16* ACT = (bf16*)(ws + WS_S + S_ACT);
    const float* cw = (const float*)karg(15) + (size_t)layer * 3 * NUP;
    for (int idx = tid; idx < 2 * (FF / 8); idx += NWAVES * 64) { const int rs = idx / (FF / 8), ch = (idx - rs * (FF / 8)) * 8;
        float o[8];
#pragma unroll
        for (int e = 0; e < 8; e += 4) {
            f32x4 cg = *(const GAS f32x4*)(FIX + ((size_t)pm * 2 + rs) * NUP + ch + e), cv = *(const GAS f32x4*)(FIX + ((size_t)pm * 2 + rs) * NUP + FF + ch + e);
            const f32x4 u1g = *(const GAS f32x4*)(HALO + ((size_t)(pm - 1) * 2 + 1) * NUP + ch + e), u1v = *(const GAS f32x4*)(HALO + ((size_t)(pm - 1) * 2 + 1) * NUP + FF + ch + e);
            const f32x4 u2g = *(const GAS f32x4*)(HALO + ((size_t)(pm - 1) * 2 + 0) * NUP + ch + e), u2v = *(const GAS f32x4*)(HALO + ((size_t)(pm - 1) * 2 + 0) * NUP + FF + ch + e);
            const f32x4 w0g = *(const f32x4*)(cw + ch + e), w0v = *(const f32x4*)(cw + FF + ch + e), w1g = *(const f32x4*)(cw + NUP + ch + e), w1v = *(const f32x4*)(cw + NUP + FF + ch + e);
            if (rs == 0) { cg = cg + w1g * u1g + w0g * u2g; cv = cv + w1v * u1v + w0v * u2v; } else { cg = cg + w0g * u1g; cv = cv + w0v * u1v; }
#pragma unroll
            for (int k = 0; k < 4; ++k) o[e + k] = cg[k] * __builtin_amdgcn_rcpf(1.0f + __builtin_amdgcn_exp2f(-1.4426950408889634f * cg[k])) * cv[k]; }
        v4u w; w.x = pk2(o[0], o[1]); w.y = pk2(o[2], o[3]); w.z = pk2(o[4], o[5]); w.w = pk2(o[6], o[7]);
        *(GAS v4u*)(ACT + ((size_t)pm * 256 + rs) * FF + ch) = w; }
}

__device__ __forceinline__ void row_scale_table(Frame& F, const float* ps, int pm) {
    LANE_IDS();
    LAS float* rsl = (LAS float*)(F.lds + RSL_OFF);
    if (tid < 256) { const GAS f32x4* p = (const GAS f32x4*)(ps + ((size_t)pm * 256 + tid) * 32); float s = 0.f;
#pragma unroll
        for (int i = 0; i < 8; ++i) { const f32x4 a = p[i]; s += (a.x + a.y) + (a.z + a.w); }
        rsl[tid] = __builtin_amdgcn_rsqf(s * (1.0f / DM) + EPS); }
    __syncthreads();
}

__device__ __forceinline__ void row_scale_table2(Frame& F, const float* pq, int pm) {
    LANE_IDS();
    LAS float* rsq = (LAS float*)(F.lds + RSQ_OFF);
    if (tid < 256) { const GAS f32x4* p = (const GAS f32x4*)(pq + ((size_t)pm * 256 + tid) * 16);
        const f32x4 a = p[0], b = p[1], c = p[2], d = p[3];
        rsq[tid] = __builtin_amdgcn_rsqf((((a.x + a.y) + (a.z + a.w)) + ((b.x + b.y) + (b.z + b.w))) * (1.0f / 512) + EPS);
        rsq[256 + tid] = __builtin_amdgcn_rsqf((((c.x + c.y) + (c.z + c.w)) + ((d.x + d.y) + (d.z + d.w))) * (1.0f / 512) + EPS); }
    __syncthreads();
}

struct MlaRef {
    const bf16* Q; const bf16* KV; const bf16* KPE; bf16* AO; int vcu;
    __device__ __forceinline__ att::BlockRef operator()(int i) const {
        const int I = vcu + 256 * (i >> 1), bh = I >> 3, x = I & 7, qb = (i & 1) ? 15 - x : x, b = bh >> 4, h = bh & 15;
        const size_t row0 = (size_t)b * SEQ + (size_t)qb * 256;
        att::BlockRef r; r.Q = Q + row0 * NQB + h * 128; r.Qpe = Q + row0 * NQB + 2048 + h * 64;
        r.K = KV + (size_t)bh * SEQ * 128; r.V = r.K + (size_t)M * DM; r.Kpe = KPE + (size_t)b * SEQ * 64;
        r.O = AO + row0 * DM + h * 128; r.Lse = nullptr; r.P0 = qb * 256; return r;
    }
};
struct DilRef {
    const bf16* QKV; bf16* OG; float* LSE; int vcu, g;
    __device__ __forceinline__ att::BlockRef operator()(int i) const {
        const int I = vcu + 256 * i, sh = 2 * g, d = 1 << sh, nqbs = 4 - sh;
        const int seq = I >> nqbs, qb = (I + ((i << nqbs) >> 2)) & ((1 << nqbs) - 1), h = seq & 15, br = seq >> 4, rr = br & (d - 1), b = br >> sh;
        const size_t sp0 = (size_t)rr * (SEQ >> sh), spq = sp0 + (size_t)qb * 256;
        const size_t hb = ((size_t)(g * 3) * 16 + h) * BATCH + b, tstep = (size_t)16 * BATCH * SEQ * 128;
        att::BlockRef r; r.Q = QKV + (hb * SEQ + spq) * 128; r.Qpe = nullptr; r.Kpe = nullptr;
        r.K = QKV + tstep + (hb * SEQ + sp0) * 128; r.V = r.K + tstep;
        const size_t ob = ((size_t)g * 16 + h) * BATCH + b;
        r.O = OG + (ob * SEQ + spq) * 128; r.Lse = LSE + ob * SEQ + spq; r.P0 = qb * 256; return r;
    }
};
template <bool PE, bool SK, bool LSE, bool EARLY, class RefFn>
__device__ __forceinline__ void attn_run(char* lds, const att::Prm& P, int n, const RefFn& ref) {
    att::BlockRef cur = ref(0); att::Seam<PE> S;
    att::swa_prime<PE>(cur, P, lds, S);
    for (int i = 0;; ++i) {
        const bool last = i + 1 >= n;
        const att::BlockRef nxt = last ? cur : ref(i + 1);
        att::swa_block<PE, SK, LSE, EARLY>(cur, nxt, P, lds, S);
        if (last) break;
        cur = nxt;
    }
}

struct Args { const void* in[18]; float* out; unsigned char* ws; };
__global__ void __launch_bounds__(NWAVES * 64, 2) fwd_kernel(Args args) {
    extern __shared__ __attribute__((aligned(16))) unsigned char lds[];
    Frame F;
    F.lds = (LAS unsigned char*)lds;
    F.MISC = (volatile LAS unsigned*)(F.lds + MISC_OFF);
    F.G = gridDim.x; { const int bx = blockIdx.x; F.vcu = (F.G % 8 == 0) ? (bx % 8) * (F.G / 8) + bx / 8 : bx; }
        F.out = args.out; F.wsb = args.ws;
    F.ctl = (gu32*)(args.ws + WS_CTL);
#define ws F.wsb
#define RELAUNDER() asm volatile("" : "+s"(F.vcu), "+s"(F.wsb), "+s"(F.out))
    for (int u = threadIdx.x; u < (LDS_BYTES - LDSCTL_OFF) / 4; u += NWAVES * 64) ((LAS unsigned*)(F.lds + LDSCTL_OFF))[u] = 0u;
    __syncthreads();
    XcdBarrier bar = xcd_barrier_post((unsigned*)(F.ctl + CW_BAR), F.MISC + 8);
#define GRID_BAR() xcd_barrier(bar)
    typedef pg8::StaticOrder SO;
#define GEMMR(EpiT, Aptr, Bptr, N_, K_, Eobj, REP_) do { pg8::Gemm g_{(const bf16*)(Aptr), (const bf16*)(Bptr), M, (N_), (K_)}; SO S_; S_.init(M, (N_), F.G, (int)blockIdx.x); \
        pg8::gemm_phase<EpiT, SO, true, true, REP_>(F.lds + RING_OFF, g_, S_, (Eobj)); } while (0)
#define GEMM(EpiT, Aptr, Bptr, N_, K_, Eobj) GEMMR(EpiT, Aptr, Bptr, N_, K_, Eobj, 1)

    bf16* H = (bf16*)(ws + WS_H);
    const float* cosM = (const float*)(ws + WS_COSM); const float* sinM = (const float*)(ws + WS_SINM);
    const float* cosD = (const float*)(ws + WS_COSD); const float* sinD = (const float*)(ws + WS_SIND);

    if (threadIdx.x == 0) (void)__hip_atomic_fetch_or((unsigned*)(F.ctl + CW_PX + (8 * ((int)blockIdx.x & 7) + (((int)blockIdx.x >> 3) & 7))), 1u << bar.x, __ATOMIC_RELAXED, __HIP_MEMORY_SCOPE_AGENT);
    p0_prologue(F);
    GRID_BAR();
    const bool panel_same_xcd = __builtin_popcount(__hip_atomic_load((unsigned*)(F.ctl + CW_PX + (8 * ((int)blockIdx.x & 7) + (((int)blockIdx.x >> 3) & 7))), __ATOMIC_RELAXED, __HIP_MEMORY_SCOPE_AGENT)) == 1;

#define PSP(i) ((float*)(ws + WS_PS + (size_t)(i) * PS_STRIDE))
    const PG8_LAS float* rsl = (const PG8_LAS float*)(F.lds + RSL_OFF);
    const int my_pm = 8 * ((int)blockIdx.x & 7) + (((int)blockIdx.x >> 3) & 7);
    for (int j = 0; j < 2; ++j) {
        {
            RELAUNDER();
            const unsigned char* wl = ws + WS_WMLA + j * WMLA_STRIDE;
            float* PQ = (float*)(ws + WS_S + S_PQ); bf16* QN = (bf16*)(ws + WS_S + S_QN); bf16* CK = (bf16*)(ws + WS_S + S_CKVN); bf16* KPE = (bf16*)(ws + WS_S + S_KPE);
            bf16* Q = (bf16*)(ws + WS_S + S_Q); bf16* KV = (bf16*)(ws + WS_S + S_KV); bf16* AO = (bf16*)(ws + WS_S + S_AO_MLA);
            row_scale_table(F, PSP(4 * j), my_pm);
            { pg8::EpiQaCkv E{QN, CK, PQ, rsl}; GEMM(pg8::EpiQaCkv, H, wl + WMLA_QKVA, 1024, DM, E); }
            panel_barrier(F, F.ctl + CW_PB2 + j * 64 + my_pm, panel_same_xcd);
            row_scale_table2(F, PQ, my_pm);
            { const int slot = (int)blockIdx.x >> 6; const PG8_LAS float* rsq = (const PG8_LAS float*)(F.lds + RSQ_OFF);
              if (slot == 0) { pg8::Gemm g_{(const bf16*)H, (const bf16*)(wl + WMLA_QKVA), M, NQKVA, DM}; pg8::OneUnit S_{my_pm, 4}; pg8::EpiKpe E{KPE, cosM, sinM, rsl};
                  pg8::gemm_phase<pg8::EpiKpe, pg8::OneUnit, true, true>(F.lds + RING_OFF, g_, S_, E); }
              if (slot < 2) { pg8::Gemm g_{(const bf16*)QN, (const bf16*)(wl + WMLA_QB), M, NQB, 512}; pg8::PanelUnits S_{my_pm, slot ? 4 : 0, slot ? 8 : 4}; pg8::EpiQMla E{Q, cosM, sinM, rsq};
                  pg8::gemm_phase<pg8::EpiQMla, pg8::PanelUnits, false, true>(F.lds + RING_OFF, g_, S_, E); }
              else { pg8::Gemm g_{(const bf16*)CK, (const bf16*)(wl + WMLA_KVB), M, NKVB, 512}; pg8::PanelUnits S_{my_pm, 8 * (slot - 2), 8}; pg8::EpiKvMla E{KV, KV + (size_t)M * DM, rsq + 256};
                  pg8::gemm_phase<pg8::EpiKvMla, pg8::PanelUnits, false, true>(F.lds + RING_OFF, g_, S_, E); }
            }
            GRID_BAR();
            RELAUNDER();
            { att::Prm P{NQB, 128, DM, NQB, 64, 0, SEQ, SEQ, 0.07216878364870322f};
              MlaRef R{Q, KV, KPE, AO, F.vcu};
              attn_run<true, false, false, false>((char*)lds + RING_OFF, P, 4, R);
            }
            GRID_BAR();
            { pg8::EpiResB<false> E{nullptr, H, PSP(1 + 4 * j), DM}; GEMM(pg8::EpiResB<false>, AO, wl + WMLA_WO, DM, DM, E); }
            GRID_BAR();
        }
        {
            RELAUNDER();
            const int layer = 2 * j; const unsigned char* wl = ws + WS_WFFN + layer * WFFN_STRIDE;
            bf16* ACT = (bf16*)(ws + WS_S + S_ACT);
            row_scale_table(F, PSP(1 + 4 * j), my_pm);
            { pg8::EpiUpConv E{ACT, (float*)(ws + WS_HALO), (float*)(ws + WS_FIX), (const float*)(ws + WS_CWS) + (size_t)layer * 4 * NUP,
                               (PG8_LAS float*)(F.lds + XH_OFF), (PG8_LAS float*)(F.lds + CWL_OFF), rsl};
              { LANE_IDS(); if (wave < 4) pg8::EpiUpConv::w_dma(E.cws, (int)blockIdx.x >> 6, E.cwl, wave, lane); }
              GEMM(pg8::EpiUpConv, H, wl + WFFN_UP, NUP, DM, E);
            }
            GRID_BAR();
            { SO S_; S_.init(M, DM, F.G, (int)blockIdx.x); pg8::Unit u_; for (int i = 0; S_.next(i, u_); ++i) ffn_fixup(F, layer, u_.pm);
              asm volatile("s_waitcnt vmcnt(0)" ::: "memory"); __syncthreads(); }
            { pg8::EpiResB<false> E{nullptr, H, PSP(2 + 4 * j), DM}; GEMM(pg8::EpiResB<false>, ACT, wl + WFFN_DOWN, DM, FF, E); }
            GRID_BAR();
        }
        {
            RELAUNDER();
            const unsigned char* wl = ws + WS_WDIL + j * WDIL_STRIDE;
            bf16* QKV = (bf16*)(ws + WS_S + S_QKV); bf16* OG = (bf16*)(ws + WS_S + S_OG); float* LSE = (float*)(ws + WS_S + S_LSE); bf16* AO = (bf16*)(ws + WS_S + S_AO_DIL);
            row_scale_table(F, PSP(2 + 4 * j), my_pm);
            { pg8::EpiQkvDil E{QKV, cosD, sinD, rsl}; GEMM(pg8::EpiQkvDil, H, wl + WDIL_IN, NDIL, DM, E); }
            GRID_BAR();
#pragma unroll 1
            for (int g = 0; g < 3; ++g) { const int d = 1 << (2 * g);
              att::Prm P{128, 128, 128, 0, 0, 1, SEQ / d, 129, 0.08838834764831845f};
              DilRef R{QKV, OG, LSE, F.vcu, g};
              attn_run<false, true, true, true>((char*)lds + RING_OFF, P, 4, R);
            }
            GRID_BAR();
            dil_merge(F, my_pm * 256 + ((int)blockIdx.x >> 6) * 64);
            panel_barrier(F, F.ctl + CW_PB + j * 64 + my_pm, panel_same_xcd);
            { pg8::EpiResB<false> E{nullptr, H, PSP(3 + 4 * j), DM}; GEMM(pg8::EpiResB<false>, AO, wl + WDIL_WO, DM, DM, E); }
            panel_barrier(F, F.ctl + CW_PB3 + j * 64 + my_pm, panel_same_xcd);
        }
        {
            RELAUNDER();
            const int layer = 2 * j + 1; const unsigned char* wl = ws + WS_WFFN + layer * WFFN_STRIDE;
            bf16* ACT = (bf16*)(ws + WS_S + S_ACT);
            row_scale_table(F, PSP(3 + 4 * j), my_pm);
            { pg8::EpiUpConv E{ACT, (float*)(ws + WS_HALO), (float*)(ws + WS_FIX), (const float*)(ws + WS_CWS) + (size_t)layer * 4 * NUP,
                               (PG8_LAS float*)(F.lds + XH_OFF), (PG8_LAS float*)(F.lds + CWL_OFF), rsl};
              { LANE_IDS(); if (wave < 4) pg8::EpiUpConv::w_dma(E.cws, (int)blockIdx.x >> 6, E.cwl, wave, lane); }
              GEMM(pg8::EpiUpConv, H, wl + WFFN_UP, NUP, DM, E);
            }
            GRID_BAR();
            { SO S_; S_.init(M, DM, F.G, (int)blockIdx.x); pg8::Unit u_; for (int i = 0; S_.next(i, u_); ++i) ffn_fixup(F, layer, u_.pm);
              asm volatile("s_waitcnt vmcnt(0)" ::: "memory"); __syncthreads(); }
            if (j == 0) { pg8::EpiResB<false> E{nullptr, H, PSP(4), DM}; GEMM(pg8::EpiResB<false>, ACT, wl + WFFN_DOWN, DM, FF, E); }
            else { pg8::EpiResB<false> E{nullptr, H, PSP(0), DM}; GEMM(pg8::EpiResB<false>, ACT, wl + WFFN_DOWN, DM, FF, E); }
            GRID_BAR();
        }
    }
    RELAUNDER();
    norm_rows_bf16_to_f32(F, H, (const float*)karg(4), F.out);
#undef PSP
#undef ws
#undef RELAUNDER
#undef GEMM
#undef GEMMR
#undef GRID_BAR
}

extern "C" void kernel_launch(void* const* d_in, const int* in_sizes, int n_in, void* d_out, int out_size, void* d_ws, size_t ws_size, hipStream_t stream) {
    static int grid = 0;
    if (grid == 0) {
        if (n_in != 18 || in_sizes[0] != M * DM || out_size != M * DM || ws_size < WS_END) {
            fprintf(stderr, "kernel_launch: shape / workspace mismatch (n_in %d, in0 %d, out %d, ws %zu, need %zu); nothing launched\n", n_in, n_in > 0 ? in_sizes[0] : -1, out_size, ws_size, (size_t)WS_END); grid = -1; return; }
        int dev = 0, cus = 0, per_cu = 0;
        if (hipGetDevice(&dev) != hipSuccess || hipDeviceGetAttribute(&cus, hipDeviceAttributeMultiprocessorCount, dev) != hipSuccess) { grid = -1; return; }
        if (hipFuncSetAttribute((const void*)fwd_kernel, hipFuncAttributeMaxDynamicSharedMemorySize, LDS_BYTES) != hipSuccess) { fprintf(stderr, "kernel_launch: hipFuncSetAttribute failed\n"); grid = -1; return; }
        if (hipOccupancyMaxActiveBlocksPerMultiprocessor(&per_cu, (const void*)fwd_kernel, NWAVES * 64, LDS_BYTES) != hipSuccess || per_cu < 1) fprintf(stderr, "kernel_launch: occupancy query reports %d\n", per_cu);
        (void)hipGetLastError();
        if (cus < 256) { fprintf(stderr, "kernel_launch: built for a 256-CU device, found %d CUs; nothing launched\n", cus); grid = -1; return; }
        grid = 256;
    }
    if (grid < 0) return;
    if (hipMemsetAsync((char*)d_ws + WS_CTL, 0, CTL_ZERO_BYTES, stream) != hipSuccess) return;
    Args a{};
    for (int i = 0; i < 18; ++i) a.in[i] = d_in[i];
    a.out = (float*)d_out; a.ws = (unsigned char*)d_ws;
    hipLaunchKernelGGL(fwd_kernel, dim3(grid), dim3(NWAVES * 64), LDS_BYTES, stream, a);
}
```
